# Optimizing an MI355X kernel written in HIP

```python
import jax, jax.numpy as jnp
from jax import lax
import numpy as np

D_MODEL = 1024
BATCH = 8
SEQ = 4096
DEPTH = 1

HEAD_DIM = 64
N_Q_HEADS = 8
N_KV_HEADS = 2
Q_GROUP = N_Q_HEADS // N_KV_HEADS
Q_WIDTH = N_Q_HEADS * HEAD_DIM
KV_WIDTH = N_KV_HEADS * HEAD_DIM
AXIS_DIM = HEAD_DIM // 2
ROPE_THETA = 10000.0
Q_BLOCK = 128
GRID_W = 64
LRU_WIDTH = D_MODEL
LRU_BLOCKS = 16
LRU_BLOCK_W = LRU_WIDTH // LRU_BLOCKS
CONV_WIDTH = 4
CONV_PAD = (1, 2)
RG_C = 8.0
N_BRANCHES = 2
IN_WIDTH = Q_WIDTH + 2 * KV_WIDTH + 2 * LRU_WIDTH + N_BRANCHES * D_MODEL
SPLITS = (Q_WIDTH, Q_WIDTH + KV_WIDTH, Q_WIDTH + 2 * KV_WIDTH,
          Q_WIDTH + 2 * KV_WIDTH + LRU_WIDTH, Q_WIDTH + 2 * KV_WIDTH + 2 * LRU_WIDTH)
N_EXPERTS = 32
TOP_K = 4
D_FF = D_MODEL
SWIGLU_LIMIT = 7.0
SWIGLU_ALPHA = 1.702
DISPATCH_BLOCK = 256
NORM_EPS = 1e-6

kernel_name = 'hybrid_gqa_rglru_moe_encoder'


def rmsnorm(x, g):
    xf = x.astype(jnp.float32)
    y = xf * lax.rsqrt(jnp.mean(xf * xf, axis=-1, keepdims=True) + NORM_EPS)
    return (y * g.astype(jnp.float32)).astype(x.dtype)


def axial_rope_tables(S, dtype):
    rows = S // GRID_W
    row = jnp.repeat(jnp.arange(rows, dtype=jnp.int32), GRID_W).astype(jnp.float32)
    col = jnp.tile(jnp.arange(GRID_W, dtype=jnp.int32), rows).astype(jnp.float32)
    inv = ROPE_THETA ** (-jnp.arange(0, AXIS_DIM, 2, dtype=jnp.float32) / AXIS_DIM)
    ang_r = row[:, None] * inv[None, :]
    ang_c = col[:, None] * inv[None, :]
    f = lambda a: a[None, :, None, :].astype(dtype)
    return f(jnp.cos(ang_r)), f(jnp.sin(ang_r)), f(jnp.cos(ang_c)), f(jnp.sin(ang_c))


def rotate(x, cos, sin):
    x1, x2 = jnp.split(x, 2, axis=-1)
    return jnp.concatenate([x1 * cos - x2 * sin, x2 * cos + x1 * sin], axis=-1)


def apply_axial_rope(x, tables):
    cos_r, sin_r, cos_c, sin_c = tables
    return jnp.concatenate([rotate(x[..., :AXIS_DIM], cos_r, sin_r),
                            rotate(x[..., AXIS_DIM:], cos_c, sin_c)], axis=-1)


def block_attention(q, k, v):
    B, S = q.shape[0], q.shape[1]
    scale = HEAD_DIM ** -0.5
    qb = q.reshape(B, S // Q_BLOCK, Q_BLOCK, N_KV_HEADS, Q_GROUP, HEAD_DIM)
    qb = jnp.moveaxis(qb, 1, 0)

    def one_block(qblk):
        s = jnp.einsum('bqkgd,bskd->bkgqs', qblk, k).astype(jnp.float32) * scale
        p = jax.nn.softmax(s, axis=-1).astype(v.dtype)
        return jnp.einsum('bkgqs,bskd->bqkgd', p, v)

    o = lax.map(one_block, qb)
    return jnp.moveaxis(o, 0, 1).reshape(B, S, Q_WIDTH)


def depthwise_conv(x, w, b):
    C = x.shape[-1]
    y = lax.conv_general_dilated(x, w[:, None, :].astype(x.dtype), window_strides=(1,),
                                 padding=(CONV_PAD,), dimension_numbers=('NWC', 'WIO', 'NWC'),
                                 feature_group_count=C)
    return y + b


def block_diag(x, w, b):
    B, S, _ = x.shape
    xb = x.reshape(B, S, LRU_BLOCKS, LRU_BLOCK_W)
    y = jnp.einsum('bsnc,ncd->bsnd', xb, w) + b
    return y.reshape(B, S, LRU_WIDTH)


def linear_combine(earlier, later):
    a1, b1 = earlier
    a2, b2 = later
    return a1 * a2, a2 * b1 + b2


def rglru(x, wa, ba, wi, bi, lam, reverse):
    r = jax.nn.sigmoid(block_diag(x, wa, ba)).astype(jnp.float32)
    i = jax.nn.sigmoid(block_diag(x, wi, bi))
    log_a = RG_C * r * jax.nn.log_sigmoid(lam.astype(jnp.float32))
    a = jnp.exp(log_a)
    u = jnp.sqrt(-jnp.expm1(2.0 * log_a)) * (i * x).astype(jnp.float32)
    _, h = lax.associative_scan(linear_combine, (a, u), reverse=reverse, axis=1)
    return h.astype(x.dtype)


def token_mixer(h, w_in, b_in, q_norm_g, k_norm_g, conv_w, conv_b, lru_wa, lru_ba,
                lru_wi, lru_bi, lru_lambda, w_attn_o, w_lru_o, w_out):
    B, S, _ = h.shape
    proj = h @ w_in + b_in
    q, k, v, xr, yr, gate_logits = jnp.split(proj, SPLITS, axis=-1)
    tables = axial_rope_tables(S, h.dtype)
    q = apply_axial_rope(rmsnorm(q.reshape(B, S, N_Q_HEADS, HEAD_DIM), q_norm_g), tables)
    k = apply_axial_rope(rmsnorm(k.reshape(B, S, N_KV_HEADS, HEAD_DIM), k_norm_g), tables)
    v = v.reshape(B, S, N_KV_HEADS, HEAD_DIM)
    attn = block_attention(q, k, v)
    xc = depthwise_conv(xr, conv_w, conv_b)
    lru = (rglru(xc, lru_wa[0], lru_ba[0], lru_wi[0], lru_bi[0], lru_lambda[0], False)
           + rglru(xc, lru_wa[1], lru_ba[1], lru_wi[1], lru_bi[1], lru_lambda[1], True))
    rec = lru * jax.nn.gelu(yr, approximate=True)
    g_attn, g_rec = jnp.split(jax.nn.sigmoid(gate_logits), N_BRANCHES, axis=-1)
    merged = g_attn * (attn @ w_attn_o) + g_rec * (rec @ w_lru_o)
    return merged @ w_out


def moe_ffn(h, w_router, b_router, w_gu, b_gu, w_down, b_down):
    B, S, D = h.shape
    t = h.reshape(B * S, D)
    T = B * S
    A = T * TOP_K
    logits = (t @ w_router + b_router).astype(jnp.float32)
    top_val, top_idx = lax.top_k(logits, TOP_K)
    gates = jax.nn.softmax(top_val, axis=-1).astype(t.dtype)
    e_flat = top_idx.reshape(A).astype(jnp.int32)
    tok_flat = jnp.arange(A, dtype=jnp.int32) // TOP_K
    e_sorted, order = lax.sort((e_flat, jnp.arange(A, dtype=jnp.int32)), num_keys=2)
    tok_sorted = tok_flat[order]
    gate_sorted = gates.reshape(A)[order]
    counts = jnp.bincount(e_flat, length=N_EXPERTS)
    padded = (counts + DISPATCH_BLOCK - 1) // DISPATCH_BLOCK * DISPATCH_BLOCK
    start = jnp.cumsum(counts) - counts
    pend = jnp.cumsum(padded)
    pstart = pend - padded
    dest = pstart[e_sorted] + jnp.arange(A, dtype=jnp.int32) - start[e_sorted]
    n_blocks = (A + N_EXPERTS * (DISPATCH_BLOCK - 1) + DISPATCH_BLOCK - 1) // DISPATCH_BLOCK
    P = n_blocks * DISPATCH_BLOCK
    buf = jnp.zeros((P, D), t.dtype).at[dest].set(t[tok_sorted])
    blk_start = jnp.arange(n_blocks, dtype=jnp.int32) * DISPATCH_BLOCK
    blk_exp = jnp.minimum(jnp.searchsorted(pend, blk_start, side='right'), N_EXPERTS - 1)

    def expert_block(args):
        xb, e = args
        gu = xb @ w_gu[e] + b_gu[e]
        g, u = jnp.split(gu, 2, axis=-1)
        g = jnp.minimum(g, SWIGLU_LIMIT)
        u = jnp.clip(u, -SWIGLU_LIMIT, SWIGLU_LIMIT)
        act = g * jax.nn.sigmoid(SWIGLU_ALPHA * g) * (u + 1.0)
        return act @ w_down[e] + b_down[e]

    out_buf = lax.map(expert_block, (buf.reshape(n_blocks, DISPATCH_BLOCK, D), blk_exp))
    y_sorted = out_buf.reshape(P, D)[dest] * gate_sorted[:, None]
    y = jax.ops.segment_sum(y_sorted, tok_sorted, num_segments=T)
    return y.reshape(B, S, D)


def setup_inputs(seed: int = 0) -> dict:
    key = jax.random.key(seed)
    ks = jax.random.split(key, 24)
    f32 = jnp.float32
    nrm = lambda k, shape, fan_in: jax.random.normal(k, shape, f32) * (fan_in ** -0.5)
    small = lambda k, shape: 0.01 * jax.random.normal(k, shape, f32)
    gain = lambda k, shape: 1.0 + 0.05 * jax.random.normal(k, shape, f32)
    u = jax.random.uniform(ks[13], (DEPTH, 2, LRU_WIDTH), f32, 0.9, 0.999)
    s = u ** (1.0 / RG_C)
    lru_lambda = jnp.log(s) - jnp.log1p(-s)
    return {
        'x': jax.random.normal(ks[0], (BATCH, SEQ, D_MODEL), f32),
        'norm1_g': gain(ks[1], (DEPTH, D_MODEL)),
        'w_in': nrm(ks[2], (DEPTH, D_MODEL, IN_WIDTH), D_MODEL),
        'b_in': small(ks[3], (DEPTH, IN_WIDTH)),
        'q_norm_g': gain(ks[4], (DEPTH, HEAD_DIM)),
        'k_norm_g': gain(ks[5], (DEPTH, HEAD_DIM)),
        'conv_w': nrm(ks[6], (DEPTH, CONV_WIDTH, LRU_WIDTH), CONV_WIDTH),
        'conv_b': small(ks[7], (DEPTH, LRU_WIDTH)),
        'lru_wa': nrm(ks[8], (DEPTH, 2, LRU_BLOCKS, LRU_BLOCK_W, LRU_BLOCK_W), LRU_BLOCK_W),
        'lru_ba': small(ks[9], (DEPTH, 2, LRU_BLOCKS, LRU_BLOCK_W)),
        'lru_wi': nrm(ks[10], (DEPTH, 2, LRU_BLOCKS, LRU_BLOCK_W, LRU_BLOCK_W), LRU_BLOCK_W),
        'lru_bi': small(ks[11], (DEPTH, 2, LRU_BLOCKS, LRU_BLOCK_W)),
        'lru_lambda': lru_lambda,
        'w_attn_o': nrm(ks[14], (DEPTH, Q_WIDTH, D_MODEL), Q_WIDTH),
        'w_lru_o': nrm(ks[15], (DEPTH, LRU_WIDTH, D_MODEL), LRU_WIDTH),
        'w_out': nrm(ks[16], (DEPTH, D_MODEL, D_MODEL), D_MODEL),
        'norm2_g': gain(ks[17], (DEPTH, D_MODEL)),
        'w_router': nrm(ks[18], (DEPTH, D_MODEL, N_EXPERTS), D_MODEL),
        'b_router': small(ks[19], (DEPTH, N_EXPERTS)),
        'w_gu': nrm(ks[20], (DEPTH, N_EXPERTS, D_MODEL, 2 * D_FF), D_MODEL),
        'b_gu': small(ks[21], (DEPTH, N_EXPERTS, 2 * D_FF)),
        'w_down': nrm(ks[22], (DEPTH, N_EXPERTS, D_FF, D_MODEL), D_FF),
        'b_down': small(ks[23], (DEPTH, N_EXPERTS, D_MODEL)),
        'final_g': gain(ks[12], (D_MODEL,)),
    }


def reference(x, norm1_g, w_in, b_in, q_norm_g, k_norm_g, conv_w, conv_b, lru_wa, lru_ba,
              lru_wi, lru_bi, lru_lambda, w_attn_o, w_lru_o, w_out, norm2_g, w_router,
              b_router, w_gu, b_gu, w_down, b_down, final_g):
    for l in range(DEPTH):
        h = rmsnorm(x, norm1_g[l])
        x = x + token_mixer(h, w_in[l], b_in[l], q_norm_g[l], k_norm_g[l], conv_w[l], conv_b[l],
                            lru_wa[l], lru_ba[l], lru_wi[l], lru_bi[l], lru_lambda[l],
                            w_attn_o[l], w_lru_o[l], w_out[l])
        h = rmsnorm(x, norm2_g[l])
        x = x + moe_ffn(h, w_router[l], b_router[l], w_gu[l], b_gu[l], w_down[l], b_down[l])
    return rmsnorm(x, final_g)
```

```cpp
#include <hip/hip_runtime.h>
#include <hip/hip_cooperative_groups.h>
#include <cstdio>
#include <cstdint>
namespace pg8 {
#define PG8_LAS __attribute__((address_space(3)))
typedef unsigned short bf16_t;
typedef short bf16x8 __attribute__((ext_vector_type(8)));
typedef float f32x4 __attribute__((ext_vector_type(4)));
typedef float f32x2 __attribute__((ext_vector_type(2)));
typedef unsigned u32x4 __attribute__((ext_vector_type(4)));
typedef unsigned u32x2 __attribute__((ext_vector_type(2)));
constexpr int BM = 256, BK = 64, HALF = 128, HTB = HALF * BK * 2  , STAGE_BYTES = 8 * HTB, NXCD = 8, WGM = 8;

__host__ __device__ __forceinline__ int lds_byte(int r, int c) { const int st = (r >> 4) * 2 + (c >> 5), rr = r & 15, cc = c & 31, ob = rr * 64 + cc * 2; return st * 1024 + (ob ^ (((ob >> 9) & 1) << 5)); }
__host__ __device__ __forceinline__ void stage_rc(int b, int& R, int& C) { const int st = b / 1024, sb = b % 1024, swz = sb ^ (((sb >> 9) & 1) << 5); R = (st >> 1) * 16 + swz / 64; C = (st & 1) * 32 + (swz % 64) / 2; }
__host__ __device__ __forceinline__ int perm32(int rho) { const int n = rho >> 4, i = rho & 15; return 8 * (i >> 2) + 4 * n + (i & 3); }

struct Unit { int pm, pn, aux; };

__device__ __forceinline__ void dense_tile(int L, int nM, int nN, int& pm, int& pn) {
    const int nwg = nM * nN; int wgid = L;
    { const int q = nwg / NXCD, r = nwg % NXCD, xcd = wgid % NXCD, off = wgid / NXCD; wgid = (xcd < r ? xcd * (q + 1) : r * (q + 1) + (xcd - r) * q) + off; }
    const int nig = WGM * nN, gid = wgid / nig, fm = gid * WGM, gsz = (nM - fm) < WGM ? (nM - fm) : WGM;
    pm = fm + ((wgid % nig) % gsz); pn = (wgid % nig) / gsz;
}

__device__ __forceinline__ unsigned cvt_pk_bf16(float lo, float hi) { unsigned r; asm volatile("v_cvt_pk_bf16_f32 %0, %1, %2" : "=v"(r) : "v"(lo), "v"(hi)); return r; }
__device__ __forceinline__ float bf_lo(unsigned w) { return __uint_as_float(w << 16); }
__device__ __forceinline__ float bf_hi(unsigned w) { return __uint_as_float(w & 0xffff0000u); }
__device__ __forceinline__ float fast_sigmoid(float x) { return __builtin_amdgcn_rcpf(1.0f + __builtin_amdgcn_exp2f(-1.4426950408889634f * x)); }

template <class Epi, class Sched, bool ALIGN_EPI, bool GATHER>
__device__ __forceinline__ void gemm_phase(PG8_LAS unsigned char* lds, const int lda, const int ldb, const Sched& S, const Epi& E, const PG8_LAS int* gtab) {
    const int tid = threadIdx.x, wid = __builtin_amdgcn_readfirstlane(tid >> 6), lane = tid & 63, wr = wid >> 2, wc = wid & 3, fr = lane & 15, fq = lane >> 4;
    unsigned voffA[2], voffB[2]; int RA[2];
#pragma unroll
    for (int i = 0; i < 2; ++i) { int R, C; stage_rc(tid * 16 + i * 8192, R, C); const int Rb = Epi::PERM ? ((R & ~31) + perm32(R & 31)) : R;
        voffA[i] = GATHER ? (unsigned)(C * 2) : (unsigned)(R * lda + C) * 2u; voffB[i] = (unsigned)(Rb * ldb + C) * 2u; RA[i] = R; }
    const size_t kstep = (size_t)(BK * 2);
    const size_t hstepA = GATHER ? 0 : (size_t)HALF * lda * 2;
    const size_t hstepB = (size_t)HALF * ldb * 2;
    const unsigned ldsw = (unsigned)wid * 1024u;
    const int aoff = lds_byte(wr * 64 + fr, fq * 8), boff = lds_byte(wc * 32 + fr, fq * 8);
    unsigned gC[2][2], gN[2][2];
#define PG8_SA(b, h) (((b) * 2 + (h)) * HTB)
#define PG8_SB(b, h) ((4 + (b) * 2 + (h)) * HTB)
#define PG8_GLDS(gp, bufoff, i) __builtin_amdgcn_global_load_lds((const unsigned*)(gp), (PG8_LAS unsigned*)(lds + (bufoff) + ldsw + (i) * 8192), 16, 0, 0)
#define PG8_STAGE_B(bufoff, gbase) do { _Pragma("unroll") for (int _i = 0; _i < 2; ++_i) PG8_GLDS((const char*)(gbase) + voffB[_i], bufoff, _i); } while (0)
#define PG8_STAGE_A(bufoff, gbase, h, nx) do { _Pragma("unroll") for (int _i = 0; _i < 2; ++_i) { \
        if constexpr (GATHER) PG8_GLDS((const char*)(gbase) + ((nx) ? gN[h][_i] : gC[h][_i]) + voffA[_i], bufoff, _i); \
        else PG8_GLDS((const char*)(gbase) + voffA[_i], bufoff, _i); } } while (0)
#define PG8_LDA(dst, b, h) do { _Pragma("unroll") for (int m = 0; m < 4; ++m) _Pragma("unroll") for (int k = 0; k < 2; ++k) dst[m][k] = *(const PG8_LAS bf16x8*)(lds + PG8_SA(b, h) + aoff + m * 2048 + k * 1024); } while (0)
#define PG8_LDB(dst, b, h) do { _Pragma("unroll") for (int n = 0; n < 2; ++n) _Pragma("unroll") for (int k = 0; k < 2; ++k) dst[n][k] = *(const PG8_LAS bf16x8*)(lds + PG8_SB(b, h) + boff + n * 2048 + k * 1024); } while (0)
#define PG8_MMA(ai, bj, At, Bt) do { __builtin_amdgcn_s_setprio(1); _Pragma("unroll") for (int m = 0; m < 4; ++m) _Pragma("unroll") for (int n = 0; n < 2; ++n) _Pragma("unroll") for (int k = 0; k < 2; ++k) \
        acc[ai][bj][m][n] = __builtin_amdgcn_mfma_f32_16x16x32_bf16(Bt[n][k], At[m][k], acc[ai][bj][m][n], 0, 0, 0); __builtin_amdgcn_s_setprio(0); } while (0)
#define PG8_WAIT_V(n) asm volatile("s_waitcnt vmcnt(" #n ")" ::: "memory")
#define PG8_WAIT_L(n) asm volatile("s_waitcnt lgkmcnt(" #n ")" ::: "memory")
#define PG8_BAR __builtin_amdgcn_s_barrier()
#define PG8_SCHED __builtin_amdgcn_sched_barrier(0)
#define PG8_GOFF(dst, ui_) do { if constexpr (GATHER) { _Pragma("unroll") for (int _h = 0; _h < 2; ++_h) _Pragma("unroll") for (int _i = 0; _i < 2; ++_i) \
        dst[_h][_i] = (unsigned)gtab[(ui_) * 256 + _h * HALF + RA[_i]] * (unsigned)(lda * 2); } } while (0)
    Unit cur, nxt; int ui = 0;
    if (!S.next(0, cur)) return;
    f32x4 acc[2][2][4][2];
#pragma unroll
    for (int a = 0; a < 2; ++a)
#pragma unroll
        for (int b = 0; b < 2; ++b)
#pragma unroll
            for (int m = 0; m < 4; ++m)
#pragma unroll
                for (int n = 0; n < 2; ++n) acc[a][b][m][n] = (f32x4){0.f, 0.f, 0.f, 0.f};
    bf16x8 At[4][2], B0[2][2], B1[2][2];
    const char* cA = S.a_ptr(cur); const char* cB = S.b_ptr(cur);
    PG8_GOFF(gC, 0);
#pragma unroll
    for (int _h = 0; _h < 2; ++_h)
#pragma unroll
        for (int _i = 0; _i < 2; ++_i) gN[_h][_i] = gC[_h][_i];
    PG8_STAGE_B(PG8_SB(0, 0), cB); PG8_STAGE_B(PG8_SB(0, 1), cB + hstepB); PG8_STAGE_A(PG8_SA(0, 0), cA, 0, false); PG8_STAGE_A(PG8_SA(0, 1), cA + hstepA, 1, false);
    if (wr == 1) PG8_BAR;
    PG8_WAIT_V(2); PG8_BAR;
    PG8_STAGE_B(PG8_SB(1, 0), cB + kstep); PG8_STAGE_A(PG8_SA(1, 0), cA + kstep, 0, false); PG8_STAGE_B(PG8_SB(1, 1), cB + hstepB + kstep);
    PG8_WAIT_V(6); PG8_BAR;
    for (;;) {
        const bool has_next = S.next(ui + 1, nxt);
        const int nt = S.ntiles(cur);
        const char* nA = has_next ? S.a_ptr(nxt) : cA; const char* nB = has_next ? S.b_ptr(nxt) : cB;
        if (has_next) PG8_GOFF(gN, ui + 1);
        for (int t = 0; t < nt; t += 2) {
            const bool last = (t == nt - 2);
            const char* a1 = cA + (size_t)(t + 1) * kstep;
            const char* a2 = last ? nA : cA + (size_t)(t + 2) * kstep; const char* b2 = last ? nB : cB + (size_t)(t + 2) * kstep;
            const char* a3 = a2 + kstep; const char* b3 = b2 + kstep;
            PG8_LDB(B0, 0, 0); PG8_LDB(B1, 0, 1); PG8_SCHED; PG8_LDA(At, 0, 0); PG8_STAGE_A(PG8_SA(1, 1), a1 + hstepA, 1, false);
            PG8_WAIT_V(8); PG8_WAIT_L(0); PG8_BAR; PG8_MMA(0, 0, At, B0); PG8_MMA(0, 1, At, B1); PG8_BAR; PG8_SCHED;
            PG8_LDA(At, 0, 1); PG8_STAGE_B(PG8_SB(0, 0), b2); PG8_STAGE_B(PG8_SB(0, 1), b2 + hstepB); PG8_STAGE_A(PG8_SA(0, 0), a2, 0, last);
            PG8_WAIT_V(8); PG8_WAIT_L(0); PG8_BAR; PG8_MMA(1, 0, At, B0); PG8_MMA(1, 1, At, B1); PG8_BAR; PG8_SCHED;
            PG8_LDB(B0, 1, 0); PG8_LDB(B1, 1, 1); PG8_SCHED; PG8_LDA(At, 1, 0); PG8_STAGE_A(PG8_SA(0, 1), a2 + hstepA, 1, last);
            PG8_WAIT_V(8); PG8_WAIT_L(0); PG8_BAR; PG8_MMA(0, 0, At, B0); PG8_MMA(0, 1, At, B1); PG8_BAR; PG8_SCHED;
            PG8_LDA(At, 1, 1); PG8_STAGE_B(PG8_SB(1, 0), b3); PG8_STAGE_B(PG8_SB(1, 1), b3 + hstepB); PG8_STAGE_A(PG8_SA(1, 0), a3, 0, last);
            PG8_WAIT_V(8); PG8_WAIT_L(0); PG8_BAR; PG8_MMA(1, 0, At, B0); PG8_MMA(1, 1, At, B1); PG8_BAR; PG8_SCHED;
        }
        if constexpr (ALIGN_EPI) { if (wr == 0) PG8_BAR; }
        E(acc, cur, wr, wc, fr, fq);
        if (!E.keep(cur)) {
#pragma unroll
        for (int a = 0; a < 2; ++a)
#pragma unroll
            for (int b = 0; b < 2; ++b)
#pragma unroll
                for (int m = 0; m < 4; ++m)
#pragma unroll
                    for (int n = 0; n < 2; ++n) acc[a][b][m][n] = (f32x4){0.f, 0.f, 0.f, 0.f};
        }
        if (!has_next) break;
        cur = nxt; cA = nA; cB = nB; ++ui;
#pragma unroll
        for (int _h = 0; _h < 2; ++_h)
#pragma unroll
            for (int _i = 0; _i < 2; ++_i) gC[_h][_i] = gN[_h][_i];
        if constexpr (ALIGN_EPI) { if (wr == 1) PG8_BAR; }
    }
    PG8_WAIT_V(0);
    if constexpr (!ALIGN_EPI) { if (wr == 0) PG8_BAR; }
    PG8_BAR;
#undef PG8_SA
#undef PG8_SB
#undef PG8_GLDS
#undef PG8_STAGE_A
#undef PG8_STAGE_B
#undef PG8_LDA
#undef PG8_LDB
#undef PG8_MMA
#undef PG8_WAIT_V
#undef PG8_WAIT_L
#undef PG8_BAR
#undef PG8_SCHED
#undef PG8_GOFF
}
}
#include <hip/hip_bf16.h>
#include <cmath>
namespace attn_body {
using bf16=__hip_bfloat16;
using bf16x8=__attribute__((ext_vector_type(8)))short;
using s16x4=__attribute__((ext_vector_type(4)))short;
using f32x16=__attribute__((ext_vector_type(16)))float;
using u32x4=__attribute__((ext_vector_type(4)))unsigned;
constexpr int BATCH=8,NHEAD=8,NKV=2,SEQ=4096,D=64;
constexpr int QP=512,KVP=256,OP=1536;
constexpr int NW=8,QBLK=32,QB=QBLK*NW,KVBLK=64,NQB=SEQ/QB;
constexpr int ATTN_UNIT_ROWS=QB;
__device__ __forceinline__ int crow(int r,int hi){return (r&3)+8*(r>>2)+4*hi;}
#define SBAR() __builtin_amdgcn_sched_barrier(0)
constexpr int NSLOT=3, SLOTB=8192;
constexpr int LDS_K=0, LDS_V=NSLOT*SLOTB, LDS_WS=2*NSLOT*SLOTB, LDS_OST=LDS_WS+NW*64*4, LDS_BYTES=LDS_OST+NW*4096;
constexpr float C2=0.125f*1.4426950408889634f;
__device__ __forceinline__ void glds16(const void*gsrc,unsigned lds_dst){unsigned keep;
  asm volatile("s_mov_b32 %0, m0\n\ts_mov_b32 m0, %2\n\ts_nop 0\n\tglobal_load_lds_dwordx4 %1, off\n\ts_mov_b32 m0, %0":"=&s"(keep):"v"(gsrc),"s"(lds_dst):"memory");}
__device__ __forceinline__ float max3f(float a,float b,float c){float r;asm("v_max3_f32 %0, %1, %2, %3":"=v"(r):"v"(a),"v"(b),"v"(c));return r;}
__device__ __forceinline__ float max2f(float a,float b){float r;asm("v_max_f32_e32 %0, %1, %2":"=v"(r):"v"(a),"v"(b));return r;}
__device__ __forceinline__ float fadd_s(float a,float b){float r;asm("v_add_f32_e32 %0, %1, %2":"=v"(r):"v"(a),"v"(b));return r;}
__device__ __forceinline__ float fsub_s(float a,float b){float r;asm("v_sub_f32_e32 %0, %1, %2":"=v"(r):"v"(a),"v"(b));return r;}
typedef float f32x2_t __attribute__((ext_vector_type(2))); typedef __bf16 bf16x2_t __attribute__((ext_vector_type(2)));
__device__ __forceinline__ unsigned cvtpk_s(float lo,float hi){f32x2_t v={lo,hi};bf16x2_t b=__builtin_convertvector(v,bf16x2_t);return __builtin_bit_cast(unsigned,b);}
#define WAIT_BAR(N) asm volatile("s_waitcnt vmcnt(" #N ") lgkmcnt(0)\n\ts_barrier":::"memory")

__device__ __forceinline__ void qkt(f32x16&p0,f32x16&p1,const char*Kslot,const bf16x8*qr,const f32x16&negm,int r32,int hi){
  const char*kb=Kslot+hi*1024+r32*16;
  #pragma unroll
  for(int d0=0;d0<4;++d0){
    const bf16x8 b0=*reinterpret_cast<const bf16x8*>(kb+d0*2048);
    const bf16x8 b1=*reinterpret_cast<const bf16x8*>(kb+d0*2048+512);
    if(d0==0){p0=__builtin_amdgcn_mfma_f32_32x32x16_bf16(b0,qr[0],negm,0,0,0);p1=__builtin_amdgcn_mfma_f32_32x32x16_bf16(b1,qr[0],negm,0,0,0);}
    else{p0=__builtin_amdgcn_mfma_f32_32x32x16_bf16(b0,qr[d0],p0,0,0,0);p1=__builtin_amdgcn_mfma_f32_32x32x16_bf16(b1,qr[d0],p1,0,0,0);}}
}
typedef __attribute__((address_space(3))) const char* lds_cptr;
typedef short v4i16_t __attribute__((ext_vector_type(4)));
__device__ __forceinline__ void kload8(bf16x8*kf,lds_cptr kp){
  kf[0]=*(const __attribute__((address_space(3))) bf16x8*)(kp);      kf[1]=*(const __attribute__((address_space(3))) bf16x8*)(kp+512);
  kf[2]=*(const __attribute__((address_space(3))) bf16x8*)(kp+2048); kf[3]=*(const __attribute__((address_space(3))) bf16x8*)(kp+2560);
  kf[4]=*(const __attribute__((address_space(3))) bf16x8*)(kp+4096); kf[5]=*(const __attribute__((address_space(3))) bf16x8*)(kp+4608);
  kf[6]=*(const __attribute__((address_space(3))) bf16x8*)(kp+6144); kf[7]=*(const __attribute__((address_space(3))) bf16x8*)(kp+6656);
}
__device__ __forceinline__ void kload2(bf16x8*kf,lds_cptr kp,int j){ kf[2*j]=*(const __attribute__((address_space(3))) bf16x8*)(kp+j*2048); kf[2*j+1]=*(const __attribute__((address_space(3))) bf16x8*)(kp+j*2048+512); }
__device__ __forceinline__ s16x4 vtr(lds_cptr p){ return __builtin_bit_cast(s16x4,__builtin_amdgcn_ds_read_tr16_b64_v4i16((__attribute__((address_space(3))) v4i16_t*)p)); }
__device__ __forceinline__ float rowmax(const f32x16&p0,const f32x16&p1){
  float a=max3f(p0[0],p0[1],p1[0]),b=max3f(p0[2],p0[3],p1[1]);a=max3f(a,p1[2],p1[3]);
  #pragma unroll
  for(int r=4;r<16;r+=4){a=max3f(a,p0[r],p0[r+1]);b=max3f(b,p0[r+2],p0[r+3]);a=max3f(a,p1[r],p1[r+1]);b=max3f(b,p1[r+2],p1[r+3]);}
  const float m=max2f(a,b);
  auto rr=__builtin_amdgcn_permlane32_swap(__float_as_uint(m),__float_as_uint(m),false,false);
  return max2f(__uint_as_float(rr[0]),__uint_as_float(rr[1]));
}
__device__ __forceinline__ void pv(f32x16*o,int vb,bf16x8 pa0,bf16x8 pa1,bf16x8 pa2,bf16x8 pa3){
  #pragma unroll
  for(int d0=0;d0<2;++d0){s16x4 lo[4],hi[4];
    #pragma unroll
    for(int ks=0;ks<4;++ks){
      asm volatile("ds_read_b64_tr_b16 %0,%1 offset:%c2":"=&v"(lo[ks]):"v"(vb),"i"(d0*4096+ks*1024):"memory");
      asm volatile("ds_read_b64_tr_b16 %0,%1 offset:%c2":"=&v"(hi[ks]):"v"(vb),"i"(d0*4096+ks*1024+512):"memory");}
    asm volatile("s_waitcnt lgkmcnt(0)":::"memory");SBAR();
    #define PK(k) (bf16x8){lo[k][0],lo[k][1],lo[k][2],lo[k][3],hi[k][0],hi[k][1],hi[k][2],hi[k][3]}
    o[d0]=__builtin_amdgcn_mfma_f32_32x32x16_bf16(pa0,PK(0),o[d0],0,0,0);
    o[d0]=__builtin_amdgcn_mfma_f32_32x32x16_bf16(pa1,PK(1),o[d0],0,0,0);
    o[d0]=__builtin_amdgcn_mfma_f32_32x32x16_bf16(pa2,PK(2),o[d0],0,0,0);
    o[d0]=__builtin_amdgcn_mfma_f32_32x32x16_bf16(pa3,PK(3),o[d0],0,0,0);
    #undef PK
  }
}

#ifndef ATTN_STORE16
#define ATTN_STORE16(p,v) (*(u32x4*)(p)=(v))
#endif
template<int THRL> __device__ __forceinline__ void attn_unit(int b,int h,int qb,const bf16*Q,const bf16*__restrict__ K,const bf16*__restrict__ V,bf16*O,char*shm){
  const int tid=threadIdx.x,lane=tid&63,r32=lane&31,hi=lane>>5; const int wid=__builtin_amdgcn_readfirstlane(tid>>6);
  const long rowbase=(long)b*SEQ; const int q0=qb*QB;
  const bf16*Qw=Q+(rowbase+q0+wid*QBLK)*QP+h*D; const int kvh=h/(NHEAD/NKV);
  const bf16*Kh=K+rowbase*KVP+kvh*D,*Vh=V+rowbase*KVP+kvh*D;
  const unsigned lds0=(unsigned)(uintptr_t)shm;
  float*wsf=(float*)(shm+LDS_WS)+wid*64;
  const bf16*ksrc=Kh+(long)lane*KVP+wid*8;
  const bf16*vsrc=Vh+(long)(16*(wid&3)+(lane>>2))*KVP+(wid>>2)*32+(lane&3)*8;
  const unsigned kdst=lds0+LDS_K+wid*1024, vdst=lds0+LDS_V+wid*1024;
  #define DMA_K(t,slot) glds16(ksrc+(long)(t)*KVBLK*KVP,(unsigned)__builtin_amdgcn_readfirstlane(kdst+(slot)))
  #define DMA_V(t,slot) glds16(vsrc+(long)(t)*KVBLK*KVP,(unsigned)__builtin_amdgcn_readfirstlane(vdst+(slot)))
  const int vb0=(int)(lds0+LDS_V)+((lane>>4)&1)*32+(lane&3)*8+(4*hi+((lane&15)>>2))*64;
  const char*Kbase=shm+LDS_K; bf16x8 kf[8];
  const lds_cptr shm3=(lds_cptr)shm; const lds_cptr kp0=shm3+LDS_K+hi*1024+r32*16; const lds_cptr vp0=shm3+LDS_V+((lane>>4)&1)*32+(lane&3)*8+(4*hi+((lane&15)>>2))*64;
  constexpr int NT=SEQ/KVBLK;
  DMA_K(0,0);DMA_V(0,0);DMA_K(1,SLOTB);
  bf16x8 qr[4];
  #pragma unroll
  for(int d0=0;d0<4;++d0)qr[d0]=*reinterpret_cast<const bf16x8*>(&Qw[(long)r32*QP+d0*16+hi*8]);
  float mhat=0.f,l_reg=0.f;f32x16 o[2];o[0]=f32x16{};o[1]=f32x16{};f32x16 negm=f32x16{};asm volatile("":"+v"(negm));
  #define CMASK(P0,P1,t) do{}while(0)
  bool resc=false;
  #define START(P0,P1) do{ const float rm=rowmax(P0,P1); resc=false; \
    { const float dl=rm; mhat=fadd_s(mhat,dl); \
      _Pragma("unroll") for(int r=0;r<16;++r){P0[r]=fsub_s(P0[r],dl);P1[r]=fsub_s(P1[r],dl);} \
      _Pragma("unroll") for(int r=0;r<16;++r)negm[r]=-mhat; asm volatile("":"+v"(negm)); } \
    _Pragma("unroll") for(int r=0;r<16;++r)P0[r]=__builtin_amdgcn_exp2f(P0[r]); }while(0)
  #define RESC() do{ if(resc){ asm volatile("s_waitcnt lgkmcnt(0)":::"memory"); \
      _Pragma("unroll") for(int d_=0;d_<2;++d_) _Pragma("unroll") for(int r=0;r<16;++r)o[d_][r]*=wsf[crow(r,hi)]; } }while(0)
  f32x16 pA0,pA1,pB0,pB1;
  int sl_prev=0,sl_cur=0,sl_next=SLOTB;
  #define ROT() do{sl_prev=sl_cur;sl_cur=sl_next;sl_next=(sl_next==(NSLOT-1)*SLOTB)?0:sl_next+SLOTB;}while(0)
  DMA_K(2,2*SLOTB);
  WAIT_BAR(3);
  qkt(pA0,pA1,Kbase,qr,negm,r32,hi);asm volatile("s_nop 15\n\ts_nop 7":"+v"(pA0),"+v"(pA1));CMASK(pA0,pA1,0);
  START(pA0,pA1);
  _Pragma("unroll") for(int r=0;r<16;++r)pA1[r]=__builtin_amdgcn_exp2f(pA1[r]);
  WAIT_BAR(0);
  DMA_K(3,0);DMA_V(1,SLOTB);
  ROT();
  kload8(kf,kp0+sl_cur);
  WAIT_BAR(2);
  s16x4 vlo[8],vhi[8]; u32x4 pw0,pw1,pw2,pw3;
  #define PKW(P,B) cvtpk_s(P[B],P[B+1])
  #define PAF(k) __builtin_bit_cast(bf16x8,pw##k)
  #define VFR(i) (bf16x8){vlo[i][0],vlo[i][1],vlo[i][2],vlo[i][3],vhi[i][0],vhi[i][1],vhi[i][2],vhi[i][3]}
  #define PIN(x) asm volatile("":"+v"(x))
  #define MX3(a,b,c) __builtin_fmaxf(__builtin_fmaxf((a),(b)),(c))
  #define GAPA(MF,A0,A1,A2,A3,W0,W1,PW) do{ MF; sacc+=A0; sacc+=A1; sacc+=A2; sacc+=A3; PIN(sacc); W0; W1; PIN(PW); SBAR(); }while(0)
  #define EX(v) __builtin_amdgcn_exp2f(v)
  #define GAPB(MF,X,B) do{ MF; X[B]=EX(X[B]); X[B+1]=EX(X[B+1]); X[B+2]=EX(X[B+2]); X[B+3]=EX(X[B+3]); PIN(X); SBAR(); }while(0)
  #define VRD(i) do{ vlo[i]=vtr(vp_+(((i)>>2)*4096+((i)&3)*1024)); vhi[i]=vtr(vp_+(((i)>>2)*4096+((i)&3)*1024+512)); }while(0)
  #define KRD(G,j) do{ if(G){ kload2(kf,kp0+sl_next,j); SBAR(); } }while(0)
  #define STEP(C0,C1,P0,P1,t,GK,GV,GL) do{ SBAR(); \
    const lds_cptr vp_=vp0+sl_prev; \
    VRD(0); SBAR(); float sacc=(P0[0]+P0[1]); \
    GAPA(C0=__builtin_amdgcn_mfma_f32_32x32x16_bf16(kf[0],qr[0],negm,0,0,0), P0[2],P0[3],P0[4],P0[5],     pw0[0]=PKW(P0,0), pw0[1]=PKW(P0,2), pw0); \
    VRD(4); SBAR(); GAPA(C1=__builtin_amdgcn_mfma_f32_32x32x16_bf16(kf[1],qr[0],negm,0,0,0), P0[6],P0[7],P0[8],P0[9],     pw0[2]=PKW(P0,4), pw0[3]=PKW(P0,6), pw0); \
    VRD(1); SBAR(); GAPA(C0=__builtin_amdgcn_mfma_f32_32x32x16_bf16(kf[2],qr[1],C0,0,0,0),   P0[10],P0[11],P0[12],P0[13], pw1[0]=PKW(P0,8), pw1[1]=PKW(P0,10), pw1); \
    VRD(5); SBAR(); GAPA(C1=__builtin_amdgcn_mfma_f32_32x32x16_bf16(kf[3],qr[1],C1,0,0,0),   P0[14],P0[15],P1[0],P1[1],   pw1[2]=PKW(P0,12),pw1[3]=PKW(P0,14), pw1); \
    VRD(2); SBAR(); GAPA(C0=__builtin_amdgcn_mfma_f32_32x32x16_bf16(kf[4],qr[2],C0,0,0,0),   P1[2],P1[3],P1[4],P1[5],     pw2[0]=PKW(P1,0), pw2[1]=PKW(P1,2), pw2); \
    VRD(6); SBAR(); GAPA(C1=__builtin_amdgcn_mfma_f32_32x32x16_bf16(kf[5],qr[2],C1,0,0,0),   P1[6],P1[7],P1[8],P1[9],     pw2[2]=PKW(P1,4), pw2[3]=PKW(P1,6), pw2); \
    VRD(3); SBAR(); GAPA(C0=__builtin_amdgcn_mfma_f32_32x32x16_bf16(kf[6],qr[3],C0,0,0,0),   P1[10],P1[11],P1[12],P1[13], pw3[0]=PKW(P1,8), pw3[1]=PKW(P1,10), pw3); \
    VRD(7); SBAR(); GAPA(C1=__builtin_amdgcn_mfma_f32_32x32x16_bf16(kf[7],qr[3],C1,0,0,0),   P1[14],P1[15],0.f,0.f,       pw3[2]=PKW(P1,12),pw3[3]=PKW(P1,14), pw3); \
    l_reg+=sacc; \
    if(GK){DMA_K((t)+3,sl_cur);} if(GV){DMA_V((t)+1,sl_next);} \
    CMASK(C0,C1,t); \
    { float a=MX3(C0[0],C0[1],C1[0]),b=MX3(C0[2],C0[3],C1[1]); a=MX3(a,C1[2],C1[3]); \
      _Pragma("unroll") for(int r=4;r<16;r+=4){a=MX3(a,C0[r],C0[r+1]);b=MX3(b,C0[r+2],C0[r+3]);a=MX3(a,C1[r],C1[r+1]);b=MX3(b,C1[r+2],C1[r+3]);} \
      float rm=__builtin_fmaxf(a,b); { auto rr=__builtin_amdgcn_permlane32_swap(__float_as_uint(rm),__float_as_uint(rm),false,false); rm=__builtin_fmaxf(__uint_as_float(rr[0]),__uint_as_float(rr[1])); } \
      resc=false; \
      if(__builtin_expect(__any(rm>(float)THRL),0)){ const float dl=__builtin_fmaxf(rm,0.f); mhat+=dl; \
        _Pragma("unroll") for(int r=0;r<16;++r){C0[r]-=dl;C1[r]-=dl;} \
        _Pragma("unroll") for(int r=0;r<16;++r)negm[r]=-mhat; asm volatile("":"+v"(negm)); \
        const float f=__builtin_amdgcn_exp2f(-dl); l_reg*=f; if(hi==0)wsf[r32]=f; resc=true; } } \
    SBAR(); \
    GAPB(o[0]=__builtin_amdgcn_mfma_f32_32x32x16_bf16(PAF(0),VFR(0),o[0],0,0,0), C0,0); \
    GAPB(o[1]=__builtin_amdgcn_mfma_f32_32x32x16_bf16(PAF(0),VFR(4),o[1],0,0,0), C0,4); \
    KRD(GL,0); GAPB(o[0]=__builtin_amdgcn_mfma_f32_32x32x16_bf16(PAF(1),VFR(1),o[0],0,0,0), C0,8); \
    KRD(GL,1); GAPB(o[1]=__builtin_amdgcn_mfma_f32_32x32x16_bf16(PAF(1),VFR(5),o[1],0,0,0), C0,12); \
    KRD(GL,2); GAPB(o[0]=__builtin_amdgcn_mfma_f32_32x32x16_bf16(PAF(2),VFR(2),o[0],0,0,0), C1,0); \
    KRD(GL,3); GAPB(o[1]=__builtin_amdgcn_mfma_f32_32x32x16_bf16(PAF(2),VFR(6),o[1],0,0,0), C1,4); \
    GAPB(o[0]=__builtin_amdgcn_mfma_f32_32x32x16_bf16(PAF(3),VFR(3),o[0],0,0,0), C1,8); \
    GAPB(o[1]=__builtin_amdgcn_mfma_f32_32x32x16_bf16(PAF(3),VFR(7),o[1],0,0,0), C1,12); \
    }while(0)
  int t=1;
  for(;t+5<NT;t+=2){
    STEP(pB0,pB1,pA0,pA1,t,true,true,true);     WAIT_BAR(2); RESC(); ROT();
    STEP(pA0,pA1,pB0,pB1,t+1,true,true,true);   WAIT_BAR(2); RESC(); ROT();
  }
  #define ENDW(tt) do{ if((tt)+3<NT){WAIT_BAR(2);} else if((tt)+2<NT){WAIT_BAR(1);} else {WAIT_BAR(0);} }while(0)
  for(;t+1<NT;t+=2){
    STEP(pB0,pB1,pA0,pA1,t,(t+3<NT),(t+1<NT),(t+1<NT));       ENDW(t);   RESC(); ROT();
    STEP(pA0,pA1,pB0,pB1,t+1,(t+4<NT),(t+2<NT),(t+2<NT));     ENDW(t+1); RESC(); ROT();
  }
  STEP(pB0,pB1,pA0,pA1,NT-1,false,false,false); RESC();
  { float sacc=pB0[0]+pB0[1]; _Pragma("unroll") for(int r=2;r<16;++r)sacc+=pB0[r]; _Pragma("unroll") for(int r=0;r<16;++r)sacc+=pB1[r]; l_reg+=sacc;
    pw0=(u32x4){PKW(pB0,0),PKW(pB0,2),PKW(pB0,4),PKW(pB0,6)};pw1=(u32x4){PKW(pB0,8),PKW(pB0,10),PKW(pB0,12),PKW(pB0,14)};pw2=(u32x4){PKW(pB1,0),PKW(pB1,2),PKW(pB1,4),PKW(pB1,6)};pw3=(u32x4){PKW(pB1,8),PKW(pB1,10),PKW(pB1,12),PKW(pB1,14)};
    SBAR(); pv(o,vb0+sl_cur,PAF(0),PAF(1),PAF(2),PAF(3)); }
  #undef PKW
  #undef PAF
  #undef VFR
  #undef PIN
  #undef MX3
  #undef GAPA
  #undef GAPB
  #undef EX
  #undef VRD
  #undef KRD
  #undef STEP
  #undef ENDW
  {auto rr=__builtin_amdgcn_permlane32_swap(__float_as_uint(l_reg),__float_as_uint(l_reg),false,false);l_reg=__uint_as_float(rr[0])+__uint_as_float(rr[1]);}
  if(hi==0)wsf[32+r32]=l_reg;asm volatile("s_waitcnt lgkmcnt(0)":::"memory");
  float rli[16];
  #pragma unroll
  for(int r=0;r<16;++r)rli[r]=__builtin_amdgcn_rcpf(wsf[32+crow(r,hi)]);
  bf16*Ow=O+(rowbase+q0+wid*QBLK)*OP+h*D;
  { bf16*stg=(bf16*)(shm+LDS_OST)+wid*2048;
    #pragma unroll
    for(int r=0;r<16;++r){const int orow=crow(r,hi);
      #pragma unroll
      for(int d0=0;d0<2;++d0)stg[orow*64+d0*32+r32]=__float2bfloat16(o[d0][r]*rli[r]);}
    asm volatile("s_waitcnt lgkmcnt(0)":::"memory");
    #pragma unroll
    for(int i=0;i<4;++i){const int row=i*8+(lane>>3),ch=lane&7; const u32x4 v=*(const u32x4*)(stg+row*64+ch*8); ATTN_STORE16(Ow+(long)row*OP+ch*8,v);} }
  asm volatile("s_waitcnt lgkmcnt(0)\n\ts_barrier":::"memory");
  #undef DMA_K
  #undef DMA_V
  #undef CMASK
  #undef START
  #undef RESC
  #undef ROT
}
constexpr int ATTN_LDS_BYTES=LDS_BYTES;
struct AttnTensors { const bf16* Q; const bf16* K; const bf16* V; bf16* O; };
struct AttnUnit { int bh; int qb; };
struct StaticOrder {
  int vcu,G;
  __device__ __forceinline__ explicit StaticOrder(int grid,int v):vcu(v),G(grid){}
  __device__ __forceinline__ bool next(int i,AttnUnit&u)const{ const int L=i*G+vcu; if(L>=BATCH*NHEAD*NQB)return false;
    const int pairhalf=L>>5,l=L&31; const int pair=pairhalf>>1,uu=l+32*(pairhalf&1); const int b=pair>>1,kvh=pair&1; u.bh=b*NHEAD+kvh*(NHEAD/NKV)+(uu>>4); u.qb=uu&15; return true; }
  __device__ __forceinline__ void a_ready(const AttnUnit&)const{}
  __device__ __forceinline__ void done(const AttnUnit&)const{}
};
template<class Sched,int THRL=8> __device__ __forceinline__ void attn_phase(char*lds,const AttnTensors&T,const Sched&S){
  AttnUnit u;
  for(int i=0;S.next(i,u);++i){ S.a_ready(u); attn_unit<THRL>(u.bh/NHEAD,u.bh%NHEAD,u.qb,T.Q,T.K,T.V,T.O,lds); S.done(u); }
}
#undef SBAR
#undef WAIT_BAR
}
namespace cg = cooperative_groups;
constexpr int NWAVES = 8;
constexpr int BATCH = 8, SEQ = 4096, D = 1024, T = BATCH * SEQ;
constexpr int HD = 64, NQH = 8, NKVH = 2, QW = NQH * HD, KVW = NKVH * HD;
constexpr int LRU_W = 1024, LRU_NB = 16, LRU_BW = 64;
constexpr int INW = QW + 2 * KVW + 2 * LRU_W + 2 * D;
constexpr int NE = 32, TOPK = 4, DFF = 1024;
constexpr float NORM_EPS = 1e-6f;
constexpr int ARW = QW + LRU_W;
constexpr int ECAP = T;
constexpr int MAXBLK = (T * TOPK) / 256 + NE;
constexpr int MAX_GUNITS = 24;

constexpr size_t MiB = 1u << 20;
constexpr size_t WS_CTL = 0, CTL_ZERO_BYTES = 64 * 1024;
constexpr size_t WS_TOKL = 1 * MiB, WS_GATEL = 5 * MiB, WS_TOKREC = 9 * MiB;
constexpr size_t WS_WIN = 10 * MiB, WS_WCAT = 20 * MiB, WS_WO = 23 * MiB, WS_WGU = 26 * MiB, WS_WD = 154 * MiB;
constexpr size_t WS_XN = 218 * MiB;
constexpr size_t WS_Q = 282 * MiB, WS_KV = 314 * MiB, WS_AR = 330 * MiB, WS_XR = 426 * MiB, WS_YR = 490 * MiB, WS_GL = 554 * MiB;
constexpr size_t WS_MERGED = WS_XR;
constexpr size_t WS_ACT = 282 * MiB, WS_Y = 554 * MiB, WS_END = 826 * MiB;
static_assert(WS_ACT + (size_t)MAXBLK * 256 * DFF * 2 <= WS_Y && WS_Y + (size_t)MAXBLK * 256 * D * 2 <= WS_END, "ws map");
constexpr int CW_CNT = 0;

constexpr int RING_BYTES = 131072;
constexpr int GTAB_OFF = RING_BYTES;
constexpr int MISC_OFF = GTAB_OFF + MAX_GUNITS * 1024;
constexpr int LDS_BYTES = MISC_OFF + 1024;
static_assert(LDS_BYTES <= 163840, "LDS");

#define GAS __attribute__((address_space(1)))
#define LAS __attribute__((address_space(3)))
typedef unsigned short bf16;
typedef unsigned v4u __attribute__((ext_vector_type(4)));
typedef unsigned v2u __attribute__((ext_vector_type(2)));
typedef float f32x4 __attribute__((ext_vector_type(4)));
typedef float f32x2 __attribute__((ext_vector_type(2)));
typedef short bf16x8 __attribute__((ext_vector_type(8)));
#define LDS_WAIT() asm volatile("s_waitcnt lgkmcnt(0)" ::: "memory")
__device__ __forceinline__ unsigned f2bf(float f) { unsigned u = __builtin_bit_cast(unsigned, f); return (u + 0x7fffu + ((u >> 16) & 1u)) >> 16; }
__device__ __forceinline__ unsigned pk2(float lo, float hi) { return f2bf(lo) | (f2bf(hi) << 16); }
__device__ __forceinline__ float bflo(unsigned w) { return __uint_as_float(w << 16); }
__device__ __forceinline__ float bfhi(unsigned w) { return __uint_as_float(w & 0xffff0000u); }
__device__ __forceinline__ float wave_sum(float v) {
#pragma unroll
    for (int o = 1; o < 64; o <<= 1) v += __shfl_xor(v, o);
    return v;
}
__device__ __forceinline__ float sigmoidf_fast(float x) { return __builtin_amdgcn_rcpf(1.0f + __builtin_amdgcn_exp2f(-1.4426950408889634f * x)); }

struct Frame {
    LAS unsigned char* lds;
    int tid, lane, wave, vcu, G;
    const float* const* in;
    float* out; unsigned char* ws;
};
enum { I_X = 0, I_N1G, I_WIN, I_BIN, I_QNG, I_KNG, I_CONVW, I_CONVB, I_WA, I_BA, I_WI, I_BI, I_LAM, I_WAO, I_WLO, I_WOUT, I_N2G, I_WR, I_BR, I_WGU, I_BGU, I_WDN, I_BDN, I_FG };

__device__ __forceinline__ void p0_transpose_item(const float* W, int N, bf16* WT, int ldt, int coloff, int rowbase, LAS float* scr, int kb, int nb, int lane) {
    const int k0 = 64 * kb, n0 = 32 * nb;
#pragma unroll 8
    for (int i = 0; i < 32; ++i) { const int kk = 2 * i + (lane >> 5); scr[kk * 33 + (lane & 31)] = W[(size_t)(k0 + kk) * N + n0 + (lane & 31)]; }
    LDS_WAIT(); asm volatile("" ::: "memory");
    const int c = lane & 7;
#pragma unroll
    for (int j = 0; j < 4; ++j) { const int n = (lane >> 3) + 8 * j; const LAS float* s = scr + (8 * c) * 33 + n;
        v4u o; o.x = pk2(s[0 * 33], s[1 * 33]); o.y = pk2(s[2 * 33], s[3 * 33]); o.z = pk2(s[4 * 33], s[5 * 33]); o.w = pk2(s[6 * 33], s[7 * 33]);
        *(GAS v4u*)(WT + (size_t)(rowbase + n) * ldt + coloff + k0 + 8 * c) = o; }
    LDS_WAIT(); asm volatile("" ::: "memory");
}
__device__ __forceinline__ void p0_prologue(Frame& F) {
    LAS float* scr = (LAS float*)(F.lds + F.wave * 16384);
    const int gw = F.vcu * NWAVES + F.wave, NGW = F.G * NWAVES;
    unsigned char* ws = F.ws;
    constexpr int I_IN = 16 * (INW / 32), I_AO = 8 * 32, I_LO = 16 * 32, I_OUT = 16 * 32, I_GU1 = 16 * 64, I_DN1 = 16 * 32;
    constexpr int NITEMS = I_IN + I_AO + I_LO + I_OUT + NE * I_GU1 + NE * I_DN1;
    for (int it = gw; it < NITEMS; it += NGW) {
        int r = it;
        if (r < I_IN) { const int nblk = INW / 32; p0_transpose_item(F.in[I_WIN], INW, (bf16*)(ws + WS_WIN), D, 0, 32 * (r % nblk), scr, r / nblk, r % nblk, F.lane); continue; } r -= I_IN;
        if (r < I_AO) { p0_transpose_item(F.in[I_WAO], D, (bf16*)(ws + WS_WCAT), ARW, 0, 32 * (r % 32), scr, r / 32, r % 32, F.lane); continue; } r -= I_AO;
        if (r < I_LO) { p0_transpose_item(F.in[I_WLO], D, (bf16*)(ws + WS_WCAT), ARW, QW, 32 * (r % 32), scr, r / 32, r % 32, F.lane); continue; } r -= I_LO;
        if (r < I_OUT) { p0_transpose_item(F.in[I_WOUT], D, (bf16*)(ws + WS_WO), D, 0, 32 * (r % 32), scr, r / 32, r % 32, F.lane); continue; } r -= I_OUT;
        if (r < NE * I_GU1) { const int e = r / I_GU1, q = r % I_GU1, kb = q / 64, nb = q % 64, n0 = 32 * nb;
            const int cc = n0 & 1023, isu = n0 >> 10, rowb = 256 * (cc >> 7) + 128 * isu + (cc & 127);
            p0_transpose_item(F.in[I_WGU] + (size_t)e * D * 2 * DFF, 2 * DFF, (bf16*)(ws + WS_WGU) + (size_t)e * 2 * DFF * D, D, 0, rowb, scr, kb, nb, F.lane); continue; } r -= NE * I_GU1;
        { const int e = r / I_DN1, q = r % I_DN1;
            p0_transpose_item(F.in[I_WDN] + (size_t)e * DFF * D, D, (bf16*)(ws + WS_WD) + (size_t)e * D * DFF, DFF, 0, 32 * (q % 32), scr, q / 32, q % 32, F.lane); }
    }
    const GAS f32x4* gp = (const GAS f32x4*)F.in[I_N1G] + F.lane;
    f32x4 g[4];
#pragma unroll
    for (int j = 0; j < 4; ++j) g[j] = gp[64 * j];
    bf16* XN = (bf16*)(ws + WS_XN);
    for (int m = gw; m < T; m += NGW) {
        const GAS f32x4* xr = (const GAS f32x4*)(F.in[I_X] + (size_t)m * D) + F.lane;
        f32x4 v[4]; float s = 0.f;
#pragma unroll
        for (int j = 0; j < 4; ++j) { v[j] = xr[64 * j]; s += (v[j].x * v[j].x + v[j].y * v[j].y) + (v[j].z * v[j].z + v[j].w * v[j].w); }
        const float rstd = 1.0f / sqrtf(wave_sum(s) * (1.f / D) + NORM_EPS);
        GAS unsigned long long* o8 = (GAS unsigned long long*)(XN + (size_t)m * D) + F.lane;
#pragma unroll
        for (int j = 0; j < 4; ++j) { const f32x4 y = v[j] * rstd * g[j]; o8[64 * j] = (unsigned long long)pk2(y.x, y.y) | ((unsigned long long)pk2(y.z, y.w) << 32); }
    }
}

struct DenseSched {
    const char* A; const char* B; int nM, nN, nt, G, c; size_t tstepA, tstepB;
    __device__ __forceinline__ bool next(int i, pg8::Unit& u) const { const long L = (long)i * G + c; if (L >= (long)nM * nN) return false; pg8::dense_tile((int)L, nM, nN, u.pm, u.pn); u.aux = 0; return true; }
    __device__ __forceinline__ const char* a_ptr(const pg8::Unit& u) const { return A + (size_t)u.pm * tstepA; }
    __device__ __forceinline__ const char* b_ptr(const pg8::Unit& u) const { return B + (size_t)u.pn * tstepB; }
    __device__ __forceinline__ int ntiles(const pg8::Unit&) const { return nt; }
};
struct MergeSched {
    const char* A; const char* B; int G, c;
    __device__ __forceinline__ bool next(int i, pg8::Unit& u) const { const long L = (long)(i >> 1) * G + c; if (L >= 128 * 4) return false; pg8::dense_tile((int)L, 128, 4, u.pm, u.pn); u.aux = i & 1; return true; }
    __device__ __forceinline__ const char* a_ptr(const pg8::Unit& u) const { return A + (size_t)u.pm * (256 * ARW * 2) + (u.aux ? QW * 2 : 0); }
    __device__ __forceinline__ const char* b_ptr(const pg8::Unit& u) const { return B + (size_t)u.pn * (256 * ARW * 2) + (u.aux ? QW * 2 : 0); }
    __device__ __forceinline__ int ntiles(const pg8::Unit& u) const { return u.aux ? (LRU_W / 64) : (QW / 64); }
};
template <int NTN> struct MoeSched {
    const char* A; const char* B; const LAS int* nbp; int G, c; size_t estepB;
    __device__ __forceinline__ bool next(int i, pg8::Unit& u) const {
        const int NB = nbp[NE], U = NB * NTN; const long L = (long)i * G + c; if (L >= U) return false;
        int w = (int)L; { const int q = U / 8, r = U % 8, xcd = w % 8, off = w / 8; w = (xcd < r ? xcd * (q + 1) : r * (q + 1) + (xcd - r) * q) + off; }
        int e = 0;
        for (int k = 1; k < NE; ++k) e += (w >= nbp[k] * NTN) ? 1 : 0;
        const int b0 = nbp[e], nM = nbp[e + 1] - b0, wl = w - b0 * NTN;
        const int nig = 8 * NTN, gid = wl / nig, fm = gid * 8, gsz = (nM - fm) < 8 ? (nM - fm) : 8;
        const int rb = fm + ((wl % nig) % gsz); u.pn = (wl % nig) / gsz; u.pm = b0 + rb; u.aux = e | (rb << 8); return true;
    }
    __device__ __forceinline__ const char* a_ptr(const pg8::Unit& u) const { return A; }
    __device__ __forceinline__ const char* b_ptr(const pg8::Unit& u) const { return B + (size_t)(u.aux & 0xff) * estepB + (size_t)u.pn * (256 * D * 2); }
    __device__ __forceinline__ int ntiles(const pg8::Unit&) const { return D / 64; }
};
struct MoeDownSched : MoeSched<4> {
    __device__ __forceinline__ const char* a_ptr(const pg8::Unit& u) const { return A + (size_t)u.pm * (256 * DFF * 2); }
};

struct EpiInProj {
    static constexpr bool PERM = true;
    unsigned char* ws; const float* bias;
    __device__ __forceinline__ bool keep(const pg8::Unit&) const { return false; }
    __device__ __forceinline__ void operator()(pg8::f32x4 (&acc)[2][2][4][2], const pg8::Unit& u, int wr, int wc, int fr, int fq) const {
        using namespace pg8;
        const int pn = u.pn; bf16_t* base; int ldc, colt;
        if (pn < 2) { base = (bf16_t*)(ws + WS_Q); ldc = QW; colt = pn * 256; }
        else if (pn == 2) { base = (bf16_t*)(ws + WS_KV); ldc = 2 * KVW; colt = 0; }
        else if (pn < 7) { base = (bf16_t*)(ws + WS_XR); ldc = LRU_W; colt = (pn - 3) * 256; }
        else if (pn < 11) { base = (bf16_t*)(ws + WS_YR); ldc = LRU_W; colt = (pn - 7) * 256; }
        else { base = (bf16_t*)(ws + WS_GL); ldc = 2 * D; colt = (pn - 11) * 256; }
        const int row0 = u.pm * BM + wr * 64 + fr, col0 = colt + wc * 32 + 8 * fq, bcol0 = pn * BM + wc * 32 + 8 * fq;
        f32x4 bv[2][2];
#pragma unroll
        for (int bj = 0; bj < 2; ++bj)
#pragma unroll
            for (int n = 0; n < 2; ++n) bv[bj][n] = *(const f32x4*)(bias + bcol0 + bj * HALF + 4 * n);
#pragma unroll
        for (int ai = 0; ai < 2; ++ai)
#pragma unroll
            for (int m = 0; m < 4; ++m) { bf16_t* rowp = base + (size_t)(row0 + ai * HALF + m * 16) * ldc + col0;
#pragma unroll
                for (int bj = 0; bj < 2; ++bj) { const f32x4 v0 = acc[ai][bj][m][0] + bv[bj][0], v1 = acc[ai][bj][m][1] + bv[bj][1];
                    u32x4 w; w.x = cvt_pk_bf16(v0[0], v0[1]); w.y = cvt_pk_bf16(v0[2], v0[3]); w.z = cvt_pk_bf16(v1[0], v1[1]); w.w = cvt_pk_bf16(v1[2], v1[3]);
                    *(u32x4*)(rowp + bj * HALF) = w; } }
    }
};
struct EpiMerge {
    static constexpr bool PERM = true;
    const bf16* GL; bf16* MG;
    __device__ __forceinline__ bool keep(const pg8::Unit& u) const { return u.aux == 0; }
    __device__ __forceinline__ void operator()(pg8::f32x4 (&acc)[2][2][4][2], const pg8::Unit& u, int wr, int wc, int fr, int fq) const {
        using namespace pg8;
        const int row0 = u.pm * BM + wr * 64 + fr, col0 = u.pn * BM + wc * 32 + 8 * fq;
        if (u.aux == 0) {
#pragma unroll
            for (int ai = 0; ai < 2; ++ai)
#pragma unroll
                for (int m = 0; m < 4; ++m) { const bf16* gp = GL + (size_t)(row0 + ai * HALF + m * 16) * (2 * D) + col0;
#pragma unroll
                    for (int bj = 0; bj < 2; ++bj) { const u32x4 ga = *(const u32x4*)(gp + bj * HALF), gr = *(const u32x4*)(gp + D + bj * HALF);
#pragma unroll
                        for (int q = 0; q < 4; ++q) { const float a0 = bf_lo(ga[q]), a1 = bf_hi(ga[q]), r0 = bf_lo(gr[q]), r1 = bf_hi(gr[q]);
                            const float f0 = (1.0f + __builtin_amdgcn_exp2f(-1.4426950408889634f * r0)) * __builtin_amdgcn_rcpf(1.0f + __builtin_amdgcn_exp2f(-1.4426950408889634f * a0));
                            const float f1 = (1.0f + __builtin_amdgcn_exp2f(-1.4426950408889634f * r1)) * __builtin_amdgcn_rcpf(1.0f + __builtin_amdgcn_exp2f(-1.4426950408889634f * a1));
                            acc[ai][bj][m][q >> 1][(q & 1) * 2] *= f0; acc[ai][bj][m][q >> 1][(q & 1) * 2 + 1] *= f1; } } }
        } else {
#pragma unroll
            for (int ai = 0; ai < 2; ++ai)
#pragma unroll
                for (int m = 0; m < 4; ++m) { const size_t ro = (size_t)(row0 + ai * HALF + m * 16); const bf16* gp = GL + ro * (2 * D) + D + col0; bf16* op = MG + ro * D + col0;
#pragma unroll
                    for (int bj = 0; bj < 2; ++bj) { const u32x4 gr = *(const u32x4*)(gp + bj * HALF); u32x4 w;
#pragma unroll
                        for (int q = 0; q < 4; ++q) { const float s0 = fast_sigmoid(bf_lo(gr[q])), s1 = fast_sigmoid(bf_hi(gr[q]));
                            w[q] = cvt_pk_bf16(acc[ai][bj][m][q >> 1][(q & 1) * 2] * s0, acc[ai][bj][m][q >> 1][(q & 1) * 2 + 1] * s1); }
                        *(u32x4*)(op + bj * HALF) = w; } }
        }
    }
};
struct EpiResF32 {
    static constexpr bool PERM = false;
    const float* X; float* O;
    __device__ __forceinline__ bool keep(const pg8::Unit&) const { return false; }
    __device__ __forceinline__ void operator()(pg8::f32x4 (&acc)[2][2][4][2], const pg8::Unit& u, int wr, int wc, int fr, int fq) const {
        using namespace pg8;
        const int row0 = u.pm * BM + wr * 64 + fr, col0 = u.pn * BM + wc * 32 + 4 * fq;
#pragma unroll
        for (int ai = 0; ai < 2; ++ai)
#pragma unroll
            for (int m = 0; m < 4; ++m) { const size_t off = (size_t)(row0 + ai * HALF + m * 16) * D + col0;
#pragma unroll
                for (int bj = 0; bj < 2; ++bj)
#pragma unroll
                    for (int n = 0; n < 2; ++n) *(f32x4*)(O + off + bj * HALF + n * 16) = *(const f32x4*)(X + off + bj * HALF + n * 16) + acc[ai][bj][m][n]; }
    }
};
struct EpiSwiGLU {
    static constexpr bool PERM = true;
    const float* bgu; bf16* ACT;
    __device__ __forceinline__ bool keep(const pg8::Unit&) const { return false; }
    __device__ __forceinline__ void operator()(pg8::f32x4 (&acc)[2][2][4][2], const pg8::Unit& u, int wr, int wc, int fr, int fq) const {
        using namespace pg8;
        const int e = u.aux & 0xff, cl = wc * 32 + 8 * fq, col0 = u.pn * 128 + cl, row0 = u.pm * BM + wr * 64 + fr;
        const float* bp = bgu + (size_t)e * (2 * DFF) + col0;
        const f32x4 bg0 = *(const f32x4*)(bp), bg1 = *(const f32x4*)(bp + 4), bu0 = *(const f32x4*)(bp + DFF), bu1 = *(const f32x4*)(bp + DFF + 4);
#pragma unroll
        for (int ai = 0; ai < 2; ++ai)
#pragma unroll
            for (int m = 0; m < 4; ++m) { u32x4 w;
#pragma unroll
                for (int n = 0; n < 2; ++n) { const f32x4 g = acc[ai][0][m][n] + (n ? bg1 : bg0), uu = acc[ai][1][m][n] + (n ? bu1 : bu0); float a[4];
#pragma unroll
                    for (int j = 0; j < 4; ++j) { const float gg = fminf(g[j], 7.0f), uc = fminf(fmaxf(uu[j], -7.0f), 7.0f);
                        a[j] = gg * __builtin_amdgcn_rcpf(1.0f + __builtin_amdgcn_exp2f(-1.702f * 1.4426950408889634f * gg)) * (uc + 1.0f); }
                    w[2 * n] = cvt_pk_bf16(a[0], a[1]); w[2 * n + 1] = cvt_pk_bf16(a[2], a[3]); }
                *(u32x4*)(ACT + (size_t)(row0 + ai * HALF + m * 16) * DFF + col0) = w; }
    }
};
struct EpiDown {
    static constexpr bool PERM = true;
    const float* bdn; const float* gatel; bf16* Y;
    __device__ __forceinline__ bool keep(const pg8::Unit&) const { return false; }
    __device__ __forceinline__ void operator()(pg8::f32x4 (&acc)[2][2][4][2], const pg8::Unit& u, int wr, int wc, int fr, int fq) const {
        using namespace pg8;
        const int e = u.aux & 0xff, rb = u.aux >> 8, col0 = u.pn * BM + wc * 32 + 8 * fq, rl0 = wr * 64 + fr;
        f32x4 bv[2][2];
#pragma unroll
        for (int bj = 0; bj < 2; ++bj)
#pragma unroll
            for (int n = 0; n < 2; ++n) bv[bj][n] = *(const f32x4*)(bdn + (size_t)e * D + col0 + bj * HALF + 4 * n);
        const float* gl = gatel + (size_t)e * ECAP + rb * 256;
#pragma unroll
        for (int ai = 0; ai < 2; ++ai)
#pragma unroll
            for (int m = 0; m < 4; ++m) { const int rl = rl0 + ai * HALF + m * 16; const float gt = gl[rl]; bf16* rowp = Y + (size_t)(u.pm * BM + rl) * D + col0;
#pragma unroll
                for (int bj = 0; bj < 2; ++bj) { const f32x4 v0 = (acc[ai][bj][m][0] + bv[bj][0]) * gt, v1 = (acc[ai][bj][m][1] + bv[bj][1]) * gt;
                    u32x4 w; w.x = cvt_pk_bf16(v0[0], v0[1]); w.y = cvt_pk_bf16(v0[2], v0[3]); w.z = cvt_pk_bf16(v1[0], v1[1]); w.w = cvt_pk_bf16(v1[2], v1[3]);
                    *(u32x4*)(rowp + bj * HALF) = w; } }
    }
};

__device__ __forceinline__ void fix_row(bf16* p, const float* g8, float scale, int c, int prow, int pcol, const LAS f32x2* tab) {
    const v4u raw = *(const GAS v4u*)p;
    float v[8];
#pragma unroll
    for (int q = 0; q < 4; ++q) { v[2 * q] = bflo(raw[q]); v[2 * q + 1] = bfhi(raw[q]); }
    float ss = 0.f;
#pragma unroll
    for (int j = 0; j < 8; ++j) ss += v[j] * v[j];
    ss += __shfl_xor(ss, 1); ss += __shfl_xor(ss, 2); ss += __shfl_xor(ss, 4);
    const float rstd = 1.0f / sqrtf(ss * (1.0f / HD) + NORM_EPS);
    const int pos = (c >> 2) ? pcol : prow; const bool second = (c >> 1) & 1; const int f0 = (c & 1) * 8;
    float o[8];
#pragma unroll
    for (int j = 0; j < 8; ++j) { const float y = v[j] * rstd * g8[j]; const float pr = __shfl_xor(y, 2); const f32x2 cs = tab[pos * 16 + f0 + j];
        o[j] = (second ? (y * cs.x + pr * cs.y) : (y * cs.x - pr * cs.y)) * scale; }
    v4u w; w.x = pk2(o[0], o[1]); w.y = pk2(o[2], o[3]); w.z = pk2(o[4], o[5]); w.w = pk2(o[6], o[7]);
    *(GAS v4u*)p = w;
}
__device__ __forceinline__ void p2_fixup(Frame& F) {
    LAS f32x2* tab = (LAS f32x2*)(F.lds);
    for (int idx = F.tid; idx < 1024; idx += NWAVES * 64) { const int pos = idx >> 4, f = idx & 15; const float inv = powf(10000.0f, -(float)f / 16.0f); const float ang = (float)pos * inv;
        tab[idx] = (f32x2){cosf(ang), sinf(ang)}; }
    __syncthreads();
    const int gw = F.vcu * NWAVES + F.wave, NGW = F.G * NWAVES, c = F.lane & 7;
    float gq[8], gk[8];
#pragma unroll
    for (int j = 0; j < 8; ++j) { gq[j] = F.in[I_QNG][8 * c + j]; gk[j] = F.in[I_KNG][8 * c + j]; }
    bf16* Q = (bf16*)(F.ws + WS_Q); bf16* KV = (bf16*)(F.ws + WS_KV);
    for (int t = gw; t < T; t += NGW) {
        const int s = t & (SEQ - 1), prow = s >> 6, pcol = s & 63;
        fix_row(Q + (size_t)t * QW + F.lane * 8, gq, attn_body::C2, c, prow, pcol, tab);
        if (F.lane < 16) fix_row(KV + (size_t)t * (2 * KVW) + F.lane * 8, gk, 1.0f, c, prow, pcol, tab);
    }
    __syncthreads();
}
constexpr int LRU_CH = 256;
constexpr int LRU_XC = 0, LRU_XC_STRIDE = 144;
constexpr int LRU_WT = LRU_CH * LRU_XC_STRIDE;
constexpr int LRU_HS = LRU_WT + 2 * 4 * 32 * 8;
static_assert(LRU_HS + 256 * 33 * 4 <= RING_BYTES, "lru lds");

__device__ __forceinline__ float gelu_tanh(float y) { const float z = 0.7978845608028654f * (y + 0.044715f * y * y * y); return y * sigmoidf_fast(2.0f * z); }

template <int DIR> __device__ __forceinline__ void lru_sweep(Frame& F, int b, int n, int half) {
    LAS unsigned char* lds = F.lds;
    const int tid = F.tid, lane = F.lane, wave = F.wave;
    const int ch16 = lane & 15, q = lane >> 4, ct = wave & 1, tq = wave >> 1;
    const int cl = 16 * ct + ch16, co_l = 32 * half + cl, cgl = 64 * n + co_l;
    const int ql = DIR ? 3 - q : q, tql = DIR ? 3 - tq : tq;
    bf16x8 Ba[2], Bi[2];
    { const float* wa = F.in[I_WA] + ((size_t)(DIR * LRU_NB + n) * 64) * 64 + co_l; const float* wi = F.in[I_WI] + ((size_t)(DIR * LRU_NB + n) * 64) * 64 + co_l;
#pragma unroll
      for (int ks = 0; ks < 2; ++ks)
#pragma unroll
          for (int j = 0; j < 8; ++j) { const int k = 32 * ks + 8 * q + j; Ba[ks][j] = (short)f2bf(wa[(size_t)k * 64]); Bi[ks][j] = (short)f2bf(wi[(size_t)k * 64]); } }
    const float ba = F.in[I_BA][(DIR * LRU_NB + n) * 64 + co_l], bi = F.in[I_BI][(DIR * LRU_NB + n) * 64 + co_l];
    const float lam = F.in[I_LAM][DIR * LRU_W + cgl];
    const float clam = -8.0f * log1pf(expf(-lam)) * 1.4426950408889634f;
    const int c8 = tid & 7, rr = tid >> 3;
    float cw[4][8], cb[8];
#pragma unroll
    for (int i = 0; i < 8; ++i) { cb[i] = F.in[I_CONVB][64 * n + 8 * c8 + i];
#pragma unroll
        for (int j = 0; j < 4; ++j) cw[j][i] = F.in[I_CONVW][j * LRU_W + 64 * n + 8 * c8 + i]; }
    const bf16* XR = (const bf16*)(F.ws + WS_XR); const bf16* YR = (const bf16*)(F.ws + WS_YR); bf16* HF = (bf16*)(F.ws + WS_XN); bf16* AR = (bf16*)(F.ws + WS_AR);
    float hcarry = 0.f;
    for (int ck = 0; ck < SEQ / LRU_CH; ++ck) {
        const int pc = DIR ? (SEQ / LRU_CH - 1 - ck) : ck, par = ck & 1;
        const size_t t0 = (size_t)b * SEQ + (size_t)pc * LRU_CH;
#pragma unroll
        for (int p = 0; p < 4; ++p) {
            const int trow = p * 64 + rr, s = pc * LRU_CH + trow;
            float o[8];
#pragma unroll
            for (int i = 0; i < 8; ++i) o[i] = cb[i];
#pragma unroll
            for (int j = 0; j < 4; ++j) { const int sj = s + j - 1;
                if (sj >= 0 && sj < SEQ) { const v4u raw = *(const GAS v4u*)(XR + ((size_t)b * SEQ + sj) * LRU_W + 64 * n + 8 * c8);
#pragma unroll
                    for (int qq = 0; qq < 4; ++qq) { o[2 * qq] += cw[j][2 * qq] * bflo(raw[qq]); o[2 * qq + 1] += cw[j][2 * qq + 1] * bfhi(raw[qq]); } } }
            v4u w; w.x = pk2(o[0], o[1]); w.y = pk2(o[2], o[3]); w.z = pk2(o[4], o[5]); w.w = pk2(o[6], o[7]);
            *(LAS v4u*)(lds + LRU_XC + trow * LRU_XC_STRIDE + c8 * 16) = w;
        }
        __syncthreads();
        float Aloc[4][4], Hloc[4][4];
        float AR_ = 1.f, HR_ = 0.f;
#pragma unroll
        for (int rtl = 0; rtl < 4; ++rtl) {
            const int rt = DIR ? 3 - rtl : rtl;
            const int arow = 64 * tq + 16 * rt + ch16;
            const bf16x8 a0 = *(const LAS bf16x8*)(lds + LRU_XC + arow * LRU_XC_STRIDE + q * 16), a1 = *(const LAS bf16x8*)(lds + LRU_XC + arow * LRU_XC_STRIDE + 64 + q * 16);
            f32x4 Da = (f32x4){0.f, 0.f, 0.f, 0.f}, Di = (f32x4){0.f, 0.f, 0.f, 0.f};
            Da = __builtin_amdgcn_mfma_f32_16x16x32_bf16(a0, Ba[0], Da, 0, 0, 0); Da = __builtin_amdgcn_mfma_f32_16x16x32_bf16(a1, Ba[1], Da, 0, 0, 0);
            Di = __builtin_amdgcn_mfma_f32_16x16x32_bf16(a0, Bi[0], Di, 0, 0, 0); Di = __builtin_amdgcn_mfma_f32_16x16x32_bf16(a1, Bi[1], Di, 0, 0, 0);
            float av[4], uv[4];
#pragma unroll
            for (int j = 0; j < 4; ++j) { const int tr = 64 * tq + 16 * rt + 4 * q + j;
                const float xcv = __uint_as_float((unsigned)(*(const LAS unsigned short*)(lds + LRU_XC + tr * LRU_XC_STRIDE + co_l * 2)) << 16);
                const float r = sigmoidf_fast(Da[j] + ba), ig = sigmoidf_fast(Di[j] + bi);
                const float a = __builtin_amdgcn_exp2f(clam * r);
                av[j] = a; uv[j] = sqrtf(fmaxf(1.0f - a * a, 0.f)) * (ig * xcv); }
            float Ain[4], Hin[4];
            { const int j0 = DIR ? 3 : 0; float A = av[j0], H = uv[j0]; Ain[j0] = A; Hin[j0] = H;
#pragma unroll
              for (int st = 1; st < 4; ++st) { const int j = DIR ? 3 - st : st; H = av[j] * H + uv[j]; A = A * av[j]; Ain[j] = A; Hin[j] = H; } }
            const int jl = DIR ? 0 : 3;
            float Ai = Ain[jl], Hi = Hin[jl];
            { const int nb1 = DIR ? lane + 16 : lane - 16, nb2 = DIR ? lane + 32 : lane - 32;
              float An = __shfl(Ai, nb1 & 63), Hn = __shfl(Hi, nb1 & 63); if (ql >= 1) { Hi = Ai * Hn + Hi; Ai = An * Ai; }
              An = __shfl(Ai, nb2 & 63); Hn = __shfl(Hi, nb2 & 63); if (ql >= 2) { Hi = Ai * Hn + Hi; Ai = An * Ai; }
              float Ae = __shfl(Ai, nb1 & 63), He = __shfl(Hi, nb1 & 63); if (ql == 0) { Ae = 1.f; He = 0.f; }
              const int lastl = ch16 + 16 * (DIR ? 0 : 3);
              const float Atile = __shfl(Ai, lastl), Htile = __shfl(Hi, lastl);
              const float Ap = AR_ * Ae, Hp = Ae * HR_ + He;
#pragma unroll
              for (int j = 0; j < 4; ++j) { Aloc[rt][j] = Ap * Ain[j]; Hloc[rt][j] = Ain[j] * Hp + Hin[j]; }
              HR_ = Atile * HR_ + Htile; AR_ = AR_ * Atile; }
        }
        LAS f32x2* WT = (LAS f32x2*)(lds + LRU_WT) + par * 128;
        if (q == 0) WT[tql * 32 + cl] = (f32x2){AR_, HR_};
        __syncthreads();
        float hin = hcarry, hnew = hcarry;
#pragma unroll
        for (int w2 = 0; w2 < 4; ++w2) { const f32x2 wv = WT[w2 * 32 + cl]; hnew = wv.x * hnew + wv.y; if (w2 < tql) hin = hnew; }
        hcarry = hnew;
        LAS float* HS = (LAS float*)(lds + LRU_HS);
#pragma unroll
        for (int rt = 0; rt < 4; ++rt)
#pragma unroll
            for (int j = 0; j < 4; ++j) HS[(64 * tq + 16 * rt + 4 * q + j) * 33 + cl] = Hloc[rt][j] + Aloc[rt][j] * hin;
        __syncthreads();
        { const int tok = tid >> 1, part = tid & 1; const size_t trow = t0 + tok; const int colb = 64 * n + 32 * half + 16 * part;
          float hv[16];
#pragma unroll
          for (int i = 0; i < 16; ++i) hv[i] = HS[tok * 33 + 16 * part + i];
          if (DIR == 0) {
              v4u w0, w1; w0.x = pk2(hv[0], hv[1]); w0.y = pk2(hv[2], hv[3]); w0.z = pk2(hv[4], hv[5]); w0.w = pk2(hv[6], hv[7]);
              w1.x = pk2(hv[8], hv[9]); w1.y = pk2(hv[10], hv[11]); w1.z = pk2(hv[12], hv[13]); w1.w = pk2(hv[14], hv[15]);
              GAS v4u* op = (GAS v4u*)(HF + trow * LRU_W + colb); op[0] = w0; op[1] = w1;
          } else {
              const GAS v4u* fp = (const GAS v4u*)(HF + trow * LRU_W + colb); const GAS v4u* yp = (const GAS v4u*)(YR + trow * LRU_W + colb);
              const v4u f0 = fp[0], f1 = fp[1], y0 = yp[0], y1 = yp[1]; v4u w0, w1;
#pragma unroll
              for (int qq = 0; qq < 4; ++qq) {
                  w0[qq] = pk2((hv[2 * qq] + bflo(f0[qq])) * gelu_tanh(bflo(y0[qq])), (hv[2 * qq + 1] + bfhi(f0[qq])) * gelu_tanh(bfhi(y0[qq])));
                  w1[qq] = pk2((hv[8 + 2 * qq] + bflo(f1[qq])) * gelu_tanh(bflo(y1[qq])), (hv[8 + 2 * qq + 1] + bfhi(f1[qq])) * gelu_tanh(bfhi(y1[qq]))); }
              GAS v4u* op = (GAS v4u*)(AR + trow * ARW + QW + colb); op[0] = w0; op[1] = w1;
          } }
    }
    __syncthreads();
}
__device__ __forceinline__ void p2_lru(Frame& F) {
    for (int it = F.vcu; it < BATCH * LRU_NB * 2; it += F.G) {
        const int b = it >> 5, n = (it & 31) >> 1, half = it & 1;
        lru_sweep<0>(F, b, n, half);
        lru_sweep<1>(F, b, n, half);
    }
}

constexpr int RT_STRIDE = 1028;
constexpr int ROWINFO_OFF = GTAB_OFF + 1024;
__device__ __forceinline__ void p6_router(Frame& F) {
    LAS float* wT = (LAS float*)F.lds;
    LAS unsigned* misc = (LAS unsigned*)(F.lds + MISC_OFF);
    LAS unsigned* hist = misc + 128; LAS unsigned* basew = misc + 160;
    LAS v2u* rowinfo = (LAS v2u*)(F.lds + ROWINFO_OFF);
    const int tid = F.tid, lane = F.lane, wave = F.wave;
    for (int idx = tid; idx < D * NE; idx += NWAVES * 64) { const int k = idx >> 5, e = idx & 31; wT[e * RT_STRIDE + k] = F.in[I_WR][idx]; }
    if (tid < 32) hist[tid] = 0u;
    f32x4 g2[4];
#pragma unroll
    for (int j = 0; j < 4; ++j) g2[j] = *((const GAS f32x4*)F.in[I_N2G] + lane + 64 * j);
    const float brl = F.in[I_BR][lane >> 1];
    __syncthreads();
    bf16* H2 = (bf16*)(F.ws + WS_XN);
    unsigned* gcnt = (unsigned*)(F.ws + WS_CTL) + CW_CNT;
    int* TOKL = (int*)(F.ws + WS_TOKL); float* GATEL = (float*)(F.ws + WS_GATEL); int* TOKREC = (int*)(F.ws + WS_TOKREC);
    for (int bi = F.vcu; bi < T / 128; bi += F.G) {
        const int rbase = bi * 128;
        for (int p = 0; p < 8; ++p) {
            const int rl0 = 16 * wave + 2 * p; const size_t r0 = (size_t)rbase + rl0;
            f32x4 h0[4], h1[4];
            { const GAS f32x4* x0 = (const GAS f32x4*)(F.out + r0 * D) + lane; const GAS f32x4* x1 = (const GAS f32x4*)(F.out + (r0 + 1) * D) + lane;
              float s0 = 0.f, s1 = 0.f;
#pragma unroll
              for (int j = 0; j < 4; ++j) { h0[j] = x0[64 * j]; h1[j] = x1[64 * j];
                  s0 += (h0[j].x * h0[j].x + h0[j].y * h0[j].y) + (h0[j].z * h0[j].z + h0[j].w * h0[j].w); s1 += (h1[j].x * h1[j].x + h1[j].y * h1[j].y) + (h1[j].z * h1[j].z + h1[j].w * h1[j].w); }
              const float rs0 = 1.0f / sqrtf(wave_sum(s0) * (1.f / D) + NORM_EPS), rs1 = 1.0f / sqrtf(wave_sum(s1) * (1.f / D) + NORM_EPS);
              GAS unsigned long long* o0 = (GAS unsigned long long*)(H2 + r0 * D) + lane; GAS unsigned long long* o1 = (GAS unsigned long long*)(H2 + (r0 + 1) * D) + lane;
#pragma unroll
              for (int j = 0; j < 4; ++j) { h0[j] = h0[j] * rs0 * g2[j]; h1[j] = h1[j] * rs1 * g2[j];
                  o0[64 * j] = (unsigned long long)pk2(h0[j].x, h0[j].y) | ((unsigned long long)pk2(h0[j].z, h0[j].w) << 32);
                  o1[64 * j] = (unsigned long long)pk2(h1[j].x, h1[j].y) | ((unsigned long long)pk2(h1[j].z, h1[j].w) << 32); } }
            float a0[32], a1[32];
#pragma unroll
            for (int e = 0; e < 32; ++e) { float s0 = 0.f, s1 = 0.f;
#pragma unroll
                for (int j = 0; j < 4; ++j) { const f32x4 w = *(const LAS f32x4*)(wT + e * RT_STRIDE + 256 * j + 4 * lane);
                    s0 += (h0[j].x * w.x + h0[j].y * w.y) + (h0[j].z * w.z + h0[j].w * w.w); s1 += (h1[j].x * w.x + h1[j].y * w.y) + (h1[j].z * w.z + h1[j].w * w.w); }
                a0[e] = s0; a1[e] = s1; }
#define TRED(arr, N, MASK) _Pragma("unroll") for (int i = 0; i < (N); ++i) { const bool up = (lane & (MASK)) != 0; const float snd = up ? arr[i] : arr[i + (N)]; const float kp = up ? arr[i + (N)] : arr[i]; arr[i] = kp + __shfl_xor(snd, (MASK)); }
            TRED(a0, 16, 32) TRED(a0, 8, 16) TRED(a0, 4, 8) TRED(a0, 2, 4) TRED(a0, 1, 2)
            TRED(a1, 16, 32) TRED(a1, 8, 16) TRED(a1, 4, 8) TRED(a1, 2, 4) TRED(a1, 1, 2)
#undef TRED
            float lg[2]; lg[0] = a0[0] + __shfl_xor(a0[0], 1) + brl; lg[1] = a1[0] + __shfl_xor(a1[0], 1) + brl;
#pragma unroll
            for (int rr2 = 0; rr2 < 2; ++rr2) {
                float val = lg[rr2]; int te[4]; float tv[4];
#pragma unroll
                for (int k = 0; k < 4; ++k) { float m = val;
#pragma unroll
                    for (int o = 1; o < 64; o <<= 1) m = fmaxf(m, __shfl_xor(m, o));
                    const unsigned long long bal = __ballot(val == m); const int src = __builtin_ctzll(bal); te[k] = src >> 1; tv[k] = m; if ((lane >> 1) == te[k]) val = -INFINITY; }
                const float p1 = __expf(tv[1] - tv[0]), p2 = __expf(tv[2] - tv[0]), p3 = __expf(tv[3] - tv[0]); const float inv = 1.0f / (1.0f + p1 + p2 + p3);
                if (lane < 4) { const int e = lane == 0 ? te[0] : lane == 1 ? te[1] : lane == 2 ? te[2] : te[3]; const float gt = (lane == 0 ? 1.0f : lane == 1 ? p1 : lane == 2 ? p2 : p3) * inv;
                    const unsigned rank = atomicAdd((unsigned*)(hist + e), 1u);
                    rowinfo[(rl0 + rr2) * 4 + lane] = (v2u){(unsigned)e | (rank << 8), __float_as_uint(gt)}; }
            }
        }
        __syncthreads();
        if (tid < 32) basew[tid] = __hip_atomic_fetch_add(gcnt + tid, hist[tid], __ATOMIC_RELAXED, __HIP_MEMORY_SCOPE_AGENT);
        __syncthreads();
        { const int rl = tid >> 2, k = tid & 3; const v2u inf = rowinfo[rl * 4 + k]; const int e = inf.x & 0xff; const unsigned slot = basew[e] + (inf.x >> 8); const int t = rbase + rl;
          TOKL[(size_t)e * ECAP + slot] = t; GATEL[(size_t)e * ECAP + slot] = __uint_as_float(inf.y); TOKREC[t * 4 + k] = (int)(((unsigned)e << 20) | slot); }
        __syncthreads();
        if (tid < 32) hist[tid] = 0u;
        __syncthreads();
    }
}

__device__ __forceinline__ void moe_tables(Frame& F) {
    LAS int* misc = (LAS int*)(F.lds + MISC_OFF);
    const unsigned* gcnt = (const unsigned*)(F.ws + WS_CTL) + CW_CNT;
    if (F.tid < 32) misc[F.tid] = (int)__hip_atomic_load(gcnt + F.tid, __ATOMIC_RELAXED, __HIP_MEMORY_SCOPE_AGENT);
    __syncthreads();
    if (F.tid == 0) { int s = 0; for (int e = 0; e < NE; ++e) { misc[32 + e] = s; s += (misc[e] + 255) >> 8; } misc[32 + NE] = s; }
    __syncthreads();
}
__device__ __forceinline__ void moe_gather_table(Frame& F, const MoeSched<8>& S) {
    LAS int* misc = (LAS int*)(F.lds + MISC_OFF); LAS int* gtab = (LAS int*)(F.lds + GTAB_OFF);
    const int* TOKL = (const int*)(F.ws + WS_TOKL);
    pg8::Unit u;
    for (int ui = 0; ui < MAX_GUNITS && S.next(ui, u); ++ui) {
        if (F.tid < 256) { const int e = u.aux & 0xff, rb = u.aux >> 8, slot = rb * 256 + F.tid; gtab[ui * 256 + F.tid] = (slot < misc[e]) ? TOKL[(size_t)e * ECAP + slot] : 0; }
    }
    __syncthreads();
}

__device__ __forceinline__ void p10_final(Frame& F) {
    LAS int* misc = (LAS int*)(F.lds + MISC_OFF);
    const int gw = F.vcu * NWAVES + F.wave, NGW = F.G * NWAVES, lane = F.lane;
    f32x4 g[4];
#pragma unroll
    for (int j = 0; j < 4; ++j) g[j] = *((const GAS f32x4*)F.in[I_FG] + lane + 64 * j);
    const int* TOKREC = (const int*)(F.ws + WS_TOKREC); const bf16* Y = (const bf16*)(F.ws + WS_Y);
    for (int t = gw; t < T; t += NGW) {
        GAS f32x4* xp = (GAS f32x4*)(F.out + (size_t)t * D) + lane;
        f32x4 v[4];
#pragma unroll
        for (int j = 0; j < 4; ++j) v[j] = xp[64 * j];
#pragma unroll
        for (int k = 0; k < 4; ++k) { const unsigned rec = (unsigned)TOKREC[t * 4 + k]; const int e = rec >> 20, slot = rec & 0xfffff;
            const GAS v2u* yp = (const GAS v2u*)(Y + ((size_t)misc[32 + e] * 256 + slot) * D) + lane;
#pragma unroll
            for (int j = 0; j < 4; ++j) { const v2u w = yp[64 * j]; v[j].x += bflo(w.x); v[j].y += bfhi(w.x); v[j].z += bflo(w.y); v[j].w += bfhi(w.y); } }
        float s = 0.f;
#pragma unroll
        for (int j = 0; j < 4; ++j) s += (v[j].x * v[j].x + v[j].y * v[j].y) + (v[j].z * v[j].z + v[j].w * v[j].w);
        const float rstd = 1.0f / sqrtf(wave_sum(s) * (1.f / D) + NORM_EPS);
#pragma unroll
        for (int j = 0; j < 4; ++j) xp[64 * j] = v[j] * rstd * g[j];
    }
}
constexpr int N_PHASES = 10;
struct Args { const float* in[24]; float* out; unsigned char* ws; int ph_lo, ph_hi; };
__global__ void __launch_bounds__(NWAVES * 64, 2) mk_fwd(Args args) {
    extern __shared__ __attribute__((aligned(16))) unsigned char lds[];
#define MKFRAME() Frame F; { int t_ = threadIdx.x; asm volatile("" : "+v"(t_)); F.lds = (LAS unsigned char*)lds; F.tid = t_; F.lane = t_ & 63; F.wave = __builtin_amdgcn_readfirstlane(t_ >> 6); \
        F.G = gridDim.x; const int bx = blockIdx.x; F.vcu = (F.G % 8 == 0) ? (bx % 8) * (F.G / 8) + bx / 8 : bx; F.in = args.in; F.out = args.out; F.ws = args.ws; }
    unsigned char* ws = args.ws;
    const int lo = args.ph_lo, hi = args.ph_hi;
#ifndef PH_MASK
#define PH_MASK 0x3ff
#endif
#define IN(k) (((PH_MASK >> (k)) & 1) && lo <= (k) && (k) < hi)
#define SEAM(k) do { if (IN(k) && IN((k) + 1)) { cg::this_grid().sync(); } } while (0)

    if (IN(0)) { MKFRAME(); if (blockIdx.x == 0 && F.tid < 32) ((unsigned*)(ws + WS_CTL))[CW_CNT + F.tid] = 0u; p0_prologue(F); }
    SEAM(0);
    if (IN(1)) { MKFRAME();
        DenseSched S{(const char*)(ws + WS_XN), (const char*)(ws + WS_WIN), T / 256, INW / 256, D / 64, F.G, (int)blockIdx.x, (size_t)256 * D * 2, (size_t)256 * D * 2};
        EpiInProj E{ws, F.in[I_BIN]};
        pg8::gemm_phase<EpiInProj, DenseSched, true, false>(F.lds, D, D, S, E, nullptr);
    }
    SEAM(1);
    if (IN(2)) { MKFRAME(); p2_fixup(F); p2_lru(F); }
    SEAM(2);
    if (IN(3)) { MKFRAME();
        const attn_body::AttnTensors AT{(const attn_body::bf16*)(ws + WS_Q), (const attn_body::bf16*)(ws + WS_KV), (const attn_body::bf16*)(ws + WS_KV) + KVW, (attn_body::bf16*)(ws + WS_AR)};
        const attn_body::StaticOrder S((int)F.G, F.vcu);
        attn_body::attn_phase<attn_body::StaticOrder>((char*)lds, AT, S);
    }
    SEAM(3);
    if (IN(4)) { MKFRAME();
        MergeSched S{(const char*)(ws + WS_AR), (const char*)(ws + WS_WCAT), F.G, (int)blockIdx.x};
        EpiMerge E{(const bf16*)(ws + WS_GL), (bf16*)(ws + WS_MERGED)};
        pg8::gemm_phase<EpiMerge, MergeSched, true, false>(F.lds, ARW, ARW, S, E, nullptr);
    }
    SEAM(4);
    if (IN(5)) { MKFRAME();
        DenseSched S{(const char*)(ws + WS_MERGED), (const char*)(ws + WS_WO), T / 256, D / 256, D / 64, F.G, (int)blockIdx.x, (size_t)256 * D * 2, (size_t)256 * D * 2};
        EpiResF32 E{F.in[I_X], F.out};
        pg8::gemm_phase<EpiResF32, DenseSched, true, false>(F.lds, D, D, S, E, nullptr);
    }
    SEAM(5);
    if (IN(6)) { MKFRAME(); p6_router(F); }
    SEAM(6);
    if (IN(7)) { MKFRAME();
        moe_tables(F);
        MoeSched<8> S{(const char*)(ws + WS_XN), (const char*)(ws + WS_WGU), (const LAS int*)(F.lds + MISC_OFF) + 32, F.G, (int)blockIdx.x, (size_t)2 * DFF * D * 2};
        moe_gather_table(F, S);
        EpiSwiGLU E{F.in[I_BGU], (bf16*)(ws + WS_ACT)};
        pg8::gemm_phase<EpiSwiGLU, MoeSched<8>, true, true>(F.lds, D, D, S, E, (const LAS int*)(F.lds + GTAB_OFF));
    }
    SEAM(7);
    if (IN(8)) { MKFRAME();
        moe_tables(F);
        MoeDownSched S; S.A = (const char*)(ws + WS_ACT); S.B = (const char*)(ws + WS_WD); S.nbp = (const LAS int*)(F.lds + MISC_OFF) + 32; S.G = F.G; S.c = (int)blockIdx.x; S.estepB = (size_t)D * DFF * 2;
        EpiDown E{F.in[I_BDN], (const float*)(ws + WS_GATEL), (bf16*)(ws + WS_Y)};
        pg8::gemm_phase<EpiDown, MoeDownSched, true, false>(F.lds, DFF, DFF, S, E, nullptr);
    }
    SEAM(8);
    if (IN(9)) { MKFRAME(); moe_tables(F); p10_final(F); }
#undef IN
#undef SEAM
}

#ifndef MK_N_LAUNCHES
#define MK_N_LAUNCHES 1
#endif
extern "C" void kernel_launch(void* const* d_in, const int* in_sizes, int n_in, void* d_out, int out_size, void* d_ws, size_t ws_size, hipStream_t stream) {
    static int grid = 0;
    if (grid == 0) {
        if (n_in != 24 || in_sizes[0] != T * D || out_size != T * D || ws_size < WS_END) { fprintf(stderr, "kernel_launch: unexpected shapes (n_in %d, in0 %d, out %d, ws %zu < %zu)\n", n_in, n_in > 0 ? in_sizes[0] : -1, out_size, ws_size, (size_t)WS_END); grid = -1; return; }
        int dev = 0, cus = 0, per_cu = 0;
        if (hipGetDevice(&dev) != hipSuccess || hipDeviceGetAttribute(&cus, hipDeviceAttributeMultiprocessorCount, dev) != hipSuccess) { grid = -1; return; }
        if (hipFuncSetAttribute((const void*)mk_fwd, hipFuncAttributeMaxDynamicSharedMemorySize, LDS_BYTES) != hipSuccess) { fprintf(stderr, "kernel_launch: hipFuncSetAttribute failed\n"); grid = -1; return; }
        if (hipOccupancyMaxActiveBlocksPerMultiprocessor(&per_cu, (const void*)mk_fwd, NWAVES * 64, LDS_BYTES) != hipSuccess || per_cu < 1) { fprintf(stderr, "kernel_launch: occupancy query reports %d\n", per_cu); per_cu = 1; }
        (void)hipGetLastError();
        grid = cus;
    }
    if (grid < 0) return;
    Args a{};
    for (int i = 0; i < 24; ++i) a.in[i] = (const float*)d_in[i];
    a.out = (float*)d_out; a.ws = (unsigned char*)d_ws;
    const int nl = MK_N_LAUNCHES;
    for (int li = 0; li < nl; ++li) {
        a.ph_lo = (nl == 1) ? 0 : li; a.ph_hi = (nl == 1) ? N_PHASES : li + 1;
        void* kargs[] = {&a};
        const hipError_t le = hipLaunchCooperativeKernel((const void*)mk_fwd, dim3(grid), dim3(NWAVES * 64), kargs, LDS_BYTES, stream);
        if (le != hipSuccess) { fprintf(stderr, "kernel_launch: launch %d failed: %s (grid %d)\n", li, hipGetErrorName(le), grid); break; }
    }
}
```

```cpp
#include <hip/hip_runtime.h>
#include <hip/hip_cooperative_groups.h>
#include <cstdio>
#include <cstdint>
namespace pg8 {
#define PG8_LAS __attribute__((address_space(3)))
typedef unsigned short bf16_t;
typedef short bf16x8 __attribute__((ext_vector_type(8)));
typedef float f32x4 __attribute__((ext_vector_type(4)));
typedef float f32x2 __attribute__((ext_vector_type(2)));
typedef unsigned u32x4 __attribute__((ext_vector_type(4)));
typedef unsigned u32x2 __attribute__((ext_vector_type(2)));
constexpr int BM = 256, BK = 64, HALF = 128, HTB = HALF * BK * 2  , STAGE_BYTES = 8 * HTB, NXCD = 8, WGM = 8;

__host__ __device__ __forceinline__ int lds_byte(int r, int c) { const int st = (r >> 4) * 2 + (c >> 5), rr = r & 15, cc = c & 31, ob = rr * 64 + cc * 2; return st * 1024 + (ob ^ (((ob >> 9) & 1) << 5)); }
__host__ __device__ __forceinline__ void stage_rc(int b, int& R, int& C) { const int st = b / 1024, sb = b % 1024, swz = sb ^ (((sb >> 9) & 1) << 5); R = (st >> 1) * 16 + swz / 64; C = (st & 1) * 32 + (swz % 64) / 2; }
__host__ __device__ __forceinline__ int perm32(int rho) { const int n = rho >> 4, i = rho & 15; return 8 * (i >> 2) + 4 * n + (i & 3); }

struct Unit { int pm, pn, aux; };

__device__ __forceinline__ void dense_tile(int L, int nM, int nN, int& pm, int& pn) {
    const int nwg = nM * nN; int wgid = L;
    { const int q = nwg / NXCD, r = nwg % NXCD, xcd = wgid % NXCD, off = wgid / NXCD; wgid = (xcd < r ? xcd * (q + 1) : r * (q + 1) + (xcd - r) * q) + off; }
    const int nig = WGM * nN, gid = wgid / nig, fm = gid * WGM, gsz = (nM - fm) < WGM ? (nM - fm) : WGM;
    pm = fm + ((wgid % nig) % gsz); pn = (wgid % nig) / gsz;
}

__device__ __forceinline__ unsigned cvt_pk_bf16(float lo, float hi) { unsigned r; asm volatile("v_cvt_pk_bf16_f32 %0, %1, %2" : "=v"(r) : "v"(lo), "v"(hi)); return r; }
__device__ __forceinline__ float bf_lo(unsigned w) { return __uint_as_float(w << 16); }
__device__ __forceinline__ float bf_hi(unsigned w) { return __uint_as_float(w & 0xffff0000u); }
__device__ __forceinline__ float fast_sigmoid(float x) { return __builtin_amdgcn_rcpf(1.0f + __builtin_amdgcn_exp2f(-1.4426950408889634f * x)); }

template <class Epi, class Sched, bool ALIGN_EPI, bool GATHER>
__device__ __forceinline__ void gemm_phase(PG8_LAS unsigned char* lds, const int lda, const int ldb, const Sched& S, const Epi& E, const PG8_LAS int* gtab) {
    const int tid = threadIdx.x, wid = __builtin_amdgcn_readfirstlane(tid >> 6), lane = tid & 63, wr = wid >> 2, wc = wid & 3, fr = lane & 15, fq = lane >> 4;
    unsigned voffA[2], voffB[2]; int RA[2];
#pragma unroll
    for (int i = 0; i < 2; ++i) { int R, C; stage_rc(tid * 16 + i * 8192, R, C); const int Rb = Epi::PERM ? ((R & ~31) + perm32(R & 31)) : R;
        voffA[i] = GATHER ? (unsigned)(C * 2) : (unsigned)(R * lda + C) * 2u; voffB[i] = (unsigned)(Rb * ldb + C) * 2u; RA[i] = R; }
    const size_t kstep = (size_t)(BK * 2);
    const size_t hstepA = GATHER ? 0 : (size_t)HALF * lda * 2;
    const size_t hstepB = (size_t)HALF * ldb * 2;
    const unsigned ldsw = (unsigned)wid * 1024u;
    const int aoff = lds_byte(wr * 64 + fr, fq * 8), boff = lds_byte(wc * 32 + fr, fq * 8);
    unsigned gC[2][2], gN[2][2];
#define PG8_SA(b, h) (((b) * 2 + (h)) * HTB)
#define PG8_SB(b, h) ((4 + (b) * 2 + (h)) * HTB)
#define PG8_GLDS(gp, bufoff, i) __builtin_amdgcn_global_load_lds((const unsigned*)(gp), (PG8_LAS unsigned*)(lds + (bufoff) + ldsw + (i) * 8192), 16, 0, 0)
#define PG8_STAGE_B(bufoff, gbase) do { _Pragma("unroll") for (int _i = 0; _i < 2; ++_i) PG8_GLDS((const char*)(gbase) + voffB[_i], bufoff, _i); } while (0)
#define PG8_STAGE_A(bufoff, gbase, h, nx) do { _Pragma("unroll") for (int _i = 0; _i < 2; ++_i) { \
        if constexpr (GATHER) PG8_GLDS((const char*)(gbase) + ((nx) ? gN[h][_i] : gC[h][_i]) + voffA[_i], bufoff, _i); \
        else PG8_GLDS((const char*)(gbase) + voffA[_i], bufoff, _i); } } while (0)
#define PG8_LDA(dst, b, h) do { _Pragma("unroll") for (int m = 0; m < 4; ++m) _Pragma("unroll") for (int k = 0; k < 2; ++k) dst[m][k] = *(const PG8_LAS bf16x8*)(lds + PG8_SA(b, h) + aoff + m * 2048 + k * 1024); } while (0)
#define PG8_LDB(dst, b, h) do { _Pragma("unroll") for (int n = 0; n < 2; ++n) _Pragma("unroll") for (int k = 0; k < 2; ++k) dst[n][k] = *(const PG8_LAS bf16x8*)(lds + PG8_SB(b, h) + boff + n * 2048 + k * 1024); } while (0)
#define PG8_MMA(ai, bj, At, Bt) do { __builtin_amdgcn_s_setprio(1); _Pragma("unroll") for (int m = 0; m < 4; ++m) _Pragma("unroll") for (int n = 0; n < 2; ++n) _Pragma("unroll") for (int k = 0; k < 2; ++k) \
        acc[ai][bj][m][n] = __builtin_amdgcn_mfma_f32_16x16x32_bf16(Bt[n][k], At[m][k], acc[ai][bj][m][n], 0, 0, 0); __builtin_amdgcn_s_setprio(0); } while (0)
#define PG8_WAIT_V(n) asm volatile("s_waitcnt vmcnt(" #n ")" ::: "memory")
#define PG8_WAIT_L(n) asm volatile("s_waitcnt lgkmcnt(" #n ")" ::: "memory")
#define PG8_BAR __builtin_amdgcn_s_barrier()
#define PG8_SCHED __builtin_amdgcn_sched_barrier(0)
#define PG8_GOFF(dst, ui_) do { if constexpr (GATHER) { _Pragma("unroll") for (int _h = 0; _h < 2; ++_h) _Pragma("unroll") for (int _i = 0; _i < 2; ++_i) \
        dst[_h][_i] = (unsigned)gtab[(ui_) * 256 + _h * HALF + RA[_i]] * (unsigned)(lda * 2); } } while (0)
    Unit cur, nxt; int ui = 0;
    if (!S.next(0, cur)) return;
    f32x4 acc[2][2][4][2];
#pragma unroll
    for (int a = 0; a < 2; ++a)
#pragma unroll
        for (int b = 0; b < 2; ++b)
#pragma unroll
            for (int m = 0; m < 4; ++m)
#pragma unroll
                for (int n = 0; n < 2; ++n) acc[a][b][m][n] = (f32x4){0.f, 0.f, 0.f, 0.f};
    bf16x8 At[4][2], B0[2][2], B1[2][2];
    const char* cA = S.a_ptr(cur); const char* cB = S.b_ptr(cur);
    PG8_GOFF(gC, 0);
#pragma unroll
    for (int _h = 0; _h < 2; ++_h)
#pragma unroll
        for (int _i = 0; _i < 2; ++_i) gN[_h][_i] = gC[_h][_i];
    PG8_STAGE_B(PG8_SB(0, 0), cB); PG8_STAGE_B(PG8_SB(0, 1), cB + hstepB); PG8_STAGE_A(PG8_SA(0, 0), cA, 0, false); PG8_STAGE_A(PG8_SA(0, 1), cA + hstepA, 1, false);
    if (wr == 1) PG8_BAR;
    PG8_WAIT_V(2); PG8_BAR;
    PG8_STAGE_B(PG8_SB(1, 0), cB + kstep); PG8_STAGE_A(PG8_SA(1, 0), cA + kstep, 0, false); PG8_STAGE_B(PG8_SB(1, 1), cB + hstepB + kstep);
    PG8_WAIT_V(6); PG8_BAR;
    for (;;) {
        const bool has_next = S.next(ui + 1, nxt);
        const int nt = S.ntiles(cur);
        const char* nA = has_next ? S.a_ptr(nxt) : cA; const char* nB = has_next ? S.b_ptr(nxt) : cB;
        if (has_next) PG8_GOFF(gN, ui + 1);
        for (int t = 0; t < nt; t += 2) {
            const bool last = (t == nt - 2);
            const char* a1 = cA + (size_t)(t + 1) * kstep;
            const char* a2 = last ? nA : cA + (size_t)(t + 2) * kstep; const char* b2 = last ? nB : cB + (size_t)(t + 2) * kstep;
            const char* a3 = a2 + kstep; const char* b3 = b2 + kstep;
            PG8_LDB(B0, 0, 0); PG8_LDB(B1, 0, 1); PG8_SCHED; PG8_LDA(At, 0, 0); PG8_STAGE_A(PG8_SA(1, 1), a1 + hstepA, 1, false);
            PG8_WAIT_V(8); PG8_WAIT_L(0); PG8_BAR; PG8_MMA(0, 0, At, B0); PG8_MMA(0, 1, At, B1); PG8_BAR; PG8_SCHED;
            PG8_LDA(At, 0, 1); PG8_STAGE_B(PG8_SB(0, 0), b2); PG8_STAGE_B(PG8_SB(0, 1), b2 + hstepB); PG8_STAGE_A(PG8_SA(0, 0), a2, 0, last);
            PG8_WAIT_V(8); PG8_WAIT_L(0); PG8_BAR; PG8_MMA(1, 0, At, B0); PG8_MMA(1, 1, At, B1); PG8_BAR; PG8_SCHED;
            PG8_LDB(B0, 1, 0); PG8_LDB(B1, 1, 1); PG8_SCHED; PG8_LDA(At, 1, 0); PG8_STAGE_A(PG8_SA(0, 1), a2 + hstepA, 1, last);
            PG8_WAIT_V(8); PG8_WAIT_L(0); PG8_BAR; PG8_MMA(0, 0, At, B0); PG8_MMA(0, 1, At, B1); PG8_BAR; PG8_SCHED;
            PG8_LDA(At, 1, 1); PG8_STAGE_B(PG8_SB(1, 0), b3); PG8_STAGE_B(PG8_SB(1, 1), b3 + hstepB); PG8_STAGE_A(PG8_SA(1, 0), a3, 0, last);
            PG8_WAIT_V(8); PG8_WAIT_L(0); PG8_BAR; PG8_MMA(1, 0, At, B0); PG8_MMA(1, 1, At, B1); PG8_BAR; PG8_SCHED;
        }
        if constexpr (ALIGN_EPI) { if (wr == 0) PG8_BAR; }
        E(acc, cur, wr, wc, fr, fq);
        if (!E.keep(cur)) {
#pragma unroll
        for (int a = 0; a < 2; ++a)
#pragma unroll
            for (int b = 0; b < 2; ++b)
#pragma unroll
                for (int m = 0; m < 4; ++m)
#pragma unroll
                    for (int n = 0; n < 2; ++n) acc[a][b][m][n] = (f32x4){0.f, 0.f, 0.f, 0.f};
        }
        if (!has_next) break;
        cur = nxt; cA = nA; cB = nB; ++ui;
#pragma unroll
        for (int _h = 0; _h < 2; ++_h)
#pragma unroll
            for (int _i = 0; _i < 2; ++_i) gC[_h][_i] = gN[_h][_i];
        if constexpr (ALIGN_EPI) { if (wr == 1) PG8_BAR; }
    }
    PG8_WAIT_V(0);
    if constexpr (!ALIGN_EPI) { if (wr == 0) PG8_BAR; }
    PG8_BAR;
#undef PG8_SA
#undef PG8_SB
#undef PG8_GLDS
#undef PG8_STAGE_A
#undef PG8_STAGE_B
#undef PG8_LDA
#undef PG8_LDB
#undef PG8_MMA
#undef PG8_WAIT_V
#undef PG8_WAIT_L
#undef PG8_BAR
#undef PG8_SCHED
#undef PG8_GOFF
}
}
#include <hip/hip_bf16.h>
#include <cmath>
namespace attn_body {
using bf16=__hip_bfloat16;
using bf16x8=__attribute__((ext_vector_type(8)))short;
using s16x4=__attribute__((ext_vector_type(4)))short;
using f32x16=__attribute__((ext_vector_type(16)))float;
using u32x4=__attribute__((ext_vector_type(4)))unsigned;
constexpr int BATCH=8,NHEAD=8,NKV=2,SEQ=4096,D=64;
constexpr int QP=512,KVP=256,OP=1536;
constexpr int NW=8,QBLK=32,QB=QBLK*NW,KVBLK=64,NQB=SEQ/QB;
constexpr int ATTN_UNIT_ROWS=QB;
__device__ __forceinline__ int crow(int r,int hi){return (r&3)+8*(r>>2)+4*hi;}
#define SBAR() __builtin_amdgcn_sched_barrier(0)
constexpr int NSLOT=3, SLOTB=8192;
constexpr int LDS_K=0, LDS_V=NSLOT*SLOTB, LDS_WS=2*NSLOT*SLOTB, LDS_OST=LDS_WS+NW*64*4, LDS_BYTES=LDS_OST+NW*4096;
constexpr float C2=0.125f*1.4426950408889634f;
__device__ __forceinline__ void glds16(const void*gsrc,unsigned lds_dst){unsigned keep;
  asm volatile("s_mov_b32 %0, m0\n\ts_mov_b32 m0, %2\n\ts_nop 0\n\tglobal_load_lds_dwordx4 %1, off\n\ts_mov_b32 m0, %0":"=&s"(keep):"v"(gsrc),"s"(lds_dst):"memory");}
__device__ __forceinline__ float max3f(float a,float b,float c){float r;asm("v_max3_f32 %0, %1, %2, %3":"=v"(r):"v"(a),"v"(b),"v"(c));return r;}
__device__ __forceinline__ float max2f(float a,float b){float r;asm("v_max_f32_e32 %0, %1, %2":"=v"(r):"v"(a),"v"(b));return r;}
__device__ __forceinline__ float fadd_s(float a,float b){float r;asm("v_add_f32_e32 %0, %1, %2":"=v"(r):"v"(a),"v"(b));return r;}
__device__ __forceinline__ float fsub_s(float a,float b){float r;asm("v_sub_f32_e32 %0, %1, %2":"=v"(r):"v"(a),"v"(b));return r;}
typedef float f32x2_t __attribute__((ext_vector_type(2))); typedef __bf16 bf16x2_t __attribute__((ext_vector_type(2)));
__device__ __forceinline__ unsigned cvtpk_s(float lo,float hi){f32x2_t v={lo,hi};bf16x2_t b=__builtin_convertvector(v,bf16x2_t);return __builtin_bit_cast(unsigned,b);}
#define WAIT_BAR(N) asm volatile("s_waitcnt vmcnt(" #N ") lgkmcnt(0)\n\ts_barrier":::"memory")

__device__ __forceinline__ void qkt(f32x16&p0,f32x16&p1,const char*Kslot,const bf16x8*qr,const f32x16&negm,int r32,int hi){
  const char*kb=Kslot+hi*1024+r32*16;
  #pragma unroll
  for(int d0=0;d0<4;++d0){
    const bf16x8 b0=*reinterpret_cast<const bf16x8*>(kb+d0*2048);
    const bf16x8 b1=*reinterpret_cast<const bf16x8*>(kb+d0*2048+512);
    if(d0==0){p0=__builtin_amdgcn_mfma_f32_32x32x16_bf16(b0,qr[0],negm,0,0,0);p1=__builtin_amdgcn_mfma_f32_32x32x16_bf16(b1,qr[0],negm,0,0,0);}
    else{p0=__builtin_amdgcn_mfma_f32_32x32x16_bf16(b0,qr[d0],p0,0,0,0);p1=__builtin_amdgcn_mfma_f32_32x32x16_bf16(b1,qr[d0],p1,0,0,0);}}
}
typedef __attribute__((address_space(3))) const char* lds_cptr;
typedef short v4i16_t __attribute__((ext_vector_type(4)));
__device__ __forceinline__ void kload8(bf16x8*kf,lds_cptr kp){
  kf[0]=*(const __attribute__((address_space(3))) bf16x8*)(kp);      kf[1]=*(const __attribute__((address_space(3))) bf16x8*)(kp+512);
  kf[2]=*(const __attribute__((address_space(3))) bf16x8*)(kp+2048); kf[3]=*(const __attribute__((address_space(3))) bf16x8*)(kp+2560);
  kf[4]=*(const __attribute__((address_space(3))) bf16x8*)(kp+4096); kf[5]=*(const __attribute__((address_space(3))) bf16x8*)(kp+4608);
  kf[6]=*(const __attribute__((address_space(3))) bf16x8*)(kp+6144); kf[7]=*(const __attribute__((address_space(3))) bf16x8*)(kp+6656);
}
__device__ __forceinline__ void kload2(bf16x8*kf,lds_cptr kp,int j){ kf[2*j]=*(const __attribute__((address_space(3))) bf16x8*)(kp+j*2048); kf[2*j+1]=*(const __attribute__((address_space(3))) bf16x8*)(kp+j*2048+512); }
__device__ __forceinline__ s16x4 vtr(lds_cptr p){ return __builtin_bit_cast(s16x4,__builtin_amdgcn_ds_read_tr16_b64_v4i16((__attribute__((address_space(3))) v4i16_t*)p)); }
__device__ __forceinline__ float rowmax(const f32x16&p0,const f32x16&p1){
  float a=max3f(p0[0],p0[1],p1[0]),b=max3f(p0[2],p0[3],p1[1]);a=max3f(a,p1[2],p1[3]);
  #pragma unroll
  for(int r=4;r<16;r+=4){a=max3f(a,p0[r],p0[r+1]);b=max3f(b,p0[r+2],p0[r+3]);a=max3f(a,p1[r],p1[r+1]);b=max3f(b,p1[r+2],p1[r+3]);}
  const float m=max2f(a,b);
  auto rr=__builtin_amdgcn_permlane32_swap(__float_as_uint(m),__float_as_uint(m),false,false);
  return max2f(__uint_as_float(rr[0]),__uint_as_float(rr[1]));
}
__device__ __forceinline__ void pv(f32x16*o,int vb,bf16x8 pa0,bf16x8 pa1,bf16x8 pa2,bf16x8 pa3){
  #pragma unroll
  for(int d0=0;d0<2;++d0){s16x4 lo[4],hi[4];
    #pragma unroll
    for(int ks=0;ks<4;++ks){
      asm volatile("ds_read_b64_tr_b16 %0,%1 offset:%c2":"=&v"(lo[ks]):"v"(vb),"i"(d0*4096+ks*1024):"memory");
      asm volatile("ds_read_b64_tr_b16 %0,%1 offset:%c2":"=&v"(hi[ks]):"v"(vb),"i"(d0*4096+ks*1024+512):"memory");}
    asm volatile("s_waitcnt lgkmcnt(0)":::"memory");SBAR();
    #define PK(k) (bf16x8){lo[k][0],lo[k][1],lo[k][2],lo[k][3],hi[k][0],hi[k][1],hi[k][2],hi[k][3]}
    o[d0]=__builtin_amdgcn_mfma_f32_32x32x16_bf16(pa0,PK(0),o[d0],0,0,0);
    o[d0]=__builtin_amdgcn_mfma_f32_32x32x16_bf16(pa1,PK(1),o[d0],0,0,0);
    o[d0]=__builtin_amdgcn_mfma_f32_32x32x16_bf16(pa2,PK(2),o[d0],0,0,0);
    o[d0]=__builtin_amdgcn_mfma_f32_32x32x16_bf16(pa3,PK(3),o[d0],0,0,0);
    #undef PK
  }
}

#ifndef ATTN_STORE16
#define ATTN_STORE16(p,v) (*(u32x4*)(p)=(v))
#endif
template<int THRL> __device__ __forceinline__ void attn_unit(int b,int h,int qb,const bf16*Q,const bf16*__restrict__ K,const bf16*__restrict__ V,bf16*O,char*shm){
  const int tid=threadIdx.x,lane=tid&63,r32=lane&31,hi=lane>>5; const int wid=__builtin_amdgcn_readfirstlane(tid>>6);
  const long rowbase=(long)b*SEQ; const int q0=qb*QB;
  const bf16*Qw=Q+(rowbase+q0+wid*QBLK)*QP+h*D; const int kvh=h/(NHEAD/NKV);
  const bf16*Kh=K+rowbase*KVP+kvh*D,*Vh=V+rowbase*KVP+kvh*D;
  const unsigned lds0=(unsigned)(uintptr_t)shm;
  float*wsf=(float*)(shm+LDS_WS)+wid*64;
  const bf16*ksrc=Kh+(long)lane*KVP+wid*8;
  const bf16*vsrc=Vh+(long)(16*(wid&3)+(lane>>2))*KVP+(wid>>2)*32+(lane&3)*8;
  const unsigned kdst=lds0+LDS_K+wid*1024, vdst=lds0+LDS_V+wid*1024;
  #define DMA_K(t,slot) glds16(ksrc+(long)(t)*KVBLK*KVP,(unsigned)__builtin_amdgcn_readfirstlane(kdst+(slot)))
  #define DMA_V(t,slot) glds16(vsrc+(long)(t)*KVBLK*KVP,(unsigned)__builtin_amdgcn_readfirstlane(vdst+(slot)))
  const int vb0=(int)(lds0+LDS_V)+((lane>>4)&1)*32+(lane&3)*8+(4*hi+((lane&15)>>2))*64;
  const char*Kbase=shm+LDS_K; bf16x8 kf[8];
  const lds_cptr shm3=(lds_cptr)shm; const lds_cptr kp0=shm3+LDS_K+hi*1024+r32*16; const lds_cptr vp0=shm3+LDS_V+((lane>>4)&1)*32+(lane&3)*8+(4*hi+((lane&15)>>2))*64;
  constexpr int NT=SEQ/KVBLK;
  DMA_K(0,0);DMA_V(0,0);DMA_K(1,SLOTB);
  bf16x8 qr[4];
  #pragma unroll
  for(int d0=0;d0<4;++d0)qr[d0]=*reinterpret_cast<const bf16x8*>(&Qw[(long)r32*QP+d0*16+hi*8]);
  float mhat=0.f,l_reg=0.f;f32x16 o[2];o[0]=f32x16{};o[1]=f32x16{};f32x16 negm=f32x16{};asm volatile("":"+v"(negm));
  #define CMASK(P0,P1,t) do{}while(0)
  bool resc=false;
  #define START(P0,P1) do{ const float rm=rowmax(P0,P1); resc=false; \
    { const float dl=rm; mhat=fadd_s(mhat,dl); \
      _Pragma("unroll") for(int r=0;r<16;++r){P0[r]=fsub_s(P0[r],dl);P1[r]=fsub_s(P1[r],dl);} \
      _Pragma("unroll") for(int r=0;r<16;++r)negm[r]=-mhat; asm volatile("":"+v"(negm)); } \
    _Pragma("unroll") for(int r=0;r<16;++r)P0[r]=__builtin_amdgcn_exp2f(P0[r]); }while(0)
  #define RESC() do{ if(resc){ asm volatile("s_waitcnt lgkmcnt(0)":::"memory"); \
      _Pragma("unroll") for(int d_=0;d_<2;++d_) _Pragma("unroll") for(int r=0;r<16;++r)o[d_][r]*=wsf[crow(r,hi)]; } }while(0)
  f32x16 pA0,pA1,pB0,pB1;
  int sl_prev=0,sl_cur=0,sl_next=SLOTB;
  #define ROT() do{sl_prev=sl_cur;sl_cur=sl_next;sl_next=(sl_next==(NSLOT-1)*SLOTB)?0:sl_next+SLOTB;}while(0)
  DMA_K(2,2*SLOTB);
  WAIT_BAR(3);
  qkt(pA0,pA1,Kbase,qr,negm,r32,hi);asm volatile("s_nop 15\n\ts_nop 7":"+v"(pA0),"+v"(pA1));CMASK(pA0,pA1,0);
  START(pA0,pA1);
  _Pragma("unroll") for(int r=0;r<16;++r)pA1[r]=__builtin_amdgcn_exp2f(pA1[r]);
  WAIT_BAR(0);
  DMA_K(3,0);DMA_V(1,SLOTB);
  ROT();
  kload8(kf,kp0+sl_cur);
  WAIT_BAR(2);
  s16x4 vlo[8],vhi[8]; u32x4 pw0,pw1,pw2,pw3;
  #define PKW(P,B) cvtpk_s(P[B],P[B+1])
  #define PAF(k) __builtin_bit_cast(bf16x8,pw##k)
  #define VFR(i) (bf16x8){vlo[i][0],vlo[i][1],vlo[i][2],vlo[i][3],vhi[i][0],vhi[i][1],vhi[i][2],vhi[i][3]}
  #define PIN(x) asm volatile("":"+v"(x))
  #define MX3(a,b,c) __builtin_fmaxf(__builtin_fmaxf((a),(b)),(c))
  #define GAPA(MF,A0,A1,A2,A3,W0,W1,PW) do{ MF; sacc+=A0; sacc+=A1; sacc+=A2; sacc+=A3; PIN(sacc); W0; W1; PIN(PW); SBAR(); }while(0)
  #define EX(v) __builtin_amdgcn_exp2f(v)
  #define GAPB(MF,X,B) do{ MF; X[B]=EX(X[B]); X[B+1]=EX(X[B+1]); X[B+2]=EX(X[B+2]); X[B+3]=EX(X[B+3]); PIN(X); SBAR(); }while(0)
  #define VRD(i) do{ vlo[i]=vtr(vp_+(((i)>>2)*4096+((i)&3)*1024)); vhi[i]=vtr(vp_+(((i)>>2)*4096+((i)&3)*1024+512)); }while(0)
  #define KRD(G,j) do{ if(G){ kload2(kf,kp0+sl_next,j); SBAR(); } }while(0)
  #define STEP(C0,C1,P0,P1,t,GK,GV,GL) do{ SBAR(); \
    const lds_cptr vp_=vp0+sl_prev; \
    VRD(0); SBAR(); float sacc=(P0[0]+P0[1]); \
    GAPA(C0=__builtin_amdgcn_mfma_f32_32x32x16_bf16(kf[0],qr[0],negm,0,0,0), P0[2],P0[3],P0[4],P0[5],     pw0[0]=PKW(P0,0), pw0[1]=PKW(P0,2), pw0); \
    VRD(4); SBAR(); GAPA(C1=__builtin_amdgcn_mfma_f32_32x32x16_bf16(kf[1],qr[0],negm,0,0,0), P0[6],P0[7],P0[8],P0[9],     pw0[2]=PKW(P0,4), pw0[3]=PKW(P0,6), pw0); \
    VRD(1); SBAR(); GAPA(C0=__builtin_amdgcn_mfma_f32_32x32x16_bf16(kf[2],qr[1],C0,0,0,0),   P0[10],P0[11],P0[12],P0[13], pw1[0]=PKW(P0,8), pw1[1]=PKW(P0,10), pw1); \
    VRD(5); SBAR(); GAPA(C1=__builtin_amdgcn_mfma_f32_32x32x16_bf16(kf[3],qr[1],C1,0,0,0),   P0[14],P0[15],P1[0],P1[1],   pw1[2]=PKW(P0,12),pw1[3]=PKW(P0,14), pw1); \
    VRD(2); SBAR(); GAPA(C0=__builtin_amdgcn_mfma_f32_32x32x16_bf16(kf[4],qr[2],C0,0,0,0),   P1[2],P1[3],P1[4],P1[5],     pw2[0]=PKW(P1,0), pw2[1]=PKW(P1,2), pw2); \
    VRD(6); SBAR(); GAPA(C1=__builtin_amdgcn_mfma_f32_32x32x16_bf16(kf[5],qr[2],C1,0,0,0),   P1[6],P1[7],P1[8],P1[9],     pw2[2]=PKW(P1,4), pw2[3]=PKW(P1,6), pw2); \
    VRD(3); SBAR(); GAPA(C0=__builtin_amdgcn_mfma_f32_32x32x16_bf16(kf[6],qr[3],C0,0,0,0),   P1[10],P1[11],P1[12],P1[13], pw3[0]=PKW(P1,8), pw3[1]=PKW(P1,10), pw3); \
    VRD(7); SBAR(); GAPA(C1=__builtin_amdgcn_mfma_f32_32x32x16_bf16(kf[7],qr[3],C1,0,0,0),   P1[14],P1[15],0.f,0.f,       pw3[2]=PKW(P1,12),pw3[3]=PKW(P1,14), pw3); \
    l_reg+=sacc; \
    if(GK){DMA_K((t)+3,sl_cur);} if(GV){DMA_V((t)+1,sl_next);} \
    CMASK(C0,C1,t); \
    { float a=MX3(C0[0],C0[1],C1[0]),b=MX3(C0[2],C0[3],C1[1]); a=MX3(a,C1[2],C1[3]); \
      _Pragma("unroll") for(int r=4;r<16;r+=4){a=MX3(a,C0[r],C0[r+1]);b=MX3(b,C0[r+2],C0[r+3]);a=MX3(a,C1[r],C1[r+1]);b=MX3(b,C1[r+2],C1[r+3]);} \
      float rm=__builtin_fmaxf(a,b); { auto rr=__builtin_amdgcn_permlane32_swap(__float_as_uint(rm),__float_as_uint(rm),false,false); rm=__builtin_fmaxf(__uint_as_float(rr[0]),__uint_as_float(rr[1])); } \
      resc=false; \
      if(__builtin_expect(__any(rm>(float)THRL),0)){ const float dl=__builtin_fmaxf(rm,0.f); mhat+=dl; \
        _Pragma("unroll") for(int r=0;r<16;++r){C0[r]-=dl;C1[r]-=dl;} \
        _Pragma("unroll") for(int r=0;r<16;++r)negm[r]=-mhat; asm volatile("":"+v"(negm)); \
        const float f=__builtin_amdgcn_exp2f(-dl); l_reg*=f; if(hi==0)wsf[r32]=f; resc=true; } } \
    SBAR(); \
    GAPB(o[0]=__builtin_amdgcn_mfma_f32_32x32x16_bf16(PAF(0),VFR(0),o[0],0,0,0), C0,0); \
    GAPB(o[1]=__builtin_amdgcn_mfma_f32_32x32x16_bf16(PAF(0),VFR(4),o[1],0,0,0), C0,4); \
    KRD(GL,0); GAPB(o[0]=__builtin_amdgcn_mfma_f32_32x32x16_bf16(PAF(1),VFR(1),o[0],0,0,0), C0,8); \
    KRD(GL,1); GAPB(o[1]=__builtin_amdgcn_mfma_f32_32x32x16_bf16(PAF(1),VFR(5),o[1],0,0,0), C0,12); \
    KRD(GL,2); GAPB(o[0]=__builtin_amdgcn_mfma_f32_32x32x16_bf16(PAF(2),VFR(2),o[0],0,0,0), C1,0); \
    KRD(GL,3); GAPB(o[1]=__builtin_amdgcn_mfma_f32_32x32x16_bf16(PAF(2),VFR(6),o[1],0,0,0), C1,4); \
    GAPB(o[0]=__builtin_amdgcn_mfma_f32_32x32x16_bf16(PAF(3),VFR(3),o[0],0,0,0), C1,8); \
    GAPB(o[1]=__builtin_amdgcn_mfma_f32_32x32x16_bf16(PAF(3),VFR(7),o[1],0,0,0), C1,12); \
    }while(0)
  int t=1;
  for(;t+5<NT;t+=2){
    STEP(pB0,pB1,pA0,pA1,t,true,true,true);     WAIT_BAR(2); RESC(); ROT();
    STEP(pA0,pA1,pB0,pB1,t+1,true,true,true);   WAIT_BAR(2); RESC(); ROT();
  }
  #define ENDW(tt) do{ if((tt)+3<NT){WAIT_BAR(2);} else if((tt)+2<NT){WAIT_BAR(1);} else {WAIT_BAR(0);} }while(0)
  for(;t+1<NT;t+=2){
    STEP(pB0,pB1,pA0,pA1,t,(t+3<NT),(t+1<NT),(t+1<NT));       ENDW(t);   RESC(); ROT();
    STEP(pA0,pA1,pB0,pB1,t+1,(t+4<NT),(t+2<NT),(t+2<NT));     ENDW(t+1); RESC(); ROT();
  }
  STEP(pB0,pB1,pA0,pA1,NT-1,false,false,false); RESC();
  { float sacc=pB0[0]+pB0[1]; _Pragma("unroll") for(int r=2;r<16;++r)sacc+=pB0[r]; _Pragma("unroll") for(int r=0;r<16;++r)sacc+=pB1[r]; l_reg+=sacc;
    pw0=(u32x4){PKW(pB0,0),PKW(pB0,2),PKW(pB0,4),PKW(pB0,6)};pw1=(u32x4){PKW(pB0,8),PKW(pB0,10),PKW(pB0,12),PKW(pB0,14)};pw2=(u32x4){PKW(pB1,0),PKW(pB1,2),PKW(pB1,4),PKW(pB1,6)};pw3=(u32x4){PKW(pB1,8),PKW(pB1,10),PKW(pB1,12),PKW(pB1,14)};
    SBAR(); pv(o,vb0+sl_cur,PAF(0),PAF(1),PAF(2),PAF(3)); }
  #undef PKW
  #undef PAF
  #undef VFR
  #undef PIN
  #undef MX3
  #undef GAPA
  #undef GAPB
  #undef EX
  #undef VRD
  #undef KRD
  #undef STEP
  #undef ENDW
  {auto rr=__builtin_amdgcn_permlane32_swap(__float_as_uint(l_reg),__float_as_uint(l_reg),false,false);l_reg=__uint_as_float(rr[0])+__uint_as_float(rr[1]);}
  if(hi==0)wsf[32+r32]=l_reg;asm volatile("s_waitcnt lgkmcnt(0)":::"memory");
  float rli[16];
  #pragma unroll
  for(int r=0;r<16;++r)rli[r]=__builtin_amdgcn_rcpf(wsf[32+crow(r,hi)]);
  bf16*Ow=O+(rowbase+q0+wid*QBLK)*OP+h*D;
  { bf16*stg=(bf16*)(shm+LDS_OST)+wid*2048;
    #pragma unroll
    for(int r=0;r<16;++r){const int orow=crow(r,hi);
      #pragma unroll
      for(int d0=0;d0<2;++d0)stg[orow*64+d0*32+r32]=__float2bfloat16(o[d0][r]*rli[r]);}
    asm volatile("s_waitcnt lgkmcnt(0)":::"memory");
    #pragma unroll
    for(int i=0;i<4;++i){const int row=i*8+(lane>>3),ch=lane&7; const u32x4 v=*(const u32x4*)(stg+row*64+ch*8); ATTN_STORE16(Ow+(long)row*OP+ch*8,v);} }
  asm volatile("s_waitcnt lgkmcnt(0)\n\ts_barrier":::"memory");
  #undef DMA_K
  #undef DMA_V
  #undef CMASK
  #undef START
  #undef RESC
  #undef ROT
}
constexpr int ATTN_LDS_BYTES=LDS_BYTES;
struct AttnTensors { const bf16* Q; const bf16* K; const bf16* V; bf16* O; };
struct AttnUnit { int bh; int qb; };
struct StaticOrder {
  int vcu,G;
  __device__ __forceinline__ explicit StaticOrder(int grid,int v):vcu(v),G(grid){}
  __device__ __forceinline__ bool next(int i,AttnUnit&u)const{ const int L=i*G+vcu; if(L>=BATCH*NHEAD*NQB)return false;
    const int pairhalf=L>>5,l=L&31; const int pair=pairhalf>>1,uu=l+32*(pairhalf&1); const int b=pair>>1,kvh=pair&1; u.bh=b*NHEAD+kvh*(NHEAD/NKV)+(uu>>4); u.qb=uu&15; return true; }
  __device__ __forceinline__ void a_ready(const AttnUnit&)const{}
  __device__ __forceinline__ void done(const AttnUnit&)const{}
};
template<class Sched,int THRL=8> __device__ __forceinline__ void attn_phase(char*lds,const AttnTensors&T,const Sched&S){
  AttnUnit u;
  for(int i=0;S.next(i,u);++i){ S.a_ready(u); attn_unit<THRL>(u.bh/NHEAD,u.bh%NHEAD,u.qb,T.Q,T.K,T.V,T.O,lds); S.done(u); }
}
#undef SBAR
#undef WAIT_BAR
}
namespace cg = cooperative_groups;
constexpr int NWAVES = 8;
constexpr int BATCH = 8, SEQ = 4096, D = 1024, T = BATCH * SEQ;
constexpr int HD = 64, NQH = 8, NKVH = 2, QW = NQH * HD, KVW = NKVH * HD;
constexpr int LRU_W = 1024, LRU_NB = 16, LRU_BW = 64;
constexpr int INW = QW + 2 * KVW + 2 * LRU_W + 2 * D;
constexpr int NE = 32, TOPK = 4, DFF = 1024;
constexpr float NORM_EPS = 1e-6f;
constexpr int ARW = QW + LRU_W;
constexpr int ECAP = T;
constexpr int MAXBLK = (T * TOPK) / 256 + NE;
constexpr int MAX_GUNITS = 24;

constexpr size_t MiB = 1u << 20;
constexpr size_t WS_CTL = 0, CTL_ZERO_BYTES = 64 * 1024;
constexpr size_t WS_TOKL = 1 * MiB, WS_GATEL = 5 * MiB, WS_TOKREC = 9 * MiB;
constexpr size_t WS_WIN = 10 * MiB, WS_WCAT = 20 * MiB, WS_WO = 23 * MiB, WS_WGU = 26 * MiB, WS_WD = 154 * MiB;
constexpr size_t WS_XN = 218 * MiB;
constexpr size_t WS_Q = 282 * MiB, WS_KV = 314 * MiB, WS_AR = 330 * MiB, WS_XR = 426 * MiB, WS_YR = 490 * MiB, WS_GL = 554 * MiB;
constexpr size_t WS_MERGED = WS_XR;
constexpr size_t WS_ACT = 282 * MiB, WS_Y = 554 * MiB, WS_END = 826 * MiB;
static_assert(WS_ACT + (size_t)MAXBLK * 256 * DFF * 2 <= WS_Y && WS_Y + (size_t)MAXBLK * 256 * D * 2 <= WS_END, "ws map");
constexpr int CW_CNT = 0;
constexpr int CW_BAR = 1024;

constexpr int RING_BYTES = 131072;
constexpr int GTAB_OFF = RING_BYTES;
constexpr int MISC_OFF = GTAB_OFF + MAX_GUNITS * 1024;
constexpr int LDS_BYTES = MISC_OFF + 1024;
static_assert(LDS_BYTES <= 163840, "LDS");

#define GAS __attribute__((address_space(1)))
#define LAS __attribute__((address_space(3)))
typedef unsigned short bf16;
typedef unsigned v4u __attribute__((ext_vector_type(4)));
typedef unsigned v2u __attribute__((ext_vector_type(2)));
typedef float f32x4 __attribute__((ext_vector_type(4)));
typedef float f32x2 __attribute__((ext_vector_type(2)));
typedef short bf16x8 __attribute__((ext_vector_type(8)));
#define LDS_WAIT() asm volatile("s_waitcnt lgkmcnt(0)" ::: "memory")
__device__ __forceinline__ unsigned f2bf(float f) { unsigned u = __builtin_bit_cast(unsigned, f); return (u + 0x7fffu + ((u >> 16) & 1u)) >> 16; }
__device__ __forceinline__ unsigned pk2(float lo, float hi) { return f2bf(lo) | (f2bf(hi) << 16); }
__device__ __forceinline__ float bflo(unsigned w) { return __uint_as_float(w << 16); }
__device__ __forceinline__ float bfhi(unsigned w) { return __uint_as_float(w & 0xffff0000u); }
__device__ __forceinline__ float wave_sum(float v) {
#pragma unroll
    for (int o = 1; o < 64; o <<= 1) v += __shfl_xor(v, o);
    return v;
}
__device__ __forceinline__ float sigmoidf_fast(float x) { return __builtin_amdgcn_rcpf(1.0f + __builtin_amdgcn_exp2f(-1.4426950408889634f * x)); }

struct Frame {
    LAS unsigned char* lds;
    int tid, lane, wave, vcu, G;
    const float* const* in;
    float* out; unsigned char* ws;
};
enum { I_X = 0, I_N1G, I_WIN, I_BIN, I_QNG, I_KNG, I_CONVW, I_CONVB, I_WA, I_BA, I_WI, I_BI, I_LAM, I_WAO, I_WLO, I_WOUT, I_N2G, I_WR, I_BR, I_WGU, I_BGU, I_WDN, I_BDN, I_FG };

__device__ __forceinline__ void p0_transpose_item(const float* W, int N, bf16* WT, int ldt, int coloff, int rowbase, LAS float* scr, int kb, int nb, int lane) {
    const int k0 = 64 * kb, n0 = 32 * nb;
#pragma unroll 8
    for (int i = 0; i < 32; ++i) { const int kk = 2 * i + (lane >> 5); scr[kk * 33 + (lane & 31)] = W[(size_t)(k0 + kk) * N + n0 + (lane & 31)]; }
    LDS_WAIT(); asm volatile("" ::: "memory");
    const int c = lane & 7;
#pragma unroll
    for (int j = 0; j < 4; ++j) { const int n = (lane >> 3) + 8 * j; const LAS float* s = scr + (8 * c) * 33 + n;
        v4u o; o.x = pk2(s[0 * 33], s[1 * 33]); o.y = pk2(s[2 * 33], s[3 * 33]); o.z = pk2(s[4 * 33], s[5 * 33]); o.w = pk2(s[6 * 33], s[7 * 33]);
        *(GAS v4u*)(WT + (size_t)(rowbase + n) * ldt + coloff + k0 + 8 * c) = o; }
    LDS_WAIT(); asm volatile("" ::: "memory");
}
__device__ __forceinline__ void p0_prologue(Frame& F) {
    LAS float* scr = (LAS float*)(F.lds + F.wave * 16384);
    const int gw = F.vcu * NWAVES + F.wave, NGW = F.G * NWAVES;
    unsigned char* ws = F.ws;
    constexpr int I_IN = 16 * (INW / 32), I_AO = 8 * 32, I_LO = 16 * 32, I_OUT = 16 * 32, I_GU1 = 16 * 64, I_DN1 = 16 * 32;
    constexpr int NITEMS = I_IN + I_AO + I_LO + I_OUT + NE * I_GU1 + NE * I_DN1;
    for (int it = gw; it < NITEMS; it += NGW) {
        int r = it;
        if (r < I_IN) { const int nblk = INW / 32; p0_transpose_item(F.in[I_WIN], INW, (bf16*)(ws + WS_WIN), D, 0, 32 * (r % nblk), scr, r / nblk, r % nblk, F.lane); continue; } r -= I_IN;
        if (r < I_AO) { p0_transpose_item(F.in[I_WAO], D, (bf16*)(ws + WS_WCAT), ARW, 0, 32 * (r % 32), scr, r / 32, r % 32, F.lane); continue; } r -= I_AO;
        if (r < I_LO) { p0_transpose_item(F.in[I_WLO], D, (bf16*)(ws + WS_WCAT), ARW, QW, 32 * (r % 32), scr, r / 32, r % 32, F.lane); continue; } r -= I_LO;
        if (r < I_OUT) { p0_transpose_item(F.in[I_WOUT], D, (bf16*)(ws + WS_WO), D, 0, 32 * (r % 32), scr, r / 32, r % 32, F.lane); continue; } r -= I_OUT;
        if (r < NE * I_GU1) { const int e = r / I_GU1, q = r % I_GU1, kb = q / 64, nb = q % 64, n0 = 32 * nb;
            const int cc = n0 & 1023, isu = n0 >> 10, rowb = 256 * (cc >> 7) + 128 * isu + (cc & 127);
            p0_transpose_item(F.in[I_WGU] + (size_t)e * D * 2 * DFF, 2 * DFF, (bf16*)(ws + WS_WGU) + (size_t)e * 2 * DFF * D, D, 0, rowb, scr, kb, nb, F.lane); continue; } r -= NE * I_GU1;
        { const int e = r / I_DN1, q = r % I_DN1;
            p0_transpose_item(F.in[I_WDN] + (size_t)e * DFF * D, D, (bf16*)(ws + WS_WD) + (size_t)e * D * DFF, DFF, 0, 32 * (q % 32), scr, q / 32, q % 32, F.lane); }
    }
    const GAS f32x4* gp = (const GAS f32x4*)F.in[I_N1G] + F.lane;
    f32x4 g[4];
#pragma unroll
    for (int j = 0; j < 4; ++j) g[j] = gp[64 * j];
    bf16* XN = (bf16*)(ws + WS_XN);
    for (int m = gw; m < T; m += NGW) {
        const GAS f32x4* xr = (const GAS f32x4*)(F.in[I_X] + (size_t)m * D) + F.lane;
        f32x4 v[4]; float s = 0.f;
#pragma unroll
        for (int j = 0; j < 4; ++j) { v[j] = xr[64 * j]; s += (v[j].x * v[j].x + v[j].y * v[j].y) + (v[j].z * v[j].z + v[j].w * v[j].w); }
        const float rstd = 1.0f / sqrtf(wave_sum(s) * (1.f / D) + NORM_EPS);
        GAS unsigned long long* o8 = (GAS unsigned long long*)(XN + (size_t)m * D) + F.lane;
#pragma unroll
        for (int j = 0; j < 4; ++j) { const f32x4 y = v[j] * rstd * g[j]; o8[64 * j] = (unsigned long long)pk2(y.x, y.y) | ((unsigned long long)pk2(y.z, y.w) << 32); }
    }
}

struct DenseSched {
    const char* A; const char* B; int nM, nN, nt, G, c; size_t tstepA, tstepB;
    __device__ __forceinline__ bool next(int i, pg8::Unit& u) const { const long L = (long)i * G + c; if (L >= (long)nM * nN) return false; pg8::dense_tile((int)L, nM, nN, u.pm, u.pn); u.aux = 0; return true; }
    __device__ __forceinline__ const char* a_ptr(const pg8::Unit& u) const { return A + (size_t)u.pm * tstepA; }
    __device__ __forceinline__ const char* b_ptr(const pg8::Unit& u) const { return B + (size_t)u.pn * tstepB; }
    __device__ __forceinline__ int ntiles(const pg8::Unit&) const { return nt; }
};
struct MergeSched {
    const char* A; const char* B; int G, c;
    __device__ __forceinline__ bool next(int i, pg8::Unit& u) const { const long L = (long)(i >> 1) * G + c; if (L >= 128 * 4) return false; pg8::dense_tile((int)L, 128, 4, u.pm, u.pn); u.aux = i & 1; return true; }
    __device__ __forceinline__ const char* a_ptr(const pg8::Unit& u) const { return A + (size_t)u.pm * (256 * ARW * 2) + (u.aux ? QW * 2 : 0); }
    __device__ __forceinline__ const char* b_ptr(const pg8::Unit& u) const { return B + (size_t)u.pn * (256 * ARW * 2) + (u.aux ? QW * 2 : 0); }
    __device__ __forceinline__ int ntiles(const pg8::Unit& u) const { return u.aux ? (LRU_W / 64) : (QW / 64); }
};
template <int NTN> struct MoeSched {
    const char* A; const char* B; const LAS int* nbp; int G, c; size_t estepB;
    __device__ __forceinline__ bool next(int i, pg8::Unit& u) const {
        const int NB = nbp[NE], U = NB * NTN; const long L = (long)i * G + c; if (L >= U) return false;
        int w = (int)L; { const int q = U / 8, r = U % 8, xcd = w % 8, off = w / 8; w = (xcd < r ? xcd * (q + 1) : r * (q + 1) + (xcd - r) * q) + off; }
        int e = 0;
        for (int k = 1; k < NE; ++k) e += (w >= nbp[k] * NTN) ? 1 : 0;
        const int b0 = nbp[e], nM = nbp[e + 1] - b0, wl = w - b0 * NTN;
        const int nig = 8 * NTN, gid = wl / nig, fm = gid * 8, gsz = (nM - fm) < 8 ? (nM - fm) : 8;
        const int rb = fm + ((wl % nig) % gsz); u.pn = (wl % nig) / gsz; u.pm = b0 + rb; u.aux = e | (rb << 8); return true;
    }
    __device__ __forceinline__ const char* a_ptr(const pg8::Unit& u) const { return A; }
    __device__ __forceinline__ const char* b_ptr(const pg8::Unit& u) const { return B + (size_t)(u.aux & 0xff) * estepB + (size_t)u.pn * (256 * D * 2); }
    __device__ __forceinline__ int ntiles(const pg8::Unit&) const { return D / 64; }
};
struct MoeDownSched : MoeSched<4> {
    __device__ __forceinline__ const char* a_ptr(const pg8::Unit& u) const { return A + (size_t)u.pm * (256 * DFF * 2); }
};

struct EpiInProj {
    static constexpr bool PERM = true;
    unsigned char* ws; const float* bias;
    __device__ __forceinline__ bool keep(const pg8::Unit&) const { return false; }
    __device__ __forceinline__ void operator()(pg8::f32x4 (&acc)[2][2][4][2], const pg8::Unit& u, int wr, int wc, int fr, int fq) const {
        using namespace pg8;
        const int pn = u.pn; bf16_t* base; int ldc, colt;
        if (pn < 2) { base = (bf16_t*)(ws + WS_Q); ldc = QW; colt = pn * 256; }
        else if (pn == 2) { base = (bf16_t*)(ws + WS_KV); ldc = 2 * KVW; colt = 0; }
        else if (pn < 7) { base = (bf16_t*)(ws + WS_XR); ldc = LRU_W; colt = (pn - 3) * 256; }
        else if (pn < 11) { base = (bf16_t*)(ws + WS_YR); ldc = LRU_W; colt = (pn - 7) * 256; }
        else { base = (bf16_t*)(ws + WS_GL); ldc = 2 * D; colt = (pn - 11) * 256; }
        const int row0 = u.pm * BM + wr * 64 + fr, col0 = colt + wc * 32 + 8 * fq, bcol0 = pn * BM + wc * 32 + 8 * fq;
        f32x4 bv[2][2];
#pragma unroll
        for (int bj = 0; bj < 2; ++bj)
#pragma unroll
            for (int n = 0; n < 2; ++n) bv[bj][n] = *(const f32x4*)(bias + bcol0 + bj * HALF + 4 * n);
#pragma unroll
        for (int ai = 0; ai < 2; ++ai)
#pragma unroll
            for (int m = 0; m < 4; ++m) { bf16_t* rowp = base + (size_t)(row0 + ai * HALF + m * 16) * ldc + col0;
#pragma unroll
                for (int bj = 0; bj < 2; ++bj) { const f32x4 v0 = acc[ai][bj][m][0] + bv[bj][0], v1 = acc[ai][bj][m][1] + bv[bj][1];
                    u32x4 w; w.x = cvt_pk_bf16(v0[0], v0[1]); w.y = cvt_pk_bf16(v0[2], v0[3]); w.z = cvt_pk_bf16(v1[0], v1[1]); w.w = cvt_pk_bf16(v1[2], v1[3]);
                    *(u32x4*)(rowp + bj * HALF) = w; } }
    }
};
struct EpiMerge {
    static constexpr bool PERM = true;
    const bf16* GL; bf16* MG;
    __device__ __forceinline__ bool keep(const pg8::Unit& u) const { return u.aux == 0; }
    __device__ __forceinline__ void operator()(pg8::f32x4 (&acc)[2][2][4][2], const pg8::Unit& u, int wr, int wc, int fr, int fq) const {
        using namespace pg8;
        const int row0 = u.pm * BM + wr * 64 + fr, col0 = u.pn * BM + wc * 32 + 8 * fq;
        if (u.aux == 0) {
#pragma unroll
            for (int ai = 0; ai < 2; ++ai)
#pragma unroll
                for (int m = 0; m < 4; ++m) { const bf16* gp = GL + (size_t)(row0 + ai * HALF + m * 16) * (2 * D) + col0;
#pragma unroll
                    for (int bj = 0; bj < 2; ++bj) { const u32x4 ga = *(const u32x4*)(gp + bj * HALF), gr = *(const u32x4*)(gp + D + bj * HALF);
#pragma unroll
                        for (int q = 0; q < 4; ++q) { const float a0 = bf_lo(ga[q]), a1 = bf_hi(ga[q]), r0 = bf_lo(gr[q]), r1 = bf_hi(gr[q]);
                            const float f0 = (1.0f + __builtin_amdgcn_exp2f(-1.4426950408889634f * r0)) * __builtin_amdgcn_rcpf(1.0f + __builtin_amdgcn_exp2f(-1.4426950408889634f * a0));
                            const float f1 = (1.0f + __builtin_amdgcn_exp2f(-1.4426950408889634f * r1)) * __builtin_amdgcn_rcpf(1.0f + __builtin_amdgcn_exp2f(-1.4426950408889634f * a1));
                            acc[ai][bj][m][q >> 1][(q & 1) * 2] *= f0; acc[ai][bj][m][q >> 1][(q & 1) * 2 + 1] *= f1; } } }
        } else {
#pragma unroll
            for (int ai = 0; ai < 2; ++ai)
#pragma unroll
                for (int m = 0; m < 4; ++m) { const size_t ro = (size_t)(row0 + ai * HALF + m * 16); const bf16* gp = GL + ro * (2 * D) + D + col0; bf16* op = MG + ro * D + col0;
#pragma unroll
                    for (int bj = 0; bj < 2; ++bj) { const u32x4 gr = *(const u32x4*)(gp + bj * HALF); u32x4 w;
#pragma unroll
                        for (int q = 0; q < 4; ++q) { const float s0 = fast_sigmoid(bf_lo(gr[q])), s1 = fast_sigmoid(bf_hi(gr[q]));
                            w[q] = cvt_pk_bf16(acc[ai][bj][m][q >> 1][(q & 1) * 2] * s0, acc[ai][bj][m][q >> 1][(q & 1) * 2 + 1] * s1); }
                        *(u32x4*)(op + bj * HALF) = w; } }
        }
    }
};
struct EpiResF32 {
    static constexpr bool PERM = false;
    const float* X; float* O;
    __device__ __forceinline__ bool keep(const pg8::Unit&) const { return false; }
    __device__ __forceinline__ void operator()(pg8::f32x4 (&acc)[2][2][4][2], const pg8::Unit& u, int wr, int wc, int fr, int fq) const {
        using namespace pg8;
        const int row0 = u.pm * BM + wr * 64 + fr, col0 = u.pn * BM + wc * 32 + 4 * fq;
#pragma unroll
        for (int ai = 0; ai < 2; ++ai)
#pragma unroll
            for (int m = 0; m < 4; ++m) { const size_t off = (size_t)(row0 + ai * HALF + m * 16) * D + col0;
#pragma unroll
                for (int bj = 0; bj < 2; ++bj)
#pragma unroll
                    for (int n = 0; n < 2; ++n) *(f32x4*)(O + off + bj * HALF + n * 16) = *(const f32x4*)(X + off + bj * HALF + n * 16) + acc[ai][bj][m][n]; }
    }
};
struct EpiSwiGLU {
    static constexpr bool PERM = true;
    const float* bgu; bf16* ACT;
    __device__ __forceinline__ bool keep(const pg8::Unit&) const { return false; }
    __device__ __forceinline__ void operator()(pg8::f32x4 (&acc)[2][2][4][2], const pg8::Unit& u, int wr, int wc, int fr, int fq) const {
        using namespace pg8;
        const int e = u.aux & 0xff, cl = wc * 32 + 8 * fq, col0 = u.pn * 128 + cl, row0 = u.pm * BM + wr * 64 + fr;
        const float* bp = bgu + (size_t)e * (2 * DFF) + col0;
        const f32x4 bg0 = *(const f32x4*)(bp), bg1 = *(const f32x4*)(bp + 4), bu0 = *(const f32x4*)(bp + DFF), bu1 = *(const f32x4*)(bp + DFF + 4);
#pragma unroll
        for (int ai = 0; ai < 2; ++ai)
#pragma unroll
            for (int m = 0; m < 4; ++m) { u32x4 w;
#pragma unroll
                for (int n = 0; n < 2; ++n) { const f32x4 g = acc[ai][0][m][n] + (n ? bg1 : bg0), uu = acc[ai][1][m][n] + (n ? bu1 : bu0); float a[4];
#pragma unroll
                    for (int j = 0; j < 4; ++j) { const float gg = fminf(g[j], 7.0f), uc = fminf(fmaxf(uu[j], -7.0f), 7.0f);
                        a[j] = gg * __builtin_amdgcn_rcpf(1.0f + __builtin_amdgcn_exp2f(-1.702f * 1.4426950408889634f * gg)) * (uc + 1.0f); }
                    w[2 * n] = cvt_pk_bf16(a[0], a[1]); w[2 * n + 1] = cvt_pk_bf16(a[2], a[3]); }
                *(u32x4*)(ACT + (size_t)(row0 + ai * HALF + m * 16) * DFF + col0) = w; }
    }
};
struct EpiDown {
    static constexpr bool PERM = true;
    const float* bdn; const float* gatel; bf16* Y;
    __device__ __forceinline__ bool keep(const pg8::Unit&) const { return false; }
    __device__ __forceinline__ void operator()(pg8::f32x4 (&acc)[2][2][4][2], const pg8::Unit& u, int wr, int wc, int fr, int fq) const {
        using namespace pg8;
        const int e = u.aux & 0xff, rb = u.aux >> 8, col0 = u.pn * BM + wc * 32 + 8 * fq, rl0 = wr * 64 + fr;
        f32x4 bv[2][2];
#pragma unroll
        for (int bj = 0; bj < 2; ++bj)
#pragma unroll
            for (int n = 0; n < 2; ++n) bv[bj][n] = *(const f32x4*)(bdn + (size_t)e * D + col0 + bj * HALF + 4 * n);
        const float* gl = gatel + (size_t)e * ECAP + rb * 256;
#pragma unroll
        for (int ai = 0; ai < 2; ++ai)
#pragma unroll
            for (int m = 0; m < 4; ++m) { const int rl = rl0 + ai * HALF + m * 16; const float gt = gl[rl]; bf16* rowp = Y + (size_t)(u.pm * BM + rl) * D + col0;
#pragma unroll
                for (int bj = 0; bj < 2; ++bj) { const f32x4 v0 = (acc[ai][bj][m][0] + bv[bj][0]) * gt, v1 = (acc[ai][bj][m][1] + bv[bj][1]) * gt;
                    u32x4 w; w.x = cvt_pk_bf16(v0[0], v0[1]); w.y = cvt_pk_bf16(v0[2], v0[3]); w.z = cvt_pk_bf16(v1[0], v1[1]); w.w = cvt_pk_bf16(v1[2], v1[3]);
                    *(u32x4*)(rowp + bj * HALF) = w; } }
    }
};

__device__ __forceinline__ void fix_row(bf16* p, const float* g8, float scale, int c, int prow, int pcol, const LAS f32x2* tab) {
    const v4u raw = *(const GAS v4u*)p;
    float v[8];
#pragma unroll
    for (int q = 0; q < 4; ++q) { v[2 * q] = bflo(raw[q]); v[2 * q + 1] = bfhi(raw[q]); }
    float ss = 0.f;
#pragma unroll
    for (int j = 0; j < 8; ++j) ss += v[j] * v[j];
    ss += __shfl_xor(ss, 1); ss += __shfl_xor(ss, 2); ss += __shfl_xor(ss, 4);
    const float rstd = 1.0f / sqrtf(ss * (1.0f / HD) + NORM_EPS);
    const int pos = (c >> 2) ? pcol : prow; const bool second = (c >> 1) & 1; const int f0 = (c & 1) * 8;
    float o[8];
#pragma unroll
    for (int j = 0; j < 8; ++j) { const float y = v[j] * rstd * g8[j]; const float pr = __shfl_xor(y, 2); const f32x2 cs = tab[pos * 16 + f0 + j];
        o[j] = (second ? (y * cs.x + pr * cs.y) : (y * cs.x - pr * cs.y)) * scale; }
    v4u w; w.x = pk2(o[0], o[1]); w.y = pk2(o[2], o[3]); w.z = pk2(o[4], o[5]); w.w = pk2(o[6], o[7]);
    *(GAS v4u*)p = w;
}
__device__ __forceinline__ void p2_fixup(Frame& F) {
    LAS f32x2* tab = (LAS f32x2*)(F.lds);
    for (int idx = F.tid; idx < 1024; idx += NWAVES * 64) { const int pos = idx >> 4, f = idx & 15; const float inv = powf(10000.0f, -(float)f / 16.0f); const float ang = (float)pos * inv;
        tab[idx] = (f32x2){cosf(ang), sinf(ang)}; }
    __syncthreads();
    const int gw = F.vcu * NWAVES + F.wave, NGW = F.G * NWAVES, c = F.lane & 7;
    float gq[8], gk[8];
#pragma unroll
    for (int j = 0; j < 8; ++j) { gq[j] = F.in[I_QNG][8 * c + j]; gk[j] = F.in[I_KNG][8 * c + j]; }
    bf16* Q = (bf16*)(F.ws + WS_Q); bf16* KV = (bf16*)(F.ws + WS_KV);
    for (int t = gw; t < T; t += NGW) {
        const int s = t & (SEQ - 1), prow = s >> 6, pcol = s & 63;
        fix_row(Q + (size_t)t * QW + F.lane * 8, gq, attn_body::C2, c, prow, pcol, tab);
        if (F.lane < 16) fix_row(KV + (size_t)t * (2 * KVW) + F.lane * 8, gk, 1.0f, c, prow, pcol, tab);
    }
    __syncthreads();
}
constexpr int LRU_CH = 256;
constexpr int LRU_XC = 0, LRU_XC_STRIDE = 144;
constexpr int LRU_WT = LRU_CH * LRU_XC_STRIDE;
constexpr int LRU_HS = LRU_WT + 2 * 4 * 32 * 8;
static_assert(LRU_HS + 256 * 33 * 4 <= RING_BYTES, "lru lds");

__device__ __forceinline__ float gelu_tanh(float y) { const float z = 0.7978845608028654f * (y + 0.044715f * y * y * y); return y * sigmoidf_fast(2.0f * z); }

template <int DIR> __device__ __forceinline__ void lru_sweep(Frame& F, int b, int n, int half) {
    LAS unsigned char* lds = F.lds;
    const int tid = F.tid, lane = F.lane, wave = F.wave;
    const int ch16 = lane & 15, q = lane >> 4, ct = wave & 1, tq = wave >> 1;
    const int cl = 16 * ct + ch16, co_l = 32 * half + cl, cgl = 64 * n + co_l;
    const int ql = DIR ? 3 - q : q, tql = DIR ? 3 - tq : tq;
    bf16x8 Ba[2], Bi[2];
    { const float* wa = F.in[I_WA] + ((size_t)(DIR * LRU_NB + n) * 64) * 64 + co_l; const float* wi = F.in[I_WI] + ((size_t)(DIR * LRU_NB + n) * 64) * 64 + co_l;
#pragma unroll
      for (int ks = 0; ks < 2; ++ks)
#pragma unroll
          for (int j = 0; j < 8; ++j) { const int k = 32 * ks + 8 * q + j; Ba[ks][j] = (short)f2bf(wa[(size_t)k * 64]); Bi[ks][j] = (short)f2bf(wi[(size_t)k * 64]); } }
    const float ba = F.in[I_BA][(DIR * LRU_NB + n) * 64 + co_l], bi = F.in[I_BI][(DIR * LRU_NB + n) * 64 + co_l];
    const float lam = F.in[I_LAM][DIR * LRU_W + cgl];
    const float clam = -8.0f * log1pf(expf(-lam)) * 1.4426950408889634f;
    const int c8 = tid & 7, rr = tid >> 3;
    float cw[4][8], cb[8];
#pragma unroll
    for (int i = 0; i < 8; ++i) { cb[i] = F.in[I_CONVB][64 * n + 8 * c8 + i];
#pragma unroll
        for (int j = 0; j < 4; ++j) cw[j][i] = F.in[I_CONVW][j * LRU_W + 64 * n + 8 * c8 + i]; }
    const bf16* XR = (const bf16*)(F.ws + WS_XR); const bf16* YR = (const bf16*)(F.ws + WS_YR); bf16* HF = (bf16*)(F.ws + WS_XN); bf16* AR = (bf16*)(F.ws + WS_AR);
    float hcarry = 0.f;
    for (int ck = 0; ck < SEQ / LRU_CH; ++ck) {
        const int pc = DIR ? (SEQ / LRU_CH - 1 - ck) : ck, par = ck & 1;
        const size_t t0 = (size_t)b * SEQ + (size_t)pc * LRU_CH;
#pragma unroll
        for (int p = 0; p < 4; ++p) {
            const int trow = p * 64 + rr, s = pc * LRU_CH + trow;
            float o[8];
#pragma unroll
            for (int i = 0; i < 8; ++i) o[i] = cb[i];
#pragma unroll
            for (int j = 0; j < 4; ++j) { const int sj = s + j - 1;
                if (sj >= 0 && sj < SEQ) { const v4u raw = *(const GAS v4u*)(XR + ((size_t)b * SEQ + sj) * LRU_W + 64 * n + 8 * c8);
#pragma unroll
                    for (int qq = 0; qq < 4; ++qq) { o[2 * qq] += cw[j][2 * qq] * bflo(raw[qq]); o[2 * qq + 1] += cw[j][2 * qq + 1] * bfhi(raw[qq]); } } }
            v4u w; w.x = pk2(o[0], o[1]); w.y = pk2(o[2], o[3]); w.z = pk2(o[4], o[5]); w.w = pk2(o[6], o[7]);
            *(LAS v4u*)(lds + LRU_XC + trow * LRU_XC_STRIDE + c8 * 16) = w;
        }
        __syncthreads();
        float Aloc[4][4], Hloc[4][4];
        float AR_ = 1.f, HR_ = 0.f;
#pragma unroll
        for (int rtl = 0; rtl < 4; ++rtl) {
            const int rt = DIR ? 3 - rtl : rtl;
            const int arow = 64 * tq + 16 * rt + ch16;
            const bf16x8 a0 = *(const LAS bf16x8*)(lds + LRU_XC + arow * LRU_XC_STRIDE + q * 16), a1 = *(const LAS bf16x8*)(lds + LRU_XC + arow * LRU_XC_STRIDE + 64 + q * 16);
            f32x4 Da = (f32x4){0.f, 0.f, 0.f, 0.f}, Di = (f32x4){0.f, 0.f, 0.f, 0.f};
            Da = __builtin_amdgcn_mfma_f32_16x16x32_bf16(a0, Ba[0], Da, 0, 0, 0); Da = __builtin_amdgcn_mfma_f32_16x16x32_bf16(a1, Ba[1], Da, 0, 0, 0);
            Di = __builtin_amdgcn_mfma_f32_16x16x32_bf16(a0, Bi[0], Di, 0, 0, 0); Di = __builtin_amdgcn_mfma_f32_16x16x32_bf16(a1, Bi[1], Di, 0, 0, 0);
            float av[4], uv[4];
#pragma unroll
            for (int j = 0; j < 4; ++j) { const int tr = 64 * tq + 16 * rt + 4 * q + j;
                const float xcv = __uint_as_float((unsigned)(*(const LAS unsigned short*)(lds + LRU_XC + tr * LRU_XC_STRIDE + co_l * 2)) << 16);
                const float r = sigmoidf_fast(Da[j] + ba), ig = sigmoidf_fast(Di[j] + bi);
                const float a = __builtin_amdgcn_exp2f(clam * r);
                av[j] = a; uv[j] = sqrtf(fmaxf(1.0f - a * a, 0.f)) * (ig * xcv); }
            float Ain[4], Hin[4];
            { const int j0 = DIR ? 3 : 0; float A = av[j0], H = uv[j0]; Ain[j0] = A; Hin[j0] = H;
#pragma unroll
              for (int st = 1; st < 4; ++st) { const int j = DIR ? 3 - st : st; H = av[j] * H + uv[j]; A = A * av[j]; Ain[j] = A; Hin[j] = H; } }
            const int jl = DIR ? 0 : 3;
            float Ai = Ain[jl], Hi = Hin[jl];
            { const int nb1 = DIR ? lane + 16 : lane - 16, nb2 = DIR ? lane + 32 : lane - 32;
              float An = __shfl(Ai, nb1 & 63), Hn = __shfl(Hi, nb1 & 63); if (ql >= 1) { Hi = Ai * Hn + Hi; Ai = An * Ai; }
              An = __shfl(Ai, nb2 & 63); Hn = __shfl(Hi, nb2 & 63); if (ql >= 2) { Hi = Ai * Hn + Hi; Ai = An * Ai; }
              float Ae = __shfl(Ai, nb1 & 63), He = __shfl(Hi, nb1 & 63); if (ql == 0) { Ae = 1.f; He = 0.f; }
              const int lastl = ch16 + 16 * (DIR ? 0 : 3);
              const float Atile = __shfl(Ai, lastl), Htile = __shfl(Hi, lastl);
              const float Ap = AR_ * Ae, Hp = Ae * HR_ + He;
#pragma unroll
              for (int j = 0; j < 4; ++j) { Aloc[rt][j] = Ap * Ain[j]; Hloc[rt][j] = Ain[j] * Hp + Hin[j]; }
              HR_ = Atile * HR_ + Htile; AR_ = AR_ * Atile; }
        }
        LAS f32x2* WT = (LAS f32x2*)(lds + LRU_WT) + par * 128;
        if (q == 0) WT[tql * 32 + cl] = (f32x2){AR_, HR_};
        __syncthreads();
        float hin = hcarry, hnew = hcarry;
#pragma unroll
        for (int w2 = 0; w2 < 4; ++w2) { const f32x2 wv = WT[w2 * 32 + cl]; hnew = wv.x * hnew + wv.y; if (w2 < tql) hin = hnew; }
        hcarry = hnew;
        LAS float* HS = (LAS float*)(lds + LRU_HS);
#pragma unroll
        for (int rt = 0; rt < 4; ++rt)
#pragma unroll
            for (int j = 0; j < 4; ++j) HS[(64 * tq + 16 * rt + 4 * q + j) * 33 + cl] = Hloc[rt][j] + Aloc[rt][j] * hin;
        __syncthreads();
        { const int tok = tid >> 1, part = tid & 1; const size_t trow = t0 + tok; const int colb = 64 * n + 32 * half + 16 * part;
          float hv[16];
#pragma unroll
          for (int i = 0; i < 16; ++i) hv[i] = HS[tok * 33 + 16 * part + i];
          if (DIR == 0) {
              v4u w0, w1; w0.x = pk2(hv[0], hv[1]); w0.y = pk2(hv[2], hv[3]); w0.z = pk2(hv[4], hv[5]); w0.w = pk2(hv[6], hv[7]);
              w1.x = pk2(hv[8], hv[9]); w1.y = pk2(hv[10], hv[11]); w1.z = pk2(hv[12], hv[13]); w1.w = pk2(hv[14], hv[15]);
              GAS v4u* op = (GAS v4u*)(HF + trow * LRU_W + colb); op[0] = w0; op[1] = w1;
          } else {
              const GAS v4u* fp = (const GAS v4u*)(HF + trow * LRU_W + colb); const GAS v4u* yp = (const GAS v4u*)(YR + trow * LRU_W + colb);
              const v4u f0 = fp[0], f1 = fp[1], y0 = yp[0], y1 = yp[1]; v4u w0, w1;
#pragma unroll
              for (int qq = 0; qq < 4; ++qq) {
                  w0[qq] = pk2((hv[2 * qq] + bflo(f0[qq])) * gelu_tanh(bflo(y0[qq])), (hv[2 * qq + 1] + bfhi(f0[qq])) * gelu_tanh(bfhi(y0[qq])));
                  w1[qq] = pk2((hv[8 + 2 * qq] + bflo(f1[qq])) * gelu_tanh(bflo(y1[qq])), (hv[8 + 2 * qq + 1] + bfhi(f1[qq])) * gelu_tanh(bfhi(y1[qq]))); }
              GAS v4u* op = (GAS v4u*)(AR + trow * ARW + QW + colb); op[0] = w0; op[1] = w1;
          } }
    }
    __syncthreads();
}
__device__ __forceinline__ void p2_lru(Frame& F) {
    for (int it = F.vcu; it < BATCH * LRU_NB * 2; it += F.G) {
        const int b = it >> 5, n = (it & 31) >> 1, half = it & 1;
        lru_sweep<0>(F, b, n, half);
        lru_sweep<1>(F, b, n, half);
    }
}

constexpr int RT_STRIDE = 1028;
constexpr int ROWINFO_OFF = GTAB_OFF + 1024;
__device__ __forceinline__ void p6_router(Frame& F) {
    LAS float* wT = (LAS float*)F.lds;
    LAS unsigned* misc = (LAS unsigned*)(F.lds + MISC_OFF);
    LAS unsigned* hist = misc + 128; LAS unsigned* basew = misc + 160;
    LAS v2u* rowinfo = (LAS v2u*)(F.lds + ROWINFO_OFF);
    const int tid = F.tid, lane = F.lane, wave = F.wave;
    for (int idx = tid; idx < D * NE; idx += NWAVES * 64) { const int k = idx >> 5, e = idx & 31; wT[e * RT_STRIDE + k] = F.in[I_WR][idx]; }
    if (tid < 32) hist[tid] = 0u;
    f32x4 g2[4];
#pragma unroll
    for (int j = 0; j < 4; ++j) g2[j] = *((const GAS f32x4*)F.in[I_N2G] + lane + 64 * j);
    const float brl = F.in[I_BR][lane >> 1];
    __syncthreads();
    bf16* H2 = (bf16*)(F.ws + WS_XN);
    unsigned* gcnt = (unsigned*)(F.ws + WS_CTL) + CW_CNT;
    int* TOKL = (int*)(F.ws + WS_TOKL); float* GATEL = (float*)(F.ws + WS_GATEL); int* TOKREC = (int*)(F.ws + WS_TOKREC);
    for (int bi = F.vcu; bi < T / 128; bi += F.G) {
        const int rbase = bi * 128;
        for (int p = 0; p < 8; ++p) {
            const int rl0 = 16 * wave + 2 * p; const size_t r0 = (size_t)rbase + rl0;
            f32x4 h0[4], h1[4];
            { const GAS f32x4* x0 = (const GAS f32x4*)(F.out + r0 * D) + lane; const GAS f32x4* x1 = (const GAS f32x4*)(F.out + (r0 + 1) * D) + lane;
              float s0 = 0.f, s1 = 0.f;
#pragma unroll
              for (int j = 0; j < 4; ++j) { h0[j] = x0[64 * j]; h1[j] = x1[64 * j];
                  s0 += (h0[j].x * h0[j].x + h0[j].y * h0[j].y) + (h0[j].z * h0[j].z + h0[j].w * h0[j].w); s1 += (h1[j].x * h1[j].x + h1[j].y * h1[j].y) + (h1[j].z * h1[j].z + h1[j].w * h1[j].w); }
              const float rs0 = 1.0f / sqrtf(wave_sum(s0) * (1.f / D) + NORM_EPS), rs1 = 1.0f / sqrtf(wave_sum(s1) * (1.f / D) + NORM_EPS);
              GAS unsigned long long* o0 = (GAS unsigned long long*)(H2 + r0 * D) + lane; GAS unsigned long long* o1 = (GAS unsigned long long*)(H2 + (r0 + 1) * D) + lane;
#pragma unroll
              for (int j = 0; j < 4; ++j) { h0[j] = h0[j] * rs0 * g2[j]; h1[j] = h1[j] * rs1 * g2[j];
                  o0[64 * j] = (unsigned long long)pk2(h0[j].x, h0[j].y) | ((unsigned long long)pk2(h0[j].z, h0[j].w) << 32);
                  o1[64 * j] = (unsigned long long)pk2(h1[j].x, h1[j].y) | ((unsigned long long)pk2(h1[j].z, h1[j].w) << 32); } }
            float a0[32], a1[32];
#pragma unroll
            for (int e = 0; e < 32; ++e) { float s0 = 0.f, s1 = 0.f;
#pragma unroll
                for (int j = 0; j < 4; ++j) { const f32x4 w = *(const LAS f32x4*)(wT + e * RT_STRIDE + 256 * j + 4 * lane);
                    s0 += (h0[j].x * w.x + h0[j].y * w.y) + (h0[j].z * w.z + h0[j].w * w.w); s1 += (h1[j].x * w.x + h1[j].y * w.y) + (h1[j].z * w.z + h1[j].w * w.w); }
                a0[e] = s0; a1[e] = s1; }
#define TRED(arr, N, MASK) _Pragma("unroll") for (int i = 0; i < (N); ++i) { const bool up = (lane & (MASK)) != 0; const float snd = up ? arr[i] : arr[i + (N)]; const float kp = up ? arr[i + (N)] : arr[i]; arr[i] = kp + __shfl_xor(snd, (MASK)); }
            TRED(a0, 16, 32) TRED(a0, 8, 16) TRED(a0, 4, 8) TRED(a0, 2, 4) TRED(a0, 1, 2)
            TRED(a1, 16, 32) TRED(a1, 8, 16) TRED(a1, 4, 8) TRED(a1, 2, 4) TRED(a1, 1, 2)
#undef TRED
            float lg[2]; lg[0] = a0[0] + __shfl_xor(a0[0], 1) + brl; lg[1] = a1[0] + __shfl_xor(a1[0], 1) + brl;
#pragma unroll
            for (int rr2 = 0; rr2 < 2; ++rr2) {
                float val = lg[rr2]; int te[4]; float tv[4];
#pragma unroll
                for (int k = 0; k < 4; ++k) { float m = val;
#pragma unroll
                    for (int o = 1; o < 64; o <<= 1) m = fmaxf(m, __shfl_xor(m, o));
                    const unsigned long long bal = __ballot(val == m); const int src = __builtin_ctzll(bal); te[k] = src >> 1; tv[k] = m; if ((lane >> 1) == te[k]) val = -INFINITY; }
                const float p1 = __expf(tv[1] - tv[0]), p2 = __expf(tv[2] - tv[0]), p3 = __expf(tv[3] - tv[0]); const float inv = 1.0f / (1.0f + p1 + p2 + p3);
                if (lane < 4) { const int e = lane == 0 ? te[0] : lane == 1 ? te[1] : lane == 2 ? te[2] : te[3]; const float gt = (lane == 0 ? 1.0f : lane == 1 ? p1 : lane == 2 ? p2 : p3) * inv;
                    const unsigned rank = atomicAdd((unsigned*)(hist + e), 1u);
                    rowinfo[(rl0 + rr2) * 4 + lane] = (v2u){(unsigned)e | (rank << 8), __float_as_uint(gt)}; }
            }
        }
        __syncthreads();
        if (tid < 32) basew[tid] = __hip_atomic_fetch_add(gcnt + tid, hist[tid], __ATOMIC_RELAXED, __HIP_MEMORY_SCOPE_AGENT);
        __syncthreads();
        { const int rl = tid >> 2, k = tid & 3; const v2u inf = rowinfo[rl * 4 + k]; const int e = inf.x & 0xff; const unsigned slot = basew[e] + (inf.x >> 8); const int t = rbase + rl;
          TOKL[(size_t)e * ECAP + slot] = t; GATEL[(size_t)e * ECAP + slot] = __uint_as_float(inf.y); TOKREC[t * 4 + k] = (int)(((unsigned)e << 20) | slot); }
        __syncthreads();
        if (tid < 32) hist[tid] = 0u;
        __syncthreads();
    }
}

__device__ __forceinline__ void moe_tables(Frame& F) {
    LAS int* misc = (LAS int*)(F.lds + MISC_OFF);
    const unsigned* gcnt = (const unsigned*)(F.ws + WS_CTL) + CW_CNT;
    if (F.tid < 32) misc[F.tid] = (int)__hip_atomic_load(gcnt + F.tid, __ATOMIC_RELAXED, __HIP_MEMORY_SCOPE_AGENT);
    __syncthreads();
    if (F.tid == 0) { int s = 0; for (int e = 0; e < NE; ++e) { misc[32 + e] = s; s += (misc[e] + 255) >> 8; } misc[32 + NE] = s; }
    __syncthreads();
}
__device__ __forceinline__ void moe_gather_table(Frame& F, const MoeSched<8>& S) {
    LAS int* misc = (LAS int*)(F.lds + MISC_OFF); LAS int* gtab = (LAS int*)(F.lds + GTAB_OFF);
    const int* TOKL = (const int*)(F.ws + WS_TOKL);
    pg8::Unit u;
    for (int ui = 0; ui < MAX_GUNITS && S.next(ui, u); ++ui) {
        if (F.tid < 256) { const int e = u.aux & 0xff, rb = u.aux >> 8, slot = rb * 256 + F.tid; gtab[ui * 256 + F.tid] = (slot < misc[e]) ? TOKL[(size_t)e * ECAP + slot] : 0; }
    }
    __syncthreads();
}

__device__ __forceinline__ void p10_final(Frame& F) {
    LAS int* misc = (LAS int*)(F.lds + MISC_OFF);
    const int gw = F.vcu * NWAVES + F.wave, NGW = F.G * NWAVES, lane = F.lane;
    f32x4 g[4];
#pragma unroll
    for (int j = 0; j < 4; ++j) g[j] = *((const GAS f32x4*)F.in[I_FG] + lane + 64 * j);
    const int* TOKREC = (const int*)(F.ws + WS_TOKREC); const bf16* Y = (const bf16*)(F.ws + WS_Y);
    for (int t = gw; t < T; t += NGW) {
        GAS f32x4* xp = (GAS f32x4*)(F.out + (size_t)t * D) + lane;
        f32x4 v[4];
#pragma unroll
        for (int j = 0; j < 4; ++j) v[j] = xp[64 * j];
#pragma unroll
        for (int k = 0; k < 4; ++k) { const unsigned rec = (unsigned)TOKREC[t * 4 + k]; const int e = rec >> 20, slot = rec & 0xfffff;
            const GAS v2u* yp = (const GAS v2u*)(Y + ((size_t)misc[32 + e] * 256 + slot) * D) + lane;
#pragma unroll
            for (int j = 0; j < 4; ++j) { const v2u w = yp[64 * j]; v[j].x += bflo(w.x); v[j].y += bfhi(w.x); v[j].z += bflo(w.y); v[j].w += bfhi(w.y); } }
        float s = 0.f;
#pragma unroll
        for (int j = 0; j < 4; ++j) s += (v[j].x * v[j].x + v[j].y * v[j].y) + (v[j].z * v[j].z + v[j].w * v[j].w);
        const float rstd = 1.0f / sqrtf(wave_sum(s) * (1.f / D) + NORM_EPS);
#pragma unroll
        for (int j = 0; j < 4; ++j) xp[64 * j] = v[j] * rstd * g[j];
    }
}
typedef GAS unsigned gu32;
#define RLX_AGENT __ATOMIC_RELAXED, __HIP_MEMORY_SCOPE_AGENT
#define XB_TMO      128
#define XB_XCNT(j)  (256  + 64 * (j))
#define XB_XSUB(j)  (1280 + 64 * (j))
#define XB_XGEN(j)  (2304 + 64 * (j))
#define XB_TOP      3328
#define XB_TOPGEN   3392
#define XCD_BAR_WORDS 3456
#define XB_SPIN_CAP (1u << 18)

__device__ __forceinline__ unsigned xb_ld(unsigned* p)              { return __hip_atomic_load(p, __ATOMIC_RELAXED, __HIP_MEMORY_SCOPE_AGENT); }
__device__ __forceinline__ unsigned xb_add(unsigned* p, unsigned v) { return __hip_atomic_fetch_add(p, v, __ATOMIC_RELAXED, __HIP_MEMORY_SCOPE_AGENT); }
__device__ __forceinline__ unsigned xb_xcc_id() { return (unsigned)__builtin_amdgcn_s_getreg((3 << 11) | 20) & 0xFu; }
#define XB_SPIN(cond, bar) do { unsigned _sp = 0; while (cond) { __builtin_amdgcn_s_sleep(1); \
    if ((++_sp & 255u) == 0u) { if (xb_ld(&(bar)[XB_TMO])) break; if (_sp > XB_SPIN_CAP) { atomicAdd(&(bar)[XB_TMO], 1u); break; } } } } while (0)

struct XcdBarrier {
    unsigned* bar; unsigned x;
    volatile LAS unsigned* st;
};

__device__ __forceinline__ XcdBarrier xcd_barrier_post(unsigned* bar, volatile LAS unsigned* st) {
    XcdBarrier b; b.bar = bar; b.x = xb_xcc_id(); b.st = st;
    if (threadIdx.x == 0) (void)xb_add(&bar[XB_XCNT(b.x)], 1u);
    return b;
}
__device__ __forceinline__ void xcd_barrier_complete(unsigned* bar, unsigned x, unsigned& nloc, unsigned& nx) {
    const unsigned G = gridDim.x * gridDim.y * gridDim.z;
    unsigned sum, cnt, mine, sp = 0u;
    for (;;) {
        sum = 0u; cnt = 0u; mine = 0u;
#pragma unroll
        for (unsigned j = 0; j < 16; ++j) { const unsigned c = xb_ld(&bar[XB_XCNT(j)]); sum += c; cnt += (c > 0u) ? 1u : 0u; mine = (j == x) ? c : mine; }
        if (sum == G) break;
        __builtin_amdgcn_s_sleep(1);
        if ((++sp & 255u) == 0u) { if (xb_ld(&bar[XB_TMO])) break; if (sp > XB_SPIN_CAP) { atomicAdd(&bar[XB_TMO], 1u); break; } }
    }
    nloc = mine > 0u ? mine : 1u; nx = cnt > 0u ? cnt : 1u;
}

__device__ __forceinline__ void xcd_barrier(const XcdBarrier& b) {
    asm volatile("s_waitcnt vmcnt(0)" ::: "memory");
    __syncthreads();
    if (threadIdx.x == 0) {
        unsigned* bar = b.bar;
        __builtin_amdgcn_s_waitcnt(0);
        unsigned nloc = b.st[0], nx = b.st[1];
        if (nloc == 0u) { xcd_barrier_complete(bar, b.x, nloc, nx); b.st[0] = nloc; b.st[1] = nx; }
        const unsigned old = xb_add(&bar[XB_XSUB(b.x)], 1u);
        const unsigned gen = old / nloc;
        if (old + 1u == (gen + 1u) * nloc) {
            __builtin_amdgcn_fence(__ATOMIC_RELEASE, "agent");
            asm volatile("s_waitcnt vmcnt(0)" ::: "memory");
            const unsigned og = xb_add(&bar[XB_TOP], 1u);
            const unsigned tg = og / nx;
            if (og + 1u == (tg + 1u) * nx) xb_add(&bar[XB_TOPGEN], 1u);
            else XB_SPIN(xb_ld(&bar[XB_TOPGEN]) == tg, bar);
            __builtin_amdgcn_fence(__ATOMIC_ACQUIRE, "agent");
            xb_add(&bar[XB_XGEN(b.x)], 1u);
            asm volatile("s_waitcnt vmcnt(0)" ::: "memory");
        } else {
            XB_SPIN(xb_ld(&bar[XB_XGEN(b.x)]) == gen, bar);
            __builtin_amdgcn_fence(__ATOMIC_ACQUIRE, "agent");
            asm volatile("s_waitcnt vmcnt(0)" ::: "memory");
        }
    }
    __syncthreads();
}

constexpr int N_PHASES = 10;
struct Args { const float* in[24]; float* out; unsigned char* ws; int ph_lo, ph_hi; };
__global__ void __launch_bounds__(NWAVES * 64, 2) mk_fwd(Args args) {
    extern __shared__ __attribute__((aligned(16))) unsigned char lds[];
#define MKFRAME() Frame F; { int t_ = threadIdx.x; asm volatile("" : "+v"(t_)); F.lds = (LAS unsigned char*)lds; F.tid = t_; F.lane = t_ & 63; F.wave = __builtin_amdgcn_readfirstlane(t_ >> 6); \
        F.G = gridDim.x; const int bx = blockIdx.x; F.vcu = (F.G % 8 == 0) ? (bx % 8) * (F.G / 8) + bx / 8 : bx; F.in = args.in; F.out = args.out; F.ws = args.ws; }
    unsigned char* ws = args.ws;
    const int lo = args.ph_lo, hi = args.ph_hi;
#ifndef PH_MASK
#define PH_MASK 0x3ff
#endif
#define IN(k) (((PH_MASK >> (k)) & 1) && lo <= (k) && (k) < hi)
#ifndef REP_MASK
#define REP_MASK 0
#endif
#define REPS(k) for (int rep_ = 0; rep_ < ((((REP_MASK) >> (k)) & 1) ? 2 : 1); ++rep_)
#define SEAM(k) do { if (IN(k) && IN((k) + 1)) { xcd_barrier(bar); } } while (0)

    if (IN(0)) { MKFRAME(); if (blockIdx.x == 0) { for (int i = F.tid; i < CW_BAR + XCD_BAR_WORDS; i += NWAVES * 64) ((unsigned*)(ws + WS_CTL))[i] = 0u; } REPS(0) p0_prologue(F); }
    cg::this_grid().sync();
    XcdBarrier bar;
    { volatile LAS unsigned* st = (volatile LAS unsigned*)(lds + MISC_OFF) + 200; if (threadIdx.x == 0) { st[0] = 0u; st[1] = 0u; } __syncthreads(); bar = xcd_barrier_post((unsigned*)(ws + WS_CTL) + CW_BAR, st); }
    if (IN(1)) { MKFRAME();
        DenseSched S{(const char*)(ws + WS_XN), (const char*)(ws + WS_WIN), T / 256, INW / 256, D / 64, F.G, (int)blockIdx.x, (size_t)256 * D * 2, (size_t)256 * D * 2};
        EpiInProj E{ws, F.in[I_BIN]};
        REPS(1) pg8::gemm_phase<EpiInProj, DenseSched, true, false>(F.lds, D, D, S, E, nullptr);
    }
    SEAM(1);
    if (IN(2)) { MKFRAME(); p2_fixup(F); REPS(2) p2_lru(F); }
    SEAM(2);
    if (IN(3)) { MKFRAME();
        const attn_body::AttnTensors AT{(const attn_body::bf16*)(ws + WS_Q), (const attn_body::bf16*)(ws + WS_KV), (const attn_body::bf16*)(ws + WS_KV) + KVW, (attn_body::bf16*)(ws + WS_AR)};
        const attn_body::StaticOrder S((int)F.G, F.vcu);
        REPS(3) attn_body::attn_phase<attn_body::StaticOrder>((char*)lds, AT, S);
    }
    SEAM(3);
    if (IN(4)) { MKFRAME();
        MergeSched S{(const char*)(ws + WS_AR), (const char*)(ws + WS_WCAT), F.G, (int)blockIdx.x};
        EpiMerge E{(const bf16*)(ws + WS_GL), (bf16*)(ws + WS_MERGED)};
        REPS(4) pg8::gemm_phase<EpiMerge, MergeSched, true, false>(F.lds, ARW, ARW, S, E, nullptr);
    }
    SEAM(4);
    if (IN(5)) { MKFRAME();
        DenseSched S{(const char*)(ws + WS_MERGED), (const char*)(ws + WS_WO), T / 256, D / 256, D / 64, F.G, (int)blockIdx.x, (size_t)256 * D * 2, (size_t)256 * D * 2};
        EpiResF32 E{F.in[I_X], F.out};
        REPS(5) pg8::gemm_phase<EpiResF32, DenseSched, true, false>(F.lds, D, D, S, E, nullptr);
    }
    SEAM(5);
    if (IN(6)) { MKFRAME(); p6_router(F); }
    SEAM(6);
    if (IN(7)) { MKFRAME();
        moe_tables(F);
        MoeSched<8> S{(const char*)(ws + WS_XN), (const char*)(ws + WS_WGU), (const LAS int*)(F.lds + MISC_OFF) + 32, F.G, (int)blockIdx.x, (size_t)2 * DFF * D * 2};
        moe_gather_table(F, S);
        EpiSwiGLU E{F.in[I_BGU], (bf16*)(ws + WS_ACT)};
        REPS(7) pg8::gemm_phase<EpiSwiGLU, MoeSched<8>, true, true>(F.lds, D, D, S, E, (const LAS int*)(F.lds + GTAB_OFF));
    }
    SEAM(7);
    if (IN(8)) { MKFRAME();
        moe_tables(F);
        MoeDownSched S; S.A = (const char*)(ws + WS_ACT); S.B = (const char*)(ws + WS_WD); S.nbp = (const LAS int*)(F.lds + MISC_OFF) + 32; S.G = F.G; S.c = (int)blockIdx.x; S.estepB = (size_t)D * DFF * 2;
        EpiDown E{F.in[I_BDN], (const float*)(ws + WS_GATEL), (bf16*)(ws + WS_Y)};
        REPS(8) pg8::gemm_phase<EpiDown, MoeDownSched, true, false>(F.lds, DFF, DFF, S, E, nullptr);
    }
    SEAM(8);
    if (IN(9)) { MKFRAME(); moe_tables(F); p10_final(F); }
#undef IN
#undef SEAM
}

#ifndef MK_N_LAUNCHES
#define MK_N_LAUNCHES 1
#endif
extern "C" void kernel_launch(void* const* d_in, const int* in_sizes, int n_in, void* d_out, int out_size, void* d_ws, size_t ws_size, hipStream_t stream) {
    static int grid = 0;
    if (grid == 0) {
        if (n_in != 24 || in_sizes[0] != T * D || out_size != T * D || ws_size < WS_END) { fprintf(stderr, "kernel_launch: unexpected shapes (n_in %d, in0 %d, out %d, ws %zu < %zu)\n", n_in, n_in > 0 ? in_sizes[0] : -1, out_size, ws_size, (size_t)WS_END); grid = -1; return; }
        int dev = 0, cus = 0, per_cu = 0;
        if (hipGetDevice(&dev) != hipSuccess || hipDeviceGetAttribute(&cus, hipDeviceAttributeMultiprocessorCount, dev) != hipSuccess) { grid = -1; return; }
        if (hipFuncSetAttribute((const void*)mk_fwd, hipFuncAttributeMaxDynamicSharedMemorySize, LDS_BYTES) != hipSuccess) { fprintf(stderr, "kernel_launch: hipFuncSetAttribute failed\n"); grid = -1; return; }
        if (hipOccupancyMaxActiveBlocksPerMultiprocessor(&per_cu, (const void*)mk_fwd, NWAVES * 64, LDS_BYTES) != hipSuccess || per_cu < 1) { fprintf(stderr, "kernel_launch: occupancy query reports %d\n", per_cu); per_cu = 1; }
        (void)hipGetLastError();
        grid = cus;
    }
    if (grid < 0) return;
    Args a{};
    for (int i = 0; i < 24; ++i) a.in[i] = (const float*)d_in[i];
    a.out = (float*)d_out; a.ws = (unsigned char*)d_ws;
    const int nl = 1;
    for (int li = 0; li < nl; ++li) {
        a.ph_lo = (nl == 1) ? 0 : li; a.ph_hi = (nl == 1) ? N_PHASES : li + 1;
        void* kargs[] = {&a};
        const hipError_t le = hipLaunchCooperativeKernel((const void*)mk_fwd, dim3(grid), dim3(NWAVES * 64), kargs, LDS_BYTES, stream);
        if (le != hipSuccess) { fprintf(stderr, "kernel_launch: launch %d failed: %s (grid %d)\n", li, hipGetErrorName(le), grid); break; }
    }
}
```

```cpp
#include <hip/hip_runtime.h>
#include <hip/hip_cooperative_groups.h>
#include <cstdio>
#include <cstdint>
namespace pg8 {
#define PG8_LAS __attribute__((address_space(3)))
typedef unsigned short bf16_t;
typedef short bf16x8 __attribute__((ext_vector_type(8)));
typedef float f32x4 __attribute__((ext_vector_type(4)));
typedef float f32x2 __attribute__((ext_vector_type(2)));
typedef unsigned u32x4 __attribute__((ext_vector_type(4)));
typedef unsigned u32x2 __attribute__((ext_vector_type(2)));
typedef int v8i32 __attribute__((ext_vector_type(8)));
constexpr int BM = 256, BK = 64, HALF = 128, HTB = HALF * BK * 2  , STAGE_BYTES = 8 * HTB, NXCD = 8, WGM = 8;

__host__ __device__ __forceinline__ int lds_byte(int r, int c) { const int st = (r >> 4) * 2 + (c >> 5), rr = r & 15, cc = c & 31, ob = rr * 64 + cc * 2; return st * 1024 + (ob ^ (((ob >> 9) & 1) << 5)); }
__host__ __device__ __forceinline__ void stage_rc(int b, int& R, int& C) { const int st = b / 1024, sb = b % 1024, swz = sb ^ (((sb >> 9) & 1) << 5); R = (st >> 1) * 16 + swz / 64; C = (st & 1) * 32 + (swz % 64) / 2; }
__host__ __device__ __forceinline__ int perm32(int rho) { const int n = rho >> 4, i = rho & 15; return 8 * (i >> 2) + 4 * n + (i & 3); }

struct Unit { int pm, pn, aux; };

__device__ __forceinline__ void dense_tile(int L, int nM, int nN, int& pm, int& pn) {
    const int nwg = nM * nN; int wgid = L;
    { const int q = nwg / NXCD, r = nwg % NXCD, xcd = wgid % NXCD, off = wgid / NXCD; wgid = (xcd < r ? xcd * (q + 1) : r * (q + 1) + (xcd - r) * q) + off; }
    const int nig = WGM * nN, gid = wgid / nig, fm = gid * WGM, gsz = (nM - fm) < WGM ? (nM - fm) : WGM;
    pm = fm + ((wgid % nig) % gsz); pn = (wgid % nig) / gsz;
}

__device__ __forceinline__ unsigned cvt_pk_bf16(float lo, float hi) { unsigned r; asm volatile("v_cvt_pk_bf16_f32 %0, %1, %2" : "=v"(r) : "v"(lo), "v"(hi)); return r; }
__device__ __forceinline__ float bf_lo(unsigned w) { return __uint_as_float(w << 16); }
__device__ __forceinline__ float bf_hi(unsigned w) { return __uint_as_float(w & 0xffff0000u); }
__device__ __forceinline__ float fast_sigmoid(float x) { return __builtin_amdgcn_rcpf(1.0f + __builtin_amdgcn_exp2f(-1.4426950408889634f * x)); }

template <class Epi, class Sched, bool ALIGN_EPI, bool GATHER, bool FP8 = false>
__device__ __forceinline__ void gemm_phase(PG8_LAS unsigned char* lds, const int lda, const int ldb, const Sched& S, const Epi& E, const PG8_LAS int* gtab) {
    const int tid = threadIdx.x, wid = __builtin_amdgcn_readfirstlane(tid >> 6), lane = tid & 63, wr = wid >> 2, wc = wid & 3, fr = lane & 15, fq = lane >> 4;
    unsigned voffA[2], voffB[2]; int RA[2];
#pragma unroll
    for (int i = 0; i < 2; ++i) { int R, C; stage_rc(tid * 16 + i * 8192, R, C); const int Rb = Epi::PERM ? ((R & ~31) + perm32(R & 31)) : R;
        voffA[i] = GATHER ? (unsigned)(C * 2) : (unsigned)(R * lda + C * 2); voffB[i] = (unsigned)(Rb * ldb + C * 2); RA[i] = R; }
    const size_t kstep = (size_t)(BK * 2);
    const size_t hstepA = GATHER ? 0 : (size_t)HALF * lda;
    const size_t hstepB = (size_t)HALF * ldb;
    const unsigned ldsw = (unsigned)wid * 1024u;
    const int aoff = lds_byte(wr * 64 + fr, fq * 8), boff = lds_byte(wc * 32 + fr, fq * 8);
    const int aoff8 = lds_byte(wr * 64 + fr, (fq >> 1) * 32 + (fq & 1) * 16), boff8 = lds_byte(wc * 32 + fr, (fq >> 1) * 32 + (fq & 1) * 16);
    unsigned gC[2][2], gN[2][2];
#define PG8_SA(b, h) (((b) * 2 + (h)) * HTB)
#define PG8_SB(b, h) ((4 + (b) * 2 + (h)) * HTB)
#define PG8_GLDS(gp, bufoff, i) __builtin_amdgcn_global_load_lds((const unsigned*)(gp), (PG8_LAS unsigned*)(lds + (bufoff) + ldsw + (i) * 8192), 16, 0, 0)
#define PG8_STAGE_B(bufoff, gbase) do { _Pragma("unroll") for (int _i = 0; _i < 2; ++_i) PG8_GLDS((const char*)(gbase) + voffB[_i], bufoff, _i); } while (0)
#define PG8_STAGE_A(bufoff, gbase, h, nx) do { _Pragma("unroll") for (int _i = 0; _i < 2; ++_i) { \
        if constexpr (GATHER) PG8_GLDS((const char*)(gbase) + ((nx) ? gN[h][_i] : gC[h][_i]) + voffA[_i], bufoff, _i); \
        else PG8_GLDS((const char*)(gbase) + voffA[_i], bufoff, _i); } } while (0)
#define PG8_LDA(dst, b, h) do { if constexpr (FP8) { _Pragma("unroll") for (int m = 0; m < 4; ++m) dst##8[m] = *(const PG8_LAS v8i32*)(lds + PG8_SA(b, h) + aoff8 + m * 2048); } \
        else { _Pragma("unroll") for (int m = 0; m < 4; ++m) _Pragma("unroll") for (int k = 0; k < 2; ++k) dst[m][k] = *(const PG8_LAS bf16x8*)(lds + PG8_SA(b, h) + aoff + m * 2048 + k * 1024); } } while (0)
#define PG8_LDB(dst, b, h) do { if constexpr (FP8) { _Pragma("unroll") for (int n = 0; n < 2; ++n) dst##8[n] = *(const PG8_LAS v8i32*)(lds + PG8_SB(b, h) + boff8 + n * 2048); } \
        else { _Pragma("unroll") for (int n = 0; n < 2; ++n) _Pragma("unroll") for (int k = 0; k < 2; ++k) dst[n][k] = *(const PG8_LAS bf16x8*)(lds + PG8_SB(b, h) + boff + n * 2048 + k * 1024); } } while (0)
#define PG8_MMA(ai, bj, At, Bt) do { __builtin_amdgcn_s_setprio(1); _Pragma("unroll") for (int m = 0; m < 4; ++m) _Pragma("unroll") for (int n = 0; n < 2; ++n) { \
        if constexpr (FP8) { asm volatile("v_mfma_scale_f32_16x16x128_f8f6f4 %0, %1, %2, %0, %3, %3 op_sel_hi:[0,0,0]" : "+v"(acc[ai][bj][m][n]) : "v"(Bt##8[n]), "v"(At##8[m]), "v"(scale1)); } \
        else { _Pragma("unroll") for (int k = 0; k < 2; ++k) acc[ai][bj][m][n] = __builtin_amdgcn_mfma_f32_16x16x32_bf16(Bt[n][k], At[m][k], acc[ai][bj][m][n], 0, 0, 0); } } \
        __builtin_amdgcn_s_setprio(0); } while (0)
#define PG8_WAIT_V(n) asm volatile("s_waitcnt vmcnt(" #n ")" ::: "memory")
#define PG8_WAIT_L(n) asm volatile("s_waitcnt lgkmcnt(" #n ")" ::: "memory")
#define PG8_BAR __builtin_amdgcn_s_barrier()
#define PG8_SCHED __builtin_amdgcn_sched_barrier(0)
#define PG8_GOFF(dst, ui_) do { if constexpr (GATHER) { _Pragma("unroll") for (int _h = 0; _h < 2; ++_h) _Pragma("unroll") for (int _i = 0; _i < 2; ++_i) \
        dst[_h][_i] = (unsigned)gtab[(ui_) * 256 + _h * HALF + RA[_i]] * (unsigned)lda; } } while (0)
    Unit cur, nxt; int ui = 0;
    if (!S.next(0, cur)) return;
    f32x4 acc[2][2][4][2];
#pragma unroll
    for (int a = 0; a < 2; ++a)
#pragma unroll
        for (int b = 0; b < 2; ++b)
#pragma unroll
            for (int m = 0; m < 4; ++m)
#pragma unroll
                for (int n = 0; n < 2; ++n) acc[a][b][m][n] = (f32x4){0.f, 0.f, 0.f, 0.f};
    bf16x8 At[4][2], B0[2][2], B1[2][2]; v8i32 At8[4], B08[2], B18[2];
    int scale1 = 0x7f7f7f7f; asm volatile("" : "+v"(scale1));
    const char* cA = S.a_ptr(cur); const char* cB = S.b_ptr(cur);
    PG8_GOFF(gC, 0);
#pragma unroll
    for (int _h = 0; _h < 2; ++_h)
#pragma unroll
        for (int _i = 0; _i < 2; ++_i) gN[_h][_i] = gC[_h][_i];
    PG8_STAGE_B(PG8_SB(0, 0), cB); PG8_STAGE_B(PG8_SB(0, 1), cB + hstepB); PG8_STAGE_A(PG8_SA(0, 0), cA, 0, false); PG8_STAGE_A(PG8_SA(0, 1), cA + hstepA, 1, false);
    if (wr == 1) PG8_BAR;
    PG8_WAIT_V(2); PG8_BAR;
    PG8_STAGE_B(PG8_SB(1, 0), cB + kstep); PG8_STAGE_A(PG8_SA(1, 0), cA + kstep, 0, false); PG8_STAGE_B(PG8_SB(1, 1), cB + hstepB + kstep);
    PG8_WAIT_V(6); PG8_BAR;
    for (;;) {
        const bool has_next = S.next(ui + 1, nxt);
        const int nt = S.ntiles(cur);
        const char* nA = has_next ? S.a_ptr(nxt) : cA; const char* nB = has_next ? S.b_ptr(nxt) : cB;
        if (has_next) PG8_GOFF(gN, ui + 1);
#pragma unroll 1
        for (int t = 0; t < nt; t += 2) {
            const bool last = (t == nt - 2);
            const char* a1 = cA + (size_t)(t + 1) * kstep;
            const char* a2 = last ? nA : cA + (size_t)(t + 2) * kstep; const char* b2 = last ? nB : cB + (size_t)(t + 2) * kstep;
            const char* a3 = a2 + kstep; const char* b3 = b2 + kstep;
            PG8_LDB(B0, 0, 0); PG8_LDB(B1, 0, 1); PG8_SCHED; PG8_LDA(At, 0, 0); PG8_STAGE_A(PG8_SA(1, 1), a1 + hstepA, 1, false);
            PG8_WAIT_V(8); PG8_WAIT_L(0); PG8_BAR; PG8_MMA(0, 0, At, B0); PG8_MMA(0, 1, At, B1); PG8_BAR; PG8_SCHED;
            PG8_LDA(At, 0, 1); PG8_STAGE_B(PG8_SB(0, 0), b2); PG8_STAGE_B(PG8_SB(0, 1), b2 + hstepB); PG8_STAGE_A(PG8_SA(0, 0), a2, 0, last);
            PG8_WAIT_V(8); PG8_WAIT_L(0); PG8_BAR; PG8_MMA(1, 0, At, B0); PG8_MMA(1, 1, At, B1); PG8_BAR; PG8_SCHED;
            PG8_LDB(B0, 1, 0); PG8_LDB(B1, 1, 1); PG8_SCHED; PG8_LDA(At, 1, 0); PG8_STAGE_A(PG8_SA(0, 1), a2 + hstepA, 1, last);
            PG8_WAIT_V(8); PG8_WAIT_L(0); PG8_BAR; PG8_MMA(0, 0, At, B0); PG8_MMA(0, 1, At, B1); PG8_BAR; PG8_SCHED;
            PG8_LDA(At, 1, 1); PG8_STAGE_B(PG8_SB(1, 0), b3); PG8_STAGE_B(PG8_SB(1, 1), b3 + hstepB); PG8_STAGE_A(PG8_SA(1, 0), a3, 0, last);
            PG8_WAIT_V(8); PG8_WAIT_L(0); PG8_BAR; PG8_MMA(1, 0, At, B0); PG8_MMA(1, 1, At, B1); PG8_BAR; PG8_SCHED;
        }
        if constexpr (ALIGN_EPI) { if (wr == 0) PG8_BAR; }
        if constexpr (FP8) asm volatile("s_nop 15\n\ts_nop 15" ::: "memory");
        { int fr_ = fr, fq_ = fq; asm volatile("" : "+v"(fr_), "+v"(fq_));
          E(acc, cur, wr, wc, fr_, fq_); }
        if (!E.keep(cur)) {
#pragma unroll
        for (int a = 0; a < 2; ++a)
#pragma unroll
            for (int b = 0; b < 2; ++b)
#pragma unroll
                for (int m = 0; m < 4; ++m)
#pragma unroll
                    for (int n = 0; n < 2; ++n) acc[a][b][m][n] = (f32x4){0.f, 0.f, 0.f, 0.f};
        }
        if (!has_next) break;
        cur = nxt; cA = nA; cB = nB; ++ui;
#pragma unroll
        for (int _h = 0; _h < 2; ++_h)
#pragma unroll
            for (int _i = 0; _i < 2; ++_i) gC[_h][_i] = gN[_h][_i];
        if constexpr (ALIGN_EPI) { if (wr == 1) PG8_BAR; }
    }
    PG8_WAIT_V(0);
    if constexpr (!ALIGN_EPI) { if (wr == 0) PG8_BAR; }
    PG8_BAR;
#undef PG8_SA
#undef PG8_SB
#undef PG8_GLDS
#undef PG8_STAGE_A
#undef PG8_STAGE_B
#undef PG8_LDA
#undef PG8_LDB
#undef PG8_MMA
#undef PG8_WAIT_V
#undef PG8_WAIT_L
#undef PG8_BAR
#undef PG8_SCHED
#undef PG8_GOFF
}
}
#include <hip/hip_bf16.h>
#include <cmath>
namespace attn_body {
using bf16=__hip_bfloat16;
using bf16x8=__attribute__((ext_vector_type(8)))short;
using s16x4=__attribute__((ext_vector_type(4)))short;
using f32x16=__attribute__((ext_vector_type(16)))float;
using u32x4=__attribute__((ext_vector_type(4)))unsigned;
constexpr int BATCH=8,NHEAD=8,NKV=2,SEQ=4096,D=64;
constexpr int QP=512,KVP=256,OP=1536;
constexpr int NW=8,QBLK=32,QB=QBLK*NW,KVBLK=64,NQB=SEQ/QB;
constexpr int ATTN_UNIT_ROWS=QB;
__device__ __forceinline__ int crow(int r,int hi){return (r&3)+8*(r>>2)+4*hi;}
#define SBAR() __builtin_amdgcn_sched_barrier(0)
constexpr int NSLOT=3, SLOTB=8192;
constexpr int LDS_K=0, LDS_V=NSLOT*SLOTB, LDS_WS=2*NSLOT*SLOTB, LDS_OST=LDS_WS+NW*64*4, LDS_BYTES=LDS_OST+NW*4096;
constexpr float C2=0.125f*1.4426950408889634f;
__device__ __forceinline__ void glds16(const void*gsrc,unsigned lds_dst){unsigned keep;
  asm volatile("s_mov_b32 %0, m0\n\ts_mov_b32 m0, %2\n\ts_nop 0\n\tglobal_load_lds_dwordx4 %1, off\n\ts_mov_b32 m0, %0":"=&s"(keep):"v"(gsrc),"s"(lds_dst):"memory");}
__device__ __forceinline__ float max3f(float a,float b,float c){float r;asm("v_max3_f32 %0, %1, %2, %3":"=v"(r):"v"(a),"v"(b),"v"(c));return r;}
__device__ __forceinline__ float max2f(float a,float b){float r;asm("v_max_f32_e32 %0, %1, %2":"=v"(r):"v"(a),"v"(b));return r;}
__device__ __forceinline__ float fadd_s(float a,float b){float r;asm("v_add_f32_e32 %0, %1, %2":"=v"(r):"v"(a),"v"(b));return r;}
__device__ __forceinline__ float fsub_s(float a,float b){float r;asm("v_sub_f32_e32 %0, %1, %2":"=v"(r):"v"(a),"v"(b));return r;}
typedef float f32x2_t __attribute__((ext_vector_type(2))); typedef __bf16 bf16x2_t __attribute__((ext_vector_type(2)));
__device__ __forceinline__ unsigned cvtpk_s(float lo,float hi){f32x2_t v={lo,hi};bf16x2_t b=__builtin_convertvector(v,bf16x2_t);return __builtin_bit_cast(unsigned,b);}
#define WAIT_BAR(N) asm volatile("s_waitcnt vmcnt(" #N ") lgkmcnt(0)\n\ts_barrier":::"memory")

__device__ __forceinline__ void qkt(f32x16&p0,f32x16&p1,const char*Kslot,const bf16x8*qr,const f32x16&negm,int r32,int hi){
  const char*kb=Kslot+hi*1024+r32*16;
  #pragma unroll
  for(int d0=0;d0<4;++d0){
    const bf16x8 b0=*reinterpret_cast<const bf16x8*>(kb+d0*2048);
    const bf16x8 b1=*reinterpret_cast<const bf16x8*>(kb+d0*2048+512);
    if(d0==0){p0=__builtin_amdgcn_mfma_f32_32x32x16_bf16(b0,qr[0],negm,0,0,0);p1=__builtin_amdgcn_mfma_f32_32x32x16_bf16(b1,qr[0],negm,0,0,0);}
    else{p0=__builtin_amdgcn_mfma_f32_32x32x16_bf16(b0,qr[d0],p0,0,0,0);p1=__builtin_amdgcn_mfma_f32_32x32x16_bf16(b1,qr[d0],p1,0,0,0);}}
}
typedef __attribute__((address_space(3))) const char* lds_cptr;
typedef short v4i16_t __attribute__((ext_vector_type(4)));
__device__ __forceinline__ void kload8(bf16x8*kf,lds_cptr kp){
  kf[0]=*(const __attribute__((address_space(3))) bf16x8*)(kp);      kf[1]=*(const __attribute__((address_space(3))) bf16x8*)(kp+512);
  kf[2]=*(const __attribute__((address_space(3))) bf16x8*)(kp+2048); kf[3]=*(const __attribute__((address_space(3))) bf16x8*)(kp+2560);
  kf[4]=*(const __attribute__((address_space(3))) bf16x8*)(kp+4096); kf[5]=*(const __attribute__((address_space(3))) bf16x8*)(kp+4608);
  kf[6]=*(const __attribute__((address_space(3))) bf16x8*)(kp+6144); kf[7]=*(const __attribute__((address_space(3))) bf16x8*)(kp+6656);
}
__device__ __forceinline__ void kload2(bf16x8*kf,lds_cptr kp,int j){ kf[2*j]=*(const __attribute__((address_space(3))) bf16x8*)(kp+j*2048); kf[2*j+1]=*(const __attribute__((address_space(3))) bf16x8*)(kp+j*2048+512); }
__device__ __forceinline__ s16x4 vtr(lds_cptr p){ return __builtin_bit_cast(s16x4,__builtin_amdgcn_ds_read_tr16_b64_v4i16((__attribute__((address_space(3))) v4i16_t*)p)); }
__device__ __forceinline__ float rowmax(const f32x16&p0,const f32x16&p1){
  float a=max3f(p0[0],p0[1],p1[0]),b=max3f(p0[2],p0[3],p1[1]);a=max3f(a,p1[2],p1[3]);
  #pragma unroll
  for(int r=4;r<16;r+=4){a=max3f(a,p0[r],p0[r+1]);b=max3f(b,p0[r+2],p0[r+3]);a=max3f(a,p1[r],p1[r+1]);b=max3f(b,p1[r+2],p1[r+3]);}
  const float m=max2f(a,b);
  auto rr=__builtin_amdgcn_permlane32_swap(__float_as_uint(m),__float_as_uint(m),false,false);
  return max2f(__uint_as_float(rr[0]),__uint_as_float(rr[1]));
}
__device__ __forceinline__ void pv(f32x16*o,int vb,bf16x8 pa0,bf16x8 pa1,bf16x8 pa2,bf16x8 pa3){
  #pragma unroll
  for(int d0=0;d0<2;++d0){s16x4 lo[4],hi[4];
    #pragma unroll
    for(int ks=0;ks<4;++ks){
      asm volatile("ds_read_b64_tr_b16 %0,%1 offset:%c2":"=&v"(lo[ks]):"v"(vb),"i"(d0*4096+ks*1024):"memory");
      asm volatile("ds_read_b64_tr_b16 %0,%1 offset:%c2":"=&v"(hi[ks]):"v"(vb),"i"(d0*4096+ks*1024+512):"memory");}
    asm volatile("s_waitcnt lgkmcnt(0)":::"memory");SBAR();
    #define PK(k) (bf16x8){lo[k][0],lo[k][1],lo[k][2],lo[k][3],hi[k][0],hi[k][1],hi[k][2],hi[k][3]}
    o[d0]=__builtin_amdgcn_mfma_f32_32x32x16_bf16(pa0,PK(0),o[d0],0,0,0);
    o[d0]=__builtin_amdgcn_mfma_f32_32x32x16_bf16(pa1,PK(1),o[d0],0,0,0);
    o[d0]=__builtin_amdgcn_mfma_f32_32x32x16_bf16(pa2,PK(2),o[d0],0,0,0);
    o[d0]=__builtin_amdgcn_mfma_f32_32x32x16_bf16(pa3,PK(3),o[d0],0,0,0);
    #undef PK
  }
}

#ifndef ATTN_STORE16
#define ATTN_STORE16(p,v) (*(u32x4*)(p)=(v))
#endif
template<int THRL> __device__ __forceinline__ void attn_unit(int b,int h,int qb,const bf16*Q,const bf16*__restrict__ K,const bf16*__restrict__ V,bf16*O,char*shm){
  const int tid=threadIdx.x,lane=tid&63,r32=lane&31,hi=lane>>5; const int wid=__builtin_amdgcn_readfirstlane(tid>>6);
  const long rowbase=(long)b*SEQ; const int q0=qb*QB;
  const bf16*Qw=Q+(rowbase+q0+wid*QBLK)*QP+h*D; const int kvh=h/(NHEAD/NKV);
  const bf16*Kh=K+rowbase*KVP+kvh*D,*Vh=V+rowbase*KVP+kvh*D;
  const unsigned lds0=(unsigned)(uintptr_t)shm;
  float*wsf=(float*)(shm+LDS_WS)+wid*64;
  const bf16*ksrc=Kh+(long)lane*KVP+wid*8;
  const bf16*vsrc=Vh+(long)(16*(wid&3)+(lane>>2))*KVP+(wid>>2)*32+(lane&3)*8;
  const unsigned kdst=lds0+LDS_K+wid*1024, vdst=lds0+LDS_V+wid*1024;
  #define DMA_K(t,slot) glds16(ksrc+(long)(t)*KVBLK*KVP,(unsigned)__builtin_amdgcn_readfirstlane(kdst+(slot)))
  #define DMA_V(t,slot) glds16(vsrc+(long)(t)*KVBLK*KVP,(unsigned)__builtin_amdgcn_readfirstlane(vdst+(slot)))
  const int vb0=(int)(lds0+LDS_V)+((lane>>4)&1)*32+(lane&3)*8+(4*hi+((lane&15)>>2))*64;
  const char*Kbase=shm+LDS_K; bf16x8 kf[8];
  const lds_cptr shm3=(lds_cptr)shm; const lds_cptr kp0=shm3+LDS_K+hi*1024+r32*16; const lds_cptr vp0=shm3+LDS_V+((lane>>4)&1)*32+(lane&3)*8+(4*hi+((lane&15)>>2))*64;
  constexpr int NT=SEQ/KVBLK;
  DMA_K(0,0);DMA_V(0,0);DMA_K(1,SLOTB);
  bf16x8 qr[4];
  #pragma unroll
  for(int d0=0;d0<4;++d0)qr[d0]=*reinterpret_cast<const bf16x8*>(&Qw[(long)r32*QP+d0*16+hi*8]);
  float mhat=0.f,l_reg=0.f;f32x16 o[2];o[0]=f32x16{};o[1]=f32x16{};f32x16 negm=f32x16{};asm volatile("":"+v"(negm));
  #define CMASK(P0,P1,t) do{}while(0)
  bool resc=false;
  #define START(P0,P1) do{ const float rm=rowmax(P0,P1); resc=false; \
    { const float dl=rm; mhat=fadd_s(mhat,dl); \
      _Pragma("unroll") for(int r=0;r<16;++r){P0[r]=fsub_s(P0[r],dl);P1[r]=fsub_s(P1[r],dl);} \
      _Pragma("unroll") for(int r=0;r<16;++r)negm[r]=-mhat; asm volatile("":"+v"(negm)); } \
    _Pragma("unroll") for(int r=0;r<16;++r)P0[r]=__builtin_amdgcn_exp2f(P0[r]); }while(0)
  #define RESC() do{ if(resc){ asm volatile("s_waitcnt lgkmcnt(0)":::"memory"); \
      _Pragma("unroll") for(int d_=0;d_<2;++d_) _Pragma("unroll") for(int r=0;r<16;++r)o[d_][r]*=wsf[crow(r,hi)]; } }while(0)
  f32x16 pA0,pA1,pB0,pB1;
  int sl_prev=0,sl_cur=0,sl_next=SLOTB;
  #define ROT() do{sl_prev=sl_cur;sl_cur=sl_next;sl_next=(sl_next==(NSLOT-1)*SLOTB)?0:sl_next+SLOTB;}while(0)
  DMA_K(2,2*SLOTB);
  WAIT_BAR(3);
  qkt(pA0,pA1,Kbase,qr,negm,r32,hi);asm volatile("s_nop 15\n\ts_nop 7":"+v"(pA0),"+v"(pA1));CMASK(pA0,pA1,0);
  START(pA0,pA1);
  _Pragma("unroll") for(int r=0;r<16;++r)pA1[r]=__builtin_amdgcn_exp2f(pA1[r]);
  WAIT_BAR(0);
  DMA_K(3,0);DMA_V(1,SLOTB);
  ROT();
  kload8(kf,kp0+sl_cur);
  WAIT_BAR(2);
  s16x4 vlo[8],vhi[8]; u32x4 pw0,pw1,pw2,pw3;
  #define PKW(P,B) cvtpk_s(P[B],P[B+1])
  #define PAF(k) __builtin_bit_cast(bf16x8,pw##k)
  #define VFR(i) (bf16x8){vlo[i][0],vlo[i][1],vlo[i][2],vlo[i][3],vhi[i][0],vhi[i][1],vhi[i][2],vhi[i][3]}
  #define PIN(x) asm volatile("":"+v"(x))
  #define MX3(a,b,c) __builtin_fmaxf(__builtin_fmaxf((a),(b)),(c))
  #define GAPA(MF,A0,A1,A2,A3,W0,W1,PW) do{ MF; sacc+=A0; sacc+=A1; sacc+=A2; sacc+=A3; PIN(sacc); W0; W1; PIN(PW); SBAR(); }while(0)
  #define EX(v) __builtin_amdgcn_exp2f(v)
  #define GAPB(MF,X,B) do{ MF; X[B]=EX(X[B]); X[B+1]=EX(X[B+1]); X[B+2]=EX(X[B+2]); X[B+3]=EX(X[B+3]); PIN(X); SBAR(); }while(0)
  #define VRD(i) do{ vlo[i]=vtr(vp_+(((i)>>2)*4096+((i)&3)*1024)); vhi[i]=vtr(vp_+(((i)>>2)*4096+((i)&3)*1024+512)); }while(0)
  #define KRD(G,j) do{ if(G){ kload2(kf,kp0+sl_next,j); SBAR(); } }while(0)
  #define STEP(C0,C1,P0,P1,t,GK,GV,GL) do{ SBAR(); \
    const lds_cptr vp_=vp0+sl_prev; \
    VRD(0); SBAR(); float sacc=(P0[0]+P0[1]); \
    GAPA(C0=__builtin_amdgcn_mfma_f32_32x32x16_bf16(kf[0],qr[0],negm,0,0,0), P0[2],P0[3],P0[4],P0[5],     pw0[0]=PKW(P0,0), pw0[1]=PKW(P0,2), pw0); \
    VRD(4); SBAR(); GAPA(C1=__builtin_amdgcn_mfma_f32_32x32x16_bf16(kf[1],qr[0],negm,0,0,0), P0[6],P0[7],P0[8],P0[9],     pw0[2]=PKW(P0,4), pw0[3]=PKW(P0,6), pw0); \
    VRD(1); SBAR(); GAPA(C0=__builtin_amdgcn_mfma_f32_32x32x16_bf16(kf[2],qr[1],C0,0,0,0),   P0[10],P0[11],P0[12],P0[13], pw1[0]=PKW(P0,8), pw1[1]=PKW(P0,10), pw1); \
    VRD(5); SBAR(); GAPA(C1=__builtin_amdgcn_mfma_f32_32x32x16_bf16(kf[3],qr[1],C1,0,0,0),   P0[14],P0[15],P1[0],P1[1],   pw1[2]=PKW(P0,12),pw1[3]=PKW(P0,14), pw1); \
    VRD(2); SBAR(); GAPA(C0=__builtin_amdgcn_mfma_f32_32x32x16_bf16(kf[4],qr[2],C0,0,0,0),   P1[2],P1[3],P1[4],P1[5],     pw2[0]=PKW(P1,0), pw2[1]=PKW(P1,2), pw2); \
    VRD(6); SBAR(); GAPA(C1=__builtin_amdgcn_mfma_f32_32x32x16_bf16(kf[5],qr[2],C1,0,0,0),   P1[6],P1[7],P1[8],P1[9],     pw2[2]=PKW(P1,4), pw2[3]=PKW(P1,6), pw2); \
    VRD(3); SBAR(); GAPA(C0=__builtin_amdgcn_mfma_f32_32x32x16_bf16(kf[6],qr[3],C0,0,0,0),   P1[10],P1[11],P1[12],P1[13], pw3[0]=PKW(P1,8), pw3[1]=PKW(P1,10), pw3); \
    VRD(7); SBAR(); GAPA(C1=__builtin_amdgcn_mfma_f32_32x32x16_bf16(kf[7],qr[3],C1,0,0,0),   P1[14],P1[15],0.f,0.f,       pw3[2]=PKW(P1,12),pw3[3]=PKW(P1,14), pw3); \
    l_reg+=sacc; \
    if(GK){DMA_K((t)+3,sl_cur);} if(GV){DMA_V((t)+1,sl_next);} \
    CMASK(C0,C1,t); \
    { float a=MX3(C0[0],C0[1],C1[0]),b=MX3(C0[2],C0[3],C1[1]); a=MX3(a,C1[2],C1[3]); \
      _Pragma("unroll") for(int r=4;r<16;r+=4){a=MX3(a,C0[r],C0[r+1]);b=MX3(b,C0[r+2],C0[r+3]);a=MX3(a,C1[r],C1[r+1]);b=MX3(b,C1[r+2],C1[r+3]);} \
      float rm=__builtin_fmaxf(a,b); { auto rr=__builtin_amdgcn_permlane32_swap(__float_as_uint(rm),__float_as_uint(rm),false,false); rm=__builtin_fmaxf(__uint_as_float(rr[0]),__uint_as_float(rr[1])); } \
      resc=false; \
      if(__builtin_expect(__any(rm>(float)THRL),0)){ const float dl=__builtin_fmaxf(rm,0.f); mhat+=dl; \
        _Pragma("unroll") for(int r=0;r<16;++r){C0[r]-=dl;C1[r]-=dl;} \
        _Pragma("unroll") for(int r=0;r<16;++r)negm[r]=-mhat; asm volatile("":"+v"(negm)); \
        const float f=__builtin_amdgcn_exp2f(-dl); l_reg*=f; if(hi==0)wsf[r32]=f; resc=true; } } \
    SBAR(); \
    GAPB(o[0]=__builtin_amdgcn_mfma_f32_32x32x16_bf16(PAF(0),VFR(0),o[0],0,0,0), C0,0); \
    GAPB(o[1]=__builtin_amdgcn_mfma_f32_32x32x16_bf16(PAF(0),VFR(4),o[1],0,0,0), C0,4); \
    KRD(GL,0); GAPB(o[0]=__builtin_amdgcn_mfma_f32_32x32x16_bf16(PAF(1),VFR(1),o[0],0,0,0), C0,8); \
    KRD(GL,1); GAPB(o[1]=__builtin_amdgcn_mfma_f32_32x32x16_bf16(PAF(1),VFR(5),o[1],0,0,0), C0,12); \
    KRD(GL,2); GAPB(o[0]=__builtin_amdgcn_mfma_f32_32x32x16_bf16(PAF(2),VFR(2),o[0],0,0,0), C1,0); \
    KRD(GL,3); GAPB(o[1]=__builtin_amdgcn_mfma_f32_32x32x16_bf16(PAF(2),VFR(6),o[1],0,0,0), C1,4); \
    GAPB(o[0]=__builtin_amdgcn_mfma_f32_32x32x16_bf16(PAF(3),VFR(3),o[0],0,0,0), C1,8); \
    GAPB(o[1]=__builtin_amdgcn_mfma_f32_32x32x16_bf16(PAF(3),VFR(7),o[1],0,0,0), C1,12); \
    }while(0)
  int t=1;
  for(;t+5<NT;t+=2){
    STEP(pB0,pB1,pA0,pA1,t,true,true,true);     WAIT_BAR(2); RESC(); ROT();
    STEP(pA0,pA1,pB0,pB1,t+1,true,true,true);   WAIT_BAR(2); RESC(); ROT();
  }
  #define ENDW(tt) do{ if((tt)+3<NT){WAIT_BAR(2);} else if((tt)+2<NT){WAIT_BAR(1);} else {WAIT_BAR(0);} }while(0)
  for(;t+1<NT;t+=2){
    STEP(pB0,pB1,pA0,pA1,t,(t+3<NT),(t+1<NT),(t+1<NT));       ENDW(t);   RESC(); ROT();
    STEP(pA0,pA1,pB0,pB1,t+1,(t+4<NT),(t+2<NT),(t+2<NT));     ENDW(t+1); RESC(); ROT();
  }
  STEP(pB0,pB1,pA0,pA1,NT-1,false,false,false); RESC();
  { float sacc=pB0[0]+pB0[1]; _Pragma("unroll") for(int r=2;r<16;++r)sacc+=pB0[r]; _Pragma("unroll") for(int r=0;r<16;++r)sacc+=pB1[r]; l_reg+=sacc;
    pw0=(u32x4){PKW(pB0,0),PKW(pB0,2),PKW(pB0,4),PKW(pB0,6)};pw1=(u32x4){PKW(pB0,8),PKW(pB0,10),PKW(pB0,12),PKW(pB0,14)};pw2=(u32x4){PKW(pB1,0),PKW(pB1,2),PKW(pB1,4),PKW(pB1,6)};pw3=(u32x4){PKW(pB1,8),PKW(pB1,10),PKW(pB1,12),PKW(pB1,14)};
    SBAR(); pv(o,vb0+sl_cur,PAF(0),PAF(1),PAF(2),PAF(3)); }
  #undef PKW
  #undef PAF
  #undef VFR
  #undef PIN
  #undef MX3
  #undef GAPA
  #undef GAPB
  #undef EX
  #undef VRD
  #undef KRD
  #undef STEP
  #undef ENDW
  {auto rr=__builtin_amdgcn_permlane32_swap(__float_as_uint(l_reg),__float_as_uint(l_reg),false,false);l_reg=__uint_as_float(rr[0])+__uint_as_float(rr[1]);}
  if(hi==0)wsf[32+r32]=l_reg;asm volatile("s_waitcnt lgkmcnt(0)":::"memory");
  float rli[16];
  #pragma unroll
  for(int r=0;r<16;++r)rli[r]=__builtin_amdgcn_rcpf(wsf[32+crow(r,hi)]);
  bf16*Ow=O+(rowbase+q0+wid*QBLK)*OP+h*D;
  { bf16*stg=(bf16*)(shm+LDS_OST)+wid*2048;
    #pragma unroll
    for(int r=0;r<16;++r){const int orow=crow(r,hi);
      #pragma unroll
      for(int d0=0;d0<2;++d0)stg[orow*64+d0*32+r32]=__float2bfloat16(o[d0][r]*rli[r]);}
    asm volatile("s_waitcnt lgkmcnt(0)":::"memory");
    #pragma unroll
    for(int i=0;i<4;++i){const int row=i*8+(lane>>3),ch=lane&7; const u32x4 v=*(const u32x4*)(stg+row*64+ch*8); ATTN_STORE16(Ow+(long)row*OP+ch*8,v);} }
  asm volatile("s_waitcnt lgkmcnt(0)\n\ts_barrier":::"memory");
  #undef DMA_K
  #undef DMA_V
  #undef CMASK
  #undef START
  #undef RESC
  #undef ROT
}
constexpr int ATTN_LDS_BYTES=LDS_BYTES;
struct AttnTensors { const bf16* Q; const bf16* K; const bf16* V; bf16* O; };
struct AttnUnit { int bh; int qb; };
struct StaticOrder {
  int vcu,G;
  __device__ __forceinline__ explicit StaticOrder(int grid,int v):vcu(v),G(grid){}
  __device__ __forceinline__ bool next(int i,AttnUnit&u)const{ const int L=i*G+vcu; if(L>=BATCH*NHEAD*NQB)return false;
    const int pairhalf=L>>5,l=L&31; const int pair=pairhalf>>1,uu=l+32*(pairhalf&1); const int b=pair>>1,kvh=pair&1; u.bh=b*NHEAD+kvh*(NHEAD/NKV)+(uu>>4); u.qb=uu&15; return true; }
  __device__ __forceinline__ void a_ready(const AttnUnit&)const{}
  __device__ __forceinline__ void done(const AttnUnit&)const{}
};
template<class Sched,int THRL=8> __device__ __forceinline__ void attn_phase(char*lds,const AttnTensors&T,const Sched&S){
  AttnUnit u;
  for(int i=0;S.next(i,u);++i){ S.a_ready(u); attn_unit<THRL>(u.bh/NHEAD,u.bh%NHEAD,u.qb,T.Q,T.K,T.V,T.O,lds); S.done(u); }
}
#undef SBAR
#undef WAIT_BAR
}
namespace cg = cooperative_groups;
constexpr int NWAVES = 8;
constexpr int BATCH = 8, SEQ = 4096, D = 1024, T = BATCH * SEQ;
constexpr int HD = 64, NQH = 8, NKVH = 2, QW = NQH * HD, KVW = NKVH * HD;
constexpr int LRU_W = 1024, LRU_NB = 16, LRU_BW = 64;
constexpr int INW = QW + 2 * KVW + 2 * LRU_W + 2 * D;
constexpr int NE = 32, TOPK = 4, DFF = 1024;
constexpr float NORM_EPS = 1e-6f;
constexpr int ARW = QW + LRU_W;
constexpr int ECAP = T;
constexpr int MAXBLK = (T * TOPK) / 256 + NE;
constexpr int MAX_GUNITS = 24;

constexpr size_t MiB = 1u << 20;
constexpr size_t WS_CTL = 0, CTL_ZERO_BYTES = 64 * 1024;
constexpr size_t WS_TOKL = 1 * MiB, WS_GATEL = 5 * MiB, WS_TOKREC = 9 * MiB;
constexpr size_t WS_WIN = 10 * MiB, WS_WCAT = 20 * MiB, WS_WO = 23 * MiB, WS_WGU = 26 * MiB, WS_WD = 154 * MiB;
constexpr size_t WS_XN = 218 * MiB;
constexpr size_t WS_Q = 282 * MiB, WS_KV = 314 * MiB, WS_AR = 330 * MiB, WS_XR = 426 * MiB, WS_YR = 490 * MiB, WS_GL = 554 * MiB;
constexpr size_t WS_MERGED = WS_XR;
constexpr size_t WS_ACT = 282 * MiB, WS_Y = 554 * MiB, WS_END = 826 * MiB;
static_assert(WS_ACT + (size_t)MAXBLK * 256 * DFF * 2 <= WS_Y && WS_Y + (size_t)MAXBLK * 256 * D * 2 <= WS_END, "ws map");
constexpr int CW_CNT = 0;
constexpr int CW_BAR = 1024;

constexpr int RING_BYTES = 131072;
constexpr int GTAB_OFF = RING_BYTES;
constexpr int MISC_OFF = GTAB_OFF + MAX_GUNITS * 1024;
constexpr int LDS_BYTES = MISC_OFF + 1024;
static_assert(LDS_BYTES <= 163840, "LDS");

#define GAS __attribute__((address_space(1)))
#define LAS __attribute__((address_space(3)))
typedef unsigned short bf16;
typedef unsigned v4u __attribute__((ext_vector_type(4)));
typedef unsigned v2u __attribute__((ext_vector_type(2)));
typedef float f32x4 __attribute__((ext_vector_type(4)));
typedef float f32x2 __attribute__((ext_vector_type(2)));
typedef short bf16x8 __attribute__((ext_vector_type(8)));
#define LDS_WAIT() asm volatile("s_waitcnt lgkmcnt(0)" ::: "memory")
__device__ __forceinline__ unsigned f2bf(float f) { unsigned u = __builtin_bit_cast(unsigned, f); return (u + 0x7fffu + ((u >> 16) & 1u)) >> 16; }
__device__ __forceinline__ unsigned pk2(float lo, float hi) { return f2bf(lo) | (f2bf(hi) << 16); }
__device__ __forceinline__ float bflo(unsigned w) { return __uint_as_float(w << 16); }
__device__ __forceinline__ float bfhi(unsigned w) { return __uint_as_float(w & 0xffff0000u); }
__device__ __forceinline__ float wave_sum(float v) {
#pragma unroll
    for (int o = 1; o < 64; o <<= 1) v += __shfl_xor(v, o);
    return v;
}
__device__ __forceinline__ float sigmoidf_fast(float x) { return __builtin_amdgcn_rcpf(1.0f + __builtin_amdgcn_exp2f(-1.4426950408889634f * x)); }

constexpr float WSCALE = 32.0f, WSCALE_INV = 1.0f / 32.0f;
struct Frame {
    LAS unsigned char* lds;
    int tid, lane, wave, vcu, G;
    const float* const* in;
    float* out; unsigned char* ws;
};
enum { I_X = 0, I_N1G, I_WIN, I_BIN, I_QNG, I_KNG, I_CONVW, I_CONVB, I_WA, I_BA, I_WI, I_BI, I_LAM, I_WAO, I_WLO, I_WOUT, I_N2G, I_WR, I_BR, I_WGU, I_BGU, I_WDN, I_BDN, I_FG };

__device__ __forceinline__ void p0_transpose_item(const float* W, int N, bf16* WT, int ldt, int coloff, int rowbase, LAS float* scr, int kb, int nb, int lane) {
    const int k0 = 64 * kb, n0 = 32 * nb;
#pragma unroll 8
    for (int i = 0; i < 32; ++i) { const int kk = 2 * i + (lane >> 5); scr[kk * 33 + (lane & 31)] = W[(size_t)(k0 + kk) * N + n0 + (lane & 31)]; }
    LDS_WAIT(); asm volatile("" ::: "memory");
    const int c = lane & 7;
#pragma unroll
    for (int j = 0; j < 4; ++j) { const int n = (lane >> 3) + 8 * j; const LAS float* s = scr + (8 * c) * 33 + n;
        v4u o; o.x = pk2(s[0 * 33], s[1 * 33]); o.y = pk2(s[2 * 33], s[3 * 33]); o.z = pk2(s[4 * 33], s[5 * 33]); o.w = pk2(s[6 * 33], s[7 * 33]);
        *(GAS v4u*)(WT + (size_t)(rowbase + n) * ldt + coloff + k0 + 8 * c) = o; }
    LDS_WAIT(); asm volatile("" ::: "memory");
}
__device__ __forceinline__ void p0_transpose_item_fp8(const float* W, int N, unsigned char* WT, int ldt, int rowbase, LAS float* scr, int kb, int nb, int lane) {
    const int k0 = 64 * kb, n0 = 32 * nb;
#pragma unroll 8
    for (int i = 0; i < 32; ++i) { const int kk = 2 * i + (lane >> 5); scr[kk * 33 + (lane & 31)] = W[(size_t)(k0 + kk) * N + n0 + (lane & 31)]; }
    LDS_WAIT(); asm volatile("" ::: "memory");
    const int c = lane & 7;
#pragma unroll
    for (int j = 0; j < 4; ++j) { const int n = (lane >> 3) + 8 * j; const LAS float* s = scr + (8 * c) * 33 + n;
        int lo = 0, hi = 0;
        lo = __builtin_amdgcn_cvt_pk_fp8_f32(s[0 * 33] * WSCALE, s[1 * 33] * WSCALE, lo, false); lo = __builtin_amdgcn_cvt_pk_fp8_f32(s[2 * 33] * WSCALE, s[3 * 33] * WSCALE, lo, true);
        hi = __builtin_amdgcn_cvt_pk_fp8_f32(s[4 * 33] * WSCALE, s[5 * 33] * WSCALE, hi, false); hi = __builtin_amdgcn_cvt_pk_fp8_f32(s[6 * 33] * WSCALE, s[7 * 33] * WSCALE, hi, true);
        *(GAS v2u*)(WT + (size_t)(rowbase + n) * ldt + k0 + 8 * c) = (v2u){(unsigned)lo, (unsigned)hi}; }
    LDS_WAIT(); asm volatile("" ::: "memory");
}
__device__ __forceinline__ void p0_prologue(Frame& F) {
    LAS float* scr = (LAS float*)(F.lds + F.wave * 16384);
    const int gw = F.vcu * NWAVES + F.wave, NGW = F.G * NWAVES;
    unsigned char* ws = F.ws;
    constexpr int I_IN = 16 * (INW / 32), I_AO = 8 * 32, I_LO = 16 * 32, I_OUT = 16 * 32, I_GU1 = 16 * 64, I_DN1 = 16 * 32;
    constexpr int NITEMS = I_IN + I_AO + I_LO + I_OUT + NE * I_GU1 + NE * I_DN1;
    for (int it = gw; it < NITEMS; it += NGW) {
        int r = it;
        if (r < I_IN) { const int nblk = INW / 32; p0_transpose_item(F.in[I_WIN], INW, (bf16*)(ws + WS_WIN), D, 0, 32 * (r % nblk), scr, r / nblk, r % nblk, F.lane); continue; } r -= I_IN;
        if (r < I_AO) { p0_transpose_item(F.in[I_WAO], D, (bf16*)(ws + WS_WCAT), ARW, 0, 32 * (r % 32), scr, r / 32, r % 32, F.lane); continue; } r -= I_AO;
        if (r < I_LO) { p0_transpose_item(F.in[I_WLO], D, (bf16*)(ws + WS_WCAT), ARW, QW, 32 * (r % 32), scr, r / 32, r % 32, F.lane); continue; } r -= I_LO;
        if (r < I_OUT) { p0_transpose_item(F.in[I_WOUT], D, (bf16*)(ws + WS_WO), D, 0, 32 * (r % 32), scr, r / 32, r % 32, F.lane); continue; } r -= I_OUT;
        if (r < NE * I_GU1) { const int e = r / I_GU1, q = r % I_GU1, kb = q / 64, nb = q % 64, n0 = 32 * nb;
            const int cc = n0 & 1023, isu = n0 >> 10, rowb = 256 * (cc >> 7) + 128 * isu + (cc & 127);
            p0_transpose_item_fp8(F.in[I_WGU] + (size_t)e * D * 2 * DFF, 2 * DFF, (unsigned char*)(ws + WS_WGU) + (size_t)e * 2 * DFF * D, D, rowb, scr, kb, nb, F.lane); continue; } r -= NE * I_GU1;
        { const int e = r / I_DN1, q = r % I_DN1;
            p0_transpose_item_fp8(F.in[I_WDN] + (size_t)e * DFF * D, D, (unsigned char*)(ws + WS_WD) + (size_t)e * D * DFF, DFF, 32 * (q % 32), scr, q / 32, q % 32, F.lane); }
    }
    const GAS f32x4* gp = (const GAS f32x4*)F.in[I_N1G] + F.lane;
    f32x4 g[4];
#pragma unroll
    for (int j = 0; j < 4; ++j) g[j] = gp[64 * j];
    bf16* XN = (bf16*)(ws + WS_XN);
    for (int m = gw; m < T; m += NGW) {
        const GAS f32x4* xr = (const GAS f32x4*)(F.in[I_X] + (size_t)m * D) + F.lane;
        f32x4 v[4]; float s = 0.f;
#pragma unroll
        for (int j = 0; j < 4; ++j) { v[j] = xr[64 * j]; s += (v[j].x * v[j].x + v[j].y * v[j].y) + (v[j].z * v[j].z + v[j].w * v[j].w); }
        const float rstd = 1.0f / sqrtf(wave_sum(s) * (1.f / D) + NORM_EPS);
        GAS unsigned long long* o8 = (GAS unsigned long long*)(XN + (size_t)m * D) + F.lane;
#pragma unroll
        for (int j = 0; j < 4; ++j) { const f32x4 y = v[j] * rstd * g[j]; o8[64 * j] = (unsigned long long)pk2(y.x, y.y) | ((unsigned long long)pk2(y.z, y.w) << 32); }
    }
}

#ifndef REP_MASK
#define REP_MASK 0
#endif
struct DenseSched {
    const char* A; const char* B; int nM, nN, nt, G, c; size_t tstepA, tstepB; int rs;
    __device__ __forceinline__ bool next(int i, pg8::Unit& u) const { const long L = (long)(i >> rs) * G + c; if (L >= (long)nM * nN) return false; pg8::dense_tile((int)L, nM, nN, u.pm, u.pn); u.aux = 0; return true; }
    __device__ __forceinline__ const char* a_ptr(const pg8::Unit& u) const { return A + (size_t)u.pm * tstepA; }
    __device__ __forceinline__ const char* b_ptr(const pg8::Unit& u) const { return B + (size_t)u.pn * tstepB; }
    __device__ __forceinline__ int ntiles(const pg8::Unit&) const { return nt; }
};
struct MergeSched {
    const char* A; const char* B; int G, c;
    __device__ __forceinline__ bool next(int i, pg8::Unit& u) const { const long L = (long)(i >> (1 + ((REP_MASK >> 4) & 1))) * G + c; if (L >= 128 * 4) return false; pg8::dense_tile((int)L, 128, 4, u.pm, u.pn); u.aux = i & 1; return true; }
    __device__ __forceinline__ const char* a_ptr(const pg8::Unit& u) const { return A + (size_t)u.pm * (256 * ARW * 2) + (u.aux ? QW * 2 : 0); }
    __device__ __forceinline__ const char* b_ptr(const pg8::Unit& u) const { return B + (size_t)u.pn * (256 * ARW * 2) + (u.aux ? QW * 2 : 0); }
    __device__ __forceinline__ int ntiles(const pg8::Unit& u) const { return u.aux ? (LRU_W / 64) : (QW / 64); }
};
template <int NTN> struct MoeSched {
    const char* A; const char* B; const LAS int* nbp; int G, c; size_t estepB;
    __device__ __forceinline__ bool next(int i, pg8::Unit& u) const {
        const int NB = nbp[NE], U = NB * NTN; const long L = (long)(i >> ((NTN == 4) ? ((REP_MASK >> 8) & 1) : 0)) * G + c; if (L >= U) return false;
        int w = (int)L; { const int q = U / 8, r = U % 8, xcd = w % 8, off = w / 8; w = (xcd < r ? xcd * (q + 1) : r * (q + 1) + (xcd - r) * q) + off; }
        int e = 0;
        for (int k = 1; k < NE; ++k) e += (w >= nbp[k] * NTN) ? 1 : 0;
        const int b0 = nbp[e], nM = nbp[e + 1] - b0, wl = w - b0 * NTN;
        const int nig = 8 * NTN, gid = wl / nig, fm = gid * 8, gsz = (nM - fm) < 8 ? (nM - fm) : 8;
        const int rb = fm + ((wl % nig) % gsz); u.pn = (wl % nig) / gsz; u.pm = b0 + rb; u.aux = e | (rb << 8); return true;
    }
    __device__ __forceinline__ const char* a_ptr(const pg8::Unit& u) const { return A; }
    __device__ __forceinline__ const char* b_ptr(const pg8::Unit& u) const { return B + (size_t)(u.aux & 0xff) * estepB + (size_t)u.pn * (256 * D); }
    __device__ __forceinline__ int ntiles(const pg8::Unit&) const { return D / 128; }
};
struct MoeDownSched : MoeSched<4> {
    __device__ __forceinline__ const char* a_ptr(const pg8::Unit& u) const { return A + (size_t)u.pm * (256 * DFF); }
};

struct EpiInProj {
    static constexpr bool PERM = true;
    unsigned char* ws; const float* bias;
    __device__ __forceinline__ bool keep(const pg8::Unit&) const { return false; }
    __device__ __forceinline__ void operator()(pg8::f32x4 (&acc)[2][2][4][2], const pg8::Unit& u, int wr, int wc, int fr, int fq) const {
        using namespace pg8;
        const int pn = u.pn; bf16_t* base; int ldc, colt;
        if (pn < 2) { base = (bf16_t*)(ws + WS_Q); ldc = QW; colt = pn * 256; }
        else if (pn == 2) { base = (bf16_t*)(ws + WS_KV); ldc = 2 * KVW; colt = 0; }
        else if (pn < 7) { base = (bf16_t*)(ws + WS_XR); ldc = LRU_W; colt = (pn - 3) * 256; }
        else if (pn < 11) { base = (bf16_t*)(ws + WS_YR); ldc = LRU_W; colt = (pn - 7) * 256; }
        else { base = (bf16_t*)(ws + WS_GL); ldc = 2 * D; colt = (pn - 11) * 256; }
        const int row0 = u.pm * BM + wr * 64 + fr, col0 = colt + wc * 32 + 8 * fq, bcol0 = pn * BM + wc * 32 + 8 * fq;
        f32x4 bv[2][2];
#pragma unroll
        for (int bj = 0; bj < 2; ++bj)
#pragma unroll
            for (int n = 0; n < 2; ++n) bv[bj][n] = *(const f32x4*)(bias + bcol0 + bj * HALF + 4 * n);
#pragma unroll
        for (int ai = 0; ai < 2; ++ai)
#pragma unroll
            for (int m = 0; m < 4; ++m) { bf16_t* rowp = base + (size_t)(row0 + ai * HALF + m * 16) * ldc + col0;
#pragma unroll
                for (int bj = 0; bj < 2; ++bj) { const f32x4 v0 = acc[ai][bj][m][0] + bv[bj][0], v1 = acc[ai][bj][m][1] + bv[bj][1];
                    u32x4 w; w.x = cvt_pk_bf16(v0[0], v0[1]); w.y = cvt_pk_bf16(v0[2], v0[3]); w.z = cvt_pk_bf16(v1[0], v1[1]); w.w = cvt_pk_bf16(v1[2], v1[3]);
                    *(u32x4*)(rowp + bj * HALF) = w; } }
    }
};
struct EpiMerge {
    static constexpr bool PERM = true;
    const bf16* GL; bf16* MG;
    __device__ __forceinline__ bool keep(const pg8::Unit& u) const { return u.aux == 0; }
    __device__ __forceinline__ void operator()(pg8::f32x4 (&acc)[2][2][4][2], const pg8::Unit& u, int wr, int wc, int fr, int fq) const {
        using namespace pg8;
        const int row0 = u.pm * BM + wr * 64 + fr, col0 = u.pn * BM + wc * 32 + 8 * fq;
        if (u.aux == 0) {
#pragma unroll
            for (int ai = 0; ai < 2; ++ai)
#pragma unroll
                for (int m = 0; m < 4; ++m) { const bf16* gp = GL + (size_t)(row0 + ai * HALF + m * 16) * (2 * D) + col0;
#pragma unroll
                    for (int bj = 0; bj < 2; ++bj) { const u32x4 ga = *(const u32x4*)(gp + bj * HALF), gr = *(const u32x4*)(gp + D + bj * HALF);
#pragma unroll
                        for (int q = 0; q < 4; ++q) { const float a0 = bf_lo(ga[q]), a1 = bf_hi(ga[q]), r0 = bf_lo(gr[q]), r1 = bf_hi(gr[q]);
                            const float f0 = (1.0f + __builtin_amdgcn_exp2f(-1.4426950408889634f * r0)) * __builtin_amdgcn_rcpf(1.0f + __builtin_amdgcn_exp2f(-1.4426950408889634f * a0));
                            const float f1 = (1.0f + __builtin_amdgcn_exp2f(-1.4426950408889634f * r1)) * __builtin_amdgcn_rcpf(1.0f + __builtin_amdgcn_exp2f(-1.4426950408889634f * a1));
                            acc[ai][bj][m][q >> 1][(q & 1) * 2] *= f0; acc[ai][bj][m][q >> 1][(q & 1) * 2 + 1] *= f1; } } }
        } else {
#pragma unroll
            for (int ai = 0; ai < 2; ++ai)
#pragma unroll
                for (int m = 0; m < 4; ++m) { const size_t ro = (size_t)(row0 + ai * HALF + m * 16); const bf16* gp = GL + ro * (2 * D) + D + col0; bf16* op = MG + ro * D + col0;
#pragma unroll
                    for (int bj = 0; bj < 2; ++bj) { const u32x4 gr = *(const u32x4*)(gp + bj * HALF); u32x4 w;
#pragma unroll
                        for (int q = 0; q < 4; ++q) { const float s0 = fast_sigmoid(bf_lo(gr[q])), s1 = fast_sigmoid(bf_hi(gr[q]));
                            w[q] = cvt_pk_bf16(acc[ai][bj][m][q >> 1][(q & 1) * 2] * s0, acc[ai][bj][m][q >> 1][(q & 1) * 2 + 1] * s1); }
                        *(u32x4*)(op + bj * HALF) = w; } }
        }
    }
};
struct EpiResF32 {
    static constexpr bool PERM = false;
    const float* X; float* O;
    __device__ __forceinline__ bool keep(const pg8::Unit&) const { return false; }
    __device__ __forceinline__ void operator()(pg8::f32x4 (&acc)[2][2][4][2], const pg8::Unit& u, int wr, int wc, int fr, int fq) const {
        using namespace pg8;
        const int row0 = u.pm * BM + wr * 64 + fr, col0 = u.pn * BM + wc * 32 + 4 * fq;
#pragma unroll
        for (int ai = 0; ai < 2; ++ai)
#pragma unroll
            for (int m = 0; m < 4; ++m) { const size_t off = (size_t)(row0 + ai * HALF + m * 16) * D + col0;
#pragma unroll
                for (int bj = 0; bj < 2; ++bj)
#pragma unroll
                    for (int n = 0; n < 2; ++n) *(f32x4*)(O + off + bj * HALF + n * 16) = *(const f32x4*)(X + off + bj * HALF + n * 16) + acc[ai][bj][m][n]; }
    }
};
struct EpiSwiGLU {
    static constexpr bool PERM = true;
    const float* bgu; unsigned char* ACT;
    __device__ __forceinline__ bool keep(const pg8::Unit&) const { return false; }
    __device__ __forceinline__ void operator()(pg8::f32x4 (&acc)[2][2][4][2], const pg8::Unit& u, int wr, int wc, int fr, int fq) const {
        using namespace pg8;
        const int e = u.aux & 0xff, cl = wc * 32 + 8 * fq, col0 = u.pn * 128 + cl, row0 = u.pm * BM + wr * 64 + fr;
        const float* bp = bgu + (size_t)e * (2 * DFF) + col0;
        const f32x4 bg0 = *(const f32x4*)(bp), bg1 = *(const f32x4*)(bp + 4), bu0 = *(const f32x4*)(bp + DFF), bu1 = *(const f32x4*)(bp + DFF + 4);
#pragma unroll
        for (int ai = 0; ai < 2; ++ai)
#pragma unroll
            for (int m = 0; m < 4; ++m) { u32x2 w;
#pragma unroll
                for (int n = 0; n < 2; ++n) { const f32x4 g = acc[ai][0][m][n] * WSCALE_INV + (n ? bg1 : bg0), uu = acc[ai][1][m][n] * WSCALE_INV + (n ? bu1 : bu0); float a[4];
#pragma unroll
                    for (int j = 0; j < 4; ++j) { const float gg = fminf(g[j], 7.0f), uc = fminf(fmaxf(uu[j], -7.0f), 7.0f);
                        a[j] = gg * __builtin_amdgcn_rcpf(1.0f + __builtin_amdgcn_exp2f(-1.702f * 1.4426950408889634f * gg)) * (uc + 1.0f); }
                    int pk = 0; pk = __builtin_amdgcn_cvt_pk_fp8_f32(a[0], a[1], pk, false); pk = __builtin_amdgcn_cvt_pk_fp8_f32(a[2], a[3], pk, true); w[n] = (unsigned)pk; }
                *(u32x2*)(ACT + (size_t)(row0 + ai * HALF + m * 16) * DFF + col0) = w; }
    }
};
struct EpiDown {
    static constexpr bool PERM = true;
    const float* bdn; const float* gatel; bf16* Y;
    __device__ __forceinline__ bool keep(const pg8::Unit&) const { return false; }
    __device__ __forceinline__ void operator()(pg8::f32x4 (&acc)[2][2][4][2], const pg8::Unit& u, int wr, int wc, int fr, int fq) const {
        using namespace pg8;
        const int e = u.aux & 0xff, rb = u.aux >> 8, col0 = u.pn * BM + wc * 32 + 8 * fq, rl0 = wr * 64 + fr;
        f32x4 bv[2][2];
#pragma unroll
        for (int bj = 0; bj < 2; ++bj)
#pragma unroll
            for (int n = 0; n < 2; ++n) bv[bj][n] = *(const f32x4*)(bdn + (size_t)e * D + col0 + bj * HALF + 4 * n);
        const float* gl = gatel + (size_t)e * ECAP + rb * 256;
#pragma unroll
        for (int ai = 0; ai < 2; ++ai)
#pragma unroll
            for (int m = 0; m < 4; ++m) { const int rl = rl0 + ai * HALF + m * 16; const float gt = gl[rl]; bf16* rowp = Y + (size_t)(u.pm * BM + rl) * D + col0;
#pragma unroll
                for (int bj = 0; bj < 2; ++bj) { const f32x4 v0 = (acc[ai][bj][m][0] * WSCALE_INV + bv[bj][0]) * gt, v1 = (acc[ai][bj][m][1] * WSCALE_INV + bv[bj][1]) * gt;
                    u32x4 w; w.x = cvt_pk_bf16(v0[0], v0[1]); w.y = cvt_pk_bf16(v0[2], v0[3]); w.z = cvt_pk_bf16(v1[0], v1[1]); w.w = cvt_pk_bf16(v1[2], v1[3]);
                    *(u32x4*)(rowp + bj * HALF) = w; } }
    }
};

__device__ __forceinline__ void fix_row(bf16* p, const float* g8, float scale, int c, int prow, int pcol, const LAS f32x2* tab) {
    const v4u raw = *(const GAS v4u*)p;
    float v[8];
#pragma unroll
    for (int q = 0; q < 4; ++q) { v[2 * q] = bflo(raw[q]); v[2 * q + 1] = bfhi(raw[q]); }
    float ss = 0.f;
#pragma unroll
    for (int j = 0; j < 8; ++j) ss += v[j] * v[j];
    ss += __shfl_xor(ss, 1); ss += __shfl_xor(ss, 2); ss += __shfl_xor(ss, 4);
    const float rstd = 1.0f / sqrtf(ss * (1.0f / HD) + NORM_EPS);
    const int pos = (c >> 2) ? pcol : prow; const bool second = (c >> 1) & 1; const int f0 = (c & 1) * 8;
    float o[8];
#pragma unroll
    for (int j = 0; j < 8; ++j) { const float y = v[j] * rstd * g8[j]; const float pr = __shfl_xor(y, 2); const f32x2 cs = tab[pos * 16 + f0 + j];
        o[j] = (second ? (y * cs.x + pr * cs.y) : (y * cs.x - pr * cs.y)) * scale; }
    v4u w; w.x = pk2(o[0], o[1]); w.y = pk2(o[2], o[3]); w.z = pk2(o[4], o[5]); w.w = pk2(o[6], o[7]);
    *(GAS v4u*)p = w;
}
__device__ __forceinline__ void p2_fixup(Frame& F) {
    LAS f32x2* tab = (LAS f32x2*)(F.lds);
    for (int idx = F.tid; idx < 1024; idx += NWAVES * 64) { const int pos = idx >> 4, f = idx & 15; const float inv = powf(10000.0f, -(float)f / 16.0f); const float ang = (float)pos * inv;
        tab[idx] = (f32x2){cosf(ang), sinf(ang)}; }
    __syncthreads();
    const int gw = F.vcu * NWAVES + F.wave, NGW = F.G * NWAVES, c = F.lane & 7;
    float gq[8], gk[8];
#pragma unroll
    for (int j = 0; j < 8; ++j) { gq[j] = F.in[I_QNG][8 * c + j]; gk[j] = F.in[I_KNG][8 * c + j]; }
    bf16* Q = (bf16*)(F.ws + WS_Q); bf16* KV = (bf16*)(F.ws + WS_KV);
    for (int t = gw; t < T; t += NGW) {
        const int s = t & (SEQ - 1), prow = s >> 6, pcol = s & 63;
        fix_row(Q + (size_t)t * QW + F.lane * 8, gq, attn_body::C2, c, prow, pcol, tab);
        if (F.lane < 16) fix_row(KV + (size_t)t * (2 * KVW) + F.lane * 8, gk, 1.0f, c, prow, pcol, tab);
    }
    __syncthreads();
}
constexpr int LRU_CH = 256;
constexpr int LRU_XC_STRIDE = 144;
constexpr int LRU_BUF = LRU_CH * LRU_XC_STRIDE;
constexpr int LRU_WT = 4 * LRU_BUF;
static_assert(LRU_BUF >= 256 * 33 * 4 && LRU_WT + 2048 + 5 * 64 * 4 <= MISC_OFF, "lru lds");

__device__ __forceinline__ float gelu_tanh(float y) { const float z = 0.7978845608028654f * (y + 0.044715f * y * y * y); return y * sigmoidf_fast(2.0f * z); }

template <int DIR> __device__ __forceinline__ void lru_dir(Frame& F, int b, int n, int half) {
    LAS unsigned char* lds = F.lds;
    int tid_ = F.tid; asm volatile("" : "+v"(tid_));
    unsigned char* ws_ = F.ws; asm volatile("" : "+s"(ws_));
    const int tid = tid_, lane = tid & 63, wave = __builtin_amdgcn_readfirstlane(tid >> 6);
    constexpr int g = DIR; const int w = wave & 3, tl = tid & 255;
#define PHY(p_) (DIR ? 255 - (p_) : (p_))
    const int ch16 = lane & 15, q = lane >> 4, ct = w & 1, th = w >> 1;
    const int cl = 16 * ct + ch16, co_l = 32 * half + cl, cgl = 64 * n + co_l;
    bf16x8 Ba[2], Bi[2];
    { const float* wa = F.in[I_WA] + ((size_t)(g * LRU_NB + n) * 64) * 64 + co_l; const float* wi = F.in[I_WI] + ((size_t)(g * LRU_NB + n) * 64) * 64 + co_l;
#pragma unroll
      for (int ks = 0; ks < 2; ++ks)
#pragma unroll
          for (int j = 0; j < 8; ++j) { const int k = 32 * ks + 8 * q + j; Ba[ks][j] = (short)f2bf(wa[(size_t)k * 64]); Bi[ks][j] = (short)f2bf(wi[(size_t)k * 64]); } }
    const float ba = F.in[I_BA][(g * LRU_NB + n) * 64 + co_l], bi = F.in[I_BI][(g * LRU_NB + n) * 64 + co_l];
    const float lam = F.in[I_LAM][g * LRU_W + cgl];
    const float clam = -8.0f * log1pf(expf(-lam)) * 1.4426950408889634f;
    const int c8 = tl & 7, tg = tl >> 3;
    LAS float* cwl = (LAS float*)(lds + LRU_WT + 2048);
    for (int i = tid; i < 5 * 64; i += NWAVES * 64) { const int j = i >> 6, c = i & 63; cwl[i] = (j < 4) ? F.in[I_CONVW][j * LRU_W + 64 * n + c] : F.in[I_CONVB][64 * n + c]; }
    __syncthreads();
    const bf16* XR = (const bf16*)(ws_ + WS_XR) + (size_t)b * SEQ * LRU_W + 64 * n + 8 * c8;
    const bf16* YR = (const bf16*)(ws_ + WS_YR) + (size_t)b * SEQ * LRU_W + 64 * n + 32 * half;
    bf16* AR = (bf16*)(ws_ + WS_AR) + (size_t)b * SEQ * ARW + QW + 64 * n + 32 * half;
    constexpr int NST = SEQ / LRU_CH;
    v4u xrp[11];
#define LRU_LOADX(pc_) do { const int s0_ = (pc_) * LRU_CH + 8 * tg - 1; _Pragma("unroll") for (int i_ = 0; i_ < 11; ++i_) { const int s_ = s0_ + i_; \
        const int sc_ = s_ < 0 ? 0 : (s_ >= SEQ ? SEQ - 1 : s_); const v4u t_ = *(const GAS v4u*)(XR + (size_t)sc_ * LRU_W); const unsigned m_ = (s_ >= 0 && s_ < SEQ) ? 0xffffffffu : 0u; \
        xrp[i_] = (v4u){t_.x & m_, t_.y & m_, t_.z & m_, t_.w & m_}; } } while (0)
    LRU_LOADX(g ? NST - 1 : 0);
    float hcarry = 0.f;
    for (int k = 0; k < NST; ++k) {
        const int pc = g ? (NST - 1 - k) : k, par = k & 1;
        LAS unsigned char* buf = lds + (g * 2 + par) * LRU_BUF;
        unsigned aA = (unsigned)((DIR ? (255 - 128 * th - ch16 - 112) : (128 * th + ch16)) * LRU_XC_STRIDE + q * 16);
        unsigned aX = (unsigned)((DIR ? (255 - 128 * th - 4 * q - 115) : (128 * th + 4 * q)) * LRU_XC_STRIDE + co_l * 2);
        unsigned aH = (unsigned)(((DIR ? (255 - 128 * th - 4 * q - 115) : (128 * th + 4 * q)) * 33 + cl) * 4);
        asm volatile("" : "+v"(aA), "+v"(aX), "+v"(aH));
#define OFS(c_, m_) (DIR ? ((m_) - (c_)) : (c_))
        { float cw[4][8], cb[8];
#pragma unroll
          for (int j = 0; j < 4; ++j) { const f32x4 c0 = *(const LAS f32x4*)(cwl + j * 64 + 8 * c8), c1 = *(const LAS f32x4*)(cwl + j * 64 + 8 * c8 + 4);
              cw[j][0] = c0.x; cw[j][1] = c0.y; cw[j][2] = c0.z; cw[j][3] = c0.w; cw[j][4] = c1.x; cw[j][5] = c1.y; cw[j][6] = c1.z; cw[j][7] = c1.w; }
          { const f32x4 c0 = *(const LAS f32x4*)(cwl + 256 + 8 * c8), c1 = *(const LAS f32x4*)(cwl + 256 + 8 * c8 + 4); cb[0] = c0.x; cb[1] = c0.y; cb[2] = c0.z; cb[3] = c0.w; cb[4] = c1.x; cb[5] = c1.y; cb[6] = c1.z; cb[7] = c1.w; }
#pragma unroll
          for (int tt = 0; tt < 8; ++tt) { float o[8];
#pragma unroll
            for (int i = 0; i < 8; ++i) o[i] = cb[i];
#pragma unroll
            for (int j = 0; j < 4; ++j) { const v4u raw = xrp[tt + j];
#pragma unroll
                for (int qq = 0; qq < 4; ++qq) { o[2 * qq] += cw[j][2 * qq] * bflo(raw[qq]); o[2 * qq + 1] += cw[j][2 * qq + 1] * bfhi(raw[qq]); } }
            v4u wv; wv.x = pk2(o[0], o[1]); wv.y = pk2(o[2], o[3]); wv.z = pk2(o[4], o[5]); wv.w = pk2(o[6], o[7]);
            *(LAS v4u*)(buf + (8 * tg + tt) * LRU_XC_STRIDE + c8 * 16) = wv; } }
        if (k + 1 < NST) LRU_LOADX(g ? (NST - 2 - k) : (k + 1));
        const size_t trow = (size_t)pc * LRU_CH + tl;
        __syncthreads();
        float Aloc[8][4], Hloc[8][4];
        float AR_ = 1.f, HR_ = 0.f;
#pragma unroll
        for (int rt = 0; rt < 8; ++rt) {
            const bf16x8 a0 = *(const LAS bf16x8*)(buf + aA + OFS(16 * rt, 112) * LRU_XC_STRIDE), a1 = *(const LAS bf16x8*)(buf + aA + OFS(16 * rt, 112) * LRU_XC_STRIDE + 64);
            f32x4 Da = (f32x4){0.f, 0.f, 0.f, 0.f}, Di = (f32x4){0.f, 0.f, 0.f, 0.f};
            Da = __builtin_amdgcn_mfma_f32_16x16x32_bf16(a0, Ba[0], Da, 0, 0, 0); Da = __builtin_amdgcn_mfma_f32_16x16x32_bf16(a1, Ba[1], Da, 0, 0, 0);
            Di = __builtin_amdgcn_mfma_f32_16x16x32_bf16(a0, Bi[0], Di, 0, 0, 0); Di = __builtin_amdgcn_mfma_f32_16x16x32_bf16(a1, Bi[1], Di, 0, 0, 0);
            float Ain[4], Hin[4];
#pragma unroll
            for (int j = 0; j < 4; ++j) {
                const float xcv = __uint_as_float((unsigned)(*(const LAS unsigned short*)(buf + aX + OFS(16 * rt + j, 115) * LRU_XC_STRIDE)) << 16);
                const float r = sigmoidf_fast(Da[j] + ba), ig = sigmoidf_fast(Di[j] + bi);
                const float a = __builtin_amdgcn_exp2f(clam * r);
                const float u = sqrtf(fmaxf(1.0f - a * a, 0.f)) * (ig * xcv);
                if (j == 0) { Ain[0] = a; Hin[0] = u; } else { Hin[j] = a * Hin[j - 1] + u; Ain[j] = Ain[j - 1] * a; } }
            float Ai = Ain[3], Hi = Hin[3];
            float An = __shfl(Ai, (lane - 16) & 63), Hn = __shfl(Hi, (lane - 16) & 63); if (q >= 1) { Hi = Ai * Hn + Hi; Ai = An * Ai; }
            An = __shfl(Ai, (lane - 32) & 63); Hn = __shfl(Hi, (lane - 32) & 63); if (q >= 2) { Hi = Ai * Hn + Hi; Ai = An * Ai; }
            float Ae = __shfl(Ai, (lane - 16) & 63), He = __shfl(Hi, (lane - 16) & 63); if (q == 0) { Ae = 1.f; He = 0.f; }
            const float Atile = __shfl(Ai, ch16 + 48), Htile = __shfl(Hi, ch16 + 48);
            const float Ap = AR_ * Ae, Hp = Ae * HR_ + He;
#pragma unroll
            for (int j = 0; j < 4; ++j) { Aloc[rt][j] = Ap * Ain[j]; Hloc[rt][j] = Ain[j] * Hp + Hin[j]; }
            HR_ = Atile * HR_ + Htile; AR_ = AR_ * Atile;
            __builtin_amdgcn_sched_barrier(0);
        }
        LAS f32x2* WT = (LAS f32x2*)(lds + LRU_WT) + (g * 2 + par) * 64;
        if (q == 0) WT[th * 32 + cl] = (f32x2){AR_, HR_};
        __syncthreads();
        v4u yv[4], ov[4];
        if (k >= NST / 2) {
#pragma unroll
            for (int i = 0; i < 4; ++i) { yv[i] = *((const GAS v4u*)(YR + trow * LRU_W) + i); ov[i] = *((const GAS v4u*)(AR + trow * ARW) + i); } }
        const f32x2 w0 = WT[cl], w1 = WT[32 + cl];
        const float hmid = w0.x * hcarry + w0.y;
        const float hin = th ? hmid : hcarry;
        hcarry = w1.x * hmid + w1.y;
        LAS float* HS = (LAS float*)buf;
#pragma unroll
        for (int rt = 0; rt < 8; ++rt)
#pragma unroll
            for (int j = 0; j < 4; ++j) *(LAS float*)(buf + aH + OFS(16 * rt + j, 115) * 132) = Hloc[rt][j] + Aloc[rt][j] * hin;
        __syncthreads();
        { float hv[32];
#pragma unroll
          for (int i = 0; i < 32; ++i) hv[i] = HS[tl * 33 + i];
          v4u wv[4];
          if (k < NST / 2) {
#pragma unroll
              for (int i = 0; i < 4; ++i) { wv[i].x = pk2(hv[8 * i], hv[8 * i + 1]); wv[i].y = pk2(hv[8 * i + 2], hv[8 * i + 3]); wv[i].z = pk2(hv[8 * i + 4], hv[8 * i + 5]); wv[i].w = pk2(hv[8 * i + 6], hv[8 * i + 7]); }
          } else {
#pragma unroll
              for (int i = 0; i < 4; ++i)
#pragma unroll
                  for (int qq = 0; qq < 4; ++qq) wv[i][qq] = pk2((hv[8 * i + 2 * qq] + bflo(ov[i][qq])) * gelu_tanh(bflo(yv[i][qq])), (hv[8 * i + 2 * qq + 1] + bfhi(ov[i][qq])) * gelu_tanh(bfhi(yv[i][qq])));
          }
          GAS v4u* op = (GAS v4u*)(AR + trow * ARW);
#pragma unroll
          for (int i = 0; i < 4; ++i) op[i] = wv[i]; }
    }
#undef LRU_LOADX
#undef PHY
#undef OFS
    __syncthreads();
}
__device__ __forceinline__ void p2_lru(Frame& F) {
    for (int it = F.vcu; it < BATCH * LRU_NB * 2; it += F.G) { if (F.wave < 4) lru_dir<0>(F, it >> 5, (it & 31) >> 1, it & 1); else lru_dir<1>(F, it >> 5, (it & 31) >> 1, it & 1); }
}

constexpr int RT_STRIDE = 1028;
constexpr int ROWINFO_OFF = GTAB_OFF + 1024;
__device__ __forceinline__ void p6_router(Frame& F) {
    LAS float* wT = (LAS float*)F.lds;
    LAS unsigned* misc = (LAS unsigned*)(F.lds + MISC_OFF);
    LAS unsigned* hist = misc + 128; LAS unsigned* basew = misc + 160;
    LAS v2u* rowinfo = (LAS v2u*)(F.lds + ROWINFO_OFF);
    const int tid = F.tid, lane = F.lane, wave = F.wave;
    for (int idx = tid; idx < D * NE; idx += NWAVES * 64) { const int k = idx >> 5, e = idx & 31; wT[e * RT_STRIDE + k] = F.in[I_WR][idx]; }
    if (tid < 32) hist[tid] = 0u;
    f32x4 g2[4];
#pragma unroll
    for (int j = 0; j < 4; ++j) g2[j] = *((const GAS f32x4*)F.in[I_N2G] + lane + 64 * j);
    const float brl = F.in[I_BR][lane >> 1];
    __syncthreads();
    unsigned char* H2 = (unsigned char*)(F.ws + WS_XN);
    unsigned* gcnt = (unsigned*)(F.ws + WS_CTL) + CW_CNT;
    int* TOKL = (int*)(F.ws + WS_TOKL); float* GATEL = (float*)(F.ws + WS_GATEL); int* TOKREC = (int*)(F.ws + WS_TOKREC);
    for (int bi = F.vcu; bi < T / 128; bi += F.G) {
        const int rbase = bi * 128;
        for (int p = 0; p < 8; ++p) {
            const int rl0 = 16 * wave + 2 * p; const size_t r0 = (size_t)rbase + rl0;
            f32x4 h0[4], h1[4];
            { const GAS f32x4* x0 = (const GAS f32x4*)(F.out + r0 * D) + lane; const GAS f32x4* x1 = (const GAS f32x4*)(F.out + (r0 + 1) * D) + lane;
              float s0 = 0.f, s1 = 0.f;
#pragma unroll
              for (int j = 0; j < 4; ++j) { h0[j] = x0[64 * j]; h1[j] = x1[64 * j];
                  s0 += (h0[j].x * h0[j].x + h0[j].y * h0[j].y) + (h0[j].z * h0[j].z + h0[j].w * h0[j].w); s1 += (h1[j].x * h1[j].x + h1[j].y * h1[j].y) + (h1[j].z * h1[j].z + h1[j].w * h1[j].w); }
              const float rs0 = 1.0f / sqrtf(wave_sum(s0) * (1.f / D) + NORM_EPS), rs1 = 1.0f / sqrtf(wave_sum(s1) * (1.f / D) + NORM_EPS);
              GAS unsigned* o0 = (GAS unsigned*)(H2 + r0 * D) + lane; GAS unsigned* o1 = (GAS unsigned*)(H2 + (r0 + 1) * D) + lane;
#pragma unroll
              for (int j = 0; j < 4; ++j) { h0[j] = h0[j] * rs0 * g2[j]; h1[j] = h1[j] * rs1 * g2[j];
                  int p0 = 0, p1 = 0; p0 = __builtin_amdgcn_cvt_pk_fp8_f32(h0[j].x, h0[j].y, p0, false); p0 = __builtin_amdgcn_cvt_pk_fp8_f32(h0[j].z, h0[j].w, p0, true);
                  p1 = __builtin_amdgcn_cvt_pk_fp8_f32(h1[j].x, h1[j].y, p1, false); p1 = __builtin_amdgcn_cvt_pk_fp8_f32(h1[j].z, h1[j].w, p1, true);
                  o0[64 * j] = (unsigned)p0; o1[64 * j] = (unsigned)p1; } }
            float a0[32], a1[32];
#pragma unroll
            for (int e = 0; e < 32; ++e) { float s0 = 0.f, s1 = 0.f;
#pragma unroll
                for (int j = 0; j < 4; ++j) { const f32x4 w = *(const LAS f32x4*)(wT + e * RT_STRIDE + 256 * j + 4 * lane);
                    s0 += (h0[j].x * w.x + h0[j].y * w.y) + (h0[j].z * w.z + h0[j].w * w.w); s1 += (h1[j].x * w.x + h1[j].y * w.y) + (h1[j].z * w.z + h1[j].w * w.w); }
                a0[e] = s0; a1[e] = s1; }
#define TRED(arr, N, MASK) _Pragma("unroll") for (int i = 0; i < (N); ++i) { const bool up = (lane & (MASK)) != 0; const float snd = up ? arr[i] : arr[i + (N)]; const float kp = up ? arr[i + (N)] : arr[i]; arr[i] = kp + __shfl_xor(snd, (MASK)); }
            TRED(a0, 16, 32) TRED(a0, 8, 16) TRED(a0, 4, 8) TRED(a0, 2, 4) TRED(a0, 1, 2)
            TRED(a1, 16, 32) TRED(a1, 8, 16) TRED(a1, 4, 8) TRED(a1, 2, 4) TRED(a1, 1, 2)
#undef TRED
            float lg[2]; lg[0] = a0[0] + __shfl_xor(a0[0], 1) + brl; lg[1] = a1[0] + __shfl_xor(a1[0], 1) + brl;
#pragma unroll
            for (int rr2 = 0; rr2 < 2; ++rr2) {
                float val = lg[rr2]; int te[4]; float tv[4];
#pragma unroll
                for (int k = 0; k < 4; ++k) { float m = val;
#pragma unroll
                    for (int o = 1; o < 64; o <<= 1) m = fmaxf(m, __shfl_xor(m, o));
                    const unsigned long long bal = __ballot(val == m); const int src = __builtin_ctzll(bal); te[k] = src >> 1; tv[k] = m; if ((lane >> 1) == te[k]) val = -INFINITY; }
                const float p1 = __expf(tv[1] - tv[0]), p2 = __expf(tv[2] - tv[0]), p3 = __expf(tv[3] - tv[0]); const float inv = 1.0f / (1.0f + p1 + p2 + p3);
                if (lane < 4) { const int e = lane == 0 ? te[0] : lane == 1 ? te[1] : lane == 2 ? te[2] : te[3]; const float gt = (lane == 0 ? 1.0f : lane == 1 ? p1 : lane == 2 ? p2 : p3) * inv;
                    const unsigned rank = atomicAdd((unsigned*)(hist + e), 1u);
                    rowinfo[(rl0 + rr2) * 4 + lane] = (v2u){(unsigned)e | (rank << 8), __float_as_uint(gt)}; }
            }
        }
        __syncthreads();
        if (tid < 32) basew[tid] = __hip_atomic_fetch_add(gcnt + tid, hist[tid], __ATOMIC_RELAXED, __HIP_MEMORY_SCOPE_AGENT);
        __syncthreads();
        { const int rl = tid >> 2, k = tid & 3; const v2u inf = rowinfo[rl * 4 + k]; const int e = inf.x & 0xff; const unsigned slot = basew[e] + (inf.x >> 8); const int t = rbase + rl;
          TOKL[(size_t)e * ECAP + slot] = t; GATEL[(size_t)e * ECAP + slot] = __uint_as_float(inf.y); TOKREC[t * 4 + k] = (int)(((unsigned)e << 20) | slot); }
        __syncthreads();
        if (tid < 32) hist[tid] = 0u;
        __syncthreads();
    }
}

__device__ __forceinline__ void moe_tables(Frame& F) {
    LAS int* misc = (LAS int*)(F.lds + MISC_OFF);
    const unsigned* gcnt = (const unsigned*)(F.ws + WS_CTL) + CW_CNT;
    if (F.tid < 32) misc[F.tid] = (int)__hip_atomic_load(gcnt + F.tid, __ATOMIC_RELAXED, __HIP_MEMORY_SCOPE_AGENT);
    __syncthreads();
    if (F.tid == 0) { int s = 0; for (int e = 0; e < NE; ++e) { misc[32 + e] = s; s += (misc[e] + 255) >> 8; } misc[32 + NE] = s; }
    __syncthreads();
}
__device__ __forceinline__ void moe_gather_table(Frame& F, const MoeSched<8>& S) {
    LAS int* misc = (LAS int*)(F.lds + MISC_OFF); LAS int* gtab = (LAS int*)(F.lds + GTAB_OFF);
    const int* TOKL = (const int*)(F.ws + WS_TOKL);
    pg8::Unit u;
    for (int ui = 0; ui < MAX_GUNITS && S.next(ui, u); ++ui) {
        if (F.tid < 256) { const int e = u.aux & 0xff, rb = u.aux >> 8, slot = rb * 256 + F.tid; gtab[ui * 256 + F.tid] = (slot < misc[e]) ? TOKL[(size_t)e * ECAP + slot] : 0; }
    }
    __syncthreads();
}

__device__ __forceinline__ void p10_final(Frame& F) {
    LAS int* misc = (LAS int*)(F.lds + MISC_OFF);
    const int gw = F.vcu * NWAVES + F.wave, NGW = F.G * NWAVES, lane = F.lane;
    f32x4 g[4];
#pragma unroll
    for (int j = 0; j < 4; ++j) g[j] = *((const GAS f32x4*)F.in[I_FG] + lane + 64 * j);
    const int* TOKREC = (const int*)(F.ws + WS_TOKREC); const bf16* Y = (const bf16*)(F.ws + WS_Y);
    for (int t = gw; t < T; t += NGW) {
        GAS f32x4* xp = (GAS f32x4*)(F.out + (size_t)t * D) + lane;
        f32x4 v[4];
#pragma unroll
        for (int j = 0; j < 4; ++j) v[j] = xp[64 * j];
#pragma unroll
        for (int k = 0; k < 4; ++k) { const unsigned rec = (unsigned)TOKREC[t * 4 + k]; const int e = rec >> 20, slot = rec & 0xfffff;
            const GAS v2u* yp = (const GAS v2u*)(Y + ((size_t)misc[32 + e] * 256 + slot) * D) + lane;
#pragma unroll
            for (int j = 0; j < 4; ++j) { const v2u w = yp[64 * j]; v[j].x += bflo(w.x); v[j].y += bfhi(w.x); v[j].z += bflo(w.y); v[j].w += bfhi(w.y); } }
        float s = 0.f;
#pragma unroll
        for (int j = 0; j < 4; ++j) s += (v[j].x * v[j].x + v[j].y * v[j].y) + (v[j].z * v[j].z + v[j].w * v[j].w);
        const float rstd = 1.0f / sqrtf(wave_sum(s) * (1.f / D) + NORM_EPS);
#pragma unroll
        for (int j = 0; j < 4; ++j) xp[64 * j] = v[j] * rstd * g[j];
    }
}
typedef GAS unsigned gu32;
#define RLX_AGENT __ATOMIC_RELAXED, __HIP_MEMORY_SCOPE_AGENT
#define XB_TMO      128
#define XB_XCNT(j)  (256  + 64 * (j))
#define XB_XSUB(j)  (1280 + 64 * (j))
#define XB_XGEN(j)  (2304 + 64 * (j))
#define XB_TOP      3328
#define XB_TOPGEN   3392
#define XCD_BAR_WORDS 3456
#define XB_SPIN_CAP (1u << 18)

__device__ __forceinline__ unsigned xb_ld(unsigned* p)              { return __hip_atomic_load(p, __ATOMIC_RELAXED, __HIP_MEMORY_SCOPE_AGENT); }
__device__ __forceinline__ unsigned xb_add(unsigned* p, unsigned v) { return __hip_atomic_fetch_add(p, v, __ATOMIC_RELAXED, __HIP_MEMORY_SCOPE_AGENT); }
__device__ __forceinline__ unsigned xb_xcc_id() { return (unsigned)__builtin_amdgcn_s_getreg((3 << 11) | 20) & 0xFu; }
#define XB_SPIN(cond, bar) do { unsigned _sp = 0; while (cond) { __builtin_amdgcn_s_sleep(1); \
    if ((++_sp & 255u) == 0u) { if (xb_ld(&(bar)[XB_TMO])) break; if (_sp > XB_SPIN_CAP) { atomicAdd(&(bar)[XB_TMO], 1u); break; } } } } while (0)

struct XcdBarrier {
    unsigned* bar; unsigned x;
    volatile LAS unsigned* st;
};

__device__ __forceinline__ XcdBarrier xcd_barrier_post(unsigned* bar, volatile LAS unsigned* st) {
    XcdBarrier b; b.bar = bar; b.x = xb_xcc_id(); b.st = st;
    if (threadIdx.x == 0) (void)xb_add(&bar[XB_XCNT(b.x)], 1u);
    return b;
}
__device__ __forceinline__ void xcd_barrier_complete(unsigned* bar, unsigned x, unsigned& nloc, unsigned& nx) {
    const unsigned G = gridDim.x * gridDim.y * gridDim.z;
    unsigned sum, cnt, mine, sp = 0u;
    for (;;) {
        sum = 0u; cnt = 0u; mine = 0u;
#pragma unroll
        for (unsigned j = 0; j < 16; ++j) { const unsigned c = xb_ld(&bar[XB_XCNT(j)]); sum += c; cnt += (c > 0u) ? 1u : 0u; mine = (j == x) ? c : mine; }
        if (sum == G) break;
        __builtin_amdgcn_s_sleep(1);
        if ((++sp & 255u) == 0u) { if (xb_ld(&bar[XB_TMO])) break; if (sp > XB_SPIN_CAP) { atomicAdd(&bar[XB_TMO], 1u); break; } }
    }
    nloc = mine > 0u ? mine : 1u; nx = cnt > 0u ? cnt : 1u;
}

__device__ __forceinline__ void xcd_barrier(const XcdBarrier& b) {
    asm volatile("s_waitcnt vmcnt(0)" ::: "memory");
    __syncthreads();
    if (threadIdx.x == 0) {
        unsigned* bar = b.bar;
        __builtin_amdgcn_s_waitcnt(0);
        unsigned nloc = b.st[0], nx = b.st[1];
        if (nloc == 0u) { xcd_barrier_complete(bar, b.x, nloc, nx); b.st[0] = nloc; b.st[1] = nx; }
        const unsigned old = xb_add(&bar[XB_XSUB(b.x)], 1u);
        const unsigned gen = old / nloc;
        if (old + 1u == (gen + 1u) * nloc) {
            __builtin_amdgcn_fence(__ATOMIC_RELEASE, "agent");
            asm volatile("s_waitcnt vmcnt(0)" ::: "memory");
            const unsigned og = xb_add(&bar[XB_TOP], 1u);
            const unsigned tg = og / nx;
            if (og + 1u == (tg + 1u) * nx) xb_add(&bar[XB_TOPGEN], 1u);
            else XB_SPIN(xb_ld(&bar[XB_TOPGEN]) == tg, bar);
            __builtin_amdgcn_fence(__ATOMIC_ACQUIRE, "agent");
            xb_add(&bar[XB_XGEN(b.x)], 1u);
            asm volatile("s_waitcnt vmcnt(0)" ::: "memory");
        } else {
            XB_SPIN(xb_ld(&bar[XB_XGEN(b.x)]) == gen, bar);
            __builtin_amdgcn_fence(__ATOMIC_ACQUIRE, "agent");
            asm volatile("s_waitcnt vmcnt(0)" ::: "memory");
        }
    }
    __syncthreads();
}

constexpr int N_PHASES = 10;
struct Args { const float* in[24]; float* out; unsigned char* ws; int ph_lo, ph_hi; };
__global__ void __launch_bounds__(NWAVES * 64, 2) mk_fwd(Args args) {
    extern __shared__ __attribute__((aligned(16))) unsigned char lds[];
#define MKFRAME() Frame F; { int t_ = threadIdx.x; asm volatile("" : "+v"(t_)); F.lds = (LAS unsigned char*)lds; F.tid = t_; F.lane = t_ & 63; F.wave = __builtin_amdgcn_readfirstlane(t_ >> 6); \
        F.G = gridDim.x; const int bx = blockIdx.x; F.vcu = (F.G % 8 == 0) ? (bx % 8) * (F.G / 8) + bx / 8 : bx; F.in = args.in; F.out = args.out; F.ws = args.ws; }
    unsigned char* ws = args.ws;
    const int lo = args.ph_lo, hi = args.ph_hi;
#ifndef PH_MASK
#define PH_MASK 0x3ff
#endif
#define IN(k) (((PH_MASK >> (k)) & 1) && lo <= (k) && (k) < hi)
#ifndef REP_MASK
#define REP_MASK 0
#endif
#define REPS(k) for (int rep_ = 0; rep_ < ((((REP_MASK) >> (k)) & 1) ? 2 : 1); ++rep_)
#define SEAM(k) do { if (IN(k) && IN((k) + 1)) { xcd_barrier(bar); } } while (0)

    if (IN(0)) { MKFRAME(); if (blockIdx.x == 0) { for (int i = F.tid; i < CW_BAR + XCD_BAR_WORDS; i += NWAVES * 64) ((unsigned*)(ws + WS_CTL))[i] = 0u; } REPS(0) p0_prologue(F); }
    cg::this_grid().sync();
    XcdBarrier bar;
    { volatile LAS unsigned* st = (volatile LAS unsigned*)(lds + MISC_OFF) + 200; if (threadIdx.x == 0) { st[0] = 0u; st[1] = 0u; } __syncthreads(); bar = xcd_barrier_post((unsigned*)(ws + WS_CTL) + CW_BAR, st); }
    if (IN(1)) { MKFRAME();
        DenseSched S{(const char*)(ws + WS_XN), (const char*)(ws + WS_WIN), T / 256, INW / 256, D / 64, F.G, (int)blockIdx.x, (size_t)256 * D * 2, (size_t)256 * D * 2, (REP_MASK >> 1) & 1};
        EpiInProj E{ws, F.in[I_BIN]};
        pg8::gemm_phase<EpiInProj, DenseSched, true, false>(F.lds, D * 2, D * 2, S, E, nullptr);
    }
    SEAM(1);
    if (IN(2)) { MKFRAME(); p2_fixup(F); REPS(2) p2_lru(F); }
    SEAM(2);
    if (IN(3)) { MKFRAME();
        const attn_body::AttnTensors AT{(const attn_body::bf16*)(ws + WS_Q), (const attn_body::bf16*)(ws + WS_KV), (const attn_body::bf16*)(ws + WS_KV) + KVW, (attn_body::bf16*)(ws + WS_AR)};
        const attn_body::StaticOrder S((int)F.G, F.vcu);
        REPS(3) attn_body::attn_phase<attn_body::StaticOrder>((char*)lds, AT, S);
    }
    SEAM(3);
    if (IN(4)) { MKFRAME();
        MergeSched S{(const char*)(ws + WS_AR), (const char*)(ws + WS_WCAT), F.G, (int)blockIdx.x};
        EpiMerge E{(const bf16*)(ws + WS_GL), (bf16*)(ws + WS_MERGED)};
        pg8::gemm_phase<EpiMerge, MergeSched, true, false>(F.lds, ARW * 2, ARW * 2, S, E, nullptr);
    }
    SEAM(4);
    if (IN(5)) { MKFRAME();
        DenseSched S{(const char*)(ws + WS_MERGED), (const char*)(ws + WS_WO), T / 256, D / 256, D / 64, F.G, (int)blockIdx.x, (size_t)256 * D * 2, (size_t)256 * D * 2, (REP_MASK >> 5) & 1};
        EpiResF32 E{F.in[I_X], F.out};
        pg8::gemm_phase<EpiResF32, DenseSched, true, false>(F.lds, D * 2, D * 2, S, E, nullptr);
    }
    SEAM(5);
    if (IN(6)) { MKFRAME(); p6_router(F); }
    SEAM(6);
    if (IN(7)) { MKFRAME();
        moe_tables(F);
        MoeSched<8> S{(const char*)(ws + WS_XN), (const char*)(ws + WS_WGU), (const LAS int*)(F.lds + MISC_OFF) + 32, F.G, (int)blockIdx.x, (size_t)2 * DFF * D};
        moe_gather_table(F, S);
        EpiSwiGLU E{F.in[I_BGU], (unsigned char*)(ws + WS_ACT)};
        pg8::gemm_phase<EpiSwiGLU, MoeSched<8>, true, true, true>(F.lds, D, D, S, E, (const LAS int*)(F.lds + GTAB_OFF));
    }
    SEAM(7);
    if (IN(8)) { MKFRAME();
        moe_tables(F);
        MoeDownSched S; S.A = (const char*)(ws + WS_ACT); S.B = (const char*)(ws + WS_WD); S.nbp = (const LAS int*)(F.lds + MISC_OFF) + 32; S.G = F.G; S.c = (int)blockIdx.x; S.estepB = (size_t)D * DFF;
        EpiDown E{F.in[I_BDN], (const float*)(ws + WS_GATEL), (bf16*)(ws + WS_Y)};
        pg8::gemm_phase<EpiDown, MoeDownSched, true, false, true>(F.lds, DFF, DFF, S, E, nullptr);
    }
    SEAM(8);
    if (IN(9)) { MKFRAME(); moe_tables(F); p10_final(F); }
#undef IN
#undef SEAM
}

#ifndef MK_N_LAUNCHES
#define MK_N_LAUNCHES 1
#endif
extern "C" void kernel_launch(void* const* d_in, const int* in_sizes, int n_in, void* d_out, int out_size, void* d_ws, size_t ws_size, hipStream_t stream) {
    static int grid = 0;
    if (grid == 0) {
        if (n_in != 24 || in_sizes[0] != T * D || out_size != T * D || ws_size < WS_END) { fprintf(stderr, "kernel_launch: unexpected shapes (n_in %d, in0 %d, out %d, ws %zu < %zu)\n", n_in, n_in > 0 ? in_sizes[0] : -1, out_size, ws_size, (size_t)WS_END); grid = -1; return; }
        int dev = 0, cus = 0, per_cu = 0;
        if (hipGetDevice(&dev) != hipSuccess || hipDeviceGetAttribute(&cus, hipDeviceAttributeMultiprocessorCount, dev) != hipSuccess) { grid = -1; return; }
        if (hipFuncSetAttribute((const void*)mk_fwd, hipFuncAttributeMaxDynamicSharedMemorySize, LDS_BYTES) != hipSuccess) { fprintf(stderr, "kernel_launch: hipFuncSetAttribute failed\n"); grid = -1; return; }
        if (hipOccupancyMaxActiveBlocksPerMultiprocessor(&per_cu, (const void*)mk_fwd, NWAVES * 64, LDS_BYTES) != hipSuccess || per_cu < 1) { fprintf(stderr, "kernel_launch: occupancy query reports %d\n", per_cu); per_cu = 1; }
        (void)hipGetLastError();
        grid = cus;
    }
    if (grid < 0) return;
    Args a{};
    for (int i = 0; i < 24; ++i) a.in[i] = (const float*)d_in[i];
    a.out = (float*)d_out; a.ws = (unsigned char*)d_ws;
    const int nl = 1;
    for (int li = 0; li < nl; ++li) {
        a.ph_lo = (nl == 1) ? 0 : li; a.ph_hi = (nl == 1) ? N_PHASES : li + 1;
        void* kargs[] = {&a};
        const hipError_t le = hipLaunchCooperativeKernel((const void*)mk_fwd, dim3(grid), dim3(NWAVES * 64), kargs, LDS_BYTES, stream);
        if (le != hipSuccess) { fprintf(stderr, "kernel_launch: launch %d failed: %s (grid %d)\n", li, hipGetErrorName(le), grid); break; }
    }
}
```

```cpp
#include <hip/hip_runtime.h>
#include <hip/hip_cooperative_groups.h>
#include <cstdio>
#include <cstdint>
namespace pg8 {
#define PG8_LAS __attribute__((address_space(3)))
typedef unsigned short bf16_t;
typedef short bf16x8 __attribute__((ext_vector_type(8)));
typedef float f32x4 __attribute__((ext_vector_type(4)));
typedef float f32x2 __attribute__((ext_vector_type(2)));
typedef unsigned u32x4 __attribute__((ext_vector_type(4)));
typedef unsigned u32x2 __attribute__((ext_vector_type(2)));
typedef int v8i32 __attribute__((ext_vector_type(8)));
typedef int v4i32 __attribute__((ext_vector_type(4)));
constexpr int BM = 256, BK = 64, HALF = 128, HTB = HALF * BK * 2  , STAGE_BYTES = 8 * HTB, NXCD = 8, WGM = 8;

__host__ __device__ __forceinline__ int lds_byte(int r, int c) { const int st = (r >> 4) * 2 + (c >> 5), rr = r & 15, cc = c & 31, ob = rr * 64 + cc * 2; return st * 1024 + (ob ^ (((ob >> 9) & 1) << 5)); }
__host__ __device__ __forceinline__ void stage_rc(int b, int& R, int& C) { const int st = b / 1024, sb = b % 1024, swz = sb ^ (((sb >> 9) & 1) << 5); R = (st >> 1) * 16 + swz / 64; C = (st & 1) * 32 + (swz % 64) / 2; }
__host__ __device__ __forceinline__ int perm32(int rho) { const int n = rho >> 4, i = rho & 15; return 8 * (i >> 2) + 4 * n + (i & 3); }

struct Unit { int pm, pn, aux, ui; };

__device__ __forceinline__ void dense_tile(int L, int nM, int nN, int& pm, int& pn) {
    const int nwg = nM * nN; int wgid = L;
    { const int q = nwg / NXCD, r = nwg % NXCD, xcd = wgid % NXCD, off = wgid / NXCD; wgid = (xcd < r ? xcd * (q + 1) : r * (q + 1) + (xcd - r) * q) + off; }
    const int nig = WGM * nN, gid = wgid / nig, fm = gid * WGM, gsz = (nM - fm) < WGM ? (nM - fm) : WGM;
    pm = fm + ((wgid % nig) % gsz); pn = (wgid % nig) / gsz;
}

__device__ __forceinline__ unsigned cvt_pk_bf16(float lo, float hi) { unsigned r; asm volatile("v_cvt_pk_bf16_f32 %0, %1, %2" : "=v"(r) : "v"(lo), "v"(hi)); return r; }
__device__ __forceinline__ float bf_lo(unsigned w) { return __uint_as_float(w << 16); }
__device__ __forceinline__ float bf_hi(unsigned w) { return __uint_as_float(w & 0xffff0000u); }
__device__ __forceinline__ float fast_sigmoid(float x) { return __builtin_amdgcn_rcpf(1.0f + __builtin_amdgcn_exp2f(-1.4426950408889634f * x)); }

template <class Epi, class Sched, bool ALIGN_EPI, bool GATHER, bool FP8 = false>
__device__ __forceinline__ void gemm_phase(PG8_LAS unsigned char* lds, const int lda, const int ldb, const Sched& S, const Epi& E, const PG8_LAS unsigned short* gtab) {
    const int tid = threadIdx.x, wid = __builtin_amdgcn_readfirstlane(tid >> 6), lane = tid & 63, wr = wid >> 2, wc = wid & 3, fr = lane & 15, fq = lane >> 4;
    unsigned voffA[2], voffB[2]; int RA[2];
#pragma unroll
    for (int i = 0; i < 2; ++i) { int R, C; stage_rc(tid * 16 + i * 8192, R, C); const int Rb = Epi::PERM ? ((R & ~31) + perm32(R & 31)) : R;
        voffA[i] = GATHER ? (unsigned)(C * 2) : (unsigned)(R * lda + C * 2); voffB[i] = (unsigned)(Rb * ldb + C * 2); RA[i] = R; }
    const size_t kstep = (size_t)(BK * 2);
    const size_t hstepA = GATHER ? 0 : (size_t)HALF * lda;
    const size_t hstepB = (size_t)HALF * ldb;
    const unsigned ldsw = (unsigned)wid * 1024u;
    const int aoff = lds_byte(wr * 64 + fr, fq * 8), boff = lds_byte(wc * 32 + fr, fq * 8);
    const int aoff8 = lds_byte(wr * 64 + fr, (fq >> 1) * 32 + (fq & 1) * 16), boff8 = lds_byte(wc * 32 + fr, (fq >> 1) * 32 + (fq & 1) * 16);
    unsigned gC[2][2], gN[2][2];
#define PG8_SA(b, h) (((b) * 2 + (h)) * HTB)
#define PG8_SB(b, h) ((4 + (b) * 2 + (h)) * HTB)
#define PG8_GLDS(gp, bufoff, i) __builtin_amdgcn_global_load_lds((const unsigned*)(gp), (PG8_LAS unsigned*)(lds + (bufoff) + ldsw + (i) * 8192), 16, 0, 0)
#define PG8_STAGE_B(bufoff, gbase) do { _Pragma("unroll") for (int _i = 0; _i < 2; ++_i) PG8_GLDS((const char*)(gbase) + voffB[_i], bufoff, _i); } while (0)
#define PG8_STAGE_A(bufoff, gbase, h, nx) do { _Pragma("unroll") for (int _i = 0; _i < 2; ++_i) { \
        if constexpr (GATHER) PG8_GLDS((const char*)(gbase) + ((nx) ? gN[h][_i] : gC[h][_i]) + voffA[_i], bufoff, _i); \
        else PG8_GLDS((const char*)(gbase) + voffA[_i], bufoff, _i); } } while (0)
#define PG8_LDA(dst, b, h) do { if constexpr (FP8) { _Pragma("unroll") for (int m = 0; m < 4; ++m) dst##8[m] = __builtin_shufflevector(*(const PG8_LAS v4i32*)(lds + PG8_SA(b, h) + aoff + m * 2048), *(const PG8_LAS v4i32*)(lds + PG8_SA(b, h) + aoff + m * 2048 + 1024), 0, 1, 2, 3, 4, 5, 6, 7); } \
        else { _Pragma("unroll") for (int m = 0; m < 4; ++m) _Pragma("unroll") for (int k = 0; k < 2; ++k) dst[m][k] = *(const PG8_LAS bf16x8*)(lds + PG8_SA(b, h) + aoff + m * 2048 + k * 1024); } } while (0)
#define PG8_LDB(dst, b, h) do { if constexpr (FP8) { _Pragma("unroll") for (int n = 0; n < 2; ++n) dst##8[n] = __builtin_shufflevector(*(const PG8_LAS v4i32*)(lds + PG8_SB(b, h) + boff + n * 2048), *(const PG8_LAS v4i32*)(lds + PG8_SB(b, h) + boff + n * 2048 + 1024), 0, 1, 2, 3, 4, 5, 6, 7); } \
        else { _Pragma("unroll") for (int n = 0; n < 2; ++n) _Pragma("unroll") for (int k = 0; k < 2; ++k) dst[n][k] = *(const PG8_LAS bf16x8*)(lds + PG8_SB(b, h) + boff + n * 2048 + k * 1024); } } while (0)
#define PG8_MMA(ai, bj, At, Bt) do { __builtin_amdgcn_s_setprio(1); _Pragma("unroll") for (int m = 0; m < 4; ++m) _Pragma("unroll") for (int n = 0; n < 2; ++n) { \
        if constexpr (FP8) { asm volatile("v_mfma_scale_f32_16x16x128_f8f6f4 %0, %1, %2, %0, %3, %3 op_sel_hi:[0,0,0]" : "+v"(acc[ai][bj][m][n]) : "v"(Bt##8[n]), "v"(At##8[m]), "v"(scale1)); } \
        else { _Pragma("unroll") for (int k = 0; k < 2; ++k) acc[ai][bj][m][n] = __builtin_amdgcn_mfma_f32_16x16x32_bf16(Bt[n][k], At[m][k], acc[ai][bj][m][n], 0, 0, 0); } } \
        __builtin_amdgcn_s_setprio(0); } while (0)
#define PG8_WAIT_V(n) asm volatile("s_waitcnt vmcnt(" #n ")" ::: "memory")
#define PG8_WAIT_L(n) asm volatile("s_waitcnt lgkmcnt(" #n ")" ::: "memory")
#define PG8_BAR __builtin_amdgcn_s_barrier()
#define PG8_SCHED __builtin_amdgcn_sched_barrier(0)
#define PG8_GOFF(dst, ui_) do { if constexpr (GATHER) { _Pragma("unroll") for (int _h = 0; _h < 2; ++_h) _Pragma("unroll") for (int _i = 0; _i < 2; ++_i) \
        dst[_h][_i] = (unsigned)gtab[(ui_) * 256 + _h * HALF + RA[_i]] * (unsigned)lda; } } while (0)
    Unit cur, nxt; int ui = 0;
    if (!S.next(0, cur)) return;
    cur.ui = 0;
    f32x4 acc[2][2][4][2];
#pragma unroll
    for (int a = 0; a < 2; ++a)
#pragma unroll
        for (int b = 0; b < 2; ++b)
#pragma unroll
            for (int m = 0; m < 4; ++m)
#pragma unroll
                for (int n = 0; n < 2; ++n) acc[a][b][m][n] = (f32x4){0.f, 0.f, 0.f, 0.f};
    bf16x8 At[4][2], B0[2][2], B1[2][2]; v8i32 At8[4], B08[2], B18[2];
    int scale1 = 0x7f7f7f7f; asm volatile("" : "+v"(scale1));
    const char* cA = S.a_ptr(cur); const char* cB = S.b_ptr(cur);
    PG8_GOFF(gC, 0);
#pragma unroll
    for (int _h = 0; _h < 2; ++_h)
#pragma unroll
        for (int _i = 0; _i < 2; ++_i) gN[_h][_i] = gC[_h][_i];
    PG8_STAGE_B(PG8_SB(0, 0), cB); PG8_STAGE_B(PG8_SB(0, 1), cB + hstepB); PG8_STAGE_A(PG8_SA(0, 0), cA, 0, false); PG8_STAGE_A(PG8_SA(0, 1), cA + hstepA, 1, false);
    if (wr == 1) PG8_BAR;
    PG8_WAIT_V(2); PG8_BAR;
    PG8_STAGE_B(PG8_SB(1, 0), cB + kstep); PG8_STAGE_A(PG8_SA(1, 0), cA + kstep, 0, false); PG8_STAGE_B(PG8_SB(1, 1), cB + hstepB + kstep);
    PG8_WAIT_V(6); PG8_BAR;
    for (;;) {
        const bool has_next = S.next(ui + 1, nxt); nxt.ui = ui + 1;
        const int nt = S.ntiles(cur);
        const char* nA = has_next ? S.a_ptr(nxt) : cA; const char* nB = has_next ? S.b_ptr(nxt) : cB;
        if (has_next) PG8_GOFF(gN, ui + 1);
#pragma unroll 1
        for (int t = 0; t < nt; t += 2) {
            const bool last = (t == nt - 2);
            const char* a1 = cA + (size_t)(t + 1) * kstep;
            const char* a2 = last ? nA : cA + (size_t)(t + 2) * kstep; const char* b2 = last ? nB : cB + (size_t)(t + 2) * kstep;
            const char* a3 = a2 + kstep; const char* b3 = b2 + kstep;
            PG8_LDB(B0, 0, 0); PG8_LDB(B1, 0, 1); PG8_SCHED; PG8_LDA(At, 0, 0); PG8_STAGE_A(PG8_SA(1, 1), a1 + hstepA, 1, false);
            PG8_WAIT_V(8); PG8_WAIT_L(0); PG8_BAR; PG8_MMA(0, 0, At, B0); PG8_MMA(0, 1, At, B1); PG8_BAR; PG8_SCHED;
            PG8_LDA(At, 0, 1); PG8_STAGE_B(PG8_SB(0, 0), b2); PG8_STAGE_B(PG8_SB(0, 1), b2 + hstepB); PG8_STAGE_A(PG8_SA(0, 0), a2, 0, last);
            PG8_WAIT_V(8); PG8_WAIT_L(0); PG8_BAR; PG8_MMA(1, 0, At, B0); PG8_MMA(1, 1, At, B1); PG8_BAR; PG8_SCHED;
            PG8_LDB(B0, 1, 0); PG8_LDB(B1, 1, 1); PG8_SCHED; PG8_LDA(At, 1, 0); PG8_STAGE_A(PG8_SA(0, 1), a2 + hstepA, 1, last);
            PG8_WAIT_V(8); PG8_WAIT_L(0); PG8_BAR; PG8_MMA(0, 0, At, B0); PG8_MMA(0, 1, At, B1); PG8_BAR; PG8_SCHED;
            PG8_LDA(At, 1, 1); PG8_STAGE_B(PG8_SB(1, 0), b3); PG8_STAGE_B(PG8_SB(1, 1), b3 + hstepB); PG8_STAGE_A(PG8_SA(1, 0), a3, 0, last);
            PG8_WAIT_V(8); PG8_WAIT_L(0); PG8_BAR; PG8_MMA(1, 0, At, B0); PG8_MMA(1, 1, At, B1); PG8_BAR; PG8_SCHED;
        }
        if constexpr (ALIGN_EPI) { if (wr == 0) PG8_BAR; }
        if constexpr (FP8) asm volatile("s_nop 15\n\ts_nop 15" ::: "memory");
        { int fr_ = fr, fq_ = fq; asm volatile("" : "+v"(fr_), "+v"(fq_));
          E(acc, cur, wr, wc, fr_, fq_); }
        if (!E.keep(cur)) {
#pragma unroll
        for (int a = 0; a < 2; ++a)
#pragma unroll
            for (int b = 0; b < 2; ++b)
#pragma unroll
                for (int m = 0; m < 4; ++m)
#pragma unroll
                    for (int n = 0; n < 2; ++n) acc[a][b][m][n] = (f32x4){0.f, 0.f, 0.f, 0.f};
        }
        if (!has_next) break;
        cur = nxt; cA = nA; cB = nB; ++ui;
#pragma unroll
        for (int _h = 0; _h < 2; ++_h)
#pragma unroll
            for (int _i = 0; _i < 2; ++_i) gC[_h][_i] = gN[_h][_i];
        if constexpr (ALIGN_EPI) { if (wr == 1) PG8_BAR; }
    }
    PG8_WAIT_V(0);
    if constexpr (!ALIGN_EPI) { if (wr == 0) PG8_BAR; }
    PG8_BAR;
#undef PG8_SA
#undef PG8_SB
#undef PG8_GLDS
#undef PG8_STAGE_A
#undef PG8_STAGE_B
#undef PG8_LDA
#undef PG8_LDB
#undef PG8_MMA
#undef PG8_WAIT_V
#undef PG8_WAIT_L
#undef PG8_BAR
#undef PG8_SCHED
#undef PG8_GOFF
}
}
#include <hip/hip_bf16.h>
#include <cmath>
namespace attn_body {
using bf16=__hip_bfloat16;
using bf16x8=__attribute__((ext_vector_type(8)))short;
using s16x4=__attribute__((ext_vector_type(4)))short;
using f32x16=__attribute__((ext_vector_type(16)))float;
using u32x4=__attribute__((ext_vector_type(4)))unsigned;
constexpr int BATCH=8,NHEAD=8,NKV=2,SEQ=4096,D=64;
constexpr int QP=512,KVP=256,OP=1536;
constexpr int NW=8,QBLK=32,QB=QBLK*NW,KVBLK=64,NQB=SEQ/QB;
constexpr int ATTN_UNIT_ROWS=QB;
__device__ __forceinline__ int crow(int r,int hi){return (r&3)+8*(r>>2)+4*hi;}
#define SBAR() __builtin_amdgcn_sched_barrier(0)
constexpr int NSLOT=3, SLOTB=8192;
constexpr int LDS_K=0, LDS_V=NSLOT*SLOTB, LDS_WS=2*NSLOT*SLOTB, LDS_OST=LDS_WS+NW*64*4, LDS_BYTES=LDS_OST+NW*4096;
constexpr float C2=0.125f*1.4426950408889634f;
__device__ __forceinline__ void glds16(const void*gsrc,unsigned lds_dst){unsigned keep;
  asm volatile("s_mov_b32 %0, m0\n\ts_mov_b32 m0, %2\n\ts_nop 0\n\tglobal_load_lds_dwordx4 %1, off\n\ts_mov_b32 m0, %0":"=&s"(keep):"v"(gsrc),"s"(lds_dst):"memory");}
__device__ __forceinline__ float max3f(float a,float b,float c){float r;asm("v_max3_f32 %0, %1, %2, %3":"=v"(r):"v"(a),"v"(b),"v"(c));return r;}
__device__ __forceinline__ float max2f(float a,float b){float r;asm("v_max_f32_e32 %0, %1, %2":"=v"(r):"v"(a),"v"(b));return r;}
__device__ __forceinline__ float fadd_s(float a,float b){float r;asm("v_add_f32_e32 %0, %1, %2":"=v"(r):"v"(a),"v"(b));return r;}
__device__ __forceinline__ float fsub_s(float a,float b){float r;asm("v_sub_f32_e32 %0, %1, %2":"=v"(r):"v"(a),"v"(b));return r;}
typedef float f32x2_t __attribute__((ext_vector_type(2))); typedef __bf16 bf16x2_t __attribute__((ext_vector_type(2)));
__device__ __forceinline__ unsigned cvtpk_s(float lo,float hi){f32x2_t v={lo,hi};bf16x2_t b=__builtin_convertvector(v,bf16x2_t);return __builtin_bit_cast(unsigned,b);}
#define WAIT_BAR(N) asm volatile("s_waitcnt vmcnt(" #N ") lgkmcnt(0)\n\ts_barrier":::"memory")

__device__ __forceinline__ void qkt(f32x16&p0,f32x16&p1,const char*Kslot,const bf16x8*qr,const f32x16&negm,int r32,int hi){
  const char*kb=Kslot+hi*1024+r32*16;
  #pragma unroll
  for(int d0=0;d0<4;++d0){
    const bf16x8 b0=*reinterpret_cast<const bf16x8*>(kb+d0*2048);
    const bf16x8 b1=*reinterpret_cast<const bf16x8*>(kb+d0*2048+512);
    if(d0==0){p0=__builtin_amdgcn_mfma_f32_32x32x16_bf16(b0,qr[0],negm,0,0,0);p1=__builtin_amdgcn_mfma_f32_32x32x16_bf16(b1,qr[0],negm,0,0,0);}
    else{p0=__builtin_amdgcn_mfma_f32_32x32x16_bf16(b0,qr[d0],p0,0,0,0);p1=__builtin_amdgcn_mfma_f32_32x32x16_bf16(b1,qr[d0],p1,0,0,0);}}
}
typedef __attribute__((address_space(3))) const char* lds_cptr;
typedef short v4i16_t __attribute__((ext_vector_type(4)));
__device__ __forceinline__ void kload8(bf16x8*kf,lds_cptr kp){
  kf[0]=*(const __attribute__((address_space(3))) bf16x8*)(kp);      kf[1]=*(const __attribute__((address_space(3))) bf16x8*)(kp+512);
  kf[2]=*(const __attribute__((address_space(3))) bf16x8*)(kp+2048); kf[3]=*(const __attribute__((address_space(3))) bf16x8*)(kp+2560);
  kf[4]=*(const __attribute__((address_space(3))) bf16x8*)(kp+4096); kf[5]=*(const __attribute__((address_space(3))) bf16x8*)(kp+4608);
  kf[6]=*(const __attribute__((address_space(3))) bf16x8*)(kp+6144); kf[7]=*(const __attribute__((address_space(3))) bf16x8*)(kp+6656);
}
__device__ __forceinline__ void kload2(bf16x8*kf,lds_cptr kp,int j){ kf[2*j]=*(const __attribute__((address_space(3))) bf16x8*)(kp+j*2048); kf[2*j+1]=*(const __attribute__((address_space(3))) bf16x8*)(kp+j*2048+512); }
__device__ __forceinline__ s16x4 vtr(lds_cptr p){ return __builtin_bit_cast(s16x4,__builtin_amdgcn_ds_read_tr16_b64_v4i16((__attribute__((address_space(3))) v4i16_t*)p)); }
__device__ __forceinline__ float rowmax(const f32x16&p0,const f32x16&p1){
  float a=max3f(p0[0],p0[1],p1[0]),b=max3f(p0[2],p0[3],p1[1]);a=max3f(a,p1[2],p1[3]);
  #pragma unroll
  for(int r=4;r<16;r+=4){a=max3f(a,p0[r],p0[r+1]);b=max3f(b,p0[r+2],p0[r+3]);a=max3f(a,p1[r],p1[r+1]);b=max3f(b,p1[r+2],p1[r+3]);}
  const float m=max2f(a,b);
  auto rr=__builtin_amdgcn_permlane32_swap(__float_as_uint(m),__float_as_uint(m),false,false);
  return max2f(__uint_as_float(rr[0]),__uint_as_float(rr[1]));
}
__device__ __forceinline__ void pv(f32x16*o,int vb,bf16x8 pa0,bf16x8 pa1,bf16x8 pa2,bf16x8 pa3){
  #pragma unroll
  for(int d0=0;d0<2;++d0){s16x4 lo[4],hi[4];
    #pragma unroll
    for(int ks=0;ks<4;++ks){
      asm volatile("ds_read_b64_tr_b16 %0,%1 offset:%c2":"=&v"(lo[ks]):"v"(vb),"i"(d0*4096+ks*1024):"memory");
      asm volatile("ds_read_b64_tr_b16 %0,%1 offset:%c2":"=&v"(hi[ks]):"v"(vb),"i"(d0*4096+ks*1024+512):"memory");}
    asm volatile("s_waitcnt lgkmcnt(0)":::"memory");SBAR();
    #define PK(k) (bf16x8){lo[k][0],lo[k][1],lo[k][2],lo[k][3],hi[k][0],hi[k][1],hi[k][2],hi[k][3]}
    o[d0]=__builtin_amdgcn_mfma_f32_32x32x16_bf16(pa0,PK(0),o[d0],0,0,0);
    o[d0]=__builtin_amdgcn_mfma_f32_32x32x16_bf16(pa1,PK(1),o[d0],0,0,0);
    o[d0]=__builtin_amdgcn_mfma_f32_32x32x16_bf16(pa2,PK(2),o[d0],0,0,0);
    o[d0]=__builtin_amdgcn_mfma_f32_32x32x16_bf16(pa3,PK(3),o[d0],0,0,0);
    #undef PK
  }
}

#ifndef ATTN_STORE16
#define ATTN_STORE16(p,v) (*(u32x4*)(p)=(v))
#endif
template<int THRL> __device__ __forceinline__ void attn_unit(int b,int h,int qb,const bf16*Q,const bf16*__restrict__ K,const bf16*__restrict__ V,bf16*O,char*shm){
  const int tid=threadIdx.x,lane=tid&63,r32=lane&31,hi=lane>>5; const int wid=__builtin_amdgcn_readfirstlane(tid>>6);
  const long rowbase=(long)b*SEQ; const int q0=qb*QB;
  const bf16*Qw=Q+(rowbase+q0+wid*QBLK)*QP+h*D; const int kvh=h/(NHEAD/NKV);
  const bf16*Kh=K+rowbase*KVP+kvh*D,*Vh=V+rowbase*KVP+kvh*D;
  const unsigned lds0=(unsigned)(uintptr_t)shm;
  float*wsf=(float*)(shm+LDS_WS)+wid*64;
  const bf16*ksrc=Kh+(long)lane*KVP+wid*8;
  const bf16*vsrc=Vh+(long)(16*(wid&3)+(lane>>2))*KVP+(wid>>2)*32+(lane&3)*8;
  const unsigned kdst=lds0+LDS_K+wid*1024, vdst=lds0+LDS_V+wid*1024;
  #define DMA_K(t,slot) glds16(ksrc+(long)(t)*KVBLK*KVP,(unsigned)__builtin_amdgcn_readfirstlane(kdst+(slot)))
  #define DMA_V(t,slot) glds16(vsrc+(long)(t)*KVBLK*KVP,(unsigned)__builtin_amdgcn_readfirstlane(vdst+(slot)))
  const int vb0=(int)(lds0+LDS_V)+((lane>>4)&1)*32+(lane&3)*8+(4*hi+((lane&15)>>2))*64;
  const char*Kbase=shm+LDS_K; bf16x8 kf[8];
  const lds_cptr shm3=(lds_cptr)shm; const lds_cptr kp0=shm3+LDS_K+hi*1024+r32*16; const lds_cptr vp0=shm3+LDS_V+((lane>>4)&1)*32+(lane&3)*8+(4*hi+((lane&15)>>2))*64;
  constexpr int NT=SEQ/KVBLK;
  DMA_K(0,0);DMA_V(0,0);DMA_K(1,SLOTB);
  bf16x8 qr[4];
  #pragma unroll
  for(int d0=0;d0<4;++d0)qr[d0]=*reinterpret_cast<const bf16x8*>(&Qw[(long)r32*QP+d0*16+hi*8]);
  float mhat=0.f,l_reg=0.f;f32x16 o[2];o[0]=f32x16{};o[1]=f32x16{};f32x16 negm=f32x16{};asm volatile("":"+v"(negm));
  #define CMASK(P0,P1,t) do{}while(0)
  bool resc=false;
  #define START(P0,P1) do{ const float rm=rowmax(P0,P1); resc=false; \
    { const float dl=rm; mhat=fadd_s(mhat,dl); \
      _Pragma("unroll") for(int r=0;r<16;++r){P0[r]=fsub_s(P0[r],dl);P1[r]=fsub_s(P1[r],dl);} \
      _Pragma("unroll") for(int r=0;r<16;++r)negm[r]=-mhat; asm volatile("":"+v"(negm)); } \
    _Pragma("unroll") for(int r=0;r<16;++r)P0[r]=__builtin_amdgcn_exp2f(P0[r]); }while(0)
  #define RESC() do{ if(resc){ asm volatile("s_waitcnt lgkmcnt(0)":::"memory"); \
      _Pragma("unroll") for(int d_=0;d_<2;++d_) _Pragma("unroll") for(int r=0;r<16;++r)o[d_][r]*=wsf[crow(r,hi)]; } }while(0)
  f32x16 pA0,pA1,pB0,pB1;
  int sl_prev=0,sl_cur=0,sl_next=SLOTB;
  #define ROT() do{sl_prev=sl_cur;sl_cur=sl_next;sl_next=(sl_next==(NSLOT-1)*SLOTB)?0:sl_next+SLOTB;}while(0)
  DMA_K(2,2*SLOTB);
  WAIT_BAR(3);
  qkt(pA0,pA1,Kbase,qr,negm,r32,hi);asm volatile("s_nop 15\n\ts_nop 7":"+v"(pA0),"+v"(pA1));CMASK(pA0,pA1,0);
  START(pA0,pA1);
  _Pragma("unroll") for(int r=0;r<16;++r)pA1[r]=__builtin_amdgcn_exp2f(pA1[r]);
  WAIT_BAR(0);
  DMA_K(3,0);DMA_V(1,SLOTB);
  ROT();
  kload8(kf,kp0+sl_cur);
  WAIT_BAR(2);
  s16x4 vlo[8],vhi[8]; u32x4 pw0,pw1,pw2,pw3;
  #define PKW(P,B) cvtpk_s(P[B],P[B+1])
  #define PAF(k) __builtin_bit_cast(bf16x8,pw##k)
  #define VFR(i) (bf16x8){vlo[i][0],vlo[i][1],vlo[i][2],vlo[i][3],vhi[i][0],vhi[i][1],vhi[i][2],vhi[i][3]}
  #define PIN(x) asm volatile("":"+v"(x))
  #define MX3(a,b,c) __builtin_fmaxf(__builtin_fmaxf((a),(b)),(c))
  #define GAPA(MF,A0,A1,A2,A3,W0,W1,PW) do{ MF; sacc+=A0; sacc+=A1; sacc+=A2; sacc+=A3; PIN(sacc); W0; W1; PIN(PW); SBAR(); }while(0)
  #define EX(v) __builtin_amdgcn_exp2f(v)
  #define GAPB(MF,X,B) do{ MF; X[B]=EX(X[B]); X[B+1]=EX(X[B+1]); X[B+2]=EX(X[B+2]); X[B+3]=EX(X[B+3]); PIN(X); SBAR(); }while(0)
  #define VRD(i) do{ vlo[i]=vtr(vp_+(((i)>>2)*4096+((i)&3)*1024)); vhi[i]=vtr(vp_+(((i)>>2)*4096+((i)&3)*1024+512)); }while(0)
  #define KRD(G,j) do{ if(G){ kload2(kf,kp0+sl_next,j); SBAR(); } }while(0)
  #define STEP(C0,C1,P0,P1,t,GK,GV,GL) do{ SBAR(); \
    const lds_cptr vp_=vp0+sl_prev; \
    VRD(0); SBAR(); float sacc=(P0[0]+P0[1]); \
    GAPA(C0=__builtin_amdgcn_mfma_f32_32x32x16_bf16(kf[0],qr[0],negm,0,0,0), P0[2],P0[3],P0[4],P0[5],     pw0[0]=PKW(P0,0), pw0[1]=PKW(P0,2), pw0); \
    VRD(4); SBAR(); GAPA(C1=__builtin_amdgcn_mfma_f32_32x32x16_bf16(kf[1],qr[0],negm,0,0,0), P0[6],P0[7],P0[8],P0[9],     pw0[2]=PKW(P0,4), pw0[3]=PKW(P0,6), pw0); \
    VRD(1); SBAR(); GAPA(C0=__builtin_amdgcn_mfma_f32_32x32x16_bf16(kf[2],qr[1],C0,0,0,0),   P0[10],P0[11],P0[12],P0[13], pw1[0]=PKW(P0,8), pw1[1]=PKW(P0,10), pw1); \
    VRD(5); SBAR(); GAPA(C1=__builtin_amdgcn_mfma_f32_32x32x16_bf16(kf[3],qr[1],C1,0,0,0),   P0[14],P0[15],P1[0],P1[1],   pw1[2]=PKW(P0,12),pw1[3]=PKW(P0,14), pw1); \
    VRD(2); SBAR(); GAPA(C0=__builtin_amdgcn_mfma_f32_32x32x16_bf16(kf[4],qr[2],C0,0,0,0),   P1[2],P1[3],P1[4],P1[5],     pw2[0]=PKW(P1,0), pw2[1]=PKW(P1,2), pw2); \
    VRD(6); SBAR(); GAPA(C1=__builtin_amdgcn_mfma_f32_32x32x16_bf16(kf[5],qr[2],C1,0,0,0),   P1[6],P1[7],P1[8],P1[9],     pw2[2]=PKW(P1,4), pw2[3]=PKW(P1,6), pw2); \
    VRD(3); SBAR(); GAPA(C0=__builtin_amdgcn_mfma_f32_32x32x16_bf16(kf[6],qr[3],C0,0,0,0),   P1[10],P1[11],P1[12],P1[13], pw3[0]=PKW(P1,8), pw3[1]=PKW(P1,10), pw3); \
    VRD(7); SBAR(); GAPA(C1=__builtin_amdgcn_mfma_f32_32x32x16_bf16(kf[7],qr[3],C1,0,0,0),   P1[14],P1[15],0.f,0.f,       pw3[2]=PKW(P1,12),pw3[3]=PKW(P1,14), pw3); \
    l_reg+=sacc; \
    if(GK){DMA_K((t)+3,sl_cur);} if(GV){DMA_V((t)+1,sl_next);} \
    CMASK(C0,C1,t); \
    { float a=MX3(C0[0],C0[1],C1[0]),b=MX3(C0[2],C0[3],C1[1]); a=MX3(a,C1[2],C1[3]); \
      _Pragma("unroll") for(int r=4;r<16;r+=4){a=MX3(a,C0[r],C0[r+1]);b=MX3(b,C0[r+2],C0[r+3]);a=MX3(a,C1[r],C1[r+1]);b=MX3(b,C1[r+2],C1[r+3]);} \
      float rm=__builtin_fmaxf(a,b); { auto rr=__builtin_amdgcn_permlane32_swap(__float_as_uint(rm),__float_as_uint(rm),false,false); rm=__builtin_fmaxf(__uint_as_float(rr[0]),__uint_as_float(rr[1])); } \
      resc=false; \
      if(__builtin_expect(__any(rm>(float)THRL),0)){ const float dl=__builtin_fmaxf(rm,0.f); mhat+=dl; \
        _Pragma("unroll") for(int r=0;r<16;++r){C0[r]-=dl;C1[r]-=dl;} \
        _Pragma("unroll") for(int r=0;r<16;++r)negm[r]=-mhat; asm volatile("":"+v"(negm)); \
        const float f=__builtin_amdgcn_exp2f(-dl); l_reg*=f; if(hi==0)wsf[r32]=f; resc=true; } } \
    SBAR(); \
    GAPB(o[0]=__builtin_amdgcn_mfma_f32_32x32x16_bf16(PAF(0),VFR(0),o[0],0,0,0), C0,0); \
    GAPB(o[1]=__builtin_amdgcn_mfma_f32_32x32x16_bf16(PAF(0),VFR(4),o[1],0,0,0), C0,4); \
    KRD(GL,0); GAPB(o[0]=__builtin_amdgcn_mfma_f32_32x32x16_bf16(PAF(1),VFR(1),o[0],0,0,0), C0,8); \
    KRD(GL,1); GAPB(o[1]=__builtin_amdgcn_mfma_f32_32x32x16_bf16(PAF(1),VFR(5),o[1],0,0,0), C0,12); \
    KRD(GL,2); GAPB(o[0]=__builtin_amdgcn_mfma_f32_32x32x16_bf16(PAF(2),VFR(2),o[0],0,0,0), C1,0); \
    KRD(GL,3); GAPB(o[1]=__builtin_amdgcn_mfma_f32_32x32x16_bf16(PAF(2),VFR(6),o[1],0,0,0), C1,4); \
    GAPB(o[0]=__builtin_amdgcn_mfma_f32_32x32x16_bf16(PAF(3),VFR(3),o[0],0,0,0), C1,8); \
    GAPB(o[1]=__builtin_amdgcn_mfma_f32_32x32x16_bf16(PAF(3),VFR(7),o[1],0,0,0), C1,12); \
    }while(0)
  int t=1;
  for(;t+5<NT;t+=2){
    STEP(pB0,pB1,pA0,pA1,t,true,true,true);     WAIT_BAR(2); RESC(); ROT();
    STEP(pA0,pA1,pB0,pB1,t+1,true,true,true);   WAIT_BAR(2); RESC(); ROT();
  }
  #define ENDW(tt) do{ if((tt)+3<NT){WAIT_BAR(2);} else if((tt)+2<NT){WAIT_BAR(1);} else {WAIT_BAR(0);} }while(0)
  for(;t+1<NT;t+=2){
    STEP(pB0,pB1,pA0,pA1,t,(t+3<NT),(t+1<NT),(t+1<NT));       ENDW(t);   RESC(); ROT();
    STEP(pA0,pA1,pB0,pB1,t+1,(t+4<NT),(t+2<NT),(t+2<NT));     ENDW(t+1); RESC(); ROT();
  }
  STEP(pB0,pB1,pA0,pA1,NT-1,false,false,false); RESC();
  { float sacc=pB0[0]+pB0[1]; _Pragma("unroll") for(int r=2;r<16;++r)sacc+=pB0[r]; _Pragma("unroll") for(int r=0;r<16;++r)sacc+=pB1[r]; l_reg+=sacc;
    pw0=(u32x4){PKW(pB0,0),PKW(pB0,2),PKW(pB0,4),PKW(pB0,6)};pw1=(u32x4){PKW(pB0,8),PKW(pB0,10),PKW(pB0,12),PKW(pB0,14)};pw2=(u32x4){PKW(pB1,0),PKW(pB1,2),PKW(pB1,4),PKW(pB1,6)};pw3=(u32x4){PKW(pB1,8),PKW(pB1,10),PKW(pB1,12),PKW(pB1,14)};
    SBAR(); pv(o,vb0+sl_cur,PAF(0),PAF(1),PAF(2),PAF(3)); }
  #undef PKW
  #undef PAF
  #undef VFR
  #undef PIN
  #undef MX3
  #undef GAPA
  #undef GAPB
  #undef EX
  #undef VRD
  #undef KRD
  #undef STEP
  #undef ENDW
  {auto rr=__builtin_amdgcn_permlane32_swap(__float_as_uint(l_reg),__float_as_uint(l_reg),false,false);l_reg=__uint_as_float(rr[0])+__uint_as_float(rr[1]);}
  if(hi==0)wsf[32+r32]=l_reg;asm volatile("s_waitcnt lgkmcnt(0)":::"memory");
  float rli[16];
  #pragma unroll
  for(int r=0;r<16;++r)rli[r]=__builtin_amdgcn_rcpf(wsf[32+crow(r,hi)]);
  bf16*Ow=O+(rowbase+q0+wid*QBLK)*OP+h*D;
  { bf16*stg=(bf16*)(shm+LDS_OST)+wid*2048;
    #pragma unroll
    for(int r=0;r<16;++r){const int orow=crow(r,hi);
      #pragma unroll
      for(int d0=0;d0<2;++d0)stg[orow*64+d0*32+r32]=__float2bfloat16(o[d0][r]*rli[r]);}
    asm volatile("s_waitcnt lgkmcnt(0)":::"memory");
    #pragma unroll
    for(int i=0;i<4;++i){const int row=i*8+(lane>>3),ch=lane&7; const u32x4 v=*(const u32x4*)(stg+row*64+ch*8); ATTN_STORE16(Ow+(long)row*OP+ch*8,v);} }
  asm volatile("s_waitcnt lgkmcnt(0)\n\ts_barrier":::"memory");
  #undef DMA_K
  #undef DMA_V
  #undef CMASK
  #undef START
  #undef RESC
  #undef ROT
}
constexpr int ATTN_LDS_BYTES=LDS_BYTES;
struct AttnTensors { const bf16* Q; const bf16* K; const bf16* V; bf16* O; };
struct AttnUnit { int bh; int qb; };
struct StaticOrder {
  int vcu,G;
  __device__ __forceinline__ explicit StaticOrder(int grid,int v):vcu(v),G(grid){}
  __device__ __forceinline__ bool next(int i,AttnUnit&u)const{ const int L=i*G+vcu; if(L>=BATCH*NHEAD*NQB)return false;
    const int pairhalf=L>>5,l=L&31; const int pair=pairhalf>>1,uu=l+32*(pairhalf&1); const int b=pair>>1,kvh=pair&1; u.bh=b*NHEAD+kvh*(NHEAD/NKV)+(uu>>4); u.qb=uu&15; return true; }
  __device__ __forceinline__ void a_ready(const AttnUnit&)const{}
  __device__ __forceinline__ void done(const AttnUnit&)const{}
};
template<class Sched,int THRL=8> __device__ __forceinline__ void attn_phase(char*lds,const AttnTensors&T,const Sched&S){
  AttnUnit u;
  for(int i=0;S.next(i,u);++i){ S.a_ready(u); attn_unit<THRL>(u.bh/NHEAD,u.bh%NHEAD,u.qb,T.Q,T.K,T.V,T.O,lds); S.done(u); }
}
#undef SBAR
#undef WAIT_BAR
}
namespace cg = cooperative_groups;
constexpr int NWAVES = 8;
constexpr int BATCH = 8, SEQ = 4096, D = 1024, T = BATCH * SEQ;
constexpr int HD = 64, NQH = 8, NKVH = 2, QW = NQH * HD, KVW = NKVH * HD;
constexpr int LRU_W = 1024, LRU_NB = 16, LRU_BW = 64;
constexpr int INW = QW + 2 * KVW + 2 * LRU_W + 2 * D;
constexpr int NE = 32, TOPK = 4, DFF = 1024;
constexpr float NORM_EPS = 1e-6f;
constexpr int ARW = QW + LRU_W;
constexpr int ECAP = T;
constexpr int MAXBLK = (T * TOPK) / 256 + NE;
constexpr int MAX_GUNITS = 20;

constexpr size_t MiB = 1u << 20;
constexpr size_t WS_CTL = 0, CTL_ZERO_BYTES = 64 * 1024;
constexpr size_t WS_TOKL = 1 * MiB, WS_GATEL = 5 * MiB, WS_TOKREC = 9 * MiB;
constexpr size_t WS_WIN = 10 * MiB, WS_WCAT = 20 * MiB, WS_WO = 23 * MiB, WS_WGU = 26 * MiB, WS_WD = 154 * MiB;
constexpr size_t WS_XN = 218 * MiB;
constexpr size_t WS_Q = 282 * MiB, WS_KV = 314 * MiB, WS_AR = 330 * MiB, WS_XR = 426 * MiB, WS_YR = 490 * MiB, WS_GL = 554 * MiB;
constexpr size_t WS_MERGED = WS_XR;
constexpr size_t WS_ACT = 282 * MiB, WS_Y = 554 * MiB, WS_END = 826 * MiB;
static_assert(WS_ACT + (size_t)MAXBLK * 256 * DFF * 2 <= WS_Y && WS_Y + (size_t)MAXBLK * 256 * D * 2 <= WS_END, "ws map");
constexpr int CW_CNT = 0;
constexpr int CW_BAR = 1024;

constexpr int RING_BYTES = 131072;
constexpr int GTAB_OFF = RING_BYTES;
constexpr int ETAB_OFF = GTAB_OFF + MAX_GUNITS * 512;
constexpr int MISC_OFF = ETAB_OFF + MAX_GUNITS * 1024;
constexpr int LDS_BYTES = MISC_OFF + 1024;
static_assert(LDS_BYTES <= 163840, "LDS");

#define GAS __attribute__((address_space(1)))
#define LAS __attribute__((address_space(3)))
typedef unsigned short bf16;
typedef unsigned v4u __attribute__((ext_vector_type(4)));
typedef unsigned v2u __attribute__((ext_vector_type(2)));
typedef float f32x4 __attribute__((ext_vector_type(4)));
typedef float f32x2 __attribute__((ext_vector_type(2)));
typedef short bf16x8 __attribute__((ext_vector_type(8)));
#define LDS_WAIT() asm volatile("s_waitcnt lgkmcnt(0)" ::: "memory")
__device__ __forceinline__ unsigned f2bf(float f) { unsigned u = __builtin_bit_cast(unsigned, f); return (u + 0x7fffu + ((u >> 16) & 1u)) >> 16; }
__device__ __forceinline__ unsigned pk2(float lo, float hi) { unsigned r; asm("v_cvt_pk_bf16_f32 %0, %1, %2" : "=v"(r) : "v"(lo), "v"(hi)); return r; }
__device__ __forceinline__ float bflo(unsigned w) { return __uint_as_float(w << 16); }
__device__ __forceinline__ float bfhi(unsigned w) { return __uint_as_float(w & 0xffff0000u); }
__device__ __forceinline__ float wave_sum(float v) {
#pragma unroll
    for (int o = 1; o < 64; o <<= 1) v += __shfl_xor(v, o);
    return v;
}
__device__ __forceinline__ float sigmoidf_fast(float x) { return __builtin_amdgcn_rcpf(1.0f + __builtin_amdgcn_exp2f(-1.4426950408889634f * x)); }

constexpr float WSCALE = 32.0f, WSCALE_INV = 1.0f / 32.0f;
struct Frame {
    LAS unsigned char* lds;
    int tid, lane, wave, vcu, G;
    const float* const* in;
    float* out; unsigned char* ws;
};
enum { I_X = 0, I_N1G, I_WIN, I_BIN, I_QNG, I_KNG, I_CONVW, I_CONVB, I_WA, I_BA, I_WI, I_BI, I_LAM, I_WAO, I_WLO, I_WOUT, I_N2G, I_WR, I_BR, I_WGU, I_BGU, I_WDN, I_BDN, I_FG };

struct P0Item { const float* src; int N; unsigned char* dst; int ldtB; int fp8; };
__device__ __forceinline__ P0Item p0_decode(const Frame& F, int it) {
    constexpr int I_IN = 16 * (INW / 32), I_AO = 8 * 32, I_LO = 16 * 32, I_OUT = 16 * 32, I_GU1 = 16 * 64, I_DN1 = 16 * 32;
    unsigned char* ws = F.ws; P0Item d; int r = it;
    if (r < I_IN) { const int nblk = INW / 32, kb = r / nblk, nb = r % nblk; d.src = F.in[I_WIN] + (size_t)(64 * kb) * INW + 32 * nb; d.N = INW; d.dst = ws + WS_WIN + ((size_t)(32 * nb) * D + 64 * kb) * 2; d.ldtB = D * 2; d.fp8 = 0; return d; } r -= I_IN;
    if (r < I_AO) { const int kb = r / 32, nb = r % 32; d.src = F.in[I_WAO] + (size_t)(64 * kb) * D + 32 * nb; d.N = D; d.dst = ws + WS_WCAT + ((size_t)(32 * nb) * ARW + 64 * kb) * 2; d.ldtB = ARW * 2; d.fp8 = 0; return d; } r -= I_AO;
    if (r < I_LO) { const int kb = r / 32, nb = r % 32; d.src = F.in[I_WLO] + (size_t)(64 * kb) * D + 32 * nb; d.N = D; d.dst = ws + WS_WCAT + ((size_t)(32 * nb) * ARW + QW + 64 * kb) * 2; d.ldtB = ARW * 2; d.fp8 = 0; return d; } r -= I_LO;
    if (r < I_OUT) { const int kb = r / 32, nb = r % 32; d.src = F.in[I_WOUT] + (size_t)(64 * kb) * D + 32 * nb; d.N = D; d.dst = ws + WS_WO + ((size_t)(32 * nb) * D + 64 * kb) * 2; d.ldtB = D * 2; d.fp8 = 0; return d; } r -= I_OUT;
    if (r < NE * I_GU1) { const int e = r / I_GU1, q = r % I_GU1, kb = q / 64, nb = q % 64, n0 = 32 * nb;
        const int cc = n0 & 1023, isu = n0 >> 10, rowb = 256 * (cc >> 7) + 128 * isu + (cc & 127);
        d.src = F.in[I_WGU] + (size_t)e * D * 2 * DFF + (size_t)(64 * kb) * (2 * DFF) + n0; d.N = 2 * DFF; d.dst = ws + WS_WGU + (size_t)e * 2 * DFF * D + (size_t)rowb * D + 64 * kb; d.ldtB = D; d.fp8 = 1; return d; } r -= NE * I_GU1;
    { const int e = r / I_DN1, q = r % I_DN1, kb = q / 32, nb = q % 32;
        d.src = F.in[I_WDN] + (size_t)e * DFF * D + (size_t)(64 * kb) * D + 32 * nb; d.N = D; d.dst = ws + WS_WD + (size_t)e * D * DFF + (size_t)(32 * nb) * DFF + 64 * kb; d.ldtB = DFF; d.fp8 = 1; return d; }
}
__device__ __forceinline__ void p0_prologue(Frame& F) {
    LAS float* scr = (LAS float*)(F.lds + F.wave * 16384);
    const int gw = F.vcu * NWAVES + F.wave, NGW = F.G * NWAVES, lane = F.lane;
    unsigned char* ws = F.ws;
    constexpr int NITEMS = 16 * (INW / 32) + 8 * 32 + 16 * 32 + 16 * 32 + NE * 16 * 64 + NE * 16 * 32;
    float v[32];
    P0Item cur = p0_decode(F, gw < NITEMS ? gw : 0);
#define P0_LOAD(dst_, item_) do { const float* p_ = (item_).src + (size_t)(lane >> 5) * (item_).N + (lane & 31); const size_t st_ = (size_t)2 * (item_).N; _Pragma("unroll") for (int i_ = 0; i_ < 32; ++i_) dst_[i_] = p_[i_ * st_]; } while (0)
    if (gw < NITEMS) P0_LOAD(v, cur);
    for (int it = gw; it < NITEMS; it += NGW) {
        const int nit = it + NGW; const bool hn = nit < NITEMS;
        const P0Item nxt = p0_decode(F, hn ? nit : it);
        float vn[32];
        if (hn) P0_LOAD(vn, nxt);
#pragma unroll
        for (int i = 0; i < 32; ++i) scr[(2 * i + (lane >> 5)) * 33 + (lane & 31)] = v[i];
        LDS_WAIT(); asm volatile("" ::: "memory");
        const int c = lane & 7;
#pragma unroll
        for (int j = 0; j < 4; ++j) { const int n = (lane >> 3) + 8 * j; const LAS float* s = scr + (8 * c) * 33 + n;
            if (cur.fp8) { int lo = 0, hi = 0;
                lo = __builtin_amdgcn_cvt_pk_fp8_f32(s[0 * 33] * WSCALE, s[1 * 33] * WSCALE, lo, false); lo = __builtin_amdgcn_cvt_pk_fp8_f32(s[2 * 33] * WSCALE, s[3 * 33] * WSCALE, lo, true);
                hi = __builtin_amdgcn_cvt_pk_fp8_f32(s[4 * 33] * WSCALE, s[5 * 33] * WSCALE, hi, false); hi = __builtin_amdgcn_cvt_pk_fp8_f32(s[6 * 33] * WSCALE, s[7 * 33] * WSCALE, hi, true);
                *(GAS v2u*)(cur.dst + (size_t)n * cur.ldtB + 8 * c) = (v2u){(unsigned)lo, (unsigned)hi};
            } else { v4u o; o.x = pk2(s[0 * 33], s[1 * 33]); o.y = pk2(s[2 * 33], s[3 * 33]); o.z = pk2(s[4 * 33], s[5 * 33]); o.w = pk2(s[6 * 33], s[7 * 33]);
                *(GAS v4u*)(cur.dst + (size_t)n * cur.ldtB + 16 * c) = o; } }
        LDS_WAIT(); asm volatile("" ::: "memory");
        cur = nxt;
#pragma unroll
        for (int i = 0; i < 32; ++i) v[i] = vn[i];
    }
#undef P0_LOAD
    const GAS f32x4* gp = (const GAS f32x4*)F.in[I_N1G] + lane;
    f32x4 g[4];
#pragma unroll
    for (int j = 0; j < 4; ++j) g[j] = gp[64 * j];
    bf16* XN = (bf16*)(ws + WS_XN);
    for (int m = gw; m < T; m += 2 * NGW) {
        const int m2 = (m + NGW < T) ? m + NGW : m;
        const GAS f32x4* xr = (const GAS f32x4*)(F.in[I_X] + (size_t)m * D) + lane; const GAS f32x4* xr2 = (const GAS f32x4*)(F.in[I_X] + (size_t)m2 * D) + lane;
        f32x4 va[4], vb[4]; float sa = 0.f, sb = 0.f;
#pragma unroll
        for (int j = 0; j < 4; ++j) { va[j] = xr[64 * j]; vb[j] = xr2[64 * j]; }
#pragma unroll
        for (int j = 0; j < 4; ++j) { sa += (va[j].x * va[j].x + va[j].y * va[j].y) + (va[j].z * va[j].z + va[j].w * va[j].w); sb += (vb[j].x * vb[j].x + vb[j].y * vb[j].y) + (vb[j].z * vb[j].z + vb[j].w * vb[j].w); }
        const float ra = 1.0f / sqrtf(wave_sum(sa) * (1.f / D) + NORM_EPS), rb = 1.0f / sqrtf(wave_sum(sb) * (1.f / D) + NORM_EPS);
        GAS unsigned long long* oa = (GAS unsigned long long*)(XN + (size_t)m * D) + lane; GAS unsigned long long* ob = (GAS unsigned long long*)(XN + (size_t)m2 * D) + lane;
#pragma unroll
        for (int j = 0; j < 4; ++j) { const f32x4 ya = va[j] * ra * g[j], yb = vb[j] * rb * g[j];
            oa[64 * j] = (unsigned long long)pk2(ya.x, ya.y) | ((unsigned long long)pk2(ya.z, ya.w) << 32); ob[64 * j] = (unsigned long long)pk2(yb.x, yb.y) | ((unsigned long long)pk2(yb.z, yb.w) << 32); }
    }
}

#ifndef REP_MASK
#define REP_MASK 0
#endif
#ifndef PROBE_K2X
#define PROBE_K2X 0
#endif
struct DenseSched {
    const char* A; const char* B; int nM, nN, nt, G, c; size_t tstepA, tstepB; int rs;
    __device__ __forceinline__ bool next(int i, pg8::Unit& u) const { const long L = (long)(i >> rs) * G + c; if (L >= (long)nM * nN) return false; pg8::dense_tile((int)L, nM, nN, u.pm, u.pn); u.aux = 0; return true; }
    __device__ __forceinline__ const char* a_ptr(const pg8::Unit& u) const { return A + (size_t)u.pm * tstepA; }
    __device__ __forceinline__ const char* b_ptr(const pg8::Unit& u) const { return B + (size_t)u.pn * tstepB; }
    __device__ __forceinline__ int ntiles(const pg8::Unit&) const { return nt; }
};
struct MergeSched {
    const char* A; const char* B; int G, c;
    __device__ __forceinline__ bool next(int i, pg8::Unit& u) const { const long L = (long)(i >> (1 + ((REP_MASK >> 4) & 1))) * G + c; if (L >= 128 * 4) return false; pg8::dense_tile((int)L, 128, 4, u.pm, u.pn); u.aux = i & 1; return true; }
    __device__ __forceinline__ const char* a_ptr(const pg8::Unit& u) const { return A + (size_t)u.pm * (256 * ARW * 2) + (u.aux ? QW * 2 : 0); }
    __device__ __forceinline__ const char* b_ptr(const pg8::Unit& u) const { return B + (size_t)u.pn * (256 * ARW * 2) + (u.aux ? QW * 2 : 0); }
    __device__ __forceinline__ int ntiles(const pg8::Unit& u) const { return u.aux ? (LRU_W / 64) : (QW / 64); }
};
template <int NTN> struct MoeSched {
    const char* A; const char* B; const LAS int* nbp; int G, c; size_t estepB;
    __device__ __forceinline__ bool next(int i, pg8::Unit& u) const {
        const int NB = nbp[NE], U = NB * NTN; const long L = (long)(i >> ((NTN == 4) ? ((REP_MASK >> 8) & 1) : 0)) * G + c; if (L >= U) return false; const int seg_ = i & 1;
        int w = (int)L; { const int q = U / 8, r = U % 8, xcd = w % 8, off = w / 8; w = (xcd < r ? xcd * (q + 1) : r * (q + 1) + (xcd - r) * q) + off; }
        int e = 0;
        for (int k = 1; k < NE; ++k) e += (w >= nbp[k] * NTN) ? 1 : 0;
        const int b0 = nbp[e], nM = nbp[e + 1] - b0, wl = w - b0 * NTN;
        const int nig = 8 * NTN, gid = wl / nig, fm = gid * 8, gsz = (nM - fm) < 8 ? (nM - fm) : 8;
        const int rb = fm + ((wl % nig) % gsz); u.pn = (wl % nig) / gsz; u.pm = b0 + rb; u.aux = e | (rb << 8) | ((PROBE_K2X && NTN == 4) ? (seg_ << 30) : 0); return true;
    }
    __device__ __forceinline__ const char* a_ptr(const pg8::Unit& u) const { return A; }
    __device__ __forceinline__ const char* b_ptr(const pg8::Unit& u) const { return B + (size_t)(u.aux & 0xff) * estepB + (size_t)u.pn * (256 * D); }
    __device__ __forceinline__ int ntiles(const pg8::Unit&) const { return D / 128; }
};
struct MoeDownSched : MoeSched<4> {
    __device__ __forceinline__ const char* a_ptr(const pg8::Unit& u) const { return A + (size_t)u.pm * (256 * DFF); }
};

struct EpiInProj {
    static constexpr bool PERM = true;
    unsigned char* ws; const LAS float* etab;
    __device__ __forceinline__ bool keep(const pg8::Unit&) const { return false; }
    __device__ __forceinline__ void operator()(pg8::f32x4 (&acc)[2][2][4][2], const pg8::Unit& u, int wr, int wc, int fr, int fq) const {
        using namespace pg8;
        const int pn = u.pn; bf16_t* base; int ldc, colt;
        if (pn < 2) { base = (bf16_t*)(ws + WS_Q); ldc = QW; colt = pn * 256; }
        else if (pn == 2) { base = (bf16_t*)(ws + WS_KV); ldc = 2 * KVW; colt = 0; }
        else if (pn < 7) { base = (bf16_t*)(ws + WS_XR); ldc = LRU_W; colt = (pn - 3) * 256; }
        else if (pn < 11) { base = (bf16_t*)(ws + WS_YR); ldc = LRU_W; colt = (pn - 7) * 256; }
        else { base = (bf16_t*)(ws + WS_GL); ldc = 2 * D; colt = (pn - 11) * 256; }
        const int row0 = u.pm * BM + wr * 64 + fr, col0 = colt + wc * 32 + 8 * fq;
        const LAS float* bias = etab + u.ui * 256 + wc * 32 + 8 * fq;
        f32x4 bv[2][2];
#pragma unroll
        for (int bj = 0; bj < 2; ++bj)
#pragma unroll
            for (int n = 0; n < 2; ++n) bv[bj][n] = *(const LAS f32x4*)(bias + bj * HALF + 4 * n);
#pragma unroll
        for (int ai = 0; ai < 2; ++ai)
#pragma unroll
            for (int m = 0; m < 4; ++m) { bf16_t* rowp = base + (size_t)(row0 + ai * HALF + m * 16) * ldc + col0;
#pragma unroll
                for (int bj = 0; bj < 2; ++bj) { const f32x4 v0 = acc[ai][bj][m][0] + bv[bj][0], v1 = acc[ai][bj][m][1] + bv[bj][1];
                    u32x4 w; w.x = cvt_pk_bf16(v0[0], v0[1]); w.y = cvt_pk_bf16(v0[2], v0[3]); w.z = cvt_pk_bf16(v1[0], v1[1]); w.w = cvt_pk_bf16(v1[2], v1[3]);
                    *(u32x4*)(rowp + bj * HALF) = w; } }
    }
};
struct EpiMerge {
    static constexpr bool PERM = true;
    const bf16* GL; bf16* MG;
    __device__ __forceinline__ bool keep(const pg8::Unit& u) const { return u.aux == 0; }
    __device__ __forceinline__ void operator()(pg8::f32x4 (&acc)[2][2][4][2], const pg8::Unit& u, int wr, int wc, int fr, int fq) const {
        using namespace pg8;
        const int row0 = u.pm * BM + wr * 64 + fr, col0 = u.pn * BM + wc * 32 + 8 * fq;
        if (u.aux == 0) {
#pragma unroll
            for (int ai = 0; ai < 2; ++ai)
#pragma unroll
                for (int m = 0; m < 4; ++m) { const bf16* gp = GL + (size_t)(row0 + ai * HALF + m * 16) * (2 * D) + col0;
#pragma unroll
                    for (int bj = 0; bj < 2; ++bj) { const u32x4 ga = *(const u32x4*)(gp + bj * HALF), gr = *(const u32x4*)(gp + D + bj * HALF);
#pragma unroll
                        for (int q = 0; q < 4; ++q) { const float a0 = bf_lo(ga[q]), a1 = bf_hi(ga[q]), r0 = bf_lo(gr[q]), r1 = bf_hi(gr[q]);
                            const float f0 = (1.0f + __builtin_amdgcn_exp2f(-1.4426950408889634f * r0)) * __builtin_amdgcn_rcpf(1.0f + __builtin_amdgcn_exp2f(-1.4426950408889634f * a0));
                            const float f1 = (1.0f + __builtin_amdgcn_exp2f(-1.4426950408889634f * r1)) * __builtin_amdgcn_rcpf(1.0f + __builtin_amdgcn_exp2f(-1.4426950408889634f * a1));
                            acc[ai][bj][m][q >> 1][(q & 1) * 2] *= f0; acc[ai][bj][m][q >> 1][(q & 1) * 2 + 1] *= f1; } } }
        } else {
#pragma unroll
            for (int ai = 0; ai < 2; ++ai)
#pragma unroll
                for (int m = 0; m < 4; ++m) { const size_t ro = (size_t)(row0 + ai * HALF + m * 16); const bf16* gp = GL + ro * (2 * D) + D + col0; bf16* op = MG + ro * D + col0;
#pragma unroll
                    for (int bj = 0; bj < 2; ++bj) { const u32x4 gr = *(const u32x4*)(gp + bj * HALF); u32x4 w;
#pragma unroll
                        for (int q = 0; q < 4; ++q) { const float s0 = fast_sigmoid(bf_lo(gr[q])), s1 = fast_sigmoid(bf_hi(gr[q]));
                            w[q] = cvt_pk_bf16(acc[ai][bj][m][q >> 1][(q & 1) * 2] * s0, acc[ai][bj][m][q >> 1][(q & 1) * 2 + 1] * s1); }
                        *(u32x4*)(op + bj * HALF) = w; } }
        }
    }
};
struct EpiResF32 {
    static constexpr bool PERM = false;
    const float* X; float* O;
    __device__ __forceinline__ bool keep(const pg8::Unit&) const { return false; }
    __device__ __forceinline__ void operator()(pg8::f32x4 (&acc)[2][2][4][2], const pg8::Unit& u, int wr, int wc, int fr, int fq) const {
        using namespace pg8;
        const int row0 = u.pm * BM + wr * 64 + fr, col0 = u.pn * BM + wc * 32 + 4 * fq;
#pragma unroll
        for (int ai = 0; ai < 2; ++ai)
#pragma unroll
            for (int m = 0; m < 4; ++m) { const size_t off = (size_t)(row0 + ai * HALF + m * 16) * D + col0;
#pragma unroll
                for (int bj = 0; bj < 2; ++bj)
#pragma unroll
                    for (int n = 0; n < 2; ++n) *(f32x4*)(O + off + bj * HALF + n * 16) = *(const f32x4*)(X + off + bj * HALF + n * 16) + acc[ai][bj][m][n]; }
    }
};
struct EpiSwiGLU {
    static constexpr bool PERM = true;
    const LAS float* etab; unsigned char* ACT;
    __device__ __forceinline__ bool keep(const pg8::Unit&) const { return false; }
    __device__ __forceinline__ void operator()(pg8::f32x4 (&acc)[2][2][4][2], const pg8::Unit& u, int wr, int wc, int fr, int fq) const {
        using namespace pg8;
        const int cl = wc * 32 + 8 * fq, col0 = u.pn * 128 + cl, row0 = u.pm * BM + wr * 64 + fr;
        const LAS float* bp = etab + u.ui * 256 + cl;
        const f32x4 bg0 = *(const LAS f32x4*)(bp), bg1 = *(const LAS f32x4*)(bp + 4), bu0 = *(const LAS f32x4*)(bp + 128), bu1 = *(const LAS f32x4*)(bp + 132);
#pragma unroll
        for (int ai = 0; ai < 2; ++ai)
#pragma unroll
            for (int m = 0; m < 4; ++m) { u32x2 w;
#pragma unroll
                for (int n = 0; n < 2; ++n) { const f32x4 g = acc[ai][0][m][n] * WSCALE_INV + (n ? bg1 : bg0), uu = acc[ai][1][m][n] * WSCALE_INV + (n ? bu1 : bu0); float a[4];
#pragma unroll
                    for (int j = 0; j < 4; ++j) { const float gg = fminf(g[j], 7.0f), uc = fminf(fmaxf(uu[j], -7.0f), 7.0f);
                        a[j] = gg * __builtin_amdgcn_rcpf(1.0f + __builtin_amdgcn_exp2f(-1.702f * 1.4426950408889634f * gg)) * (uc + 1.0f); }
                    int pk = 0; pk = __builtin_amdgcn_cvt_pk_fp8_f32(a[0], a[1], pk, false); pk = __builtin_amdgcn_cvt_pk_fp8_f32(a[2], a[3], pk, true); w[n] = (unsigned)pk; }
                *(u32x2*)(ACT + (size_t)(row0 + ai * HALF + m * 16) * DFF + col0) = w; }
    }
};
struct EpiDown {
    static constexpr bool PERM = true;
    const LAS float* etab; const LAS float* gtab2; bf16* Y;
    __device__ __forceinline__ bool keep(const pg8::Unit& u) const { return PROBE_K2X && ((u.aux >> 30) & 1) == 0; }
    __device__ __forceinline__ void operator()(pg8::f32x4 (&acc)[2][2][4][2], const pg8::Unit& u, int wr, int wc, int fr, int fq) const {
        using namespace pg8;
        if (PROBE_K2X && ((u.aux >> 30) & 1) == 0) return;
        const int tui = PROBE_K2X ? (u.ui >> 1) : u.ui; const float ksc = PROBE_K2X ? 0.5f * WSCALE_INV : WSCALE_INV;
        const int col0 = u.pn * BM + wc * 32 + 8 * fq, rl0 = wr * 64 + fr;
        const LAS float* bias = etab + tui * 256 + wc * 32 + 8 * fq;
        f32x4 bv[2][2];
#pragma unroll
        for (int bj = 0; bj < 2; ++bj)
#pragma unroll
            for (int n = 0; n < 2; ++n) bv[bj][n] = *(const LAS f32x4*)(bias + bj * HALF + 4 * n);
        const LAS float* gl = gtab2 + tui * 256;
#pragma unroll
        for (int ai = 0; ai < 2; ++ai)
#pragma unroll
            for (int m = 0; m < 4; ++m) { const int rl = rl0 + ai * HALF + m * 16; const float gt = gl[rl]; bf16* rowp = Y + (size_t)(u.pm * BM + rl) * D + col0;
#pragma unroll
                for (int bj = 0; bj < 2; ++bj) { const f32x4 v0 = (acc[ai][bj][m][0] * ksc + bv[bj][0]) * gt, v1 = (acc[ai][bj][m][1] * ksc + bv[bj][1]) * gt;
                    u32x4 w; w.x = cvt_pk_bf16(v0[0], v0[1]); w.y = cvt_pk_bf16(v0[2], v0[3]); w.z = cvt_pk_bf16(v1[0], v1[1]); w.w = cvt_pk_bf16(v1[2], v1[3]);
                    *(u32x4*)(rowp + bj * HALF) = w; } }
    }
};

__device__ __forceinline__ v4u fix_vals(const v4u raw, const float* g8, float scale, int c, int prow, int pcol, const LAS f32x2* tab) {
    float v[8];
#pragma unroll
    for (int q = 0; q < 4; ++q) { v[2 * q] = bflo(raw[q]); v[2 * q + 1] = bfhi(raw[q]); }
    float ss = 0.f;
#pragma unroll
    for (int j = 0; j < 8; ++j) ss += v[j] * v[j];
    ss += __shfl_xor(ss, 1); ss += __shfl_xor(ss, 2); ss += __shfl_xor(ss, 4);
    const float rstd = 1.0f / sqrtf(ss * (1.0f / HD) + NORM_EPS);
    const int pos = (c >> 2) ? pcol : prow; const bool second = (c >> 1) & 1; const int f0 = (c & 1) * 8;
    float o[8];
#pragma unroll
    for (int j = 0; j < 8; ++j) { const float y = v[j] * rstd * g8[j]; const float pr = __shfl_xor(y, 2); const f32x2 cs = tab[pos * 16 + f0 + j];
        o[j] = (second ? (y * cs.x + pr * cs.y) : (y * cs.x - pr * cs.y)) * scale; }
    v4u w; w.x = pk2(o[0], o[1]); w.y = pk2(o[2], o[3]); w.z = pk2(o[4], o[5]); w.w = pk2(o[6], o[7]);
    return w;
}
__device__ __forceinline__ void p2_fixup(Frame& F) {
    LAS f32x2* tab = (LAS f32x2*)(F.lds);
    for (int idx = F.tid; idx < 1024; idx += NWAVES * 64) { const int pos = idx >> 4, f = idx & 15; const float inv = powf(10000.0f, -(float)f / 16.0f); const float ang = (float)pos * inv;
        tab[idx] = (f32x2){cosf(ang), sinf(ang)}; }
    __syncthreads();
    const int gw = F.vcu * NWAVES + F.wave, NGW = F.G * NWAVES, c = F.lane & 7;
    float gq[8], gk[8];
#pragma unroll
    for (int j = 0; j < 8; ++j) { gq[j] = F.in[I_QNG][8 * c + j]; gk[j] = F.in[I_KNG][8 * c + j]; }
    bf16* Q = (bf16*)(F.ws + WS_Q); bf16* KV = (bf16*)(F.ws + WS_KV);
    for (int t0 = gw; t0 < T; t0 += 4 * NGW) {
        v4u rq[4], rk[4]; int tt[4];
#pragma unroll
        for (int i = 0; i < 4; ++i) { const int t = t0 + i * NGW; tt[i] = t < T ? t : t0;
            rq[i] = *(const GAS v4u*)(Q + (size_t)tt[i] * QW + F.lane * 8); rk[i] = *(const GAS v4u*)(KV + (size_t)tt[i] * (2 * KVW) + (F.lane & 15) * 8); }
#pragma unroll
        for (int i = 0; i < 4; ++i) { const int t = tt[i], s = t & (SEQ - 1), prow = s >> 6, pcol = s & 63;
            const v4u wq = fix_vals(rq[i], gq, attn_body::C2, c, prow, pcol, tab);
            const v4u wk = fix_vals(rk[i], gk, 1.0f, c, prow, pcol, tab);
            if (t0 + i * NGW < T) { *(GAS v4u*)(Q + (size_t)t * QW + F.lane * 8) = wq; if (F.lane < 16) *(GAS v4u*)(KV + (size_t)t * (2 * KVW) + F.lane * 8) = wk; } }
    }
    __syncthreads();
}
constexpr int LRU_CH = 256;
constexpr int LRU_XC_STRIDE = 144;
constexpr int LRU_BUF = LRU_CH * LRU_XC_STRIDE;
constexpr int LRU_WT = 4 * LRU_BUF;
static_assert(LRU_BUF >= 256 * 33 * 4 && LRU_WT + 2048 + 5 * 64 * 4 <= MISC_OFF, "lru lds");

__device__ __forceinline__ float gelu_tanh(float y) { const float z = 0.7978845608028654f * (y + 0.044715f * y * y * y); return y * sigmoidf_fast(2.0f * z); }

template <int DIR> __device__ __forceinline__ void lru_dir(Frame& F, int b, int n, int half) {
    LAS unsigned char* lds = F.lds;
    int tid_ = F.tid; asm volatile("" : "+v"(tid_));
    unsigned char* ws_ = F.ws; asm volatile("" : "+s"(ws_));
    const int tid = tid_, lane = tid & 63, wave = __builtin_amdgcn_readfirstlane(tid >> 6);
    constexpr int g = DIR; const int w = wave & 3, tl = tid & 255;
#define PHY(p_) (DIR ? 255 - (p_) : (p_))
    const int ch16 = lane & 15, q = lane >> 4, ct = w & 1, th = w >> 1;
    const int cl = 16 * ct + ch16, co_l = 32 * half + cl, cgl = 64 * n + co_l;
    bf16x8 Ba[2], Bi[2];
    { const float* wa = F.in[I_WA] + ((size_t)(g * LRU_NB + n) * 64) * 64 + co_l; const float* wi = F.in[I_WI] + ((size_t)(g * LRU_NB + n) * 64) * 64 + co_l;
#pragma unroll
      for (int ks = 0; ks < 2; ++ks)
#pragma unroll
          for (int j = 0; j < 8; ++j) { const int k = 32 * ks + 8 * q + j; Ba[ks][j] = (short)f2bf(wa[(size_t)k * 64]); Bi[ks][j] = (short)f2bf(wi[(size_t)k * 64]); } }
    const float ba = F.in[I_BA][(g * LRU_NB + n) * 64 + co_l], bi = F.in[I_BI][(g * LRU_NB + n) * 64 + co_l];
    const float lam = F.in[I_LAM][g * LRU_W + cgl];
    const float clam = -8.0f * log1pf(expf(-lam)) * 1.4426950408889634f;
    const int c8 = tl & 7, tg = tl >> 3;
    LAS float* cwl = (LAS float*)(lds + LRU_WT + 2048);
    for (int i = tid; i < 5 * 64; i += NWAVES * 64) { const int j = i >> 6, c = i & 63; cwl[i] = (j < 4) ? F.in[I_CONVW][j * LRU_W + 64 * n + c] : F.in[I_CONVB][64 * n + c]; }
    __syncthreads();
    const bf16* XR = (const bf16*)(ws_ + WS_XR) + (size_t)b * SEQ * LRU_W + 64 * n + 8 * c8;
    const bf16* YR = (const bf16*)(ws_ + WS_YR) + (size_t)b * SEQ * LRU_W + 64 * n + 32 * half;
    bf16* AR = (bf16*)(ws_ + WS_AR) + (size_t)b * SEQ * ARW + QW + 64 * n + 32 * half;
    constexpr int NST = SEQ / LRU_CH;
    v4u xrp[11];
#define LRU_LOADX(pc_) do { const int s0_ = (pc_) * LRU_CH + 8 * tg - 1; _Pragma("unroll") for (int i_ = 0; i_ < 11; ++i_) { const int s_ = s0_ + i_; \
        const int sc_ = s_ < 0 ? 0 : (s_ >= SEQ ? SEQ - 1 : s_); const v4u t_ = *(const GAS v4u*)(XR + (size_t)sc_ * LRU_W); const unsigned m_ = (s_ >= 0 && s_ < SEQ) ? 0xffffffffu : 0u; \
        xrp[i_] = (v4u){t_.x & m_, t_.y & m_, t_.z & m_, t_.w & m_}; } } while (0)
    LRU_LOADX(g ? NST - 1 : 0);
    float hcarry = 0.f;
    for (int k = 0; k < NST; ++k) {
        const int pc = g ? (NST - 1 - k) : k, par = k & 1;
        LAS unsigned char* buf = lds + (g * 2 + par) * LRU_BUF;
        unsigned aA = (unsigned)((DIR ? (255 - 128 * th - ch16 - 112) : (128 * th + ch16)) * LRU_XC_STRIDE + q * 16);
        unsigned aX = (unsigned)((DIR ? (255 - 128 * th - 4 * q - 115) : (128 * th + 4 * q)) * LRU_XC_STRIDE + co_l * 2);
        unsigned aH = (unsigned)(((DIR ? (255 - 128 * th - 4 * q - 115) : (128 * th + 4 * q)) * 33 + cl) * 4);
        asm volatile("" : "+v"(aA), "+v"(aX), "+v"(aH));
#define OFS(c_, m_) (DIR ? ((m_) - (c_)) : (c_))
        { f32x2 cw[4][4], cb[4];
#pragma unroll
          for (int j = 0; j < 4; ++j) { const f32x4 c0 = *(const LAS f32x4*)(cwl + j * 64 + 8 * c8), c1 = *(const LAS f32x4*)(cwl + j * 64 + 8 * c8 + 4);
              cw[j][0] = (f32x2){c0.x, c0.y}; cw[j][1] = (f32x2){c0.z, c0.w}; cw[j][2] = (f32x2){c1.x, c1.y}; cw[j][3] = (f32x2){c1.z, c1.w}; }
          { const f32x4 c0 = *(const LAS f32x4*)(cwl + 256 + 8 * c8), c1 = *(const LAS f32x4*)(cwl + 256 + 8 * c8 + 4); cb[0] = (f32x2){c0.x, c0.y}; cb[1] = (f32x2){c0.z, c0.w}; cb[2] = (f32x2){c1.x, c1.y}; cb[3] = (f32x2){c1.z, c1.w}; }
#pragma unroll
          for (int tt = 0; tt < 8; ++tt) { f32x2 o[4];
#pragma unroll
            for (int i = 0; i < 4; ++i) o[i] = cb[i];
#pragma unroll
            for (int j = 0; j < 4; ++j) { const v4u raw = xrp[tt + j];
#pragma unroll
                for (int qq = 0; qq < 4; ++qq) { const f32x2 xv = (f32x2){bflo(raw[qq]), bfhi(raw[qq])}; o[qq] = __builtin_elementwise_fma(cw[j][qq], xv, o[qq]); } }
            v4u wv; wv.x = pk2(o[0].x, o[0].y); wv.y = pk2(o[1].x, o[1].y); wv.z = pk2(o[2].x, o[2].y); wv.w = pk2(o[3].x, o[3].y);
            *(LAS v4u*)(buf + (8 * tg + tt) * LRU_XC_STRIDE + c8 * 16) = wv; } }
        if (k + 1 < NST) LRU_LOADX(g ? (NST - 2 - k) : (k + 1));
        const size_t trow = (size_t)pc * LRU_CH + tl;
        __syncthreads();
        float Aloc[8][4], Hloc[8][4];
        float AR_ = 1.f, HR_ = 0.f;
#pragma unroll
        for (int rt = 0; rt < 8; ++rt) {
            const bf16x8 a0 = *(const LAS bf16x8*)(buf + aA + OFS(16 * rt, 112) * LRU_XC_STRIDE), a1 = *(const LAS bf16x8*)(buf + aA + OFS(16 * rt, 112) * LRU_XC_STRIDE + 64);
            f32x4 Da = (f32x4){0.f, 0.f, 0.f, 0.f}, Di = (f32x4){0.f, 0.f, 0.f, 0.f};
            Da = __builtin_amdgcn_mfma_f32_16x16x32_bf16(a0, Ba[0], Da, 0, 0, 0); Da = __builtin_amdgcn_mfma_f32_16x16x32_bf16(a1, Ba[1], Da, 0, 0, 0);
            Di = __builtin_amdgcn_mfma_f32_16x16x32_bf16(a0, Bi[0], Di, 0, 0, 0); Di = __builtin_amdgcn_mfma_f32_16x16x32_bf16(a1, Bi[1], Di, 0, 0, 0);
            float Ain[4], Hin[4];
#pragma unroll
            for (int j = 0; j < 4; ++j) {
                const float xcv = __uint_as_float((unsigned)(*(const LAS unsigned short*)(buf + aX + OFS(16 * rt + j, 115) * LRU_XC_STRIDE)) << 16);
                const float r = sigmoidf_fast(Da[j] + ba), ig = sigmoidf_fast(Di[j] + bi);
                const float a = __builtin_amdgcn_exp2f(clam * r);
                const float u = __builtin_amdgcn_sqrtf(fmaxf(1.0f - a * a, 0.f)) * (ig * xcv);
                if (j == 0) { Ain[0] = a; Hin[0] = u; } else { Hin[j] = a * Hin[j - 1] + u; Ain[j] = Ain[j - 1] * a; } }
            float Ai = Ain[3], Hi = Hin[3];
            float An = __shfl(Ai, (lane - 16) & 63), Hn = __shfl(Hi, (lane - 16) & 63); if (q >= 1) { Hi = Ai * Hn + Hi; Ai = An * Ai; }
            An = __shfl(Ai, (lane - 32) & 63); Hn = __shfl(Hi, (lane - 32) & 63); if (q >= 2) { Hi = Ai * Hn + Hi; Ai = An * Ai; }
            float Ae = __shfl(Ai, (lane - 16) & 63), He = __shfl(Hi, (lane - 16) & 63); if (q == 0) { Ae = 1.f; He = 0.f; }
            const float Atile = __shfl(Ai, ch16 + 48), Htile = __shfl(Hi, ch16 + 48);
            const float Ap = AR_ * Ae, Hp = Ae * HR_ + He;
#pragma unroll
            for (int j = 0; j < 4; ++j) { Aloc[rt][j] = Ap * Ain[j]; Hloc[rt][j] = Ain[j] * Hp + Hin[j]; }
            HR_ = Atile * HR_ + Htile; AR_ = AR_ * Atile;
            __builtin_amdgcn_sched_barrier(0);
        }
        LAS f32x2* WT = (LAS f32x2*)(lds + LRU_WT) + (g * 2 + par) * 64;
        if (q == 0) WT[th * 32 + cl] = (f32x2){AR_, HR_};
        __syncthreads();
        v4u yv[4], ov[4];
        if (k >= NST / 2) {
#pragma unroll
            for (int i = 0; i < 4; ++i) { yv[i] = *((const GAS v4u*)(YR + trow * LRU_W) + i); ov[i] = *((const GAS v4u*)(AR + trow * ARW) + i); } }
        const f32x2 w0 = WT[cl], w1 = WT[32 + cl];
        const float hmid = w0.x * hcarry + w0.y;
        const float hin = th ? hmid : hcarry;
        hcarry = w1.x * hmid + w1.y;
        LAS float* HS = (LAS float*)buf;
#pragma unroll
        for (int rt = 0; rt < 8; ++rt)
#pragma unroll
            for (int j = 0; j < 4; ++j) *(LAS float*)(buf + aH + OFS(16 * rt + j, 115) * 132) = Hloc[rt][j] + Aloc[rt][j] * hin;
        __syncthreads();
        { float hv[32];
#pragma unroll
          for (int i = 0; i < 32; ++i) hv[i] = HS[tl * 33 + i];
          v4u wv[4];
          if (k < NST / 2) {
#pragma unroll
              for (int i = 0; i < 4; ++i) { wv[i].x = pk2(hv[8 * i], hv[8 * i + 1]); wv[i].y = pk2(hv[8 * i + 2], hv[8 * i + 3]); wv[i].z = pk2(hv[8 * i + 4], hv[8 * i + 5]); wv[i].w = pk2(hv[8 * i + 6], hv[8 * i + 7]); }
          } else {
#pragma unroll
              for (int i = 0; i < 4; ++i)
#pragma unroll
                  for (int qq = 0; qq < 4; ++qq) wv[i][qq] = pk2((hv[8 * i + 2 * qq] + bflo(ov[i][qq])) * gelu_tanh(bflo(yv[i][qq])), (hv[8 * i + 2 * qq + 1] + bfhi(ov[i][qq])) * gelu_tanh(bfhi(yv[i][qq])));
          }
          GAS v4u* op = (GAS v4u*)(AR + trow * ARW);
#pragma unroll
          for (int i = 0; i < 4; ++i) op[i] = wv[i]; }
    }
#undef LRU_LOADX
#undef PHY
#undef OFS
    __syncthreads();
}
__device__ __forceinline__ void p2_lru(Frame& F) {
    for (int it = F.vcu; it < BATCH * LRU_NB * 2; it += F.G) { if (F.wave < 4) lru_dir<0>(F, it >> 5, (it & 31) >> 1, it & 1); else lru_dir<1>(F, it >> 5, (it & 31) >> 1, it & 1); }
}

constexpr int RT_STRIDE = 1028;
constexpr int ROWINFO_OFF = GTAB_OFF + 1024;
__device__ __forceinline__ void p6_router(Frame& F, const bool dry) {
    LAS float* wT = (LAS float*)F.lds;
    LAS unsigned* misc = (LAS unsigned*)(F.lds + MISC_OFF);
    LAS unsigned* hist = misc + 128; LAS unsigned* basew = misc + 160;
    LAS v2u* rowinfo = (LAS v2u*)(F.lds + ROWINFO_OFF);
    const int tid = F.tid, lane = F.lane, wave = F.wave;
    for (int idx = tid; idx < D * NE; idx += NWAVES * 64) { const int k = idx >> 5, e = idx & 31; wT[e * RT_STRIDE + k] = F.in[I_WR][idx]; }
    if (tid < 32) hist[tid] = 0u;
    f32x4 g2[4];
#pragma unroll
    for (int j = 0; j < 4; ++j) g2[j] = *((const GAS f32x4*)F.in[I_N2G] + lane + 64 * j);
    const float brl = F.in[I_BR][lane >> 1];
    __syncthreads();
    unsigned char* H2 = (unsigned char*)(F.ws + WS_XN);
    unsigned* gcnt = (unsigned*)(F.ws + WS_CTL) + CW_CNT;
    int* TOKL = (int*)(F.ws + WS_TOKL); float* GATEL = (float*)(F.ws + WS_GATEL); int* TOKREC = (int*)(F.ws + WS_TOKREC);
    for (int bi = F.vcu; bi < T / 128; bi += F.G) {
        const int rbase = bi * 128;
        for (int p = 0; p < 8; ++p) {
            const int rl0 = 16 * wave + 2 * p; const size_t r0 = (size_t)rbase + rl0;
            f32x4 h0[4], h1[4];
            { const GAS f32x4* x0 = (const GAS f32x4*)(F.out + r0 * D) + lane; const GAS f32x4* x1 = (const GAS f32x4*)(F.out + (r0 + 1) * D) + lane;
              float s0 = 0.f, s1 = 0.f;
#pragma unroll
              for (int j = 0; j < 4; ++j) { h0[j] = x0[64 * j]; h1[j] = x1[64 * j];
                  s0 += (h0[j].x * h0[j].x + h0[j].y * h0[j].y) + (h0[j].z * h0[j].z + h0[j].w * h0[j].w); s1 += (h1[j].x * h1[j].x + h1[j].y * h1[j].y) + (h1[j].z * h1[j].z + h1[j].w * h1[j].w); }
              const float rs0 = 1.0f / sqrtf(wave_sum(s0) * (1.f / D) + NORM_EPS), rs1 = 1.0f / sqrtf(wave_sum(s1) * (1.f / D) + NORM_EPS);
              GAS unsigned* o0 = (GAS unsigned*)(H2 + r0 * D) + lane; GAS unsigned* o1 = (GAS unsigned*)(H2 + (r0 + 1) * D) + lane;
#pragma unroll
              for (int j = 0; j < 4; ++j) { h0[j] = h0[j] * rs0 * g2[j]; h1[j] = h1[j] * rs1 * g2[j];
                  int p0 = 0, p1 = 0; p0 = __builtin_amdgcn_cvt_pk_fp8_f32(h0[j].x, h0[j].y, p0, false); p0 = __builtin_amdgcn_cvt_pk_fp8_f32(h0[j].z, h0[j].w, p0, true);
                  p1 = __builtin_amdgcn_cvt_pk_fp8_f32(h1[j].x, h1[j].y, p1, false); p1 = __builtin_amdgcn_cvt_pk_fp8_f32(h1[j].z, h1[j].w, p1, true);
                  o0[64 * j] = (unsigned)p0; o1[64 * j] = (unsigned)p1; } }
            float a0[32], a1[32];
#pragma unroll
            for (int e = 0; e < 32; ++e) { float s0 = 0.f, s1 = 0.f;
#pragma unroll
                for (int j = 0; j < 4; ++j) { const f32x4 w = *(const LAS f32x4*)(wT + e * RT_STRIDE + 256 * j + 4 * lane);
                    s0 += (h0[j].x * w.x + h0[j].y * w.y) + (h0[j].z * w.z + h0[j].w * w.w); s1 += (h1[j].x * w.x + h1[j].y * w.y) + (h1[j].z * w.z + h1[j].w * w.w); }
                a0[e] = s0; a1[e] = s1; }
#define TRED(arr, N, MASK) _Pragma("unroll") for (int i = 0; i < (N); ++i) { const bool up = (lane & (MASK)) != 0; const float snd = up ? arr[i] : arr[i + (N)]; const float kp = up ? arr[i + (N)] : arr[i]; arr[i] = kp + __shfl_xor(snd, (MASK)); }
            TRED(a0, 16, 32) TRED(a0, 8, 16) TRED(a0, 4, 8) TRED(a0, 2, 4) TRED(a0, 1, 2)
            TRED(a1, 16, 32) TRED(a1, 8, 16) TRED(a1, 4, 8) TRED(a1, 2, 4) TRED(a1, 1, 2)
#undef TRED
            float lg[2]; lg[0] = a0[0] + __shfl_xor(a0[0], 1) + brl; lg[1] = a1[0] + __shfl_xor(a1[0], 1) + brl;
#pragma unroll
            for (int rr2 = 0; rr2 < 2; ++rr2) {
                float val = lg[rr2]; int te[4]; float tv[4];
#pragma unroll
                for (int k = 0; k < 4; ++k) { float m = val;
#pragma unroll
                    for (int o = 1; o < 64; o <<= 1) m = fmaxf(m, __shfl_xor(m, o));
                    const unsigned long long bal = __ballot(val == m); const int src = __builtin_ctzll(bal); te[k] = src >> 1; tv[k] = m; if ((lane >> 1) == te[k]) val = -INFINITY; }
                const float p1 = __expf(tv[1] - tv[0]), p2 = __expf(tv[2] - tv[0]), p3 = __expf(tv[3] - tv[0]); const float inv = 1.0f / (1.0f + p1 + p2 + p3);
                if (lane < 4) { const int e = lane == 0 ? te[0] : lane == 1 ? te[1] : lane == 2 ? te[2] : te[3]; const float gt = (lane == 0 ? 1.0f : lane == 1 ? p1 : lane == 2 ? p2 : p3) * inv;
                    const unsigned rank = atomicAdd((unsigned*)(hist + e), 1u);
                    rowinfo[(rl0 + rr2) * 4 + lane] = (v2u){(unsigned)e | (rank << 8), __float_as_uint(gt)}; }
            }
        }
        __syncthreads();
        if (tid < 32) basew[tid] = dry ? 0u : __hip_atomic_fetch_add(gcnt + tid, hist[tid], __ATOMIC_RELAXED, __HIP_MEMORY_SCOPE_AGENT);
        __syncthreads();
        { const int rl = tid >> 2, k = tid & 3; const v2u inf = rowinfo[rl * 4 + k]; const int e = inf.x & 0xff; const unsigned slot = basew[e] + (inf.x >> 8); const int t = rbase + rl;
          if (!dry) { TOKL[(size_t)e * ECAP + slot] = t; GATEL[(size_t)e * ECAP + slot] = __uint_as_float(inf.y); TOKREC[t * 4 + k] = (int)(((unsigned)e << 20) | slot); } }
        __syncthreads();
        if (tid < 32) hist[tid] = 0u;
        __syncthreads();
    }
}

__device__ __forceinline__ void moe_tables(Frame& F) {
    LAS int* misc = (LAS int*)(F.lds + MISC_OFF);
    const unsigned* gcnt = (const unsigned*)(F.ws + WS_CTL) + CW_CNT;
    if (F.tid < 32) misc[F.tid] = (int)__hip_atomic_load(gcnt + F.tid, __ATOMIC_RELAXED, __HIP_MEMORY_SCOPE_AGENT);
    __syncthreads();
    if (F.tid == 0) { int s = 0; for (int e = 0; e < NE; ++e) { misc[32 + e] = s; s += (misc[e] + 255) >> 8; } misc[32 + NE] = s; }
    __syncthreads();
}
__device__ __forceinline__ void moe_gather_table(Frame& F, const MoeSched<8>& S) {
    LAS int* misc = (LAS int*)(F.lds + MISC_OFF); LAS unsigned short* gtab = (LAS unsigned short*)(F.lds + GTAB_OFF); LAS float* etab = (LAS float*)(F.lds + ETAB_OFF);
    const int* TOKL = (const int*)(F.ws + WS_TOKL);
    pg8::Unit u;
    for (int ui = 0; ui < MAX_GUNITS && S.next(ui, u); ++ui) {
        const int e = u.aux & 0xff, rb = u.aux >> 8;
        if (F.tid < 256) { const int slot = rb * 256 + F.tid; gtab[ui * 256 + F.tid] = (unsigned short)((slot < misc[e]) ? TOKL[(size_t)e * ECAP + slot] : 0); }
        else { const int c = F.tid - 256; etab[ui * 256 + c] = F.in[I_BGU][(size_t)e * (2 * DFF) + (c < 128 ? 0 : DFF - 128) + u.pn * 128 + c]; }
    }
    __syncthreads();
}
__device__ __forceinline__ void moe_down_table(Frame& F, const MoeDownSched& S) {
    LAS float* etab = (LAS float*)(F.lds + ETAB_OFF); LAS float* gt2 = etab + 10 * 256;
    const float* GATEL = (const float*)(F.ws + WS_GATEL);
    pg8::Unit u;
    for (int ui = 0; ui < 10 && S.next(PROBE_K2X ? 2 * ui : ui, u); ++ui) {
        const int e = u.aux & 0xff, rb = (u.aux >> 8) & 0xffff;
        if (F.tid < 256) etab[ui * 256 + F.tid] = F.in[I_BDN][(size_t)e * D + u.pn * 256 + F.tid];
        else { const int r = F.tid - 256; gt2[ui * 256 + r] = GATEL[(size_t)e * ECAP + rb * 256 + r]; }
    }
    __syncthreads();
}
__device__ __forceinline__ void inproj_table(Frame& F, const DenseSched& S) {
    LAS float* etab = (LAS float*)(F.lds + ETAB_OFF);
    pg8::Unit u;
    for (int ui = 0; ui < MAX_GUNITS && S.next(ui, u); ++ui) if (F.tid < 256) etab[ui * 256 + F.tid] = F.in[I_BIN][u.pn * 256 + F.tid];
    __syncthreads();
}

__device__ __forceinline__ void p10_final(Frame& F, float* dst) {
    LAS int* misc = (LAS int*)(F.lds + MISC_OFF);
    const int gw = F.vcu * NWAVES + F.wave, NGW = F.G * NWAVES, lane = F.lane;
    f32x4 g[4];
#pragma unroll
    for (int j = 0; j < 4; ++j) g[j] = *((const GAS f32x4*)F.in[I_FG] + lane + 64 * j);
    const int* TOKREC = (const int*)(F.ws + WS_TOKREC); const bf16* Y = (const bf16*)(F.ws + WS_Y);
    typedef int v4i __attribute__((ext_vector_type(4)));
    v4i rec = (gw < T) ? *(const GAS v4i*)(TOKREC + (size_t)gw * 4) : (v4i){0, 0, 0, 0};
    for (int t = gw; t < T; t += NGW) {
        const int tn = t + NGW;
        const v4i recn = (tn < T) ? *(const GAS v4i*)(TOKREC + (size_t)tn * 4) : rec;
        GAS f32x4* xp = (GAS f32x4*)(F.out + (size_t)t * D) + lane;
        f32x4 v[4]; v2u yv[4][4];
#pragma unroll
        for (int k = 0; k < 4; ++k) { const unsigned rk = (unsigned)rec[k]; const int e = rk >> 20, slot = rk & 0xfffff;
            const GAS v2u* yp = (const GAS v2u*)(Y + ((size_t)misc[32 + e] * 256 + slot) * D) + lane;
#pragma unroll
            for (int j = 0; j < 4; ++j) yv[k][j] = yp[64 * j]; }
#pragma unroll
        for (int j = 0; j < 4; ++j) v[j] = xp[64 * j];
#pragma unroll
        for (int k = 0; k < 4; ++k)
#pragma unroll
            for (int j = 0; j < 4; ++j) { const v2u w = yv[k][j]; v[j].x += bflo(w.x); v[j].y += bfhi(w.x); v[j].z += bflo(w.y); v[j].w += bfhi(w.y); }
        float s = 0.f;
#pragma unroll
        for (int j = 0; j < 4; ++j) s += (v[j].x * v[j].x + v[j].y * v[j].y) + (v[j].z * v[j].z + v[j].w * v[j].w);
        const float rstd = 1.0f / sqrtf(wave_sum(s) * (1.f / D) + NORM_EPS);
        GAS f32x4* op = (GAS f32x4*)(dst + (size_t)t * D) + lane;
#pragma unroll
        for (int j = 0; j < 4; ++j) op[64 * j] = v[j] * rstd * g[j];
        rec = recn;
    }
}
typedef GAS unsigned gu32;
#define RLX_AGENT __ATOMIC_RELAXED, __HIP_MEMORY_SCOPE_AGENT
#define XB_TMO      128
#define XB_XCNT(j)  (256  + 64 * (j))
#define XB_XSUB(j)  (1280 + 64 * (j))
#define XB_XGEN(j)  (2304 + 64 * (j))
#define XB_TOP      3328
#define XB_TOPGEN   3392
#define XCD_BAR_WORDS 3456
#define XB_SPIN_CAP (1u << 18)

__device__ __forceinline__ unsigned xb_ld(unsigned* p)              { return __hip_atomic_load(p, __ATOMIC_RELAXED, __HIP_MEMORY_SCOPE_AGENT); }
__device__ __forceinline__ unsigned xb_add(unsigned* p, unsigned v) { return __hip_atomic_fetch_add(p, v, __ATOMIC_RELAXED, __HIP_MEMORY_SCOPE_AGENT); }
__device__ __forceinline__ unsigned xb_xcc_id() { return (unsigned)__builtin_amdgcn_s_getreg((3 << 11) | 20) & 0xFu; }
#define XB_SPIN(cond, bar) do { unsigned _sp = 0; while (cond) { __builtin_amdgcn_s_sleep(1); \
    if ((++_sp & 255u) == 0u) { if (xb_ld(&(bar)[XB_TMO])) break; if (_sp > XB_SPIN_CAP) { atomicAdd(&(bar)[XB_TMO], 1u); break; } } } } while (0)

struct XcdBarrier {
    unsigned* bar; unsigned x;
    volatile LAS unsigned* st;
};

__device__ __forceinline__ XcdBarrier xcd_barrier_post(unsigned* bar, volatile LAS unsigned* st) {
    XcdBarrier b; b.bar = bar; b.x = xb_xcc_id(); b.st = st;
    if (threadIdx.x == 0) (void)xb_add(&bar[XB_XCNT(b.x)], 1u);
    return b;
}
__device__ __forceinline__ void xcd_barrier_complete(unsigned* bar, unsigned x, unsigned& nloc, unsigned& nx) {
    const unsigned G = gridDim.x * gridDim.y * gridDim.z;
    unsigned sum, cnt, mine, sp = 0u;
    for (;;) {
        sum = 0u; cnt = 0u; mine = 0u;
#pragma unroll
        for (unsigned j = 0; j < 16; ++j) { const unsigned c = xb_ld(&bar[XB_XCNT(j)]); sum += c; cnt += (c > 0u) ? 1u : 0u; mine = (j == x) ? c : mine; }
        if (sum == G) break;
        __builtin_amdgcn_s_sleep(1);
        if ((++sp & 255u) == 0u) { if (xb_ld(&bar[XB_TMO])) break; if (sp > XB_SPIN_CAP) { atomicAdd(&bar[XB_TMO], 1u); break; } }
    }
    nloc = mine > 0u ? mine : 1u; nx = cnt > 0u ? cnt : 1u;
}

__device__ __forceinline__ void xcd_barrier(const XcdBarrier& b) {
    asm volatile("s_waitcnt vmcnt(0)" ::: "memory");
    __syncthreads();
    if (threadIdx.x == 0) {
        unsigned* bar = b.bar;
        __builtin_amdgcn_s_waitcnt(0);
        unsigned nloc = b.st[0], nx = b.st[1];
        if (nloc == 0u) { xcd_barrier_complete(bar, b.x, nloc, nx); b.st[0] = nloc; b.st[1] = nx; }
        const unsigned old = xb_add(&bar[XB_XSUB(b.x)], 1u);
        const unsigned gen = old / nloc;
        if (old + 1u == (gen + 1u) * nloc) {
            __builtin_amdgcn_fence(__ATOMIC_RELEASE, "agent");
            asm volatile("s_waitcnt vmcnt(0)" ::: "memory");
            const unsigned og = xb_add(&bar[XB_TOP], 1u);
            const unsigned tg = og / nx;
            if (og + 1u == (tg + 1u) * nx) xb_add(&bar[XB_TOPGEN], 1u);
            else XB_SPIN(xb_ld(&bar[XB_TOPGEN]) == tg, bar);
            __builtin_amdgcn_fence(__ATOMIC_ACQUIRE, "agent");
            xb_add(&bar[XB_XGEN(b.x)], 1u);
            asm volatile("s_waitcnt vmcnt(0)" ::: "memory");
        } else {
            XB_SPIN(xb_ld(&bar[XB_XGEN(b.x)]) == gen, bar);
            __builtin_amdgcn_fence(__ATOMIC_ACQUIRE, "agent");
            asm volatile("s_waitcnt vmcnt(0)" ::: "memory");
        }
    }
    __syncthreads();
}

constexpr int N_PHASES = 10;
struct Args { const float* in[24]; float* out; unsigned char* ws; int ph_lo, ph_hi; };
__global__ void __launch_bounds__(NWAVES * 64, 2) mk_fwd(Args args) {
    extern __shared__ __attribute__((aligned(16))) unsigned char lds[];
#define MKFRAME() Frame F; { int t_ = threadIdx.x; asm volatile("" : "+v"(t_)); F.lds = (LAS unsigned char*)lds; F.tid = t_; F.lane = t_ & 63; F.wave = __builtin_amdgcn_readfirstlane(t_ >> 6); \
        F.G = gridDim.x; const int bx = blockIdx.x; F.vcu = (F.G % 8 == 0) ? (bx % 8) * (F.G / 8) + bx / 8 : bx; F.in = args.in; F.out = args.out; F.ws = args.ws; }
    unsigned char* ws = args.ws;
    const int lo = args.ph_lo, hi = args.ph_hi;
#ifndef PH_MASK
#define PH_MASK 0x3ff
#endif
#define IN(k) (((PH_MASK >> (k)) & 1) && lo <= (k) && (k) < hi)
#ifndef REP_MASK
#define REP_MASK 0
#endif
#define REPS(k) for (int rep_ = 0; rep_ < ((((REP_MASK) >> (k)) & 1) ? 2 : 1); ++rep_)
#define SEAM(k) do { if (IN(k) && IN((k) + 1)) { xcd_barrier(bar); } } while (0)

    if (IN(0)) { MKFRAME(); if (blockIdx.x == 0) { for (int i = F.tid; i < CW_BAR + XCD_BAR_WORDS; i += NWAVES * 64) ((unsigned*)(ws + WS_CTL))[i] = 0u; } REPS(0) p0_prologue(F); }
    cg::this_grid().sync();
    XcdBarrier bar;
    { volatile LAS unsigned* st = (volatile LAS unsigned*)(lds + MISC_OFF) + 200; if (threadIdx.x == 0) { st[0] = 0u; st[1] = 0u; } __syncthreads(); bar = xcd_barrier_post((unsigned*)(ws + WS_CTL) + CW_BAR, st); }
    if (IN(1)) { MKFRAME();
        DenseSched S{(const char*)(ws + WS_XN), (const char*)(ws + WS_WIN), T / 256, INW / 256, D / 64, F.G, (int)blockIdx.x, (size_t)256 * D * 2, (size_t)256 * D * 2, (REP_MASK >> 1) & 1};
        inproj_table(F, S);
        EpiInProj E{ws, (const LAS float*)(F.lds + ETAB_OFF)};
        pg8::gemm_phase<EpiInProj, DenseSched, true, false>(F.lds, D * 2, D * 2, S, E, nullptr);
    }
    SEAM(1);
    if (IN(2)) { MKFRAME(); p2_fixup(F); REPS(2) p2_lru(F); }
    SEAM(2);
    if (IN(3)) { MKFRAME();
        const attn_body::AttnTensors AT{(const attn_body::bf16*)(ws + WS_Q), (const attn_body::bf16*)(ws + WS_KV), (const attn_body::bf16*)(ws + WS_KV) + KVW, (attn_body::bf16*)(ws + WS_AR)};
        const attn_body::StaticOrder S((int)F.G, F.vcu);
        REPS(3) attn_body::attn_phase<attn_body::StaticOrder>((char*)lds, AT, S);
    }
    SEAM(3);
    if (IN(4)) { MKFRAME();
        MergeSched S{(const char*)(ws + WS_AR), (const char*)(ws + WS_WCAT), F.G, (int)blockIdx.x};
        EpiMerge E{(const bf16*)(ws + WS_GL), (bf16*)(ws + WS_MERGED)};
        pg8::gemm_phase<EpiMerge, MergeSched, true, false>(F.lds, ARW * 2, ARW * 2, S, E, nullptr);
    }
    SEAM(4);
    if (IN(5)) { MKFRAME();
        DenseSched S{(const char*)(ws + WS_MERGED), (const char*)(ws + WS_WO), T / 256, D / 256, D / 64, F.G, (int)blockIdx.x, (size_t)256 * D * 2, (size_t)256 * D * 2, (REP_MASK >> 5) & 1};
        EpiResF32 E{F.in[I_X], F.out};
        pg8::gemm_phase<EpiResF32, DenseSched, true, false>(F.lds, D * 2, D * 2, S, E, nullptr);
    }
    SEAM(5);
    if (IN(6)) { MKFRAME(); if ((REP_MASK >> 6) & 1) p6_router(F, true); p6_router(F, false); }
    SEAM(6);
    if (IN(7)) { MKFRAME();
        moe_tables(F);
        MoeSched<8> S{(const char*)(ws + WS_XN), (const char*)(ws + WS_WGU), (const LAS int*)(F.lds + MISC_OFF) + 32, F.G, (int)blockIdx.x, (size_t)2 * DFF * D};
        moe_gather_table(F, S);
        EpiSwiGLU E{(const LAS float*)(F.lds + ETAB_OFF), (unsigned char*)(ws + WS_ACT)};
        pg8::gemm_phase<EpiSwiGLU, MoeSched<8>, true, true, true>(F.lds, D, D, S, E, (const LAS unsigned short*)(F.lds + GTAB_OFF));
    }
    SEAM(7);
    if (IN(8)) { MKFRAME();
        moe_tables(F);
        MoeDownSched S; S.A = (const char*)(ws + WS_ACT); S.B = (const char*)(ws + WS_WD); S.nbp = (const LAS int*)(F.lds + MISC_OFF) + 32; S.G = F.G; S.c = (int)blockIdx.x; S.estepB = (size_t)D * DFF;
        moe_down_table(F, S);
        EpiDown E{(const LAS float*)(F.lds + ETAB_OFF), (const LAS float*)(F.lds + ETAB_OFF) + 10 * 256, (bf16*)(ws + WS_Y)};
        pg8::gemm_phase<EpiDown, MoeDownSched, true, false, true>(F.lds, DFF, DFF, S, E, nullptr);
    }
    SEAM(8);
    if (IN(9)) { MKFRAME(); moe_tables(F); if ((REP_MASK >> 9) & 1) p10_final(F, (float*)(ws + WS_ACT)); p10_final(F, F.out); }
#undef IN
#undef SEAM
}

#ifndef MK_N_LAUNCHES
#define MK_N_LAUNCHES 1
#endif
extern "C" void kernel_launch(void* const* d_in, const int* in_sizes, int n_in, void* d_out, int out_size, void* d_ws, size_t ws_size, hipStream_t stream) {
    static int grid = 0;
    if (grid == 0) {
        if (n_in != 24 || in_sizes[0] != T * D || out_size != T * D || ws_size < WS_END) { fprintf(stderr, "kernel_launch: unexpected shapes (n_in %d, in0 %d, out %d, ws %zu < %zu)\n", n_in, n_in > 0 ? in_sizes[0] : -1, out_size, ws_size, (size_t)WS_END); grid = -1; return; }
        int dev = 0, cus = 0, per_cu = 0;
        if (hipGetDevice(&dev) != hipSuccess || hipDeviceGetAttribute(&cus, hipDeviceAttributeMultiprocessorCount, dev) != hipSuccess) { grid = -1; return; }
        if (hipFuncSetAttribute((const void*)mk_fwd, hipFuncAttributeMaxDynamicSharedMemorySize, LDS_BYTES) != hipSuccess) { fprintf(stderr, "kernel_launch: hipFuncSetAttribute failed\n"); grid = -1; return; }
        if (hipOccupancyMaxActiveBlocksPerMultiprocessor(&per_cu, (const void*)mk_fwd, NWAVES * 64, LDS_BYTES) != hipSuccess || per_cu < 1) { fprintf(stderr, "kernel_launch: occupancy query reports %d\n", per_cu); per_cu = 1; }
        (void)hipGetLastError();
        grid = cus;
    }
    if (grid < 0) return;
    Args a{};
    for (int i = 0; i < 24; ++i) a.in[i] = (const float*)d_in[i];
    a.out = (float*)d_out; a.ws = (unsigned char*)d_ws;
    const int nl = 1;
    for (int li = 0; li < nl; ++li) {
        a.ph_lo = (nl == 1) ? 0 : li; a.ph_hi = (nl == 1) ? N_PHASES : li + 1;
        void* kargs[] = {&a};
        const hipError_t le = hipLaunchCooperativeKernel((const void*)mk_fwd, dim3(grid), dim3(NWAVES * 64), kargs, LDS_BYTES, stream);
        if (le != hipSuccess) { fprintf(stderr, "kernel_launch: launch %d failed: %s (grid %d)\n", li, hipGetErrorName(le), grid); break; }
    }
}
```

```cpp
#include <hip/hip_runtime.h>
#include <hip/hip_cooperative_groups.h>
#include <cstdio>
#include <cstdint>
namespace pg8 {
#define PG8_LAS __attribute__((address_space(3)))
typedef unsigned short bf16_t;
typedef short bf16x8 __attribute__((ext_vector_type(8)));
typedef float f32x4 __attribute__((ext_vector_type(4)));
typedef float f32x2 __attribute__((ext_vector_type(2)));
typedef unsigned u32x4 __attribute__((ext_vector_type(4)));
typedef unsigned u32x2 __attribute__((ext_vector_type(2)));
typedef int v8i32 __attribute__((ext_vector_type(8)));
typedef int v4i32 __attribute__((ext_vector_type(4)));
constexpr int BM = 256, BK = 64, HALF = 128, HTB = HALF * BK * 2  , STAGE_BYTES = 8 * HTB, NXCD = 8, WGM = 8;

__host__ __device__ __forceinline__ int lds_byte(int r, int c) { const int st = (r >> 4) * 2 + (c >> 5), rr = r & 15, cc = c & 31, ob = rr * 64 + cc * 2; return st * 1024 + (ob ^ (((ob >> 9) & 1) << 5)); }
__host__ __device__ __forceinline__ void stage_rc(int b, int& R, int& C) { const int st = b / 1024, sb = b % 1024, swz = sb ^ (((sb >> 9) & 1) << 5); R = (st >> 1) * 16 + swz / 64; C = (st & 1) * 32 + (swz % 64) / 2; }
__host__ __device__ __forceinline__ int perm32(int rho) { const int n = rho >> 4, i = rho & 15; return 8 * (i >> 2) + 4 * n + (i & 3); }

struct Unit { int pm, pn, aux, ui; };

__device__ __forceinline__ void dense_tile(int L, int nM, int nN, int& pm, int& pn) {
    const int nwg = nM * nN; int wgid = L;
    { const int q = nwg / NXCD, r = nwg % NXCD, xcd = wgid % NXCD, off = wgid / NXCD; wgid = (xcd < r ? xcd * (q + 1) : r * (q + 1) + (xcd - r) * q) + off; }
    const int nig = WGM * nN, gid = wgid / nig, fm = gid * WGM, gsz = (nM - fm) < WGM ? (nM - fm) : WGM;
    pm = fm + ((wgid % nig) % gsz); pn = (wgid % nig) / gsz;
}

__device__ __forceinline__ unsigned cvt_pk_bf16(float lo, float hi) { unsigned r; asm volatile("v_cvt_pk_bf16_f32 %0, %1, %2" : "=v"(r) : "v"(lo), "v"(hi)); return r; }
__device__ __forceinline__ float bf_lo(unsigned w) { return __uint_as_float(w << 16); }
__device__ __forceinline__ float bf_hi(unsigned w) { return __uint_as_float(w & 0xffff0000u); }
__device__ __forceinline__ float fast_sigmoid(float x) { return __builtin_amdgcn_rcpf(1.0f + __builtin_amdgcn_exp2f(-1.4426950408889634f * x)); }

template <class Epi, class Sched, bool ALIGN_EPI, bool GATHER, bool FP8 = false>
__device__ __forceinline__ void gemm_phase(PG8_LAS unsigned char* lds, const int lda, const int ldb, const Sched& S, const Epi& E, const PG8_LAS unsigned short* gtab) {
    const int tid = threadIdx.x, wid = __builtin_amdgcn_readfirstlane(tid >> 6), lane = tid & 63, wr = wid >> 2, wc = wid & 3, fr = lane & 15, fq = lane >> 4;
    unsigned voffA[2], voffB[2]; int RA[2];
#pragma unroll
    for (int i = 0; i < 2; ++i) { int R, C; stage_rc(tid * 16 + i * 8192, R, C); const int Rb = Epi::PERM ? ((R & ~31) + perm32(R & 31)) : R;
        voffA[i] = GATHER ? (unsigned)(C * 2) : (unsigned)(R * lda + C * 2); voffB[i] = (unsigned)(Rb * ldb + C * 2); RA[i] = R; }
    const size_t kstep = (size_t)(BK * 2);
    const size_t hstepA = GATHER ? 0 : (size_t)HALF * lda;
    const size_t hstepB = (size_t)HALF * ldb;
    const unsigned ldsw = (unsigned)wid * 1024u;
    const int aoff = lds_byte(wr * 64 + fr, fq * 8), boff = lds_byte(wc * 32 + fr, fq * 8);
    const int aoff8 = lds_byte(wr * 64 + fr, (fq >> 1) * 32 + (fq & 1) * 16), boff8 = lds_byte(wc * 32 + fr, (fq >> 1) * 32 + (fq & 1) * 16);
    unsigned gC[2][2], gN[2][2];
#define PG8_SA(b, h) (((b) * 2 + (h)) * HTB)
#define PG8_SB(b, h) ((4 + (b) * 2 + (h)) * HTB)
#define PG8_GLDS(gp, bufoff, i) __builtin_amdgcn_global_load_lds((const unsigned*)(gp), (PG8_LAS unsigned*)(lds + (bufoff) + ldsw + (i) * 8192), 16, 0, 0)
#define PG8_STAGE_B(bufoff, gbase) do { _Pragma("unroll") for (int _i = 0; _i < 2; ++_i) PG8_GLDS((const char*)(gbase) + voffB[_i], bufoff, _i); } while (0)
#define PG8_STAGE_A(bufoff, gbase, h, nx) do { _Pragma("unroll") for (int _i = 0; _i < 2; ++_i) { \
        if constexpr (GATHER) PG8_GLDS((const char*)(gbase) + ((nx) ? gN[h][_i] : gC[h][_i]) + voffA[_i], bufoff, _i); \
        else PG8_GLDS((const char*)(gbase) + voffA[_i], bufoff, _i); } } while (0)
#define PG8_LDA(dst, b, h) do { if constexpr (FP8) { _Pragma("unroll") for (int m = 0; m < 4; ++m) dst##8[m] = __builtin_shufflevector(*(const PG8_LAS v4i32*)(lds + PG8_SA(b, h) + aoff + m * 2048), *(const PG8_LAS v4i32*)(lds + PG8_SA(b, h) + aoff + m * 2048 + 1024), 0, 1, 2, 3, 4, 5, 6, 7); } \
        else { _Pragma("unroll") for (int m = 0; m < 4; ++m) _Pragma("unroll") for (int k = 0; k < 2; ++k) dst[m][k] = *(const PG8_LAS bf16x8*)(lds + PG8_SA(b, h) + aoff + m * 2048 + k * 1024); } } while (0)
#define PG8_LDB(dst, b, h) do { if constexpr (FP8) { _Pragma("unroll") for (int n = 0; n < 2; ++n) dst##8[n] = __builtin_shufflevector(*(const PG8_LAS v4i32*)(lds + PG8_SB(b, h) + boff + n * 2048), *(const PG8_LAS v4i32*)(lds + PG8_SB(b, h) + boff + n * 2048 + 1024), 0, 1, 2, 3, 4, 5, 6, 7); } \
        else { _Pragma("unroll") for (int n = 0; n < 2; ++n) _Pragma("unroll") for (int k = 0; k < 2; ++k) dst[n][k] = *(const PG8_LAS bf16x8*)(lds + PG8_SB(b, h) + boff + n * 2048 + k * 1024); } } while (0)
#define PG8_MMA(ai, bj, At, Bt) do { __builtin_amdgcn_s_setprio(1); _Pragma("unroll") for (int m = 0; m < 4; ++m) _Pragma("unroll") for (int n = 0; n < 2; ++n) { \
        if constexpr (FP8) { asm volatile("v_mfma_scale_f32_16x16x128_f8f6f4 %0, %1, %2, %0, %3, %3 op_sel_hi:[0,0,0]" : "+v"(acc[ai][bj][m][n]) : "v"(Bt##8[n]), "v"(At##8[m]), "v"(scale1)); } \
        else { _Pragma("unroll") for (int k = 0; k < 2; ++k) acc[ai][bj][m][n] = __builtin_amdgcn_mfma_f32_16x16x32_bf16(Bt[n][k], At[m][k], acc[ai][bj][m][n], 0, 0, 0); } } \
        __builtin_amdgcn_s_setprio(0); } while (0)
#define PG8_WAIT_V(n) asm volatile("s_waitcnt vmcnt(" #n ")" ::: "memory")
#define PG8_WAIT_L(n) asm volatile("s_waitcnt lgkmcnt(" #n ")" ::: "memory")
#define PG8_BAR __builtin_amdgcn_s_barrier()
#define PG8_SCHED __builtin_amdgcn_sched_barrier(0)
#define PG8_GOFF(dst, ui_) do { if constexpr (GATHER) { _Pragma("unroll") for (int _h = 0; _h < 2; ++_h) _Pragma("unroll") for (int _i = 0; _i < 2; ++_i) \
        dst[_h][_i] = (unsigned)gtab[(ui_) * 256 + _h * HALF + RA[_i]] * (unsigned)lda; } } while (0)
    Unit cur, nxt; int ui = 0;
    if (!S.next(0, cur)) return;
    cur.ui = 0;
    f32x4 acc[2][2][4][2];
#pragma unroll
    for (int a = 0; a < 2; ++a)
#pragma unroll
        for (int b = 0; b < 2; ++b)
#pragma unroll
            for (int m = 0; m < 4; ++m)
#pragma unroll
                for (int n = 0; n < 2; ++n) acc[a][b][m][n] = (f32x4){0.f, 0.f, 0.f, 0.f};
    bf16x8 At[4][2], B0[2][2], B1[2][2]; v8i32 At8[4], B08[2], B18[2];
    int scale1 = 0x7f7f7f7f; asm volatile("" : "+v"(scale1));
    const char* cA = S.a_ptr(cur); const char* cB = S.b_ptr(cur);
    PG8_GOFF(gC, 0);
#pragma unroll
    for (int _h = 0; _h < 2; ++_h)
#pragma unroll
        for (int _i = 0; _i < 2; ++_i) gN[_h][_i] = gC[_h][_i];
    PG8_STAGE_B(PG8_SB(0, 0), cB); PG8_STAGE_B(PG8_SB(0, 1), cB + hstepB); PG8_STAGE_A(PG8_SA(0, 0), cA, 0, false); PG8_STAGE_A(PG8_SA(0, 1), cA + hstepA, 1, false);
    if (wr == 1) PG8_BAR;
    PG8_WAIT_V(2); PG8_BAR;
    PG8_STAGE_B(PG8_SB(1, 0), cB + kstep); PG8_STAGE_A(PG8_SA(1, 0), cA + kstep, 0, false); PG8_STAGE_B(PG8_SB(1, 1), cB + hstepB + kstep);
    PG8_WAIT_V(6); PG8_BAR;
    for (;;) {
        const bool has_next = S.next(ui + 1, nxt); nxt.ui = ui + 1;
        const int nt = S.ntiles(cur);
        const char* nA = has_next ? S.a_ptr(nxt) : cA; const char* nB = has_next ? S.b_ptr(nxt) : cB;
        if (has_next) PG8_GOFF(gN, ui + 1);
#pragma unroll 1
        for (int t = 0; t < nt; t += 2) {
            const bool last = (t == nt - 2);
            const char* a1 = cA + (size_t)(t + 1) * kstep;
            const char* a2 = last ? nA : cA + (size_t)(t + 2) * kstep; const char* b2 = last ? nB : cB + (size_t)(t + 2) * kstep;
            const char* a3 = a2 + kstep; const char* b3 = b2 + kstep;
            PG8_LDB(B0, 0, 0); PG8_LDB(B1, 0, 1); PG8_SCHED; PG8_LDA(At, 0, 0); PG8_STAGE_A(PG8_SA(1, 1), a1 + hstepA, 1, false);
            PG8_WAIT_V(8); PG8_WAIT_L(0); PG8_BAR; PG8_MMA(0, 0, At, B0); PG8_MMA(0, 1, At, B1); PG8_BAR; PG8_SCHED;
            PG8_LDA(At, 0, 1); PG8_STAGE_B(PG8_SB(0, 0), b2); PG8_STAGE_B(PG8_SB(0, 1), b2 + hstepB); PG8_STAGE_A(PG8_SA(0, 0), a2, 0, last);
            PG8_WAIT_V(8); PG8_WAIT_L(0); PG8_BAR; PG8_MMA(1, 0, At, B0); PG8_MMA(1, 1, At, B1); PG8_BAR; PG8_SCHED;
            PG8_LDB(B0, 1, 0); PG8_LDB(B1, 1, 1); PG8_SCHED; PG8_LDA(At, 1, 0); PG8_STAGE_A(PG8_SA(0, 1), a2 + hstepA, 1, last);
            PG8_WAIT_V(8); PG8_WAIT_L(0); PG8_BAR; PG8_MMA(0, 0, At, B0); PG8_MMA(0, 1, At, B1); PG8_BAR; PG8_SCHED;
            PG8_LDA(At, 1, 1); PG8_STAGE_B(PG8_SB(1, 0), b3); PG8_STAGE_B(PG8_SB(1, 1), b3 + hstepB); PG8_STAGE_A(PG8_SA(1, 0), a3, 0, last);
            PG8_WAIT_V(8); PG8_WAIT_L(0); PG8_BAR; PG8_MMA(1, 0, At, B0); PG8_MMA(1, 1, At, B1); PG8_BAR; PG8_SCHED;
        }
        if constexpr (ALIGN_EPI) { if (wr == 0) PG8_BAR; }
        if constexpr (FP8) asm volatile("s_nop 15\n\ts_nop 15" ::: "memory");
        { int fr_ = fr, fq_ = fq; asm volatile("" : "+v"(fr_), "+v"(fq_));
          E(acc, cur, wr, wc, fr_, fq_); }
        if (!E.keep(cur)) {
#pragma unroll
        for (int a = 0; a < 2; ++a)
#pragma unroll
            for (int b = 0; b < 2; ++b)
#pragma unroll
                for (int m = 0; m < 4; ++m)
#pragma unroll
                    for (int n = 0; n < 2; ++n) acc[a][b][m][n] = (f32x4){0.f, 0.f, 0.f, 0.f};
        }
        if (!has_next) break;
        cur = nxt; cA = nA; cB = nB; ++ui;
#pragma unroll
        for (int _h = 0; _h < 2; ++_h)
#pragma unroll
            for (int _i = 0; _i < 2; ++_i) gC[_h][_i] = gN[_h][_i];
        if constexpr (ALIGN_EPI) { if (wr == 1) PG8_BAR; }
    }
    PG8_WAIT_V(0);
    if constexpr (!ALIGN_EPI) { if (wr == 0) PG8_BAR; }
    PG8_BAR;
#undef PG8_SA
#undef PG8_SB
#undef PG8_GLDS
#undef PG8_STAGE_A
#undef PG8_STAGE_B
#undef PG8_LDA
#undef PG8_LDB
#undef PG8_MMA
#undef PG8_WAIT_V
#undef PG8_WAIT_L
#undef PG8_BAR
#undef PG8_SCHED
#undef PG8_GOFF
}
}
#include <hip/hip_bf16.h>
#include <cmath>
namespace attn_body {
using bf16=__hip_bfloat16;
using bf16x8=__attribute__((ext_vector_type(8)))short;
using s16x4=__attribute__((ext_vector_type(4)))short;
using f32x16=__attribute__((ext_vector_type(16)))float;
using u32x4=__attribute__((ext_vector_type(4)))unsigned;
constexpr int BATCH=8,NHEAD=8,NKV=2,SEQ=4096,D=64;
constexpr int QP=512,KVP=256,OP=1536;
constexpr int NW=8,QBLK=32,QB=QBLK*NW,KVBLK=64,NQB=SEQ/QB;
constexpr int ATTN_UNIT_ROWS=QB;
__device__ __forceinline__ int crow(int r,int hi){return (r&3)+8*(r>>2)+4*hi;}
#define SBAR() __builtin_amdgcn_sched_barrier(0)
constexpr int NSLOT=3, SLOTB=8192;
constexpr int LDS_K=0, LDS_V=NSLOT*SLOTB, LDS_WS=2*NSLOT*SLOTB, LDS_OST=LDS_WS+NW*64*4, LDS_BYTES=LDS_OST+NW*4096;
constexpr float C2=0.125f*1.4426950408889634f;
__device__ __forceinline__ void glds16(const void*gsrc,unsigned lds_dst){unsigned keep;
  asm volatile("s_mov_b32 %0, m0\n\ts_mov_b32 m0, %2\n\ts_nop 0\n\tglobal_load_lds_dwordx4 %1, off\n\ts_mov_b32 m0, %0":"=&s"(keep):"v"(gsrc),"s"(lds_dst):"memory");}
__device__ __forceinline__ float max3f(float a,float b,float c){float r;asm("v_max3_f32 %0, %1, %2, %3":"=v"(r):"v"(a),"v"(b),"v"(c));return r;}
__device__ __forceinline__ float max2f(float a,float b){float r;asm("v_max_f32_e32 %0, %1, %2":"=v"(r):"v"(a),"v"(b));return r;}
__device__ __forceinline__ float fadd_s(float a,float b){float r;asm("v_add_f32_e32 %0, %1, %2":"=v"(r):"v"(a),"v"(b));return r;}
__device__ __forceinline__ float fsub_s(float a,float b){float r;asm("v_sub_f32_e32 %0, %1, %2":"=v"(r):"v"(a),"v"(b));return r;}
typedef float f32x2_t __attribute__((ext_vector_type(2))); typedef __bf16 bf16x2_t __attribute__((ext_vector_type(2)));
__device__ __forceinline__ unsigned cvtpk_s(float lo,float hi){f32x2_t v={lo,hi};bf16x2_t b=__builtin_convertvector(v,bf16x2_t);return __builtin_bit_cast(unsigned,b);}
#define WAIT_BAR(N) asm volatile("s_waitcnt vmcnt(" #N ") lgkmcnt(0)\n\ts_barrier":::"memory")

__device__ __forceinline__ void qkt(f32x16&p0,f32x16&p1,const char*Kslot,const bf16x8*qr,const f32x16&negm,int r32,int hi){
  const char*kb=Kslot+hi*1024+r32*16;
  #pragma unroll
  for(int d0=0;d0<4;++d0){
    const bf16x8 b0=*reinterpret_cast<const bf16x8*>(kb+d0*2048);
    const bf16x8 b1=*reinterpret_cast<const bf16x8*>(kb+d0*2048+512);
    if(d0==0){p0=__builtin_amdgcn_mfma_f32_32x32x16_bf16(b0,qr[0],negm,0,0,0);p1=__builtin_amdgcn_mfma_f32_32x32x16_bf16(b1,qr[0],negm,0,0,0);}
    else{p0=__builtin_amdgcn_mfma_f32_32x32x16_bf16(b0,qr[d0],p0,0,0,0);p1=__builtin_amdgcn_mfma_f32_32x32x16_bf16(b1,qr[d0],p1,0,0,0);}}
}
typedef __attribute__((address_space(3))) const char* lds_cptr;
typedef short v4i16_t __attribute__((ext_vector_type(4)));
__device__ __forceinline__ void kload8(bf16x8*kf,lds_cptr kp){
  kf[0]=*(const __attribute__((address_space(3))) bf16x8*)(kp);      kf[1]=*(const __attribute__((address_space(3))) bf16x8*)(kp+512);
  kf[2]=*(const __attribute__((address_space(3))) bf16x8*)(kp+2048); kf[3]=*(const __attribute__((address_space(3))) bf16x8*)(kp+2560);
  kf[4]=*(const __attribute__((address_space(3))) bf16x8*)(kp+4096); kf[5]=*(const __attribute__((address_space(3))) bf16x8*)(kp+4608);
  kf[6]=*(const __attribute__((address_space(3))) bf16x8*)(kp+6144); kf[7]=*(const __attribute__((address_space(3))) bf16x8*)(kp+6656);
}
__device__ __forceinline__ void kload2(bf16x8*kf,lds_cptr kp,int j){ kf[2*j]=*(const __attribute__((address_space(3))) bf16x8*)(kp+j*2048); kf[2*j+1]=*(const __attribute__((address_space(3))) bf16x8*)(kp+j*2048+512); }
__device__ __forceinline__ s16x4 vtr(lds_cptr p){ return __builtin_bit_cast(s16x4,__builtin_amdgcn_ds_read_tr16_b64_v4i16((__attribute__((address_space(3))) v4i16_t*)p)); }
__device__ __forceinline__ float rowmax(const f32x16&p0,const f32x16&p1){
  float a=max3f(p0[0],p0[1],p1[0]),b=max3f(p0[2],p0[3],p1[1]);a=max3f(a,p1[2],p1[3]);
  #pragma unroll
  for(int r=4;r<16;r+=4){a=max3f(a,p0[r],p0[r+1]);b=max3f(b,p0[r+2],p0[r+3]);a=max3f(a,p1[r],p1[r+1]);b=max3f(b,p1[r+2],p1[r+3]);}
  const float m=max2f(a,b);
  auto rr=__builtin_amdgcn_permlane32_swap(__float_as_uint(m),__float_as_uint(m),false,false);
  return max2f(__uint_as_float(rr[0]),__uint_as_float(rr[1]));
}
__device__ __forceinline__ void pv(f32x16*o,int vb,bf16x8 pa0,bf16x8 pa1,bf16x8 pa2,bf16x8 pa3){
  #pragma unroll
  for(int d0=0;d0<2;++d0){s16x4 lo[4],hi[4];
    #pragma unroll
    for(int ks=0;ks<4;++ks){
      asm volatile("ds_read_b64_tr_b16 %0,%1 offset:%c2":"=&v"(lo[ks]):"v"(vb),"i"(d0*4096+ks*1024):"memory");
      asm volatile("ds_read_b64_tr_b16 %0,%1 offset:%c2":"=&v"(hi[ks]):"v"(vb),"i"(d0*4096+ks*1024+512):"memory");}
    asm volatile("s_waitcnt lgkmcnt(0)":::"memory");SBAR();
    #define PK(k) (bf16x8){lo[k][0],lo[k][1],lo[k][2],lo[k][3],hi[k][0],hi[k][1],hi[k][2],hi[k][3]}
    o[d0]=__builtin_amdgcn_mfma_f32_32x32x16_bf16(pa0,PK(0),o[d0],0,0,0);
    o[d0]=__builtin_amdgcn_mfma_f32_32x32x16_bf16(pa1,PK(1),o[d0],0,0,0);
    o[d0]=__builtin_amdgcn_mfma_f32_32x32x16_bf16(pa2,PK(2),o[d0],0,0,0);
    o[d0]=__builtin_amdgcn_mfma_f32_32x32x16_bf16(pa3,PK(3),o[d0],0,0,0);
    #undef PK
  }
}

#ifndef ATTN_STORE16
#define ATTN_STORE16(p,v) (*(u32x4*)(p)=(v))
#endif
template<int THRL> __device__ __forceinline__ void attn_unit(int b,int h,int qb,const bf16*Q,const bf16*__restrict__ K,const bf16*__restrict__ V,bf16*O,char*shm){
  const int tid=threadIdx.x,lane=tid&63,r32=lane&31,hi=lane>>5; const int wid=__builtin_amdgcn_readfirstlane(tid>>6);
  const long rowbase=(long)b*SEQ; const int q0=qb*QB;
  const bf16*Qw=Q+(rowbase+q0+wid*QBLK)*QP+h*D; const int kvh=h/(NHEAD/NKV);
  const bf16*Kh=K+rowbase*KVP+kvh*D,*Vh=V+rowbase*KVP+kvh*D;
  const unsigned lds0=(unsigned)(uintptr_t)shm;
  float*wsf=(float*)(shm+LDS_WS)+wid*64;
  const bf16*ksrc=Kh+(long)lane*KVP+wid*8;
  const bf16*vsrc=Vh+(long)(16*(wid&3)+(lane>>2))*KVP+(wid>>2)*32+(lane&3)*8;
  const unsigned kdst=lds0+LDS_K+wid*1024, vdst=lds0+LDS_V+wid*1024;
  #define DMA_K(t,slot) glds16(ksrc+(long)(t)*KVBLK*KVP,(unsigned)__builtin_amdgcn_readfirstlane(kdst+(slot)))
  #define DMA_V(t,slot) glds16(vsrc+(long)(t)*KVBLK*KVP,(unsigned)__builtin_amdgcn_readfirstlane(vdst+(slot)))
  const int vb0=(int)(lds0+LDS_V)+((lane>>4)&1)*32+(lane&3)*8+(4*hi+((lane&15)>>2))*64;
  const char*Kbase=shm+LDS_K; bf16x8 kf[8];
  const lds_cptr shm3=(lds_cptr)shm; const lds_cptr kp0=shm3+LDS_K+hi*1024+r32*16; const lds_cptr vp0=shm3+LDS_V+((lane>>4)&1)*32+(lane&3)*8+(4*hi+((lane&15)>>2))*64;
  constexpr int NT=SEQ/KVBLK;
  DMA_K(0,0);DMA_V(0,0);DMA_K(1,SLOTB);
  bf16x8 qr[4];
  #pragma unroll
  for(int d0=0;d0<4;++d0)qr[d0]=*reinterpret_cast<const bf16x8*>(&Qw[(long)r32*QP+d0*16+hi*8]);
  float mhat=0.f,l_reg=0.f;f32x16 o[2];o[0]=f32x16{};o[1]=f32x16{};f32x16 negm=f32x16{};asm volatile("":"+v"(negm));
  #define CMASK(P0,P1,t) do{}while(0)
  bool resc=false;
  #define START(P0,P1) do{ const float rm=rowmax(P0,P1); resc=false; \
    { const float dl=rm; mhat=fadd_s(mhat,dl); \
      _Pragma("unroll") for(int r=0;r<16;++r){P0[r]=fsub_s(P0[r],dl);P1[r]=fsub_s(P1[r],dl);} \
      _Pragma("unroll") for(int r=0;r<16;++r)negm[r]=-mhat; asm volatile("":"+v"(negm)); } \
    _Pragma("unroll") for(int r=0;r<16;++r)P0[r]=__builtin_amdgcn_exp2f(P0[r]); }while(0)
  #define RESC() do{ if(resc){ asm volatile("s_waitcnt lgkmcnt(0)":::"memory"); \
      _Pragma("unroll") for(int d_=0;d_<2;++d_) _Pragma("unroll") for(int r=0;r<16;++r)o[d_][r]*=wsf[crow(r,hi)]; } }while(0)
  f32x16 pA0,pA1,pB0,pB1;
  int sl_prev=0,sl_cur=0,sl_next=SLOTB;
  #define ROT() do{sl_prev=sl_cur;sl_cur=sl_next;sl_next=(sl_next==(NSLOT-1)*SLOTB)?0:sl_next+SLOTB;}while(0)
  DMA_K(2,2*SLOTB);
  WAIT_BAR(3);
  qkt(pA0,pA1,Kbase,qr,negm,r32,hi);asm volatile("s_nop 15\n\ts_nop 7":"+v"(pA0),"+v"(pA1));CMASK(pA0,pA1,0);
  START(pA0,pA1);
  _Pragma("unroll") for(int r=0;r<16;++r)pA1[r]=__builtin_amdgcn_exp2f(pA1[r]);
  WAIT_BAR(0);
  DMA_K(3,0);DMA_V(1,SLOTB);
  ROT();
  kload8(kf,kp0+sl_cur);
  WAIT_BAR(2);
  s16x4 vlo[8],vhi[8]; u32x4 pw0,pw1,pw2,pw3;
  #define PKW(P,B) cvtpk_s(P[B],P[B+1])
  #define PAF(k) __builtin_bit_cast(bf16x8,pw##k)
  #define VFR(i) (bf16x8){vlo[i][0],vlo[i][1],vlo[i][2],vlo[i][3],vhi[i][0],vhi[i][1],vhi[i][2],vhi[i][3]}
  #define PIN(x) asm volatile("":"+v"(x))
  #define MX3(a,b,c) __builtin_fmaxf(__builtin_fmaxf((a),(b)),(c))
  #define GAPA(MF,A0,A1,A2,A3,W0,W1,PW) do{ MF; sacc+=A0; sacc+=A1; sacc+=A2; sacc+=A3; PIN(sacc); W0; W1; PIN(PW); SBAR(); }while(0)
  #define EX(v) __builtin_amdgcn_exp2f(v)
  #define GAPB(MF,X,B) do{ MF; X[B]=EX(X[B]); X[B+1]=EX(X[B+1]); X[B+2]=EX(X[B+2]); X[B+3]=EX(X[B+3]); PIN(X); SBAR(); }while(0)
  #define VRD(i) do{ vlo[i]=vtr(vp_+(((i)>>2)*4096+((i)&3)*1024)); vhi[i]=vtr(vp_+(((i)>>2)*4096+((i)&3)*1024+512)); }while(0)
  #define KRD(G,j) do{ if(G){ kload2(kf,kp0+sl_next,j); SBAR(); } }while(0)
  #define STEP(C0,C1,P0,P1,t,GK,GV,GL) do{ SBAR(); \
    const lds_cptr vp_=vp0+sl_prev; \
    VRD(0); SBAR(); float sacc=(P0[0]+P0[1]); \
    GAPA(C0=__builtin_amdgcn_mfma_f32_32x32x16_bf16(kf[0],qr[0],negm,0,0,0), P0[2],P0[3],P0[4],P0[5],     pw0[0]=PKW(P0,0), pw0[1]=PKW(P0,2), pw0); \
    VRD(4); SBAR(); GAPA(C1=__builtin_amdgcn_mfma_f32_32x32x16_bf16(kf[1],qr[0],negm,0,0,0), P0[6],P0[7],P0[8],P0[9],     pw0[2]=PKW(P0,4), pw0[3]=PKW(P0,6), pw0); \
    VRD(1); SBAR(); GAPA(C0=__builtin_amdgcn_mfma_f32_32x32x16_bf16(kf[2],qr[1],C0,0,0,0),   P0[10],P0[11],P0[12],P0[13], pw1[0]=PKW(P0,8), pw1[1]=PKW(P0,10), pw1); \
    VRD(5); SBAR(); GAPA(C1=__builtin_amdgcn_mfma_f32_32x32x16_bf16(kf[3],qr[1],C1,0,0,0),   P0[14],P0[15],P1[0],P1[1],   pw1[2]=PKW(P0,12),pw1[3]=PKW(P0,14), pw1); \
    VRD(2); SBAR(); GAPA(C0=__builtin_amdgcn_mfma_f32_32x32x16_bf16(kf[4],qr[2],C0,0,0,0),   P1[2],P1[3],P1[4],P1[5],     pw2[0]=PKW(P1,0), pw2[1]=PKW(P1,2), pw2); \
    VRD(6); SBAR(); GAPA(C1=__builtin_amdgcn_mfma_f32_32x32x16_bf16(kf[5],qr[2],C1,0,0,0),   P1[6],P1[7],P1[8],P1[9],     pw2[2]=PKW(P1,4), pw2[3]=PKW(P1,6), pw2); \
    VRD(3); SBAR(); GAPA(C0=__builtin_amdgcn_mfma_f32_32x32x16_bf16(kf[6],qr[3],C0,0,0,0),   P1[10],P1[11],P1[12],P1[13], pw3[0]=PKW(P1,8), pw3[1]=PKW(P1,10), pw3); \
    VRD(7); SBAR(); GAPA(C1=__builtin_amdgcn_mfma_f32_32x32x16_bf16(kf[7],qr[3],C1,0,0,0),   P1[14],P1[15],0.f,0.f,       pw3[2]=PKW(P1,12),pw3[3]=PKW(P1,14), pw3); \
    l_reg+=sacc; \
    if(GK){DMA_K((t)+3,sl_cur);} if(GV){DMA_V((t)+1,sl_next);} \
    CMASK(C0,C1,t); \
    { float a=MX3(C0[0],C0[1],C1[0]),b=MX3(C0[2],C0[3],C1[1]); a=MX3(a,C1[2],C1[3]); \
      _Pragma("unroll") for(int r=4;r<16;r+=4){a=MX3(a,C0[r],C0[r+1]);b=MX3(b,C0[r+2],C0[r+3]);a=MX3(a,C1[r],C1[r+1]);b=MX3(b,C1[r+2],C1[r+3]);} \
      float rm=__builtin_fmaxf(a,b); { auto rr=__builtin_amdgcn_permlane32_swap(__float_as_uint(rm),__float_as_uint(rm),false,false); rm=__builtin_fmaxf(__uint_as_float(rr[0]),__uint_as_float(rr[1])); } \
      resc=false; \
      if(__builtin_expect(__any(rm>(float)THRL),0)){ const float dl=__builtin_fmaxf(rm,0.f); mhat+=dl; \
        _Pragma("unroll") for(int r=0;r<16;++r){C0[r]-=dl;C1[r]-=dl;} \
        _Pragma("unroll") for(int r=0;r<16;++r)negm[r]=-mhat; asm volatile("":"+v"(negm)); \
        const float f=__builtin_amdgcn_exp2f(-dl); l_reg*=f; if(hi==0)wsf[r32]=f; resc=true; } } \
    SBAR(); \
    GAPB(o[0]=__builtin_amdgcn_mfma_f32_32x32x16_bf16(PAF(0),VFR(0),o[0],0,0,0), C0,0); \
    GAPB(o[1]=__builtin_amdgcn_mfma_f32_32x32x16_bf16(PAF(0),VFR(4),o[1],0,0,0), C0,4); \
    KRD(GL,0); GAPB(o[0]=__builtin_amdgcn_mfma_f32_32x32x16_bf16(PAF(1),VFR(1),o[0],0,0,0), C0,8); \
    KRD(GL,1); GAPB(o[1]=__builtin_amdgcn_mfma_f32_32x32x16_bf16(PAF(1),VFR(5),o[1],0,0,0), C0,12); \
    KRD(GL,2); GAPB(o[0]=__builtin_amdgcn_mfma_f32_32x32x16_bf16(PAF(2),VFR(2),o[0],0,0,0), C1,0); \
    KRD(GL,3); GAPB(o[1]=__builtin_amdgcn_mfma_f32_32x32x16_bf16(PAF(2),VFR(6),o[1],0,0,0), C1,4); \
    GAPB(o[0]=__builtin_amdgcn_mfma_f32_32x32x16_bf16(PAF(3),VFR(3),o[0],0,0,0), C1,8); \
    GAPB(o[1]=__builtin_amdgcn_mfma_f32_32x32x16_bf16(PAF(3),VFR(7),o[1],0,0,0), C1,12); \
    }while(0)
  int t=1;
  for(;t+5<NT;t+=2){
    STEP(pB0,pB1,pA0,pA1,t,true,true,true);     WAIT_BAR(2); RESC(); ROT();
    STEP(pA0,pA1,pB0,pB1,t+1,true,true,true);   WAIT_BAR(2); RESC(); ROT();
  }
  #define ENDW(tt) do{ if((tt)+3<NT){WAIT_BAR(2);} else if((tt)+2<NT){WAIT_BAR(1);} else {WAIT_BAR(0);} }while(0)
  for(;t+1<NT;t+=2){
    STEP(pB0,pB1,pA0,pA1,t,(t+3<NT),(t+1<NT),(t+1<NT));       ENDW(t);   RESC(); ROT();
    STEP(pA0,pA1,pB0,pB1,t+1,(t+4<NT),(t+2<NT),(t+2<NT));     ENDW(t+1); RESC(); ROT();
  }
  STEP(pB0,pB1,pA0,pA1,NT-1,false,false,false); RESC();
  { float sacc=pB0[0]+pB0[1]; _Pragma("unroll") for(int r=2;r<16;++r)sacc+=pB0[r]; _Pragma("unroll") for(int r=0;r<16;++r)sacc+=pB1[r]; l_reg+=sacc;
    pw0=(u32x4){PKW(pB0,0),PKW(pB0,2),PKW(pB0,4),PKW(pB0,6)};pw1=(u32x4){PKW(pB0,8),PKW(pB0,10),PKW(pB0,12),PKW(pB0,14)};pw2=(u32x4){PKW(pB1,0),PKW(pB1,2),PKW(pB1,4),PKW(pB1,6)};pw3=(u32x4){PKW(pB1,8),PKW(pB1,10),PKW(pB1,12),PKW(pB1,14)};
    SBAR(); pv(o,vb0+sl_cur,PAF(0),PAF(1),PAF(2),PAF(3)); }
  #undef PKW
  #undef PAF
  #undef VFR
  #undef PIN
  #undef MX3
  #undef GAPA
  #undef GAPB
  #undef EX
  #undef VRD
  #undef KRD
  #undef STEP
  #undef ENDW
  {auto rr=__builtin_amdgcn_permlane32_swap(__float_as_uint(l_reg),__float_as_uint(l_reg),false,false);l_reg=__uint_as_float(rr[0])+__uint_as_float(rr[1]);}
  if(hi==0)wsf[32+r32]=l_reg;asm volatile("s_waitcnt lgkmcnt(0)":::"memory");
  float rli[16];
  #pragma unroll
  for(int r=0;r<16;++r)rli[r]=__builtin_amdgcn_rcpf(wsf[32+crow(r,hi)]);
  bf16*Ow=O+(rowbase+q0+wid*QBLK)*OP+h*D;
  { bf16*stg=(bf16*)(shm+LDS_OST)+wid*2048;
    #pragma unroll
    for(int r=0;r<16;++r){const int orow=crow(r,hi);
      #pragma unroll
      for(int d0=0;d0<2;++d0)stg[orow*64+d0*32+r32]=__float2bfloat16(o[d0][r]*rli[r]);}
    asm volatile("s_waitcnt lgkmcnt(0)":::"memory");
    #pragma unroll
    for(int i=0;i<4;++i){const int row=i*8+(lane>>3),ch=lane&7; const u32x4 v=*(const u32x4*)(stg+row*64+ch*8); ATTN_STORE16(Ow+(long)row*OP+ch*8,v);} }
  asm volatile("s_waitcnt lgkmcnt(0)\n\ts_barrier":::"memory");
  #undef DMA_K
  #undef DMA_V
  #undef CMASK
  #undef START
  #undef RESC
  #undef ROT
}
constexpr int ATTN_LDS_BYTES=LDS_BYTES;
struct AttnTensors { const bf16* Q; const bf16* K; const bf16* V; bf16* O; };
struct AttnUnit { int bh; int qb; };
struct StaticOrder {
  int vcu,G;
  __device__ __forceinline__ explicit StaticOrder(int grid,int v):vcu(v),G(grid){}
  __device__ __forceinline__ bool next(int i,AttnUnit&u)const{ const int L=i*G+vcu; if(L>=BATCH*NHEAD*NQB)return false;
    const int pairhalf=L>>5,l=L&31; const int pair=pairhalf>>1,uu=l+32*(pairhalf&1); const int b=pair>>1,kvh=pair&1; u.bh=b*NHEAD+kvh*(NHEAD/NKV)+(uu>>4); u.qb=uu&15; return true; }
  __device__ __forceinline__ void a_ready(const AttnUnit&)const{}
  __device__ __forceinline__ void done(const AttnUnit&)const{}
};
template<class Sched,int THRL=8> __device__ __forceinline__ void attn_phase(char*lds,const AttnTensors&T,const Sched&S){
  AttnUnit u;
  for(int i=0;S.next(i,u);++i){ S.a_ready(u); attn_unit<THRL>(u.bh/NHEAD,u.bh%NHEAD,u.qb,T.Q,T.K,T.V,T.O,lds); S.done(u); }
}
#undef SBAR
#undef WAIT_BAR
}
namespace cg = cooperative_groups;
constexpr int NWAVES = 8;
constexpr int BATCH = 8, SEQ = 4096, D = 1024, T = BATCH * SEQ;
constexpr int HD = 64, NQH = 8, NKVH = 2, QW = NQH * HD, KVW = NKVH * HD;
constexpr int LRU_W = 1024, LRU_NB = 16, LRU_BW = 64;
constexpr int INW = QW + 2 * KVW + 2 * LRU_W + 2 * D;
constexpr int NE = 32, TOPK = 4, DFF = 1024;
constexpr float NORM_EPS = 1e-6f;
constexpr int ARW = QW + LRU_W;
constexpr int ECAP = T;
constexpr int MAXBLK = (T * TOPK) / 256 + NE;
constexpr int MAX_GUNITS = 18;

constexpr size_t MiB = 1u << 20;
constexpr size_t WS_CTL = 0, CTL_ZERO_BYTES = 64 * 1024;
constexpr size_t WS_TOKL = 1 * MiB, WS_GATEL = 5 * MiB, WS_TOKREC = 9 * MiB;
constexpr size_t WS_WIN = 10 * MiB, WS_WCAT = 20 * MiB, WS_WO = 23 * MiB, WS_WGU = 26 * MiB, WS_WD = 154 * MiB;
constexpr size_t WS_XN = 218 * MiB;
constexpr size_t WS_Q = 282 * MiB, WS_KV = 314 * MiB, WS_AR = 330 * MiB, WS_XR = 426 * MiB, WS_YR = 490 * MiB, WS_GL = 554 * MiB;
constexpr size_t WS_MERGED = WS_XR;
constexpr size_t WS_ACT = 282 * MiB, WS_Y = 554 * MiB, WS_END = 826 * MiB;
static_assert(WS_ACT + (size_t)MAXBLK * 256 * DFF * 2 <= WS_Y && WS_Y + (size_t)MAXBLK * 256 * D * 2 <= WS_END, "ws map");
constexpr int CW_CNT = 0;
constexpr int CW_BAR = 1024;

constexpr int RING_BYTES = 131072;
constexpr int GTAB_OFF = RING_BYTES;
constexpr int ETAB_OFF = GTAB_OFF + MAX_GUNITS * 512;
constexpr int MISC_OFF = ETAB_OFF + MAX_GUNITS * 1024;
constexpr int LDS_BYTES = MISC_OFF + 2048;
static_assert(LDS_BYTES <= 163840, "LDS");

#define GAS __attribute__((address_space(1)))
#define LAS __attribute__((address_space(3)))
typedef unsigned short bf16;
typedef unsigned v4u __attribute__((ext_vector_type(4)));
typedef unsigned v2u __attribute__((ext_vector_type(2)));
typedef float f32x4 __attribute__((ext_vector_type(4)));
typedef float f32x2 __attribute__((ext_vector_type(2)));
typedef short bf16x8 __attribute__((ext_vector_type(8)));
#define LDS_WAIT() asm volatile("s_waitcnt lgkmcnt(0)" ::: "memory")
__device__ __forceinline__ unsigned f2bf(float f) { unsigned u = __builtin_bit_cast(unsigned, f); return (u + 0x7fffu + ((u >> 16) & 1u)) >> 16; }
__device__ __forceinline__ unsigned pk2(float lo, float hi) { unsigned r; asm("v_cvt_pk_bf16_f32 %0, %1, %2" : "=v"(r) : "v"(lo), "v"(hi)); return r; }
__device__ __forceinline__ float bflo(unsigned w) { return __uint_as_float(w << 16); }
__device__ __forceinline__ float bfhi(unsigned w) { return __uint_as_float(w & 0xffff0000u); }
__device__ __forceinline__ float wave_sum(float v) {
#pragma unroll
    for (int o = 1; o < 64; o <<= 1) v += __shfl_xor(v, o);
    return v;
}
__device__ __forceinline__ float sigmoidf_fast(float x) { return __builtin_amdgcn_rcpf(1.0f + __builtin_amdgcn_exp2f(-1.4426950408889634f * x)); }

constexpr float WSCALE = 32.0f, WSCALE_INV = 1.0f / 32.0f;
struct Frame {
    LAS unsigned char* lds;
    int tid, lane, wave, vcu, G;
    const float* const* in;
    float* out; unsigned char* ws;
};
enum { I_X = 0, I_N1G, I_WIN, I_BIN, I_QNG, I_KNG, I_CONVW, I_CONVB, I_WA, I_BA, I_WI, I_BI, I_LAM, I_WAO, I_WLO, I_WOUT, I_N2G, I_WR, I_BR, I_WGU, I_BGU, I_WDN, I_BDN, I_FG };

struct P0Item { const float* src; int N; unsigned char* dst; int ldtB; int fp8; };
__device__ __forceinline__ P0Item p0_decode(const Frame& F, int it) {
    constexpr int I_IN = 16 * (INW / 32), I_AO = 8 * 32, I_LO = 16 * 32, I_OUT = 16 * 32, I_GU1 = 16 * 64, I_DN1 = 16 * 32;
    unsigned char* ws = F.ws; P0Item d; int r = it;
    if (r < I_IN) { const int nblk = INW / 32, kb = r / nblk, nb = r % nblk; d.src = F.in[I_WIN] + (size_t)(64 * kb) * INW + 32 * nb; d.N = INW; d.dst = ws + WS_WIN + ((size_t)(32 * nb) * D + 64 * kb) * 2; d.ldtB = D * 2; d.fp8 = 0; return d; } r -= I_IN;
    if (r < I_AO) { const int kb = r / 32, nb = r % 32; d.src = F.in[I_WAO] + (size_t)(64 * kb) * D + 32 * nb; d.N = D; d.dst = ws + WS_WCAT + ((size_t)(32 * nb) * ARW + 64 * kb) * 2; d.ldtB = ARW * 2; d.fp8 = 0; return d; } r -= I_AO;
    if (r < I_LO) { const int kb = r / 32, nb = r % 32; d.src = F.in[I_WLO] + (size_t)(64 * kb) * D + 32 * nb; d.N = D; d.dst = ws + WS_WCAT + ((size_t)(32 * nb) * ARW + QW + 64 * kb) * 2; d.ldtB = ARW * 2; d.fp8 = 0; return d; } r -= I_LO;
    if (r < I_OUT) { const int kb = r / 32, nb = r % 32; d.src = F.in[I_WOUT] + (size_t)(64 * kb) * D + 32 * nb; d.N = D; d.dst = ws + WS_WO + ((size_t)(32 * nb) * D + 64 * kb) * 2; d.ldtB = D * 2; d.fp8 = 0; return d; } r -= I_OUT;
    if (r < NE * I_GU1) { const int e = r / I_GU1, q = r % I_GU1, kb = q / 64, nb = q % 64, n0 = 32 * nb;
        const int cc = n0 & 1023, isu = n0 >> 10, rowb = 256 * (cc >> 7) + 128 * isu + (cc & 127);
        d.src = F.in[I_WGU] + (size_t)e * D * 2 * DFF + (size_t)(64 * kb) * (2 * DFF) + n0; d.N = 2 * DFF; d.dst = ws + WS_WGU + (size_t)e * 2 * DFF * D + (size_t)rowb * D + 64 * kb; d.ldtB = D; d.fp8 = 1; return d; } r -= NE * I_GU1;
    { const int e = r / I_DN1, q = r % I_DN1, kb = q / 32, nb = q % 32;
        d.src = F.in[I_WDN] + (size_t)e * DFF * D + (size_t)(64 * kb) * D + 32 * nb; d.N = D; d.dst = ws + WS_WD + (size_t)e * D * DFF + (size_t)(32 * nb) * DFF + 64 * kb; d.ldtB = DFF; d.fp8 = 1; return d; }
}
__device__ __forceinline__ void p0_prologue(Frame& F) {
    LAS float* scr = (LAS float*)(F.lds + F.wave * 16384);
    const int gw = F.vcu * NWAVES + F.wave, NGW = F.G * NWAVES, lane = F.lane;
    unsigned char* ws = F.ws;
    constexpr int NITEMS = 16 * (INW / 32) + 8 * 32 + 16 * 32 + 16 * 32 + NE * 16 * 64 + NE * 16 * 32;
    float v[32];
    P0Item cur = p0_decode(F, gw < NITEMS ? gw : 0);
#define P0_LOAD(dst_, item_) do { const float* p_ = (item_).src + (size_t)(lane >> 5) * (item_).N + (lane & 31); const size_t st_ = (size_t)2 * (item_).N; _Pragma("unroll") for (int i_ = 0; i_ < 32; ++i_) dst_[i_] = p_[i_ * st_]; } while (0)
    if (gw < NITEMS) P0_LOAD(v, cur);
    for (int it = gw; it < NITEMS; it += NGW) {
        const int nit = it + NGW; const bool hn = nit < NITEMS;
        const P0Item nxt = p0_decode(F, hn ? nit : it);
        float vn[32];
        if (hn) P0_LOAD(vn, nxt);
#pragma unroll
        for (int i = 0; i < 32; ++i) scr[(2 * i + (lane >> 5)) * 33 + (lane & 31)] = v[i];
        LDS_WAIT(); asm volatile("" ::: "memory");
        const int c = lane & 7;
#pragma unroll
        for (int j = 0; j < 4; ++j) { const int n = (lane >> 3) + 8 * j; const LAS float* s = scr + (8 * c) * 33 + n;
            if (cur.fp8) { int lo = 0, hi = 0;
                lo = __builtin_amdgcn_cvt_pk_fp8_f32(s[0 * 33] * WSCALE, s[1 * 33] * WSCALE, lo, false); lo = __builtin_amdgcn_cvt_pk_fp8_f32(s[2 * 33] * WSCALE, s[3 * 33] * WSCALE, lo, true);
                hi = __builtin_amdgcn_cvt_pk_fp8_f32(s[4 * 33] * WSCALE, s[5 * 33] * WSCALE, hi, false); hi = __builtin_amdgcn_cvt_pk_fp8_f32(s[6 * 33] * WSCALE, s[7 * 33] * WSCALE, hi, true);
                *(GAS v2u*)(cur.dst + (size_t)n * cur.ldtB + 8 * c) = (v2u){(unsigned)lo, (unsigned)hi};
            } else { v4u o; o.x = pk2(s[0 * 33], s[1 * 33]); o.y = pk2(s[2 * 33], s[3 * 33]); o.z = pk2(s[4 * 33], s[5 * 33]); o.w = pk2(s[6 * 33], s[7 * 33]);
                *(GAS v4u*)(cur.dst + (size_t)n * cur.ldtB + 16 * c) = o; } }
        LDS_WAIT(); asm volatile("" ::: "memory");
        cur = nxt;
#pragma unroll
        for (int i = 0; i < 32; ++i) v[i] = vn[i];
    }
#undef P0_LOAD
    const GAS f32x4* gp = (const GAS f32x4*)F.in[I_N1G] + lane;
    f32x4 g[4];
#pragma unroll
    for (int j = 0; j < 4; ++j) g[j] = gp[64 * j];
    bf16* XN = (bf16*)(ws + WS_XN);
    for (int m = gw; m < T; m += 2 * NGW) {
        const int m2 = (m + NGW < T) ? m + NGW : m;
        const GAS f32x4* xr = (const GAS f32x4*)(F.in[I_X] + (size_t)m * D) + lane; const GAS f32x4* xr2 = (const GAS f32x4*)(F.in[I_X] + (size_t)m2 * D) + lane;
        f32x4 va[4], vb[4]; float sa = 0.f, sb = 0.f;
#pragma unroll
        for (int j = 0; j < 4; ++j) { va[j] = xr[64 * j]; vb[j] = xr2[64 * j]; }
#pragma unroll
        for (int j = 0; j < 4; ++j) { sa += (va[j].x * va[j].x + va[j].y * va[j].y) + (va[j].z * va[j].z + va[j].w * va[j].w); sb += (vb[j].x * vb[j].x + vb[j].y * vb[j].y) + (vb[j].z * vb[j].z + vb[j].w * vb[j].w); }
        const float ra = 1.0f / sqrtf(wave_sum(sa) * (1.f / D) + NORM_EPS), rb = 1.0f / sqrtf(wave_sum(sb) * (1.f / D) + NORM_EPS);
        GAS unsigned long long* oa = (GAS unsigned long long*)(XN + (size_t)m * D) + lane; GAS unsigned long long* ob = (GAS unsigned long long*)(XN + (size_t)m2 * D) + lane;
#pragma unroll
        for (int j = 0; j < 4; ++j) { const f32x4 ya = va[j] * ra * g[j], yb = vb[j] * rb * g[j];
            oa[64 * j] = (unsigned long long)pk2(ya.x, ya.y) | ((unsigned long long)pk2(ya.z, ya.w) << 32); ob[64 * j] = (unsigned long long)pk2(yb.x, yb.y) | ((unsigned long long)pk2(yb.z, yb.w) << 32); }
    }
}

#ifndef REP_MASK
#define REP_MASK 0
#endif
#ifndef PROBE_K2X
#define PROBE_K2X 0
#endif
struct DenseSched {
    const char* A; const char* B; int nM, nN, nt, G, c; size_t tstepA, tstepB; int rs;
    __device__ __forceinline__ bool next(int i, pg8::Unit& u) const { const long L = (long)(i >> rs) * G + c; if (L >= (long)nM * nN) return false; pg8::dense_tile((int)L, nM, nN, u.pm, u.pn); u.aux = 0; return true; }
    __device__ __forceinline__ const char* a_ptr(const pg8::Unit& u) const { return A + (size_t)u.pm * tstepA; }
    __device__ __forceinline__ const char* b_ptr(const pg8::Unit& u) const { return B + (size_t)u.pn * tstepB; }
    __device__ __forceinline__ int ntiles(const pg8::Unit&) const { return nt; }
};
struct MergeSched {
    const char* A; const char* B; int G, c;
    __device__ __forceinline__ bool next(int i, pg8::Unit& u) const { const long L = (long)(i >> (1 + ((REP_MASK >> 4) & 1))) * G + c; if (L >= 128 * 4) return false; pg8::dense_tile((int)L, 128, 4, u.pm, u.pn); u.aux = i & 1; return true; }
    __device__ __forceinline__ const char* a_ptr(const pg8::Unit& u) const { return A + (size_t)u.pm * (256 * ARW * 2) + (u.aux ? QW * 2 : 0); }
    __device__ __forceinline__ const char* b_ptr(const pg8::Unit& u) const { return B + (size_t)u.pn * (256 * ARW * 2) + (u.aux ? QW * 2 : 0); }
    __device__ __forceinline__ int ntiles(const pg8::Unit& u) const { return u.aux ? (LRU_W / 64) : (QW / 64); }
};
template <int NTN> struct MoeSched {
    const char* A; const char* B; const LAS int* nbp; int G, c; size_t estepB;
    __device__ __forceinline__ bool next(int i, pg8::Unit& u) const {
        const int NB = nbp[NE], U = NB * NTN; const long L = (long)(i >> ((NTN == 4) ? ((REP_MASK >> 8) & 1) : 0)) * G + c; if (L >= U) return false; const int seg_ = i & 1;
        int w = (int)L; { const int q = U / 8, r = U % 8, xcd = w % 8, off = w / 8; w = (xcd < r ? xcd * (q + 1) : r * (q + 1) + (xcd - r) * q) + off; }
        int e = 0;
        for (int k = 1; k < NE; ++k) e += (w >= nbp[k] * NTN) ? 1 : 0;
        const int b0 = nbp[e], nM = nbp[e + 1] - b0, wl = w - b0 * NTN;
        const int nig = 8 * NTN, gid = wl / nig, fm = gid * 8, gsz = (nM - fm) < 8 ? (nM - fm) : 8;
        const int rb = fm + ((wl % nig) % gsz); u.pn = (wl % nig) / gsz; u.pm = b0 + rb; u.aux = e | (rb << 8) | ((PROBE_K2X && NTN == 4) ? (seg_ << 30) : 0); return true;
    }
    __device__ __forceinline__ const char* a_ptr(const pg8::Unit& u) const { return A; }
    __device__ __forceinline__ const char* b_ptr(const pg8::Unit& u) const { return B + (size_t)(u.aux & 0xff) * estepB + (size_t)u.pn * (256 * D); }
    __device__ __forceinline__ int ntiles(const pg8::Unit&) const { return D / 128; }
};
struct MoeDownSched : MoeSched<4> {
    __device__ __forceinline__ const char* a_ptr(const pg8::Unit& u) const { return A + (size_t)u.pm * (256 * DFF); }
};

__device__ __forceinline__ float gelu_tanh_f(float y) { const float z = y * (0.7978845608028654f + 0.035677408136300125f * y * y); return y * __builtin_amdgcn_rcpf(1.0f + __builtin_amdgcn_exp2f(-2.0f * 1.4426950408889634f * z)); }
struct EpiInProj {
    static constexpr bool PERM = true;
    unsigned char* ws; const LAS float* etab;
    __device__ __forceinline__ bool keep(const pg8::Unit&) const { return false; }
    __device__ __forceinline__ void operator()(pg8::f32x4 (&acc)[2][2][4][2], const pg8::Unit& u, int wr, int wc, int fr, int fq) const {
        using namespace pg8;
        const int pn = u.pn; bf16_t* base; int ldc, colt;
        if (pn < 2) { base = (bf16_t*)(ws + WS_Q); ldc = QW; colt = pn * 256; }
        else if (pn == 2) { base = (bf16_t*)(ws + WS_KV); ldc = 2 * KVW; colt = 0; }
        else if (pn < 7) { base = (bf16_t*)(ws + WS_XR); ldc = LRU_W; colt = (pn - 3) * 256; }
        else if (pn < 11) { base = (bf16_t*)(ws + WS_YR); ldc = LRU_W; colt = (pn - 7) * 256; }
        else { base = (bf16_t*)(ws + WS_GL); ldc = 2 * D; colt = (pn - 11) * 256; }
        const int row0 = u.pm * BM + wr * 64 + fr, col0 = colt + wc * 32 + 8 * fq; const bool isyr = (pn >= 7 && pn < 11);
        const LAS float* bias = etab + u.ui * 256 + wc * 32 + 8 * fq;
        f32x4 bv[2][2];
#pragma unroll
        for (int bj = 0; bj < 2; ++bj)
#pragma unroll
            for (int n = 0; n < 2; ++n) bv[bj][n] = *(const LAS f32x4*)(bias + bj * HALF + 4 * n);
#pragma unroll
        for (int ai = 0; ai < 2; ++ai)
#pragma unroll
            for (int m = 0; m < 4; ++m) { bf16_t* rowp = base + (size_t)(row0 + ai * HALF + m * 16) * ldc + col0;
#pragma unroll
                for (int bj = 0; bj < 2; ++bj) { f32x4 v0 = acc[ai][bj][m][0] + bv[bj][0], v1 = acc[ai][bj][m][1] + bv[bj][1];
                    if (isyr) {
#pragma unroll
                        for (int j = 0; j < 4; ++j) { v0[j] = gelu_tanh_f(v0[j]); v1[j] = gelu_tanh_f(v1[j]); } }
                    u32x4 w; w.x = cvt_pk_bf16(v0[0], v0[1]); w.y = cvt_pk_bf16(v0[2], v0[3]); w.z = cvt_pk_bf16(v1[0], v1[1]); w.w = cvt_pk_bf16(v1[2], v1[3]);
                    *(u32x4*)(rowp + bj * HALF) = w; } }
    }
};
struct EpiMerge {
    static constexpr bool PERM = true;
    const bf16* GL; bf16* MG;
    __device__ __forceinline__ bool keep(const pg8::Unit& u) const { return u.aux == 0; }
    __device__ __forceinline__ void operator()(pg8::f32x4 (&acc)[2][2][4][2], const pg8::Unit& u, int wr, int wc, int fr, int fq) const {
        using namespace pg8;
        const int row0 = u.pm * BM + wr * 64 + fr, col0 = u.pn * BM + wc * 32 + 8 * fq;
        if (u.aux == 0) {
#pragma unroll
            for (int ai = 0; ai < 2; ++ai)
#pragma unroll
                for (int m = 0; m < 4; ++m) { const bf16* gp = GL + (size_t)(row0 + ai * HALF + m * 16) * (2 * D) + col0;
#pragma unroll
                    for (int bj = 0; bj < 2; ++bj) { const u32x4 ga = *(const u32x4*)(gp + bj * HALF), gr = *(const u32x4*)(gp + D + bj * HALF);
#pragma unroll
                        for (int q = 0; q < 4; ++q) { const float a0 = bf_lo(ga[q]), a1 = bf_hi(ga[q]), r0 = bf_lo(gr[q]), r1 = bf_hi(gr[q]);
                            const float f0 = (1.0f + __builtin_amdgcn_exp2f(-1.4426950408889634f * r0)) * __builtin_amdgcn_rcpf(1.0f + __builtin_amdgcn_exp2f(-1.4426950408889634f * a0));
                            const float f1 = (1.0f + __builtin_amdgcn_exp2f(-1.4426950408889634f * r1)) * __builtin_amdgcn_rcpf(1.0f + __builtin_amdgcn_exp2f(-1.4426950408889634f * a1));
                            acc[ai][bj][m][q >> 1][(q & 1) * 2] *= f0; acc[ai][bj][m][q >> 1][(q & 1) * 2 + 1] *= f1; } } }
        } else {
#pragma unroll
            for (int ai = 0; ai < 2; ++ai)
#pragma unroll
                for (int m = 0; m < 4; ++m) { const size_t ro = (size_t)(row0 + ai * HALF + m * 16); const bf16* gp = GL + ro * (2 * D) + D + col0; bf16* op = MG + ro * D + col0;
#pragma unroll
                    for (int bj = 0; bj < 2; ++bj) { const u32x4 gr = *(const u32x4*)(gp + bj * HALF); u32x4 w;
#pragma unroll
                        for (int q = 0; q < 4; ++q) { const float s0 = fast_sigmoid(bf_lo(gr[q])), s1 = fast_sigmoid(bf_hi(gr[q]));
                            w[q] = cvt_pk_bf16(acc[ai][bj][m][q >> 1][(q & 1) * 2] * s0, acc[ai][bj][m][q >> 1][(q & 1) * 2 + 1] * s1); }
                        *(u32x4*)(op + bj * HALF) = w; } }
        }
    }
};
struct EpiResF32 {
    static constexpr bool PERM = false;
    const float* X; float* O;
    __device__ __forceinline__ bool keep(const pg8::Unit&) const { return false; }
    __device__ __forceinline__ void operator()(pg8::f32x4 (&acc)[2][2][4][2], const pg8::Unit& u, int wr, int wc, int fr, int fq) const {
        using namespace pg8;
        const int row0 = u.pm * BM + wr * 64 + fr, col0 = u.pn * BM + wc * 32 + 4 * fq;
#pragma unroll
        for (int ai = 0; ai < 2; ++ai)
#pragma unroll
            for (int m = 0; m < 4; ++m) { const size_t off = (size_t)(row0 + ai * HALF + m * 16) * D + col0;
#pragma unroll
                for (int bj = 0; bj < 2; ++bj)
#pragma unroll
                    for (int n = 0; n < 2; ++n) *(f32x4*)(O + off + bj * HALF + n * 16) = *(const f32x4*)(X + off + bj * HALF + n * 16) + acc[ai][bj][m][n]; }
    }
};
struct EpiSwiGLU {
    static constexpr bool PERM = true;
    const LAS float* etab; unsigned char* ACT;
    __device__ __forceinline__ bool keep(const pg8::Unit&) const { return false; }
    __device__ __forceinline__ void operator()(pg8::f32x4 (&acc)[2][2][4][2], const pg8::Unit& u, int wr, int wc, int fr, int fq) const {
        using namespace pg8;
        const int cl = wc * 32 + 8 * fq, col0 = u.pn * 128 + cl, row0 = u.pm * BM + wr * 64 + fr;
        const LAS float* bp = etab + u.ui * 256 + cl;
        const f32x4 bg0 = *(const LAS f32x4*)(bp), bg1 = *(const LAS f32x4*)(bp + 4), bu0 = *(const LAS f32x4*)(bp + 128), bu1 = *(const LAS f32x4*)(bp + 132);
#pragma unroll
        for (int ai = 0; ai < 2; ++ai)
#pragma unroll
            for (int m = 0; m < 4; ++m) { u32x2 w;
#pragma unroll
                for (int n = 0; n < 2; ++n) { const f32x4 g = acc[ai][0][m][n] * WSCALE_INV + (n ? bg1 : bg0), uu = acc[ai][1][m][n] * WSCALE_INV + (n ? bu1 : bu0); float a[4];
#pragma unroll
                    for (int j = 0; j < 4; ++j) { const float gg = fminf(g[j], 7.0f), uc = fminf(fmaxf(uu[j], -7.0f), 7.0f);
                        a[j] = gg * __builtin_amdgcn_rcpf(1.0f + __builtin_amdgcn_exp2f(-1.702f * 1.4426950408889634f * gg)) * (uc + 1.0f); }
                    int pk = 0; pk = __builtin_amdgcn_cvt_pk_fp8_f32(a[0], a[1], pk, false); pk = __builtin_amdgcn_cvt_pk_fp8_f32(a[2], a[3], pk, true); w[n] = (unsigned)pk; }
                *(u32x2*)(ACT + (size_t)(row0 + ai * HALF + m * 16) * DFF + col0) = w; }
    }
};
struct EpiDown {
    static constexpr bool PERM = true;
    const LAS float* etab; const LAS float* gtab2; bf16* Y;
    __device__ __forceinline__ bool keep(const pg8::Unit& u) const { return PROBE_K2X && ((u.aux >> 30) & 1) == 0; }
    __device__ __forceinline__ void operator()(pg8::f32x4 (&acc)[2][2][4][2], const pg8::Unit& u, int wr, int wc, int fr, int fq) const {
        using namespace pg8;
        if (PROBE_K2X && ((u.aux >> 30) & 1) == 0) return;
        const int tui = PROBE_K2X ? (u.ui >> 1) : u.ui; const float ksc = PROBE_K2X ? 0.5f * WSCALE_INV : WSCALE_INV;
        const int col0 = u.pn * BM + wc * 32 + 8 * fq, rl0 = wr * 64 + fr;
        const LAS float* bias = etab + tui * 256 + wc * 32 + 8 * fq;
        f32x4 bv[2][2];
#pragma unroll
        for (int bj = 0; bj < 2; ++bj)
#pragma unroll
            for (int n = 0; n < 2; ++n) bv[bj][n] = *(const LAS f32x4*)(bias + bj * HALF + 4 * n);
        const LAS float* gl = gtab2 + tui * 256;
#pragma unroll
        for (int ai = 0; ai < 2; ++ai)
#pragma unroll
            for (int m = 0; m < 4; ++m) { const int rl = rl0 + ai * HALF + m * 16; const float gt = gl[rl]; bf16* rowp = Y + (size_t)(u.pm * BM + rl) * D + col0;
#pragma unroll
                for (int bj = 0; bj < 2; ++bj) { const f32x4 v0 = (acc[ai][bj][m][0] * ksc + bv[bj][0]) * gt, v1 = (acc[ai][bj][m][1] * ksc + bv[bj][1]) * gt;
                    u32x4 w; w.x = cvt_pk_bf16(v0[0], v0[1]); w.y = cvt_pk_bf16(v0[2], v0[3]); w.z = cvt_pk_bf16(v1[0], v1[1]); w.w = cvt_pk_bf16(v1[2], v1[3]);
                    *(u32x4*)(rowp + bj * HALF) = w; } }
    }
};

__device__ __forceinline__ v4u fix_vals(const v4u raw, const float* g8, float scale, int c, int prow, int pcol, const LAS f32x2* tab) {
    float v[8];
#pragma unroll
    for (int q = 0; q < 4; ++q) { v[2 * q] = bflo(raw[q]); v[2 * q + 1] = bfhi(raw[q]); }
    float ss = 0.f;
#pragma unroll
    for (int j = 0; j < 8; ++j) ss += v[j] * v[j];
    ss += __shfl_xor(ss, 1); ss += __shfl_xor(ss, 2); ss += __shfl_xor(ss, 4);
    const float rstd = 1.0f / sqrtf(ss * (1.0f / HD) + NORM_EPS);
    const int pos = (c >> 2) ? pcol : prow; const bool second = (c >> 1) & 1; const int f0 = (c & 1) * 8;
    float o[8];
#pragma unroll
    for (int j = 0; j < 8; ++j) { const float y = v[j] * rstd * g8[j]; const float pr = __shfl_xor(y, 2); const f32x2 cs = tab[pos * 16 + f0 + j];
        o[j] = (second ? (y * cs.x + pr * cs.y) : (y * cs.x - pr * cs.y)) * scale; }
    v4u w; w.x = pk2(o[0], o[1]); w.y = pk2(o[2], o[3]); w.z = pk2(o[4], o[5]); w.w = pk2(o[6], o[7]);
    return w;
}
__device__ __forceinline__ void p2_fixup(Frame& F) {
    LAS f32x2* tab = (LAS f32x2*)(F.lds);
    for (int idx = F.tid; idx < 1024; idx += NWAVES * 64) { const int pos = idx >> 4, f = idx & 15; const float inv = powf(10000.0f, -(float)f / 16.0f); const float ang = (float)pos * inv;
        tab[idx] = (f32x2){cosf(ang), sinf(ang)}; }
    __syncthreads();
    const int gw = F.vcu * NWAVES + F.wave, NGW = F.G * NWAVES, c = F.lane & 7;
    float gq[8], gk[8];
#pragma unroll
    for (int j = 0; j < 8; ++j) { gq[j] = F.in[I_QNG][8 * c + j]; gk[j] = F.in[I_KNG][8 * c + j]; }
    bf16* Q = (bf16*)(F.ws + WS_Q); bf16* KV = (bf16*)(F.ws + WS_KV);
    for (int t0 = gw; t0 < T; t0 += 4 * NGW) {
        v4u rq[4], rk[4]; int tt[4];
#pragma unroll
        for (int i = 0; i < 4; ++i) { const int t = t0 + i * NGW; tt[i] = t < T ? t : t0;
            rq[i] = *(const GAS v4u*)(Q + (size_t)tt[i] * QW + F.lane * 8); rk[i] = *(const GAS v4u*)(KV + (size_t)tt[i] * (2 * KVW) + (F.lane & 15) * 8); }
#pragma unroll
        for (int i = 0; i < 4; ++i) { const int t = tt[i], s = t & (SEQ - 1), prow = s >> 6, pcol = s & 63;
            const v4u wq = fix_vals(rq[i], gq, attn_body::C2, c, prow, pcol, tab);
            const v4u wk = fix_vals(rk[i], gk, 1.0f, c, prow, pcol, tab);
            if (t0 + i * NGW < T) { *(GAS v4u*)(Q + (size_t)t * QW + F.lane * 8) = wq; if (F.lane < 16) *(GAS v4u*)(KV + (size_t)t * (2 * KVW) + F.lane * 8) = wk; } }
    }
    __syncthreads();
}
constexpr int LRU_CH = 256;
constexpr int LRU_XC_STRIDE = 144;
constexpr int LRU_BUF = LRU_CH * LRU_XC_STRIDE;
constexpr int LRU_WT = 4 * LRU_BUF;
static_assert(LRU_BUF >= 256 * 33 * 4 && LRU_WT + 2048 + 5 * 64 * 4 <= MISC_OFF, "lru lds");

__device__ __forceinline__ float gelu_tanh(float y) { const float z = 0.7978845608028654f * (y + 0.044715f * y * y * y); return y * sigmoidf_fast(2.0f * z); }

#ifndef LRU_DUP
#define LRU_DUP 0
#endif
template <int DIR> __device__ __forceinline__ void lru_dir(Frame& F, int b, int n, int half) {
    LAS unsigned char* lds = F.lds;
    int tid_ = F.tid; asm volatile("" : "+v"(tid_));
    unsigned char* ws_ = F.ws; asm volatile("" : "+s"(ws_));
    const int tid = tid_, lane = tid & 63, wave = __builtin_amdgcn_readfirstlane(tid >> 6);
    constexpr int g = DIR; const int w = wave & 3, tl = tid & 255;
#define PHY(p_) (DIR ? 255 - (p_) : (p_))
    const int ch16 = lane & 15, q = lane >> 4, ct = w & 1, th = w >> 1;
    const int cl = 16 * ct + ch16, co_l = 32 * half + cl, cgl = 64 * n + co_l;
    constexpr float NL2E = -1.4426950408889634f;
    bf16x8 Ba[2], Bi[2], Bid;
    { const float* wa = F.in[I_WA] + ((size_t)(g * LRU_NB + n) * 64) * 64 + co_l; const float* wi = F.in[I_WI] + ((size_t)(g * LRU_NB + n) * 64) * 64 + co_l;
#pragma unroll
      for (int ks = 0; ks < 2; ++ks)
#pragma unroll
          for (int j = 0; j < 8; ++j) { const int k = 32 * ks + 8 * q + j; Ba[ks][j] = (short)f2bf(NL2E * wa[(size_t)k * 64]); Bi[ks][j] = (short)f2bf(NL2E * wi[(size_t)k * 64]); }
#pragma unroll
      for (int j = 0; j < 8; ++j) Bid[j] = (short)((8 * q + j == 16 * ct + ch16) ? 0x3F80 : 0); }
    const float ba = NL2E * F.in[I_BA][(g * LRU_NB + n) * 64 + co_l], bi = NL2E * F.in[I_BI][(g * LRU_NB + n) * 64 + co_l];
    const float lam = F.in[I_LAM][g * LRU_W + cgl];
    const float clam = -8.0f * log1pf(expf(-lam)) * 1.4426950408889634f;
    const int c8 = tl & 7, tg = tl >> 3;
    LAS float* cwl = (LAS float*)(lds + LRU_WT + 2048);
    for (int i = tid; i < 5 * 64; i += NWAVES * 64) { const int j = i >> 6, c = i & 63; cwl[i] = (j < 4) ? F.in[I_CONVW][j * LRU_W + 64 * n + c] : F.in[I_CONVB][64 * n + c]; }
    __syncthreads();
    const bf16* XR = (const bf16*)(ws_ + WS_XR) + (size_t)b * SEQ * LRU_W + 64 * n + 8 * c8;
    const bf16* YR = (const bf16*)(ws_ + WS_YR) + (size_t)b * SEQ * LRU_W + 64 * n + 32 * half;
    bf16* AR = (bf16*)(ws_ + WS_AR) + (size_t)b * SEQ * ARW + QW + 64 * n + 32 * half;
    constexpr int NST = SEQ / LRU_CH;
    v4u xrp[11];
#define LRU_LOADX(pc_) do { const int s0_ = (pc_) * LRU_CH + 8 * tg - 1; _Pragma("unroll") for (int i_ = 0; i_ < 11; ++i_) { const int s_ = s0_ + i_; \
        const int sc_ = s_ < 0 ? 0 : (s_ >= SEQ ? SEQ - 1 : s_); const v4u t_ = *(const GAS v4u*)(XR + (size_t)sc_ * LRU_W); const unsigned m_ = (s_ >= 0 && s_ < SEQ) ? 0xffffffffu : 0u; \
        xrp[i_] = (v4u){t_.x & m_, t_.y & m_, t_.z & m_, t_.w & m_}; } } while (0)
    LRU_LOADX(g ? NST - 1 : 0);
    float hcarry = 0.f;
    for (int k = 0; k < NST; ++k) {
        const int pc = g ? (NST - 1 - k) : k, par = k & 1;
        LAS unsigned char* buf = lds + (g * 2 + par) * LRU_BUF;
        unsigned aA = (unsigned)((DIR ? (255 - 128 * th - ch16 - 112) : (128 * th + ch16)) * LRU_XC_STRIDE + q * 16);
        unsigned aX = (unsigned)((DIR ? (255 - 128 * th - 4 * q - 115) : (128 * th + 4 * q)) * LRU_XC_STRIDE + co_l * 2);
        unsigned aH = (unsigned)(((DIR ? (255 - 128 * th - 4 * q - 115) : (128 * th + 4 * q)) * 33 + cl) * 4);
        asm volatile("" : "+v"(aA), "+v"(aX), "+v"(aH));
#define OFS(c_, m_) (DIR ? ((m_) - (c_)) : (c_))
#pragma unroll 1
        for (int dup_ = 0; dup_ < 1 + (LRU_DUP & 1); ++dup_) { asm volatile("" : "+v"(xrp[0].x));
        { f32x2 cw[4][4], cb[4];
#pragma unroll
          for (int j = 0; j < 4; ++j) { const f32x4 c0 = *(const LAS f32x4*)(cwl + j * 64 + 8 * c8), c1 = *(const LAS f32x4*)(cwl + j * 64 + 8 * c8 + 4);
              cw[j][0] = (f32x2){c0.x, c0.y}; cw[j][1] = (f32x2){c0.z, c0.w}; cw[j][2] = (f32x2){c1.x, c1.y}; cw[j][3] = (f32x2){c1.z, c1.w}; }
          { const f32x4 c0 = *(const LAS f32x4*)(cwl + 256 + 8 * c8), c1 = *(const LAS f32x4*)(cwl + 256 + 8 * c8 + 4); cb[0] = (f32x2){c0.x, c0.y}; cb[1] = (f32x2){c0.z, c0.w}; cb[2] = (f32x2){c1.x, c1.y}; cb[3] = (f32x2){c1.z, c1.w}; }
#pragma unroll
          for (int tt = 0; tt < 8; ++tt) { f32x2 o[4];
#pragma unroll
            for (int i = 0; i < 4; ++i) o[i] = cb[i];
#pragma unroll
            for (int j = 0; j < 4; ++j) { const v4u raw = xrp[tt + j];
#pragma unroll
                for (int qq = 0; qq < 4; ++qq) { const f32x2 xv = (f32x2){bflo(raw[qq]), bfhi(raw[qq])}; o[qq] = __builtin_elementwise_fma(cw[j][qq], xv, o[qq]); } }
            v4u wv; wv.x = pk2(o[0].x, o[0].y); wv.y = pk2(o[1].x, o[1].y); wv.z = pk2(o[2].x, o[2].y); wv.w = pk2(o[3].x, o[3].y);
            *(LAS v4u*)(buf + (8 * tg + tt) * LRU_XC_STRIDE + c8 * 16) = wv; } } }
        if (k + 1 < NST) LRU_LOADX(g ? (NST - 2 - k) : (k + 1));
        const size_t trow = (size_t)pc * LRU_CH + tl;
        if (k == NST / 2) asm volatile("s_waitcnt vmcnt(0)" ::: "memory");
        __syncthreads();
        float Aloc[8][4], Hloc[8][4]; float AR_ = 1.f, HR_ = 0.f;
#pragma unroll 1
        for (int dup_ = 0; dup_ < 1 + ((LRU_DUP >> 1) & 1); ++dup_) { asm volatile("" : "+v"(aA), "+v"(aX));
#pragma unroll
        for (int rt = 0; rt < 8; ++rt) {
            const bf16x8 a0 = *(const LAS bf16x8*)(buf + aA + OFS(16 * rt, 112) * LRU_XC_STRIDE), a1 = *(const LAS bf16x8*)(buf + aA + OFS(16 * rt, 112) * LRU_XC_STRIDE + 64);
            f32x4 Da = (f32x4){ba, ba, ba, ba}, Di = (f32x4){bi, bi, bi, bi}, Dx = (f32x4){0.f, 0.f, 0.f, 0.f};
            Da = __builtin_amdgcn_mfma_f32_16x16x32_bf16(a0, Ba[0], Da, 0, 0, 0); Da = __builtin_amdgcn_mfma_f32_16x16x32_bf16(a1, Ba[1], Da, 0, 0, 0);
            Di = __builtin_amdgcn_mfma_f32_16x16x32_bf16(a0, Bi[0], Di, 0, 0, 0); Di = __builtin_amdgcn_mfma_f32_16x16x32_bf16(a1, Bi[1], Di, 0, 0, 0);
            Dx = __builtin_amdgcn_mfma_f32_16x16x32_bf16(half ? a1 : a0, Bid, Dx, 0, 0, 0);
#pragma unroll
            for (int j = 0; j < 4; ++j) {
                const float r = __builtin_amdgcn_rcpf(1.0f + __builtin_amdgcn_exp2f(Da[j])), ig = __builtin_amdgcn_rcpf(1.0f + __builtin_amdgcn_exp2f(Di[j]));
                const float a = __builtin_amdgcn_exp2f(clam * r);
                Aloc[rt][j] = a; Hloc[rt][j] = __builtin_amdgcn_sqrtf(__builtin_fmaf(-a, a, 1.0f)) * (ig * Dx[j]); }
        }
        float Ai[8], Hi[8], Ae[8], He[8];
#pragma unroll
        for (int rt = 0; rt < 8; ++rt) {
#pragma unroll
            for (int j = 1; j < 4; ++j) { Hloc[rt][j] = Aloc[rt][j] * Hloc[rt][j - 1] + Hloc[rt][j]; Aloc[rt][j] = Aloc[rt][j - 1] * Aloc[rt][j]; }
            Ai[rt] = Aloc[rt][3]; Hi[rt] = Hloc[rt][3]; }
#pragma unroll
        for (int rt = 0; rt < 8; ++rt) { const float An = __shfl(Ai[rt], (lane - 16) & 63), Hn = __shfl(Hi[rt], (lane - 16) & 63); if (q >= 1) { Hi[rt] = Ai[rt] * Hn + Hi[rt]; Ai[rt] = An * Ai[rt]; } }
#pragma unroll
        for (int rt = 0; rt < 8; ++rt) { const float An = __shfl(Ai[rt], (lane - 32) & 63), Hn = __shfl(Hi[rt], (lane - 32) & 63); if (q >= 2) { Hi[rt] = Ai[rt] * Hn + Hi[rt]; Ai[rt] = An * Ai[rt]; } }
#pragma unroll
        for (int rt = 0; rt < 8; ++rt) { Ae[rt] = __shfl(Ai[rt], (lane - 16) & 63); He[rt] = __shfl(Hi[rt], (lane - 16) & 63); if (q == 0) { Ae[rt] = 1.f; He[rt] = 0.f; }
            Ai[rt] = __shfl(Ai[rt], ch16 + 48); Hi[rt] = __shfl(Hi[rt], ch16 + 48); }
        AR_ = 1.f; HR_ = 0.f;
#pragma unroll
        for (int rt = 0; rt < 8; ++rt) {
            const float Ap = AR_ * Ae[rt], Hp = Ae[rt] * HR_ + He[rt];
#pragma unroll
            for (int j = 0; j < 4; ++j) { Hloc[rt][j] = Aloc[rt][j] * Hp + Hloc[rt][j]; Aloc[rt][j] = Ap * Aloc[rt][j]; }
            HR_ = Ai[rt] * HR_ + Hi[rt]; AR_ = AR_ * Ai[rt]; }
        }
        LAS f32x2* WT = (LAS f32x2*)(lds + LRU_WT) + (g * 2 + par) * 64;
        if (q == 0) WT[th * 32 + cl] = (f32x2){AR_, HR_};
        __syncthreads();
        v4u yv[4], ov[4];
        if (k >= NST / 2) {
#pragma unroll
            for (int i = 0; i < 4; ++i) { yv[i] = *((const GAS v4u*)(YR + trow * LRU_W) + i); ov[i] = *((const GAS v4u*)(AR + trow * ARW) + i); } }
        const f32x2 w0 = WT[cl], w1 = WT[32 + cl];
        const float hmid = w0.x * hcarry + w0.y;
        const float hin = th ? hmid : hcarry;
        hcarry = w1.x * hmid + w1.y;
        LAS float* HS = (LAS float*)buf;
#pragma unroll
        for (int rt = 0; rt < 8; ++rt)
#pragma unroll
            for (int j = 0; j < 4; ++j) *(LAS float*)(buf + aH + OFS(16 * rt + j, 115) * 132) = Hloc[rt][j] + Aloc[rt][j] * hin;
        __syncthreads();
#pragma unroll 1
        for (int dup_ = 0; dup_ < 1 + ((LRU_DUP >> 2) & 1); ++dup_) { asm volatile("" : "+v"(yv[0].x));
          float hv[32];
#pragma unroll
          for (int i = 0; i < 32; ++i) hv[i] = HS[tl * 33 + i];
          v4u wv[4];
          if (k < NST / 2) {
#pragma unroll
              for (int i = 0; i < 4; ++i) { wv[i].x = pk2(hv[8 * i], hv[8 * i + 1]); wv[i].y = pk2(hv[8 * i + 2], hv[8 * i + 3]); wv[i].z = pk2(hv[8 * i + 4], hv[8 * i + 5]); wv[i].w = pk2(hv[8 * i + 6], hv[8 * i + 7]); }
          } else {
#pragma unroll
              for (int i = 0; i < 4; ++i)
#pragma unroll
                  for (int qq = 0; qq < 4; ++qq) wv[i][qq] = pk2((hv[8 * i + 2 * qq] + bflo(ov[i][qq])) * bflo(yv[i][qq]), (hv[8 * i + 2 * qq + 1] + bfhi(ov[i][qq])) * bfhi(yv[i][qq]));
          }
          GAS v4u* op = (GAS v4u*)(AR + trow * ARW);
#pragma unroll
          for (int i = 0; i < 4; ++i) op[i] = wv[i]; }
    }
#undef LRU_LOADX
#undef PHY
#undef OFS
    __syncthreads();
}
__device__ __forceinline__ void p2_lru(Frame& F) {
    for (int it = F.vcu; it < BATCH * LRU_NB * 2; it += F.G) { if (F.wave < 4) lru_dir<0>(F, it >> 5, (it & 31) >> 1, it & 1); else lru_dir<1>(F, it >> 5, (it & 31) >> 1, it & 1); }
}

constexpr int RT_STRIDE = 1028;
constexpr int ROWINFO_OFF = GTAB_OFF + 1024;
__device__ __forceinline__ void p6_router(Frame& F, const bool dry) {
    LAS float* wT = (LAS float*)F.lds;
    LAS unsigned* misc = (LAS unsigned*)(F.lds + MISC_OFF);
    LAS unsigned* hist = misc + 128; LAS unsigned* basew = misc + 160;
    LAS v2u* rowinfo = (LAS v2u*)(F.lds + ROWINFO_OFF);
    const int tid = F.tid, lane = F.lane, wave = F.wave;
    for (int idx = tid; idx < D * NE; idx += NWAVES * 64) { const int k = idx >> 5, e = idx & 31; wT[e * RT_STRIDE + k] = F.in[I_WR][idx]; }
    if (tid < 32) hist[tid] = 0u;
    f32x4 g2[4];
#pragma unroll
    for (int j = 0; j < 4; ++j) g2[j] = *((const GAS f32x4*)F.in[I_N2G] + lane + 64 * j);
    const float brl = F.in[I_BR][lane >> 1];
    __syncthreads();
    unsigned char* H2 = (unsigned char*)(F.ws + WS_XN);
    unsigned* gcnt = (unsigned*)(F.ws + WS_CTL) + CW_CNT;
    int* TOKL = (int*)(F.ws + WS_TOKL); float* GATEL = (float*)(F.ws + WS_GATEL); int* TOKREC = (int*)(F.ws + WS_TOKREC);
    for (int bi = F.vcu; bi < T / 128; bi += F.G) {
        const int rbase = bi * 128;
        for (int p = 0; p < 8; ++p) {
            const int rl0 = 16 * wave + 2 * p; const size_t r0 = (size_t)rbase + rl0;
            f32x4 h0[4], h1[4];
            { const GAS f32x4* x0 = (const GAS f32x4*)(F.out + r0 * D) + lane; const GAS f32x4* x1 = (const GAS f32x4*)(F.out + (r0 + 1) * D) + lane;
              float s0 = 0.f, s1 = 0.f;
#pragma unroll
              for (int j = 0; j < 4; ++j) { h0[j] = x0[64 * j]; h1[j] = x1[64 * j];
                  s0 += (h0[j].x * h0[j].x + h0[j].y * h0[j].y) + (h0[j].z * h0[j].z + h0[j].w * h0[j].w); s1 += (h1[j].x * h1[j].x + h1[j].y * h1[j].y) + (h1[j].z * h1[j].z + h1[j].w * h1[j].w); }
              const float rs0 = 1.0f / sqrtf(wave_sum(s0) * (1.f / D) + NORM_EPS), rs1 = 1.0f / sqrtf(wave_sum(s1) * (1.f / D) + NORM_EPS);
              GAS unsigned* o0 = (GAS unsigned*)(H2 + r0 * D) + lane; GAS unsigned* o1 = (GAS unsigned*)(H2 + (r0 + 1) * D) + lane;
#pragma unroll
              for (int j = 0; j < 4; ++j) { h0[j] = h0[j] * rs0 * g2[j]; h1[j] = h1[j] * rs1 * g2[j];
                  int p0 = 0, p1 = 0; p0 = __builtin_amdgcn_cvt_pk_fp8_f32(h0[j].x, h0[j].y, p0, false); p0 = __builtin_amdgcn_cvt_pk_fp8_f32(h0[j].z, h0[j].w, p0, true);
                  p1 = __builtin_amdgcn_cvt_pk_fp8_f32(h1[j].x, h1[j].y, p1, false); p1 = __builtin_amdgcn_cvt_pk_fp8_f32(h1[j].z, h1[j].w, p1, true);
                  o0[64 * j] = (unsigned)p0; o1[64 * j] = (unsigned)p1; } }
            float a0[32], a1[32];
#pragma unroll
            for (int e = 0; e < 32; ++e) { float s0 = 0.f, s1 = 0.f;
#pragma unroll
                for (int j = 0; j < 4; ++j) { const f32x4 w = *(const LAS f32x4*)(wT + e * RT_STRIDE + 256 * j + 4 * lane);
                    s0 += (h0[j].x * w.x + h0[j].y * w.y) + (h0[j].z * w.z + h0[j].w * w.w); s1 += (h1[j].x * w.x + h1[j].y * w.y) + (h1[j].z * w.z + h1[j].w * w.w); }
                a0[e] = s0; a1[e] = s1; }
#define TRED(arr, N, MASK) _Pragma("unroll") for (int i = 0; i < (N); ++i) { const bool up = (lane & (MASK)) != 0; const float snd = up ? arr[i] : arr[i + (N)]; const float kp = up ? arr[i + (N)] : arr[i]; arr[i] = kp + __shfl_xor(snd, (MASK)); }
            TRED(a0, 16, 32) TRED(a0, 8, 16) TRED(a0, 4, 8) TRED(a0, 2, 4) TRED(a0, 1, 2)
            TRED(a1, 16, 32) TRED(a1, 8, 16) TRED(a1, 4, 8) TRED(a1, 2, 4) TRED(a1, 1, 2)
#undef TRED
            float lg[2]; lg[0] = a0[0] + __shfl_xor(a0[0], 1) + brl; lg[1] = a1[0] + __shfl_xor(a1[0], 1) + brl;
#pragma unroll
            for (int rr2 = 0; rr2 < 2; ++rr2) {
                float val = lg[rr2]; int te[4]; float tv[4];
#pragma unroll
                for (int k = 0; k < 4; ++k) { float m = val;
#pragma unroll
                    for (int o = 1; o < 64; o <<= 1) m = fmaxf(m, __shfl_xor(m, o));
                    const unsigned long long bal = __ballot(val == m); const int src = __builtin_ctzll(bal); te[k] = src >> 1; tv[k] = m; if ((lane >> 1) == te[k]) val = -INFINITY; }
                const float p1 = __expf(tv[1] - tv[0]), p2 = __expf(tv[2] - tv[0]), p3 = __expf(tv[3] - tv[0]); const float inv = 1.0f / (1.0f + p1 + p2 + p3);
                if (lane < 4) { const int e = lane == 0 ? te[0] : lane == 1 ? te[1] : lane == 2 ? te[2] : te[3]; const float gt = (lane == 0 ? 1.0f : lane == 1 ? p1 : lane == 2 ? p2 : p3) * inv;
                    const unsigned rank = atomicAdd((unsigned*)(hist + e), 1u);
                    rowinfo[(rl0 + rr2) * 4 + lane] = (v2u){(unsigned)e | (rank << 8), __float_as_uint(gt)}; }
            }
        }
        __syncthreads();
        if (tid < 32) basew[tid] = dry ? 0u : __hip_atomic_fetch_add(gcnt + tid, hist[tid], __ATOMIC_RELAXED, __HIP_MEMORY_SCOPE_AGENT);
        __syncthreads();
        { const int rl = tid >> 2, k = tid & 3; const v2u inf = rowinfo[rl * 4 + k]; const int e = inf.x & 0xff; const unsigned slot = basew[e] + (inf.x >> 8); const int t = rbase + rl;
          if (!dry) { TOKL[(size_t)e * ECAP + slot] = t; GATEL[(size_t)e * ECAP + slot] = __uint_as_float(inf.y); TOKREC[t * 4 + k] = (int)(((unsigned)e << 20) | slot); } }
        __syncthreads();
        if (tid < 32) hist[tid] = 0u;
        __syncthreads();
    }
}

__device__ __forceinline__ void moe_tables(Frame& F) {
    LAS int* misc = (LAS int*)(F.lds + MISC_OFF);
    const unsigned* gcnt = (const unsigned*)(F.ws + WS_CTL) + CW_CNT;
    if (F.tid < 32) misc[F.tid] = (int)__hip_atomic_load(gcnt + F.tid, __ATOMIC_RELAXED, __HIP_MEMORY_SCOPE_AGENT);
    __syncthreads();
    if (F.tid == 0) { int s = 0; for (int e = 0; e < NE; ++e) { misc[32 + e] = s; s += (misc[e] + 255) >> 8; } misc[32 + NE] = s; }
    __syncthreads();
}
constexpr int UDESC_WORD = 208;
template <class Sched> __device__ __forceinline__ int resolve_units(Frame& F, const Sched& S, int maxu, int stride) {
    LAS int* misc = (LAS int*)(F.lds + MISC_OFF);
    if (F.tid == 0) misc[UDESC_WORD - 1] = 0;
    __syncthreads();
    pg8::Unit u;
    for (int ui = F.wave; ui < maxu; ui += NWAVES) { if (!S.next(ui * stride, u)) break;
        if (F.lane == 0) { misc[UDESC_WORD + 3 * ui] = u.aux; misc[UDESC_WORD + 3 * ui + 1] = u.pn; misc[UDESC_WORD + 3 * ui + 2] = u.pm; atomicMax((int*)(misc + UDESC_WORD - 1), ui + 1); } }
    __syncthreads();
    return misc[UDESC_WORD - 1];
}
template <class Base> struct TabSched : Base {
    const LAS int* desc; int nu;
    __device__ __forceinline__ TabSched(const Base& b, const LAS int* d, int n) : Base(b), desc(d), nu(n) {}
    __device__ __forceinline__ bool next(int i, pg8::Unit& u) const { if (i >= nu) return false; u.aux = desc[3 * i]; u.pn = desc[3 * i + 1]; u.pm = desc[3 * i + 2]; return true; }
};
__device__ __forceinline__ int moe_gather_table(Frame& F, const MoeSched<8>& S) {
    LAS int* misc = (LAS int*)(F.lds + MISC_OFF); LAS unsigned short* gtab = (LAS unsigned short*)(F.lds + GTAB_OFF); LAS float* etab = (LAS float*)(F.lds + ETAB_OFF);
    const int* TOKL = (const int*)(F.ws + WS_TOKL);
    const int nu = resolve_units(F, S, MAX_GUNITS, 1);
    int tv[MAX_GUNITS / 2]; float bv[MAX_GUNITS / 2];
#pragma unroll
    for (int j = 0; j < MAX_GUNITS / 2; ++j) { const int idx = F.tid + 512 * j, ui = idx >> 8, r = idx & 255; tv[j] = 0; bv[j] = 0.f;
        if (ui < nu) { const int aux = misc[UDESC_WORD + 3 * ui], pn = misc[UDESC_WORD + 3 * ui + 1], e = aux & 0xff, rb = aux >> 8, slot = rb * 256 + r;
            tv[j] = TOKL[(size_t)e * ECAP + (slot < misc[e] ? slot : 0)]; if (slot >= misc[e]) tv[j] = 0;
            bv[j] = F.in[I_BGU][(size_t)e * (2 * DFF) + (r < 128 ? 0 : DFF - 128) + pn * 128 + r]; } }
#pragma unroll
    for (int j = 0; j < MAX_GUNITS / 2; ++j) { const int idx = F.tid + 512 * j; if ((idx >> 8) < nu) { gtab[idx] = (unsigned short)tv[j]; etab[idx] = bv[j]; } }
    __syncthreads();
    return nu;
}
__device__ __forceinline__ int moe_down_table(Frame& F, const MoeDownSched& S) {
    LAS int* misc = (LAS int*)(F.lds + MISC_OFF); LAS float* etab = (LAS float*)(F.lds + ETAB_OFF); LAS float* gt2 = (LAS float*)(F.lds + GTAB_OFF);
    const float* GATEL = (const float*)(F.ws + WS_GATEL);
    const int nu = resolve_units(F, S, 9, PROBE_K2X ? 2 : 1);
    float bv[5], gv[5];
#pragma unroll
    for (int j = 0; j < 5; ++j) { const int idx = F.tid + 512 * j, ui = idx >> 8, r = idx & 255; bv[j] = 0.f; gv[j] = 0.f;
        if (ui < nu) { const int aux = misc[UDESC_WORD + 3 * ui], pn = misc[UDESC_WORD + 3 * ui + 1], e = aux & 0xff, rb = (aux >> 8) & 0xffff;
            bv[j] = F.in[I_BDN][(size_t)e * D + pn * 256 + r]; gv[j] = GATEL[(size_t)e * ECAP + rb * 256 + r]; } }
#pragma unroll
    for (int j = 0; j < 5; ++j) { const int idx = F.tid + 512 * j; if ((idx >> 8) < nu) { etab[idx] = bv[j]; gt2[idx] = gv[j]; } }
    __syncthreads();
    return nu;
}
__device__ __forceinline__ int inproj_table(Frame& F, const DenseSched& S) {
    LAS int* misc = (LAS int*)(F.lds + MISC_OFF); LAS float* etab = (LAS float*)(F.lds + ETAB_OFF);
    const int nu = resolve_units(F, S, MAX_GUNITS, 1);
    float bv[MAX_GUNITS / 2];
#pragma unroll
    for (int j = 0; j < MAX_GUNITS / 2; ++j) { const int idx = F.tid + 512 * j, ui = idx >> 8, r = idx & 255; bv[j] = 0.f; if (ui < nu) bv[j] = F.in[I_BIN][misc[UDESC_WORD + 3 * ui + 1] * 256 + r]; }
#pragma unroll
    for (int j = 0; j < MAX_GUNITS / 2; ++j) { const int idx = F.tid + 512 * j; if ((idx >> 8) < nu) etab[idx] = bv[j]; }
    __syncthreads();
    return nu;
}

__device__ __forceinline__ void p10_final(Frame& F, float* dst) {
    LAS int* misc = (LAS int*)(F.lds + MISC_OFF);
    const int gw = F.vcu * NWAVES + F.wave, NGW = F.G * NWAVES, lane = F.lane;
    f32x4 g[4];
#pragma unroll
    for (int j = 0; j < 4; ++j) g[j] = *((const GAS f32x4*)F.in[I_FG] + lane + 64 * j);
    const int* TOKREC = (const int*)(F.ws + WS_TOKREC); const bf16* Y = (const bf16*)(F.ws + WS_Y);
    typedef int v4i __attribute__((ext_vector_type(4)));
    v4i rec = (gw < T) ? *(const GAS v4i*)(TOKREC + (size_t)gw * 4) : (v4i){0, 0, 0, 0};
    for (int t = gw; t < T; t += NGW) {
        const int tn = t + NGW;
        const v4i recn = (tn < T) ? *(const GAS v4i*)(TOKREC + (size_t)tn * 4) : rec;
        GAS f32x4* xp = (GAS f32x4*)(F.out + (size_t)t * D) + lane;
        f32x4 v[4]; v2u yv[4][4];
#pragma unroll
        for (int k = 0; k < 4; ++k) { const unsigned rk = (unsigned)rec[k]; const int e = rk >> 20, slot = rk & 0xfffff;
            const GAS v2u* yp = (const GAS v2u*)(Y + ((size_t)misc[32 + e] * 256 + slot) * D) + lane;
#pragma unroll
            for (int j = 0; j < 4; ++j) yv[k][j] = yp[64 * j]; }
#pragma unroll
        for (int j = 0; j < 4; ++j) v[j] = xp[64 * j];
#pragma unroll
        for (int k = 0; k < 4; ++k)
#pragma unroll
            for (int j = 0; j < 4; ++j) { const v2u w = yv[k][j]; v[j].x += bflo(w.x); v[j].y += bfhi(w.x); v[j].z += bflo(w.y); v[j].w += bfhi(w.y); }
        float s = 0.f;
#pragma unroll
        for (int j = 0; j < 4; ++j) s += (v[j].x * v[j].x + v[j].y * v[j].y) + (v[j].z * v[j].z + v[j].w * v[j].w);
        const float rstd = 1.0f / sqrtf(wave_sum(s) * (1.f / D) + NORM_EPS);
        GAS f32x4* op = (GAS f32x4*)(dst + (size_t)t * D) + lane;
#pragma unroll
        for (int j = 0; j < 4; ++j) op[64 * j] = v[j] * rstd * g[j];
        rec = recn;
    }
}
typedef GAS unsigned gu32;
#define RLX_AGENT __ATOMIC_RELAXED, __HIP_MEMORY_SCOPE_AGENT
#define XB_TMO      128
#define XB_XCNT(j)  (256  + 64 * (j))
#define XB_XSUB(j)  (1280 + 64 * (j))
#define XB_XGEN(j)  (2304 + 64 * (j))
#define XB_TOP      3328
#define XB_TOPGEN   3392
#define XCD_BAR_WORDS 3456
#define XB_SPIN_CAP (1u << 18)

__device__ __forceinline__ unsigned xb_ld(unsigned* p)              { return __hip_atomic_load(p, __ATOMIC_RELAXED, __HIP_MEMORY_SCOPE_AGENT); }
__device__ __forceinline__ unsigned xb_add(unsigned* p, unsigned v) { return __hip_atomic_fetch_add(p, v, __ATOMIC_RELAXED, __HIP_MEMORY_SCOPE_AGENT); }
__device__ __forceinline__ unsigned xb_xcc_id() { return (unsigned)__builtin_amdgcn_s_getreg((3 << 11) | 20) & 0xFu; }
#define XB_SPIN(cond, bar) do { unsigned _sp = 0; while (cond) { __builtin_amdgcn_s_sleep(1); \
    if ((++_sp & 255u) == 0u) { if (xb_ld(&(bar)[XB_TMO])) break; if (_sp > XB_SPIN_CAP) { atomicAdd(&(bar)[XB_TMO], 1u); break; } } } } while (0)

struct XcdBarrier {
    unsigned* bar; unsigned x;
    volatile LAS unsigned* st;
};

__device__ __forceinline__ XcdBarrier xcd_barrier_post(unsigned* bar, volatile LAS unsigned* st) {
    XcdBarrier b; b.bar = bar; b.x = xb_xcc_id(); b.st = st;
    if (threadIdx.x == 0) (void)xb_add(&bar[XB_XCNT(b.x)], 1u);
    return b;
}
__device__ __forceinline__ void xcd_barrier_complete(unsigned* bar, unsigned x, unsigned& nloc, unsigned& nx) {
    const unsigned G = gridDim.x * gridDim.y * gridDim.z;
    unsigned sum, cnt, mine, sp = 0u;
    for (;;) {
        sum = 0u; cnt = 0u; mine = 0u;
#pragma unroll
        for (unsigned j = 0; j < 16; ++j) { const unsigned c = xb_ld(&bar[XB_XCNT(j)]); sum += c; cnt += (c > 0u) ? 1u : 0u; mine = (j == x) ? c : mine; }
        if (sum == G) break;
        __builtin_amdgcn_s_sleep(1);
        if ((++sp & 255u) == 0u) { if (xb_ld(&bar[XB_TMO])) break; if (sp > XB_SPIN_CAP) { atomicAdd(&bar[XB_TMO], 1u); break; } }
    }
    nloc = mine > 0u ? mine : 1u; nx = cnt > 0u ? cnt : 1u;
}

__device__ __forceinline__ void xcd_barrier(const XcdBarrier& b) {
    asm volatile("s_waitcnt vmcnt(0)" ::: "memory");
    __syncthreads();
    if (threadIdx.x == 0) {
        unsigned* bar = b.bar;
        __builtin_amdgcn_s_waitcnt(0);
        unsigned nloc = b.st[0], nx = b.st[1];
        if (nloc == 0u) { xcd_barrier_complete(bar, b.x, nloc, nx); b.st[0] = nloc; b.st[1] = nx; }
        const unsigned old = xb_add(&bar[XB_XSUB(b.x)], 1u);
        const unsigned gen = old / nloc;
        if (old + 1u == (gen + 1u) * nloc) {
            __builtin_amdgcn_fence(__ATOMIC_RELEASE, "agent");
            asm volatile("s_waitcnt vmcnt(0)" ::: "memory");
            const unsigned og = xb_add(&bar[XB_TOP], 1u);
            const unsigned tg = og / nx;
            if (og + 1u == (tg + 1u) * nx) xb_add(&bar[XB_TOPGEN], 1u);
            else XB_SPIN(xb_ld(&bar[XB_TOPGEN]) == tg, bar);
            __builtin_amdgcn_fence(__ATOMIC_ACQUIRE, "agent");
            xb_add(&bar[XB_XGEN(b.x)], 1u);
            asm volatile("s_waitcnt vmcnt(0)" ::: "memory");
        } else {
            XB_SPIN(xb_ld(&bar[XB_XGEN(b.x)]) == gen, bar);
            __builtin_amdgcn_fence(__ATOMIC_ACQUIRE, "agent");
            asm volatile("s_waitcnt vmcnt(0)" ::: "memory");
        }
    }
    __syncthreads();
}

constexpr int N_PHASES = 10;
struct Args { const float* in[24]; float* out; unsigned char* ws; int ph_lo, ph_hi; };
__global__ void __launch_bounds__(NWAVES * 64, 2) mk_fwd(Args args) {
    extern __shared__ __attribute__((aligned(16))) unsigned char lds[];
#define MKFRAME() Frame F; { int t_ = threadIdx.x; asm volatile("" : "+v"(t_)); F.lds = (LAS unsigned char*)lds; F.tid = t_; F.lane = t_ & 63; F.wave = __builtin_amdgcn_readfirstlane(t_ >> 6); \
        F.G = gridDim.x; const int bx = blockIdx.x; F.vcu = (F.G % 8 == 0) ? (bx % 8) * (F.G / 8) + bx / 8 : bx; F.in = args.in; F.out = args.out; F.ws = args.ws; }
    unsigned char* ws = args.ws;
    const int lo = args.ph_lo, hi = args.ph_hi;
#ifndef PH_MASK
#define PH_MASK 0x3ff
#endif
#define IN(k) (((PH_MASK >> (k)) & 1) && lo <= (k) && (k) < hi)
#ifndef REP_MASK
#define REP_MASK 0
#endif
#define REPS(k) for (int rep_ = 0; rep_ < ((((REP_MASK) >> (k)) & 1) ? 2 : 1); ++rep_)
#define SEAM(k) do { if (IN(k) && IN((k) + 1)) { xcd_barrier(bar); } } while (0)

    XcdBarrier bar;
    { volatile LAS unsigned* st = (volatile LAS unsigned*)(lds + MISC_OFF) + 200; if (threadIdx.x == 0) { st[0] = 0u; st[1] = 0u; } __syncthreads(); bar = xcd_barrier_post((unsigned*)(ws + WS_CTL) + CW_BAR, st); }
    if (IN(0)) { MKFRAME(); REPS(0) p0_prologue(F); }
    SEAM(0);
    if (IN(1)) { MKFRAME();
        DenseSched S{(const char*)(ws + WS_XN), (const char*)(ws + WS_WIN), T / 256, INW / 256, D / 64, F.G, (int)blockIdx.x, (size_t)256 * D * 2, (size_t)256 * D * 2, (REP_MASK >> 1) & 1};
        const int nu = inproj_table(F, S);
        const TabSched<DenseSched> TS(S, (const LAS int*)(F.lds + MISC_OFF) + UDESC_WORD, nu);
        EpiInProj E{ws, (const LAS float*)(F.lds + ETAB_OFF)};
        pg8::gemm_phase<EpiInProj, TabSched<DenseSched>, true, false>(F.lds, D * 2, D * 2, TS, E, nullptr);
    }
    SEAM(1);
    if (IN(2)) { MKFRAME(); p2_fixup(F); REPS(2) p2_lru(F); }
    SEAM(2);
    if (IN(3)) { MKFRAME();
        const attn_body::AttnTensors AT{(const attn_body::bf16*)(ws + WS_Q), (const attn_body::bf16*)(ws + WS_KV), (const attn_body::bf16*)(ws + WS_KV) + KVW, (attn_body::bf16*)(ws + WS_AR)};
        const attn_body::StaticOrder S((int)F.G, F.vcu);
        REPS(3) attn_body::attn_phase<attn_body::StaticOrder>((char*)lds, AT, S);
    }
    SEAM(3);
    if (IN(4)) { MKFRAME();
        MergeSched S{(const char*)(ws + WS_AR), (const char*)(ws + WS_WCAT), F.G, (int)blockIdx.x};
        EpiMerge E{(const bf16*)(ws + WS_GL), (bf16*)(ws + WS_MERGED)};
        pg8::gemm_phase<EpiMerge, MergeSched, true, false>(F.lds, ARW * 2, ARW * 2, S, E, nullptr);
    }
    SEAM(4);
    if (IN(5)) { MKFRAME();
        DenseSched S{(const char*)(ws + WS_MERGED), (const char*)(ws + WS_WO), T / 256, D / 256, D / 64, F.G, (int)blockIdx.x, (size_t)256 * D * 2, (size_t)256 * D * 2, (REP_MASK >> 5) & 1};
        EpiResF32 E{F.in[I_X], F.out};
        pg8::gemm_phase<EpiResF32, DenseSched, true, false>(F.lds, D * 2, D * 2, S, E, nullptr);
    }
    SEAM(5);
    if (IN(6)) { MKFRAME(); if ((REP_MASK >> 6) & 1) p6_router(F, true); p6_router(F, false); }
    SEAM(6);
    if (IN(7)) { MKFRAME();
        moe_tables(F);
        MoeSched<8> S{(const char*)(ws + WS_XN), (const char*)(ws + WS_WGU), (const LAS int*)(F.lds + MISC_OFF) + 32, F.G, (int)blockIdx.x, (size_t)2 * DFF * D};
        const int nu = moe_gather_table(F, S);
        const TabSched<MoeSched<8>> TS(S, (const LAS int*)(F.lds + MISC_OFF) + UDESC_WORD, nu);
        EpiSwiGLU E{(const LAS float*)(F.lds + ETAB_OFF), (unsigned char*)(ws + WS_ACT)};
        REPS(7) pg8::gemm_phase<EpiSwiGLU, TabSched<MoeSched<8>>, true, true, true>(F.lds, D, D, TS, E, (const LAS unsigned short*)(F.lds + GTAB_OFF));
    }
    SEAM(7);
    if (IN(8)) { MKFRAME();
        moe_tables(F);
        MoeDownSched S; S.A = (const char*)(ws + WS_ACT); S.B = (const char*)(ws + WS_WD); S.nbp = (const LAS int*)(F.lds + MISC_OFF) + 32; S.G = F.G; S.c = (int)blockIdx.x; S.estepB = (size_t)D * DFF;
        const int nu = moe_down_table(F, S);
        const TabSched<MoeDownSched> TS(S, (const LAS int*)(F.lds + MISC_OFF) + UDESC_WORD, nu);
        EpiDown E{(const LAS float*)(F.lds + ETAB_OFF), (const LAS float*)(F.lds + GTAB_OFF), (bf16*)(ws + WS_Y)};
        REPS(8) pg8::gemm_phase<EpiDown, TabSched<MoeDownSched>, true, false, true>(F.lds, DFF, DFF, TS, E, nullptr);
    }
    SEAM(8);
    if (IN(9)) { MKFRAME(); moe_tables(F); if ((REP_MASK >> 9) & 1) p10_final(F, (float*)(ws + WS_ACT)); p10_final(F, F.out); }
#undef IN
#undef SEAM
}

#ifndef MK_N_LAUNCHES
#define MK_N_LAUNCHES 1
#endif
extern "C" void kernel_launch(void* const* d_in, const int* in_sizes, int n_in, void* d_out, int out_size, void* d_ws, size_t ws_size, hipStream_t stream) {
    static int grid = 0;
    if (grid == 0) {
        if (n_in != 24 || in_sizes[0] != T * D || out_size != T * D || ws_size < WS_END) { fprintf(stderr, "kernel_launch: unexpected shapes (n_in %d, in0 %d, out %d, ws %zu < %zu)\n", n_in, n_in > 0 ? in_sizes[0] : -1, out_size, ws_size, (size_t)WS_END); grid = -1; return; }
        int dev = 0, cus = 0, per_cu = 0;
        if (hipGetDevice(&dev) != hipSuccess || hipDeviceGetAttribute(&cus, hipDeviceAttributeMultiprocessorCount, dev) != hipSuccess) { grid = -1; return; }
        if (hipFuncSetAttribute((const void*)mk_fwd, hipFuncAttributeMaxDynamicSharedMemorySize, LDS_BYTES) != hipSuccess) { fprintf(stderr, "kernel_launch: hipFuncSetAttribute failed\n"); grid = -1; return; }
        if (hipOccupancyMaxActiveBlocksPerMultiprocessor(&per_cu, (const void*)mk_fwd, NWAVES * 64, LDS_BYTES) != hipSuccess || per_cu < 1) { fprintf(stderr, "kernel_launch: occupancy query reports %d\n", per_cu); per_cu = 1; }
        (void)hipGetLastError();
        grid = cus;
    }
    if (grid < 0) return;
    Args a{};
    for (int i = 0; i < 24; ++i) a.in[i] = (const float*)d_in[i];
    a.out = (float*)d_out; a.ws = (unsigned char*)d_ws;
    const int nl = 1;
    for (int li = 0; li < nl; ++li) {
        a.ph_lo = (nl == 1) ? 0 : li; a.ph_hi = (nl == 1) ? N_PHASES : li + 1;
        void* kargs[] = {&a};
        if (hipMemsetAsync((char*)d_ws + WS_CTL, 0, CTL_ZERO_BYTES, stream) != hipSuccess) { fprintf(stderr, "kernel_launch: hipMemsetAsync failed\n"); return; }
        const hipError_t le = hipLaunchCooperativeKernel((const void*)mk_fwd, dim3(grid), dim3(NWAVES * 64), kargs, LDS_BYTES, stream);
        if (le != hipSuccess) { fprintf(stderr, "kernel_launch: launch %d failed: %s (grid %d)\n", li, hipGetErrorName(le), grid); break; }
    }
}
```

```cpp
#include <hip/hip_runtime.h>
#include <hip/hip_cooperative_groups.h>
#include <cstdio>
#include <cstdint>
namespace pg8 {
#define PG8_LAS __attribute__((address_space(3)))
typedef unsigned short bf16_t;
typedef short bf16x8 __attribute__((ext_vector_type(8)));
typedef float f32x4 __attribute__((ext_vector_type(4)));
typedef float f32x2 __attribute__((ext_vector_type(2)));
typedef unsigned u32x4 __attribute__((ext_vector_type(4)));
typedef unsigned u32x2 __attribute__((ext_vector_type(2)));
typedef int v8i32 __attribute__((ext_vector_type(8)));
typedef int v4i32 __attribute__((ext_vector_type(4)));
constexpr int BM = 256, BK = 64, HALF = 128, HTB = HALF * BK * 2  , STAGE_BYTES = 8 * HTB, NXCD = 8, WGM = 8;

__host__ __device__ __forceinline__ int lds_byte(int r, int c) { const int st = (r >> 4) * 2 + (c >> 5), rr = r & 15, cc = c & 31, ob = rr * 64 + cc * 2; return st * 1024 + (ob ^ (((ob >> 9) & 1) << 5)); }
__host__ __device__ __forceinline__ void stage_rc(int b, int& R, int& C) { const int st = b / 1024, sb = b % 1024, swz = sb ^ (((sb >> 9) & 1) << 5); R = (st >> 1) * 16 + swz / 64; C = (st & 1) * 32 + (swz % 64) / 2; }
__host__ __device__ __forceinline__ int perm32(int rho) { const int n = rho >> 4, i = rho & 15; return 8 * (i >> 2) + 4 * n + (i & 3); }

struct Unit { int pm, pn, aux, ui; };

__device__ __forceinline__ void dense_tile(int L, int nM, int nN, int& pm, int& pn) {
    const int nwg = nM * nN; int wgid = L;
    { const int q = nwg / NXCD, r = nwg % NXCD, xcd = wgid % NXCD, off = wgid / NXCD; wgid = (xcd < r ? xcd * (q + 1) : r * (q + 1) + (xcd - r) * q) + off; }
    const int nig = WGM * nN, gid = wgid / nig, fm = gid * WGM, gsz = (nM - fm) < WGM ? (nM - fm) : WGM;
    pm = fm + ((wgid % nig) % gsz); pn = (wgid % nig) / gsz;
}

__device__ __forceinline__ unsigned cvt_pk_bf16(float lo, float hi) { unsigned r; asm volatile("v_cvt_pk_bf16_f32 %0, %1, %2" : "=v"(r) : "v"(lo), "v"(hi)); return r; }
__device__ __forceinline__ float bf_lo(unsigned w) { return __uint_as_float(w << 16); }
__device__ __forceinline__ float bf_hi(unsigned w) { return __uint_as_float(w & 0xffff0000u); }
__device__ __forceinline__ float fast_sigmoid(float x) { return __builtin_amdgcn_rcpf(1.0f + __builtin_amdgcn_exp2f(-1.4426950408889634f * x)); }

template <class Epi, class Sched, bool ALIGN_EPI, bool GATHER, bool FP8 = false>
__device__ __forceinline__ void gemm_phase(PG8_LAS unsigned char* lds, const int lda, const int ldb, const Sched& S, const Epi& E, const PG8_LAS unsigned short* gtab) {
    const int tid = threadIdx.x, wid = __builtin_amdgcn_readfirstlane(tid >> 6), lane = tid & 63, wr = wid >> 2, wc = wid & 3, fr = lane & 15, fq = lane >> 4;
    unsigned voffA[2], voffB[2]; int RA[2];
#pragma unroll
    for (int i = 0; i < 2; ++i) { int R, C; stage_rc(tid * 16 + i * 8192, R, C); const int Rb = Epi::PERM ? ((R & ~31) + perm32(R & 31)) : R;
        voffA[i] = GATHER ? (unsigned)(C * 2) : (unsigned)(R * lda + C * 2); voffB[i] = (unsigned)(Rb * ldb + C * 2); RA[i] = R; }
    const size_t kstep = (size_t)(BK * 2);
    const size_t hstepA = GATHER ? 0 : (size_t)HALF * lda;
    const size_t hstepB = (size_t)HALF * ldb;
    const unsigned ldsw = (unsigned)wid * 1024u;
    const int aoff = lds_byte(wr * 64 + fr, fq * 8), boff = lds_byte(wc * 32 + fr, fq * 8);
    const int aoff8 = lds_byte(wr * 64 + fr, (fq >> 1) * 32 + (fq & 1) * 16), boff8 = lds_byte(wc * 32 + fr, (fq >> 1) * 32 + (fq & 1) * 16);
    unsigned gC[2][2], gN[2][2];
#define PG8_SA(b, h) (((b) * 2 + (h)) * HTB)
#define PG8_SB(b, h) ((4 + (b) * 2 + (h)) * HTB)
#define PG8_GLDS(gp, bufoff, i) __builtin_amdgcn_global_load_lds((const unsigned*)(gp), (PG8_LAS unsigned*)(lds + (bufoff) + ldsw + (i) * 8192), 16, 0, 0)
#define PG8_STAGE_B(bufoff, gbase) do { _Pragma("unroll") for (int _i = 0; _i < 2; ++_i) PG8_GLDS((const char*)(gbase) + voffB[_i], bufoff, _i); } while (0)
#define PG8_STAGE_A(bufoff, gbase, h, nx) do { _Pragma("unroll") for (int _i = 0; _i < 2; ++_i) { \
        if constexpr (GATHER) PG8_GLDS((const char*)(gbase) + ((nx) ? gN[h][_i] : gC[h][_i]) + voffA[_i], bufoff, _i); \
        else PG8_GLDS((const char*)(gbase) + voffA[_i], bufoff, _i); } } while (0)
#define PG8_LDA(dst, b, h) do { if constexpr (FP8) { _Pragma("unroll") for (int m = 0; m < 4; ++m) dst##8[m] = __builtin_shufflevector(*(const PG8_LAS v4i32*)(lds + PG8_SA(b, h) + aoff + m * 2048), *(const PG8_LAS v4i32*)(lds + PG8_SA(b, h) + aoff + m * 2048 + 1024), 0, 1, 2, 3, 4, 5, 6, 7); } \
        else { _Pragma("unroll") for (int m = 0; m < 4; ++m) _Pragma("unroll") for (int k = 0; k < 2; ++k) dst[m][k] = *(const PG8_LAS bf16x8*)(lds + PG8_SA(b, h) + aoff + m * 2048 + k * 1024); } } while (0)
#define PG8_LDB(dst, b, h) do { if constexpr (FP8) { _Pragma("unroll") for (int n = 0; n < 2; ++n) dst##8[n] = __builtin_shufflevector(*(const PG8_LAS v4i32*)(lds + PG8_SB(b, h) + boff + n * 2048), *(const PG8_LAS v4i32*)(lds + PG8_SB(b, h) + boff + n * 2048 + 1024), 0, 1, 2, 3, 4, 5, 6, 7); } \
        else { _Pragma("unroll") for (int n = 0; n < 2; ++n) _Pragma("unroll") for (int k = 0; k < 2; ++k) dst[n][k] = *(const PG8_LAS bf16x8*)(lds + PG8_SB(b, h) + boff + n * 2048 + k * 1024); } } while (0)
#define PG8_MMA(ai, bj, At, Bt) do { __builtin_amdgcn_s_setprio(1); _Pragma("unroll") for (int m = 0; m < 4; ++m) _Pragma("unroll") for (int n = 0; n < 2; ++n) { \
        if constexpr (FP8) { asm volatile("v_mfma_scale_f32_16x16x128_f8f6f4 %0, %1, %2, %0, %3, %3 op_sel_hi:[0,0,0]" : "+v"(acc[ai][bj][m][n]) : "v"(Bt##8[n]), "v"(At##8[m]), "v"(scale1)); } \
        else { _Pragma("unroll") for (int k = 0; k < 2; ++k) acc[ai][bj][m][n] = __builtin_amdgcn_mfma_f32_16x16x32_bf16(Bt[n][k], At[m][k], acc[ai][bj][m][n], 0, 0, 0); } } \
        __builtin_amdgcn_s_setprio(0); } while (0)
#define PG8_WAIT_V(n) asm volatile("s_waitcnt vmcnt(" #n ")" ::: "memory")
#define PG8_WAIT_L(n) asm volatile("s_waitcnt lgkmcnt(" #n ")" ::: "memory")
#define PG8_BAR __builtin_amdgcn_s_barrier()
#define PG8_SCHED __builtin_amdgcn_sched_barrier(0)
#define PG8_GOFF(dst, ui_) do { if constexpr (GATHER) { _Pragma("unroll") for (int _h = 0; _h < 2; ++_h) _Pragma("unroll") for (int _i = 0; _i < 2; ++_i) \
        dst[_h][_i] = (unsigned)gtab[(ui_) * 256 + _h * HALF + RA[_i]] * (unsigned)lda; } } while (0)
    Unit cur, nxt; int ui = 0;
    if (!S.next(0, cur)) return;
    cur.ui = 0;
    f32x4 acc[2][2][4][2];
#pragma unroll
    for (int a = 0; a < 2; ++a)
#pragma unroll
        for (int b = 0; b < 2; ++b)
#pragma unroll
            for (int m = 0; m < 4; ++m)
#pragma unroll
                for (int n = 0; n < 2; ++n) acc[a][b][m][n] = (f32x4){0.f, 0.f, 0.f, 0.f};
    bf16x8 At[4][2], B0[2][2], B1[2][2]; v8i32 At8[4], B08[2], B18[2];
    int scale1 = 0x7f7f7f7f; asm volatile("" : "+v"(scale1));
    const char* cA = S.a_ptr(cur); const char* cB = S.b_ptr(cur);
    PG8_GOFF(gC, 0);
#pragma unroll
    for (int _h = 0; _h < 2; ++_h)
#pragma unroll
        for (int _i = 0; _i < 2; ++_i) gN[_h][_i] = gC[_h][_i];
    PG8_STAGE_B(PG8_SB(0, 0), cB); PG8_STAGE_B(PG8_SB(0, 1), cB + hstepB); PG8_STAGE_A(PG8_SA(0, 0), cA, 0, false); PG8_STAGE_A(PG8_SA(0, 1), cA + hstepA, 1, false);
    if (wr == 1) PG8_BAR;
    PG8_WAIT_V(2); PG8_BAR;
    PG8_STAGE_B(PG8_SB(1, 0), cB + kstep); PG8_STAGE_A(PG8_SA(1, 0), cA + kstep, 0, false); PG8_STAGE_B(PG8_SB(1, 1), cB + hstepB + kstep);
    PG8_WAIT_V(6); PG8_BAR;
    for (;;) {
        const bool has_next = S.next(ui + 1, nxt); nxt.ui = ui + 1;
        const int nt = S.ntiles(cur);
        const char* nA = has_next ? S.a_ptr(nxt) : cA; const char* nB = has_next ? S.b_ptr(nxt) : cB;
        if (has_next) PG8_GOFF(gN, ui + 1);
#pragma unroll 1
        for (int t = 0; t < nt; t += 2) {
            const bool last = (t == nt - 2);
            const char* a1 = cA + (size_t)(t + 1) * kstep;
            const char* a2 = last ? nA : cA + (size_t)(t + 2) * kstep; const char* b2 = last ? nB : cB + (size_t)(t + 2) * kstep;
            const char* a3 = a2 + kstep; const char* b3 = b2 + kstep;
            PG8_LDB(B0, 0, 0); PG8_LDB(B1, 0, 1); PG8_SCHED; PG8_LDA(At, 0, 0); PG8_STAGE_A(PG8_SA(1, 1), a1 + hstepA, 1, false);
            PG8_WAIT_V(8); PG8_WAIT_L(0); PG8_BAR; PG8_MMA(0, 0, At, B0); PG8_MMA(0, 1, At, B1); PG8_BAR; PG8_SCHED;
            PG8_LDA(At, 0, 1); PG8_STAGE_B(PG8_SB(0, 0), b2); PG8_STAGE_B(PG8_SB(0, 1), b2 + hstepB); PG8_STAGE_A(PG8_SA(0, 0), a2, 0, last);
            PG8_WAIT_V(8); PG8_WAIT_L(0); PG8_BAR; PG8_MMA(1, 0, At, B0); PG8_MMA(1, 1, At, B1); PG8_BAR; PG8_SCHED;
            PG8_LDB(B0, 1, 0); PG8_LDB(B1, 1, 1); PG8_SCHED; PG8_LDA(At, 1, 0); PG8_STAGE_A(PG8_SA(0, 1), a2 + hstepA, 1, last);
            PG8_WAIT_V(8); PG8_WAIT_L(0); PG8_BAR; PG8_MMA(0, 0, At, B0); PG8_MMA(0, 1, At, B1); PG8_BAR; PG8_SCHED;
            PG8_LDA(At, 1, 1); PG8_STAGE_B(PG8_SB(1, 0), b3); PG8_STAGE_B(PG8_SB(1, 1), b3 + hstepB); PG8_STAGE_A(PG8_SA(1, 0), a3, 0, last);
            PG8_WAIT_V(8); PG8_WAIT_L(0); PG8_BAR; PG8_MMA(1, 0, At, B0); PG8_MMA(1, 1, At, B1); PG8_BAR; PG8_SCHED;
        }
        if constexpr (ALIGN_EPI) { if (wr == 0) PG8_BAR; }
        if constexpr (FP8) asm volatile("s_nop 15\n\ts_nop 15" ::: "memory");
        { int fr_ = fr, fq_ = fq; asm volatile("" : "+v"(fr_), "+v"(fq_));
          E(acc, cur, wr, wc, fr_, fq_); }
        if (!E.keep(cur)) {
#pragma unroll
        for (int a = 0; a < 2; ++a)
#pragma unroll
            for (int b = 0; b < 2; ++b)
#pragma unroll
                for (int m = 0; m < 4; ++m)
#pragma unroll
                    for (int n = 0; n < 2; ++n) acc[a][b][m][n] = (f32x4){0.f, 0.f, 0.f, 0.f};
        }
        if (!has_next) break;
        cur = nxt; cA = nA; cB = nB; ++ui;
#pragma unroll
        for (int _h = 0; _h < 2; ++_h)
#pragma unroll
            for (int _i = 0; _i < 2; ++_i) gC[_h][_i] = gN[_h][_i];
        if constexpr (ALIGN_EPI) { if (wr == 1) PG8_BAR; }
    }
    PG8_WAIT_V(0);
    if constexpr (!ALIGN_EPI) { if (wr == 0) PG8_BAR; }
    PG8_BAR;
#undef PG8_SA
#undef PG8_SB
#undef PG8_GLDS
#undef PG8_STAGE_A
#undef PG8_STAGE_B
#undef PG8_LDA
#undef PG8_LDB
#undef PG8_MMA
#undef PG8_WAIT_V
#undef PG8_WAIT_L
#undef PG8_BAR
#undef PG8_SCHED
#undef PG8_GOFF
}
}
#include <hip/hip_bf16.h>
#include <cmath>
namespace attn_body {
using bf16=__hip_bfloat16;
using bf16x8=__attribute__((ext_vector_type(8)))short;
using s16x4=__attribute__((ext_vector_type(4)))short;
using f32x16=__attribute__((ext_vector_type(16)))float;
using u32x4=__attribute__((ext_vector_type(4)))unsigned;
constexpr int BATCH=8,NHEAD=8,NKV=2,SEQ=4096,D=64;
constexpr int QP=512,KVP=256,OP=1536;
constexpr int NW=8,QBLK=32,QB=QBLK*NW,KVBLK=64,NQB=SEQ/QB;
constexpr int ATTN_UNIT_ROWS=QB;
__device__ __forceinline__ int crow(int r,int hi){return (r&3)+8*(r>>2)+4*hi;}
#define SBAR() __builtin_amdgcn_sched_barrier(0)
constexpr int NSLOT=3, SLOTB=8192;
constexpr int LDS_K=0, LDS_V=NSLOT*SLOTB, LDS_WS=2*NSLOT*SLOTB, LDS_OST=LDS_WS+NW*64*4, LDS_BYTES=LDS_OST+NW*4096;
constexpr float C2=0.125f*1.4426950408889634f;
__device__ __forceinline__ void glds16(const void*gsrc,unsigned lds_dst){unsigned keep;
  asm volatile("s_mov_b32 %0, m0\n\ts_mov_b32 m0, %2\n\ts_nop 0\n\tglobal_load_lds_dwordx4 %1, off\n\ts_mov_b32 m0, %0":"=&s"(keep):"v"(gsrc),"s"(lds_dst):"memory");}
__device__ __forceinline__ float max3f(float a,float b,float c){float r;asm("v_max3_f32 %0, %1, %2, %3":"=v"(r):"v"(a),"v"(b),"v"(c));return r;}
__device__ __forceinline__ float max2f(float a,float b){float r;asm("v_max_f32_e32 %0, %1, %2":"=v"(r):"v"(a),"v"(b));return r;}
__device__ __forceinline__ float fadd_s(float a,float b){float r;asm("v_add_f32_e32 %0, %1, %2":"=v"(r):"v"(a),"v"(b));return r;}
__device__ __forceinline__ float fsub_s(float a,float b){float r;asm("v_sub_f32_e32 %0, %1, %2":"=v"(r):"v"(a),"v"(b));return r;}
typedef float f32x2_t __attribute__((ext_vector_type(2))); typedef __bf16 bf16x2_t __attribute__((ext_vector_type(2)));
__device__ __forceinline__ unsigned cvtpk_s(float lo,float hi){f32x2_t v={lo,hi};bf16x2_t b=__builtin_convertvector(v,bf16x2_t);return __builtin_bit_cast(unsigned,b);}
#define WAIT_BAR(N) asm volatile("s_waitcnt vmcnt(" #N ") lgkmcnt(0)\n\ts_barrier":::"memory")

__device__ __forceinline__ void qkt(f32x16&p0,f32x16&p1,const char*Kslot,const bf16x8*qr,const f32x16&negm,int r32,int hi){
  const char*kb=Kslot+hi*1024+r32*16;
  #pragma unroll
  for(int d0=0;d0<4;++d0){
    const bf16x8 b0=*reinterpret_cast<const bf16x8*>(kb+d0*2048);
    const bf16x8 b1=*reinterpret_cast<const bf16x8*>(kb+d0*2048+512);
    if(d0==0){p0=__builtin_amdgcn_mfma_f32_32x32x16_bf16(b0,qr[0],negm,0,0,0);p1=__builtin_amdgcn_mfma_f32_32x32x16_bf16(b1,qr[0],negm,0,0,0);}
    else{p0=__builtin_amdgcn_mfma_f32_32x32x16_bf16(b0,qr[d0],p0,0,0,0);p1=__builtin_amdgcn_mfma_f32_32x32x16_bf16(b1,qr[d0],p1,0,0,0);}}
}
typedef __attribute__((address_space(3))) const char* lds_cptr;
typedef short v4i16_t __attribute__((ext_vector_type(4)));
__device__ __forceinline__ void kload8(bf16x8*kf,lds_cptr kp){
  kf[0]=*(const __attribute__((address_space(3))) bf16x8*)(kp);      kf[1]=*(const __attribute__((address_space(3))) bf16x8*)(kp+512);
  kf[2]=*(const __attribute__((address_space(3))) bf16x8*)(kp+2048); kf[3]=*(const __attribute__((address_space(3))) bf16x8*)(kp+2560);
  kf[4]=*(const __attribute__((address_space(3))) bf16x8*)(kp+4096); kf[5]=*(const __attribute__((address_space(3))) bf16x8*)(kp+4608);
  kf[6]=*(const __attribute__((address_space(3))) bf16x8*)(kp+6144); kf[7]=*(const __attribute__((address_space(3))) bf16x8*)(kp+6656);
}
__device__ __forceinline__ void kload2(bf16x8*kf,lds_cptr kp,int j){ kf[2*j]=*(const __attribute__((address_space(3))) bf16x8*)(kp+j*2048); kf[2*j+1]=*(const __attribute__((address_space(3))) bf16x8*)(kp+j*2048+512); }
__device__ __forceinline__ s16x4 vtr(lds_cptr p){ return __builtin_bit_cast(s16x4,__builtin_amdgcn_ds_read_tr16_b64_v4i16((__attribute__((address_space(3))) v4i16_t*)p)); }
__device__ __forceinline__ float rowmax(const f32x16&p0,const f32x16&p1){
  float a=max3f(p0[0],p0[1],p1[0]),b=max3f(p0[2],p0[3],p1[1]);a=max3f(a,p1[2],p1[3]);
  #pragma unroll
  for(int r=4;r<16;r+=4){a=max3f(a,p0[r],p0[r+1]);b=max3f(b,p0[r+2],p0[r+3]);a=max3f(a,p1[r],p1[r+1]);b=max3f(b,p1[r+2],p1[r+3]);}
  const float m=max2f(a,b);
  auto rr=__builtin_amdgcn_permlane32_swap(__float_as_uint(m),__float_as_uint(m),false,false);
  return max2f(__uint_as_float(rr[0]),__uint_as_float(rr[1]));
}
__device__ __forceinline__ void pv(f32x16*o,int vb,bf16x8 pa0,bf16x8 pa1,bf16x8 pa2,bf16x8 pa3){
  #pragma unroll
  for(int d0=0;d0<2;++d0){s16x4 lo[4],hi[4];
    #pragma unroll
    for(int ks=0;ks<4;++ks){
      asm volatile("ds_read_b64_tr_b16 %0,%1 offset:%c2":"=&v"(lo[ks]):"v"(vb),"i"(d0*4096+ks*1024):"memory");
      asm volatile("ds_read_b64_tr_b16 %0,%1 offset:%c2":"=&v"(hi[ks]):"v"(vb),"i"(d0*4096+ks*1024+512):"memory");}
    asm volatile("s_waitcnt lgkmcnt(0)":::"memory");SBAR();
    #define PK(k) (bf16x8){lo[k][0],lo[k][1],lo[k][2],lo[k][3],hi[k][0],hi[k][1],hi[k][2],hi[k][3]}
    o[d0]=__builtin_amdgcn_mfma_f32_32x32x16_bf16(pa0,PK(0),o[d0],0,0,0);
    o[d0]=__builtin_amdgcn_mfma_f32_32x32x16_bf16(pa1,PK(1),o[d0],0,0,0);
    o[d0]=__builtin_amdgcn_mfma_f32_32x32x16_bf16(pa2,PK(2),o[d0],0,0,0);
    o[d0]=__builtin_amdgcn_mfma_f32_32x32x16_bf16(pa3,PK(3),o[d0],0,0,0);
    #undef PK
  }
}

#ifndef ATTN_STORE16
#define ATTN_STORE16(p,v) (*(u32x4*)(p)=(v))
#endif
template<int THRL> __device__ __forceinline__ void attn_unit(int b,int h,int qb,const bf16*Q,const bf16*__restrict__ K,const bf16*__restrict__ V,bf16*O,char*shm){
  const int tid=threadIdx.x,lane=tid&63,r32=lane&31,hi=lane>>5; const int wid=__builtin_amdgcn_readfirstlane(tid>>6);
  const long rowbase=(long)b*SEQ; const int q0=qb*QB;
  const bf16*Qw=Q+(rowbase+q0+wid*QBLK)*QP+h*D; const int kvh=h/(NHEAD/NKV);
  const bf16*Kh=K+rowbase*KVP+kvh*D,*Vh=V+rowbase*KVP+kvh*D;
  const unsigned lds0=(unsigned)(uintptr_t)shm;
  float*wsf=(float*)(shm+LDS_WS)+wid*64;
  const bf16*ksrc=Kh+(long)lane*KVP+wid*8;
  const bf16*vsrc=Vh+(long)(16*(wid&3)+(lane>>2))*KVP+(wid>>2)*32+(lane&3)*8;
  const unsigned kdst=lds0+LDS_K+wid*1024, vdst=lds0+LDS_V+wid*1024;
  #define DMA_K(t,slot) glds16(ksrc+(long)(t)*KVBLK*KVP,(unsigned)__builtin_amdgcn_readfirstlane(kdst+(slot)))
  #define DMA_V(t,slot) glds16(vsrc+(long)(t)*KVBLK*KVP,(unsigned)__builtin_amdgcn_readfirstlane(vdst+(slot)))
  const int vb0=(int)(lds0+LDS_V)+((lane>>4)&1)*32+(lane&3)*8+(4*hi+((lane&15)>>2))*64;
  const char*Kbase=shm+LDS_K; bf16x8 kf[8];
  const lds_cptr shm3=(lds_cptr)shm; const lds_cptr kp0=shm3+LDS_K+hi*1024+r32*16; const lds_cptr vp0=shm3+LDS_V+((lane>>4)&1)*32+(lane&3)*8+(4*hi+((lane&15)>>2))*64;
  constexpr int NT=SEQ/KVBLK;
  DMA_K(0,0);DMA_V(0,0);DMA_K(1,SLOTB);
  bf16x8 qr[4];
  #pragma unroll
  for(int d0=0;d0<4;++d0)qr[d0]=*reinterpret_cast<const bf16x8*>(&Qw[(long)r32*QP+d0*16+hi*8]);
  float mhat=0.f,l_reg=0.f;f32x16 o[2];o[0]=f32x16{};o[1]=f32x16{};f32x16 negm=f32x16{};asm volatile("":"+v"(negm));
  #define CMASK(P0,P1,t) do{}while(0)
  bool resc=false;
  #define START(P0,P1) do{ const float rm=rowmax(P0,P1); resc=false; \
    { const float dl=rm; mhat=fadd_s(mhat,dl); \
      _Pragma("unroll") for(int r=0;r<16;++r){P0[r]=fsub_s(P0[r],dl);P1[r]=fsub_s(P1[r],dl);} \
      _Pragma("unroll") for(int r=0;r<16;++r)negm[r]=-mhat; asm volatile("":"+v"(negm)); } \
    _Pragma("unroll") for(int r=0;r<16;++r)P0[r]=__builtin_amdgcn_exp2f(P0[r]); }while(0)
  #define RESC() do{ if(resc){ asm volatile("s_waitcnt lgkmcnt(0)":::"memory"); \
      _Pragma("unroll") for(int d_=0;d_<2;++d_) _Pragma("unroll") for(int r=0;r<16;++r)o[d_][r]*=wsf[crow(r,hi)]; } }while(0)
  f32x16 pA0,pA1,pB0,pB1;
  int sl_prev=0,sl_cur=0,sl_next=SLOTB;
  #define ROT() do{sl_prev=sl_cur;sl_cur=sl_next;sl_next=(sl_next==(NSLOT-1)*SLOTB)?0:sl_next+SLOTB;}while(0)
  DMA_K(2,2*SLOTB);
  WAIT_BAR(3);
  qkt(pA0,pA1,Kbase,qr,negm,r32,hi);asm volatile("s_nop 15\n\ts_nop 7":"+v"(pA0),"+v"(pA1));CMASK(pA0,pA1,0);
  START(pA0,pA1);
  _Pragma("unroll") for(int r=0;r<16;++r)pA1[r]=__builtin_amdgcn_exp2f(pA1[r]);
  WAIT_BAR(0);
  DMA_K(3,0);DMA_V(1,SLOTB);
  ROT();
  kload8(kf,kp0+sl_cur);
  WAIT_BAR(2);
  s16x4 vlo[8],vhi[8]; u32x4 pw0,pw1,pw2,pw3;
  #define PKW(P,B) cvtpk_s(P[B],P[B+1])
  #define PAF(k) __builtin_bit_cast(bf16x8,pw##k)
  #define VFR(i) (bf16x8){vlo[i][0],vlo[i][1],vlo[i][2],vlo[i][3],vhi[i][0],vhi[i][1],vhi[i][2],vhi[i][3]}
  #define PIN(x) asm volatile("":"+v"(x))
  #define MX3(a,b,c) __builtin_fmaxf(__builtin_fmaxf((a),(b)),(c))
  #define GAPA(MF,A0,A1,A2,A3,W0,W1,PW) do{ MF; sacc+=A0; sacc+=A1; sacc+=A2; sacc+=A3; PIN(sacc); W0; W1; PIN(PW); SBAR(); }while(0)
  #define EX(v) __builtin_amdgcn_exp2f(v)
  #define GAPB(MF,X,B) do{ MF; X[B]=EX(X[B]); X[B+1]=EX(X[B+1]); X[B+2]=EX(X[B+2]); X[B+3]=EX(X[B+3]); PIN(X); SBAR(); }while(0)
  #define VRD(i) do{ vlo[i]=vtr(vp_+(((i)>>2)*4096+((i)&3)*1024)); vhi[i]=vtr(vp_+(((i)>>2)*4096+((i)&3)*1024+512)); }while(0)
  #define KRD(G,j) do{ if(G){ kload2(kf,kp0+sl_next,j); SBAR(); } }while(0)
  #define STEP(C0,C1,P0,P1,t,GK,GV,GL) do{ SBAR(); \
    const lds_cptr vp_=vp0+sl_prev; \
    VRD(0); SBAR(); float sacc=(P0[0]+P0[1]); \
    GAPA(C0=__builtin_amdgcn_mfma_f32_32x32x16_bf16(kf[0],qr[0],negm,0,0,0), P0[2],P0[3],P0[4],P0[5],     pw0[0]=PKW(P0,0), pw0[1]=PKW(P0,2), pw0); \
    VRD(4); SBAR(); GAPA(C1=__builtin_amdgcn_mfma_f32_32x32x16_bf16(kf[1],qr[0],negm,0,0,0), P0[6],P0[7],P0[8],P0[9],     pw0[2]=PKW(P0,4), pw0[3]=PKW(P0,6), pw0); \
    VRD(1); SBAR(); GAPA(C0=__builtin_amdgcn_mfma_f32_32x32x16_bf16(kf[2],qr[1],C0,0,0,0),   P0[10],P0[11],P0[12],P0[13], pw1[0]=PKW(P0,8), pw1[1]=PKW(P0,10), pw1); \
    VRD(5); SBAR(); GAPA(C1=__builtin_amdgcn_mfma_f32_32x32x16_bf16(kf[3],qr[1],C1,0,0,0),   P0[14],P0[15],P1[0],P1[1],   pw1[2]=PKW(P0,12),pw1[3]=PKW(P0,14), pw1); \
    VRD(2); SBAR(); GAPA(C0=__builtin_amdgcn_mfma_f32_32x32x16_bf16(kf[4],qr[2],C0,0,0,0),   P1[2],P1[3],P1[4],P1[5],     pw2[0]=PKW(P1,0), pw2[1]=PKW(P1,2), pw2); \
    VRD(6); SBAR(); GAPA(C1=__builtin_amdgcn_mfma_f32_32x32x16_bf16(kf[5],qr[2],C1,0,0,0),   P1[6],P1[7],P1[8],P1[9],     pw2[2]=PKW(P1,4), pw2[3]=PKW(P1,6), pw2); \
    VRD(3); SBAR(); GAPA(C0=__builtin_amdgcn_mfma_f32_32x32x16_bf16(kf[6],qr[3],C0,0,0,0),   P1[10],P1[11],P1[12],P1[13], pw3[0]=PKW(P1,8), pw3[1]=PKW(P1,10), pw3); \
    VRD(7); SBAR(); GAPA(C1=__builtin_amdgcn_mfma_f32_32x32x16_bf16(kf[7],qr[3],C1,0,0,0),   P1[14],P1[15],0.f,0.f,       pw3[2]=PKW(P1,12),pw3[3]=PKW(P1,14), pw3); \
    l_reg+=sacc; \
    if(GK){DMA_K((t)+3,sl_cur);} if(GV){DMA_V((t)+1,sl_next);} \
    CMASK(C0,C1,t); \
    { float a=MX3(C0[0],C0[1],C1[0]),b=MX3(C0[2],C0[3],C1[1]); a=MX3(a,C1[2],C1[3]); \
      _Pragma("unroll") for(int r=4;r<16;r+=4){a=MX3(a,C0[r],C0[r+1]);b=MX3(b,C0[r+2],C0[r+3]);a=MX3(a,C1[r],C1[r+1]);b=MX3(b,C1[r+2],C1[r+3]);} \
      float rm=__builtin_fmaxf(a,b); { auto rr=__builtin_amdgcn_permlane32_swap(__float_as_uint(rm),__float_as_uint(rm),false,false); rm=__builtin_fmaxf(__uint_as_float(rr[0]),__uint_as_float(rr[1])); } \
      resc=false; \
      if(__builtin_expect(__any(rm>(float)THRL),0)){ const float dl=__builtin_fmaxf(rm,0.f); mhat+=dl; \
        _Pragma("unroll") for(int r=0;r<16;++r){C0[r]-=dl;C1[r]-=dl;} \
        _Pragma("unroll") for(int r=0;r<16;++r)negm[r]=-mhat; asm volatile("":"+v"(negm)); \
        const float f=__builtin_amdgcn_exp2f(-dl); l_reg*=f; if(hi==0)wsf[r32]=f; resc=true; } } \
    SBAR(); \
    GAPB(o[0]=__builtin_amdgcn_mfma_f32_32x32x16_bf16(PAF(0),VFR(0),o[0],0,0,0), C0,0); \
    GAPB(o[1]=__builtin_amdgcn_mfma_f32_32x32x16_bf16(PAF(0),VFR(4),o[1],0,0,0), C0,4); \
    KRD(GL,0); GAPB(o[0]=__builtin_amdgcn_mfma_f32_32x32x16_bf16(PAF(1),VFR(1),o[0],0,0,0), C0,8); \
    KRD(GL,1); GAPB(o[1]=__builtin_amdgcn_mfma_f32_32x32x16_bf16(PAF(1),VFR(5),o[1],0,0,0), C0,12); \
    KRD(GL,2); GAPB(o[0]=__builtin_amdgcn_mfma_f32_32x32x16_bf16(PAF(2),VFR(2),o[0],0,0,0), C1,0); \
    KRD(GL,3); GAPB(o[1]=__builtin_amdgcn_mfma_f32_32x32x16_bf16(PAF(2),VFR(6),o[1],0,0,0), C1,4); \
    GAPB(o[0]=__builtin_amdgcn_mfma_f32_32x32x16_bf16(PAF(3),VFR(3),o[0],0,0,0), C1,8); \
    GAPB(o[1]=__builtin_amdgcn_mfma_f32_32x32x16_bf16(PAF(3),VFR(7),o[1],0,0,0), C1,12); \
    }while(0)
  int t=1;
  for(;t+5<NT;t+=2){
    STEP(pB0,pB1,pA0,pA1,t,true,true,true);     WAIT_BAR(2); RESC(); ROT();
    STEP(pA0,pA1,pB0,pB1,t+1,true,true,true);   WAIT_BAR(2); RESC(); ROT();
  }
  #define ENDW(tt) do{ if((tt)+3<NT){WAIT_BAR(2);} else if((tt)+2<NT){WAIT_BAR(1);} else {WAIT_BAR(0);} }while(0)
  for(;t+1<NT;t+=2){
    STEP(pB0,pB1,pA0,pA1,t,(t+3<NT),(t+1<NT),(t+1<NT));       ENDW(t);   RESC(); ROT();
    STEP(pA0,pA1,pB0,pB1,t+1,(t+4<NT),(t+2<NT),(t+2<NT));     ENDW(t+1); RESC(); ROT();
  }
  STEP(pB0,pB1,pA0,pA1,NT-1,false,false,false); RESC();
  { float sacc=pB0[0]+pB0[1]; _Pragma("unroll") for(int r=2;r<16;++r)sacc+=pB0[r]; _Pragma("unroll") for(int r=0;r<16;++r)sacc+=pB1[r]; l_reg+=sacc;
    pw0=(u32x4){PKW(pB0,0),PKW(pB0,2),PKW(pB0,4),PKW(pB0,6)};pw1=(u32x4){PKW(pB0,8),PKW(pB0,10),PKW(pB0,12),PKW(pB0,14)};pw2=(u32x4){PKW(pB1,0),PKW(pB1,2),PKW(pB1,4),PKW(pB1,6)};pw3=(u32x4){PKW(pB1,8),PKW(pB1,10),PKW(pB1,12),PKW(pB1,14)};
    SBAR(); pv(o,vb0+sl_cur,PAF(0),PAF(1),PAF(2),PAF(3)); }
  #undef PKW
  #undef PAF
  #undef VFR
  #undef PIN
  #undef MX3
  #undef GAPA
  #undef GAPB
  #undef EX
  #undef VRD
  #undef KRD
  #undef STEP
  #undef ENDW
  {auto rr=__builtin_amdgcn_permlane32_swap(__float_as_uint(l_reg),__float_as_uint(l_reg),false,false);l_reg=__uint_as_float(rr[0])+__uint_as_float(rr[1]);}
  if(hi==0)wsf[32+r32]=l_reg;asm volatile("s_waitcnt lgkmcnt(0)":::"memory");
  float rli[16];
  #pragma unroll
  for(int r=0;r<16;++r)rli[r]=__builtin_amdgcn_rcpf(wsf[32+crow(r,hi)]);
  bf16*Ow=O+(rowbase+q0+wid*QBLK)*OP+h*D;
  { bf16*stg=(bf16*)(shm+LDS_OST)+wid*2048;
    #pragma unroll
    for(int r=0;r<16;++r){const int orow=crow(r,hi);
      #pragma unroll
      for(int d0=0;d0<2;++d0)stg[orow*64+d0*32+r32]=__float2bfloat16(o[d0][r]*rli[r]);}
    asm volatile("s_waitcnt lgkmcnt(0)":::"memory");
    #pragma unroll
    for(int i=0;i<4;++i){const int row=i*8+(lane>>3),ch=lane&7; const u32x4 v=*(const u32x4*)(stg+row*64+ch*8); ATTN_STORE16(Ow+(long)row*OP+ch*8,v);} }
  asm volatile("s_waitcnt lgkmcnt(0)\n\ts_barrier":::"memory");
  #undef DMA_K
  #undef DMA_V
  #undef CMASK
  #undef START
  #undef RESC
  #undef ROT
}
constexpr int ATTN_LDS_BYTES=LDS_BYTES;
struct AttnTensors { const bf16* Q; const bf16* K; const bf16* V; bf16* O; };
struct AttnUnit { int bh; int qb; };
struct StaticOrder {
  int vcu,G;
  __device__ __forceinline__ explicit StaticOrder(int grid,int v):vcu(v),G(grid){}
  __device__ __forceinline__ bool next(int i,AttnUnit&u)const{ const int L=i*G+vcu; if(L>=BATCH*NHEAD*NQB)return false;
    const int pairhalf=L>>5,l=L&31; const int pair=pairhalf>>1,uu=l+32*(pairhalf&1); const int b=pair>>1,kvh=pair&1; u.bh=b*NHEAD+kvh*(NHEAD/NKV)+(uu>>4); u.qb=uu&15; return true; }
  __device__ __forceinline__ void a_ready(const AttnUnit&)const{}
  __device__ __forceinline__ void done(const AttnUnit&)const{}
};
template<class Sched,int THRL=8> __device__ __forceinline__ void attn_phase(char*lds,const AttnTensors&T,const Sched&S){
  AttnUnit u;
  for(int i=0;S.next(i,u);++i){ S.a_ready(u); attn_unit<THRL>(u.bh/NHEAD,u.bh%NHEAD,u.qb,T.Q,T.K,T.V,T.O,lds); S.done(u); }
}
#undef SBAR
#undef WAIT_BAR
}
namespace cg = cooperative_groups;
constexpr int NWAVES = 8;
constexpr int BATCH = 8, SEQ = 4096, D = 1024, T = BATCH * SEQ;
constexpr int HD = 64, NQH = 8, NKVH = 2, QW = NQH * HD, KVW = NKVH * HD;
constexpr int LRU_W = 1024, LRU_NB = 16, LRU_BW = 64;
constexpr int INW = QW + 2 * KVW + 2 * LRU_W + 2 * D;
constexpr int NE = 32, TOPK = 4, DFF = 1024;
constexpr float NORM_EPS = 1e-6f;
constexpr int ARW = QW + LRU_W;
constexpr int ECAP = T;
constexpr int MAXBLK = (T * TOPK) / 256 + NE;
constexpr int MAX_GUNITS = 18;

constexpr size_t MiB = 1u << 20;
constexpr size_t WS_CTL = 0, CTL_ZERO_BYTES = 64 * 1024;
constexpr size_t WS_TOKL = 1 * MiB, WS_GATEL = 5 * MiB, WS_TOKREC = 9 * MiB;
constexpr size_t WS_WIN = 10 * MiB, WS_WCAT = 20 * MiB, WS_WO = 23 * MiB, WS_WGU = 26 * MiB, WS_WD = 154 * MiB;
constexpr size_t WS_XN = 218 * MiB;
constexpr size_t WS_Q = 282 * MiB, WS_KV = 314 * MiB, WS_AR = 330 * MiB, WS_XR = 426 * MiB, WS_YR = 490 * MiB, WS_GL = 554 * MiB;
constexpr size_t WS_MERGED = WS_XR;
constexpr size_t WS_X1B = WS_YR;
constexpr size_t WS_ACT = 282 * MiB, WS_Y = 554 * MiB, WS_END = 826 * MiB;
static_assert(WS_ACT + (size_t)MAXBLK * 256 * DFF * 2 <= WS_Y && WS_Y + (size_t)MAXBLK * 256 * D * 2 <= WS_END, "ws map");
constexpr int CW_CNT = 0;
constexpr int CW_BAR = 1024;

constexpr int RING_BYTES = 131072;
constexpr int GTAB_OFF = RING_BYTES;
constexpr int ETAB_OFF = GTAB_OFF + MAX_GUNITS * 512;
constexpr int MISC_OFF = ETAB_OFF + MAX_GUNITS * 1024;
constexpr int LDS_BYTES = MISC_OFF + 2048;
static_assert(LDS_BYTES <= 163840, "LDS");

#define GAS __attribute__((address_space(1)))
#define LAS __attribute__((address_space(3)))
typedef unsigned short bf16;
typedef unsigned v4u __attribute__((ext_vector_type(4)));
typedef unsigned v2u __attribute__((ext_vector_type(2)));
typedef float f32x4 __attribute__((ext_vector_type(4)));
typedef float f32x2 __attribute__((ext_vector_type(2)));
typedef short bf16x8 __attribute__((ext_vector_type(8)));
#define LDS_WAIT() asm volatile("s_waitcnt lgkmcnt(0)" ::: "memory")
__device__ __forceinline__ unsigned f2bf(float f) { unsigned u = __builtin_bit_cast(unsigned, f); return (u + 0x7fffu + ((u >> 16) & 1u)) >> 16; }
__device__ __forceinline__ unsigned pk2(float lo, float hi) { unsigned r; asm("v_cvt_pk_bf16_f32 %0, %1, %2" : "=v"(r) : "v"(lo), "v"(hi)); return r; }
__device__ __forceinline__ float bflo(unsigned w) { return __uint_as_float(w << 16); }
__device__ __forceinline__ float bfhi(unsigned w) { return __uint_as_float(w & 0xffff0000u); }
__device__ __forceinline__ float wave_sum(float v) {
#pragma unroll
    for (int o = 1; o < 64; o <<= 1) v += __shfl_xor(v, o);
    return v;
}
__device__ __forceinline__ float sigmoidf_fast(float x) { return __builtin_amdgcn_rcpf(1.0f + __builtin_amdgcn_exp2f(-1.4426950408889634f * x)); }

constexpr float WSCALE = 32.0f, WSCALE_INV = 1.0f / 32.0f;
struct Frame {
    LAS unsigned char* lds;
    int tid, lane, wave, vcu, G;
    const float* const* in;
    float* out; unsigned char* ws;
};
enum { I_X = 0, I_N1G, I_WIN, I_BIN, I_QNG, I_KNG, I_CONVW, I_CONVB, I_WA, I_BA, I_WI, I_BI, I_LAM, I_WAO, I_WLO, I_WOUT, I_N2G, I_WR, I_BR, I_WGU, I_BGU, I_WDN, I_BDN, I_FG };

struct P0Item { const float* src; int N; unsigned char* dst; int ldtB; int fp8; };
__device__ __forceinline__ P0Item p0_decode(const Frame& F, int it) {
    constexpr int I_IN = 16 * (INW / 32), I_AO = 8 * 32, I_LO = 16 * 32, I_OUT = 16 * 32, I_GU1 = 16 * 64, I_DN1 = 16 * 32;
    unsigned char* ws = F.ws; P0Item d; int r = it;
    if (r < I_IN) { const int nblk = INW / 32, kb = r / nblk, nb = r % nblk; d.src = F.in[I_WIN] + (size_t)(64 * kb) * INW + 32 * nb; d.N = INW; d.dst = ws + WS_WIN + ((size_t)(32 * nb) * D + 64 * kb) * 2; d.ldtB = D * 2; d.fp8 = 0; return d; } r -= I_IN;
    if (r < I_AO) { const int kb = r / 32, nb = r % 32; d.src = F.in[I_WAO] + (size_t)(64 * kb) * D + 32 * nb; d.N = D; d.dst = ws + WS_WCAT + ((size_t)(32 * nb) * ARW + 64 * kb) * 2; d.ldtB = ARW * 2; d.fp8 = 0; return d; } r -= I_AO;
    if (r < I_LO) { const int kb = r / 32, nb = r % 32; d.src = F.in[I_WLO] + (size_t)(64 * kb) * D + 32 * nb; d.N = D; d.dst = ws + WS_WCAT + ((size_t)(32 * nb) * ARW + QW + 64 * kb) * 2; d.ldtB = ARW * 2; d.fp8 = 0; return d; } r -= I_LO;
    if (r < I_OUT) { const int kb = r / 32, nb = r % 32; d.src = F.in[I_WOUT] + (size_t)(64 * kb) * D + 32 * nb; d.N = D; d.dst = ws + WS_WO + ((size_t)(32 * nb) * D + 64 * kb) * 2; d.ldtB = D * 2; d.fp8 = 0; return d; } r -= I_OUT;
    if (r < NE * I_GU1) { const int e = r / I_GU1, q = r % I_GU1, kb = q / 64, nb = q % 64, n0 = 32 * nb;
        const int cc = n0 & 1023, isu = n0 >> 10, rowb = 256 * (cc >> 7) + 128 * isu + (cc & 127);
        d.src = F.in[I_WGU] + (size_t)e * D * 2 * DFF + (size_t)(64 * kb) * (2 * DFF) + n0; d.N = 2 * DFF; d.dst = ws + WS_WGU + (size_t)e * 2 * DFF * D + (size_t)rowb * D + 64 * kb; d.ldtB = D; d.fp8 = 1; return d; } r -= NE * I_GU1;
    { const int e = r / I_DN1, q = r % I_DN1, kb = q / 32, nb = q % 32;
        d.src = F.in[I_WDN] + (size_t)e * DFF * D + (size_t)(64 * kb) * D + 32 * nb; d.N = D; d.dst = ws + WS_WD + (size_t)e * D * DFF + (size_t)(32 * nb) * DFF + 64 * kb; d.ldtB = DFF; d.fp8 = 1; return d; }
}
__device__ __forceinline__ void p0_prologue(Frame& F) {
    LAS float* scr = (LAS float*)(F.lds + F.wave * 16384);
    const int gw = F.vcu * NWAVES + F.wave, NGW = F.G * NWAVES, lane = F.lane;
    unsigned char* ws = F.ws;
    constexpr int NITEMS = 16 * (INW / 32) + 8 * 32 + 16 * 32 + 16 * 32 + NE * 16 * 64 + NE * 16 * 32;
    float v[32];
    P0Item cur = p0_decode(F, gw < NITEMS ? gw : 0);
#define P0_LOAD(dst_, item_) do { const float* p_ = (item_).src + (size_t)(lane >> 5) * (item_).N + (lane & 31); const size_t st_ = (size_t)2 * (item_).N; _Pragma("unroll") for (int i_ = 0; i_ < 32; ++i_) dst_[i_] = __builtin_nontemporal_load(p_ + i_ * st_); } while (0)
    if (gw < NITEMS) P0_LOAD(v, cur);
    for (int it = gw; it < NITEMS; it += NGW) {
        const int nit = it + NGW; const bool hn = nit < NITEMS;
        const P0Item nxt = p0_decode(F, hn ? nit : it);
        float vn[32];
        if (hn) P0_LOAD(vn, nxt);
#pragma unroll
        for (int i = 0; i < 32; ++i) scr[(2 * i + (lane >> 5)) * 33 + (lane & 31)] = v[i];
        LDS_WAIT(); asm volatile("" ::: "memory");
        const int c = lane & 7;
#pragma unroll
        for (int j = 0; j < 4; ++j) { const int n = (lane >> 3) + 8 * j; const LAS float* s = scr + (8 * c) * 33 + n;
            if (cur.fp8) { int lo = 0, hi = 0;
                lo = __builtin_amdgcn_cvt_pk_fp8_f32(s[0 * 33] * WSCALE, s[1 * 33] * WSCALE, lo, false); lo = __builtin_amdgcn_cvt_pk_fp8_f32(s[2 * 33] * WSCALE, s[3 * 33] * WSCALE, lo, true);
                hi = __builtin_amdgcn_cvt_pk_fp8_f32(s[4 * 33] * WSCALE, s[5 * 33] * WSCALE, hi, false); hi = __builtin_amdgcn_cvt_pk_fp8_f32(s[6 * 33] * WSCALE, s[7 * 33] * WSCALE, hi, true);
                *(GAS v2u*)(cur.dst + (size_t)n * cur.ldtB + 8 * c) = (v2u){(unsigned)lo, (unsigned)hi};
            } else { v4u o; o.x = pk2(s[0 * 33], s[1 * 33]); o.y = pk2(s[2 * 33], s[3 * 33]); o.z = pk2(s[4 * 33], s[5 * 33]); o.w = pk2(s[6 * 33], s[7 * 33]);
                *(GAS v4u*)(cur.dst + (size_t)n * cur.ldtB + 16 * c) = o; } }
        LDS_WAIT(); asm volatile("" ::: "memory");
        cur = nxt;
#pragma unroll
        for (int i = 0; i < 32; ++i) v[i] = vn[i];
    }
#undef P0_LOAD
    const GAS f32x4* gp = (const GAS f32x4*)F.in[I_N1G] + lane;
    f32x4 g[4];
#pragma unroll
    for (int j = 0; j < 4; ++j) g[j] = gp[64 * j];
    bf16* XN = (bf16*)(ws + WS_XN);
    for (int m = gw; m < T; m += 2 * NGW) {
        const int m2 = (m + NGW < T) ? m + NGW : m;
        const GAS f32x4* xr = (const GAS f32x4*)(F.in[I_X] + (size_t)m * D) + lane; const GAS f32x4* xr2 = (const GAS f32x4*)(F.in[I_X] + (size_t)m2 * D) + lane;
        f32x4 va[4], vb[4]; float sa = 0.f, sb = 0.f;
#pragma unroll
        for (int j = 0; j < 4; ++j) { va[j] = __builtin_nontemporal_load(xr + 64 * j); vb[j] = __builtin_nontemporal_load(xr2 + 64 * j); }
#pragma unroll
        for (int j = 0; j < 4; ++j) { sa += (va[j].x * va[j].x + va[j].y * va[j].y) + (va[j].z * va[j].z + va[j].w * va[j].w); sb += (vb[j].x * vb[j].x + vb[j].y * vb[j].y) + (vb[j].z * vb[j].z + vb[j].w * vb[j].w); }
        const float ra = 1.0f / sqrtf(wave_sum(sa) * (1.f / D) + NORM_EPS), rb = 1.0f / sqrtf(wave_sum(sb) * (1.f / D) + NORM_EPS);
        GAS unsigned long long* oa = (GAS unsigned long long*)(XN + (size_t)m * D) + lane; GAS unsigned long long* ob = (GAS unsigned long long*)(XN + (size_t)m2 * D) + lane;
#pragma unroll
        for (int j = 0; j < 4; ++j) { const f32x4 ya = va[j] * ra * g[j], yb = vb[j] * rb * g[j];
            oa[64 * j] = (unsigned long long)pk2(ya.x, ya.y) | ((unsigned long long)pk2(ya.z, ya.w) << 32); ob[64 * j] = (unsigned long long)pk2(yb.x, yb.y) | ((unsigned long long)pk2(yb.z, yb.w) << 32); }
    }
}

#ifndef REP_MASK
#define REP_MASK 0
#endif
#ifndef PROBE_K2X
#define PROBE_K2X 0
#endif
struct DenseSched {
    const char* A; const char* B; int nM, nN, nt, G, c; size_t tstepA, tstepB; int rs;
    __device__ __forceinline__ bool next(int i, pg8::Unit& u) const { const long L = (long)(i >> rs) * G + c; if (L >= (long)nM * nN) return false; pg8::dense_tile((int)L, nM, nN, u.pm, u.pn); u.aux = 0; return true; }
    __device__ __forceinline__ const char* a_ptr(const pg8::Unit& u) const { return A + (size_t)u.pm * tstepA; }
    __device__ __forceinline__ const char* b_ptr(const pg8::Unit& u) const { return B + (size_t)u.pn * tstepB; }
    __device__ __forceinline__ int ntiles(const pg8::Unit&) const { return nt; }
};
struct MergeSched {
    const char* A; const char* B; int G, c;
    __device__ __forceinline__ bool next(int i, pg8::Unit& u) const { const long L = (long)(i >> (1 + ((REP_MASK >> 4) & 1))) * G + c; if (L >= 128 * 4) return false; pg8::dense_tile((int)L, 128, 4, u.pm, u.pn); u.aux = i & 1; return true; }
    __device__ __forceinline__ const char* a_ptr(const pg8::Unit& u) const { return A + (size_t)u.pm * (256 * ARW * 2) + (u.aux ? QW * 2 : 0); }
    __device__ __forceinline__ const char* b_ptr(const pg8::Unit& u) const { return B + (size_t)u.pn * (256 * ARW * 2) + (u.aux ? QW * 2 : 0); }
    __device__ __forceinline__ int ntiles(const pg8::Unit& u) const { return u.aux ? (LRU_W / 64) : (QW / 64); }
};
template <int NTN> struct MoeSched {
    const char* A; const char* B; const LAS int* nbp; int G, c; size_t estepB;
    __device__ __forceinline__ bool next(int i, pg8::Unit& u) const {
        const int NB = nbp[NE], U = NB * NTN; const long L = (long)(i >> ((NTN == 4) ? ((REP_MASK >> 8) & 1) : 0)) * G + c; if (L >= U) return false; const int seg_ = i & 1;
        int w = (int)L; { const int q = U / 8, r = U % 8, xcd = w % 8, off = w / 8; w = (xcd < r ? xcd * (q + 1) : r * (q + 1) + (xcd - r) * q) + off; }
        int e = 0;
        for (int k = 1; k < NE; ++k) e += (w >= nbp[k] * NTN) ? 1 : 0;
        const int b0 = nbp[e], nM = nbp[e + 1] - b0, wl = w - b0 * NTN;
        const int nig = 8 * NTN, gid = wl / nig, fm = gid * 8, gsz = (nM - fm) < 8 ? (nM - fm) : 8;
        const int rb = fm + ((wl % nig) % gsz); u.pn = (wl % nig) / gsz; u.pm = b0 + rb; u.aux = e | (rb << 8) | ((PROBE_K2X && NTN == 4) ? (seg_ << 30) : 0); return true;
    }
    __device__ __forceinline__ const char* a_ptr(const pg8::Unit& u) const { return A; }
    __device__ __forceinline__ const char* b_ptr(const pg8::Unit& u) const { return B + (size_t)(u.aux & 0xff) * estepB + (size_t)u.pn * (256 * D); }
    __device__ __forceinline__ int ntiles(const pg8::Unit&) const { return D / 128; }
};
struct MoeDownSched : MoeSched<4> {
    __device__ __forceinline__ const char* a_ptr(const pg8::Unit& u) const { return A + (size_t)u.pm * (256 * DFF); }
};

__device__ __forceinline__ float gelu_tanh_f(float y) { const float z = y * (0.7978845608028654f + 0.035677408136300125f * y * y); return y * __builtin_amdgcn_rcpf(1.0f + __builtin_amdgcn_exp2f(-2.0f * 1.4426950408889634f * z)); }
struct EpiInProj {
    static constexpr bool PERM = true;
    unsigned char* ws; const LAS float* etab;
    __device__ __forceinline__ bool keep(const pg8::Unit&) const { return false; }
    __device__ __forceinline__ void operator()(pg8::f32x4 (&acc)[2][2][4][2], const pg8::Unit& u, int wr, int wc, int fr, int fq) const {
        using namespace pg8;
        const int pn = u.pn; bf16_t* base; int ldc, colt;
        if (pn < 2) { base = (bf16_t*)(ws + WS_Q); ldc = QW; colt = pn * 256; }
        else if (pn == 2) { base = (bf16_t*)(ws + WS_KV); ldc = 2 * KVW; colt = 0; }
        else if (pn < 7) { base = (bf16_t*)(ws + WS_XR); ldc = LRU_W; colt = (pn - 3) * 256; }
        else if (pn < 11) { base = (bf16_t*)(ws + WS_YR); ldc = LRU_W; colt = (pn - 7) * 256; }
        else { base = (bf16_t*)(ws + WS_GL); ldc = 2 * D; colt = (pn - 11) * 256; }
        const int row0 = u.pm * BM + wr * 64 + fr, col0 = colt + wc * 32 + 8 * fq; const bool isyr = (pn >= 7 && pn < 11);
        const LAS float* bias = etab + u.ui * 256 + wc * 32 + 8 * fq;
        f32x4 bv[2][2];
#pragma unroll
        for (int bj = 0; bj < 2; ++bj)
#pragma unroll
            for (int n = 0; n < 2; ++n) bv[bj][n] = *(const LAS f32x4*)(bias + bj * HALF + 4 * n);
#pragma unroll
        for (int ai = 0; ai < 2; ++ai)
#pragma unroll
            for (int m = 0; m < 4; ++m) { bf16_t* rowp = base + (size_t)(row0 + ai * HALF + m * 16) * ldc + col0;
#pragma unroll
                for (int bj = 0; bj < 2; ++bj) { f32x4 v0 = acc[ai][bj][m][0] + bv[bj][0], v1 = acc[ai][bj][m][1] + bv[bj][1];
                    if (isyr) {
#pragma unroll
                        for (int j = 0; j < 4; ++j) { v0[j] = gelu_tanh_f(v0[j]); v1[j] = gelu_tanh_f(v1[j]); } }
                    u32x4 w; w.x = cvt_pk_bf16(v0[0], v0[1]); w.y = cvt_pk_bf16(v0[2], v0[3]); w.z = cvt_pk_bf16(v1[0], v1[1]); w.w = cvt_pk_bf16(v1[2], v1[3]);
                    *(u32x4*)(rowp + bj * HALF) = w; } }
    }
};
struct EpiMerge {
    static constexpr bool PERM = true;
    const bf16* GL; bf16* MG;
    __device__ __forceinline__ bool keep(const pg8::Unit& u) const { return u.aux == 0; }
    __device__ __forceinline__ void operator()(pg8::f32x4 (&acc)[2][2][4][2], const pg8::Unit& u, int wr, int wc, int fr, int fq) const {
        using namespace pg8;
        const int row0 = u.pm * BM + wr * 64 + fr, col0 = u.pn * BM + wc * 32 + 8 * fq;
        if (u.aux == 0) {
#pragma unroll
            for (int ai = 0; ai < 2; ++ai)
#pragma unroll
                for (int m = 0; m < 4; ++m) { const bf16* gp = GL + (size_t)(row0 + ai * HALF + m * 16) * (2 * D) + col0;
#pragma unroll
                    for (int bj = 0; bj < 2; ++bj) { const u32x4 ga = *(const u32x4*)(gp + bj * HALF), gr = *(const u32x4*)(gp + D + bj * HALF);
#pragma unroll
                        for (int q = 0; q < 4; ++q) { const float a0 = bf_lo(ga[q]), a1 = bf_hi(ga[q]), r0 = bf_lo(gr[q]), r1 = bf_hi(gr[q]);
                            const float f0 = (1.0f + __builtin_amdgcn_exp2f(-1.4426950408889634f * r0)) * __builtin_amdgcn_rcpf(1.0f + __builtin_amdgcn_exp2f(-1.4426950408889634f * a0));
                            const float f1 = (1.0f + __builtin_amdgcn_exp2f(-1.4426950408889634f * r1)) * __builtin_amdgcn_rcpf(1.0f + __builtin_amdgcn_exp2f(-1.4426950408889634f * a1));
                            acc[ai][bj][m][q >> 1][(q & 1) * 2] *= f0; acc[ai][bj][m][q >> 1][(q & 1) * 2 + 1] *= f1; } } }
        } else {
#pragma unroll
            for (int ai = 0; ai < 2; ++ai)
#pragma unroll
                for (int m = 0; m < 4; ++m) { const size_t ro = (size_t)(row0 + ai * HALF + m * 16); const bf16* gp = GL + ro * (2 * D) + D + col0; bf16* op = MG + ro * D + col0;
#pragma unroll
                    for (int bj = 0; bj < 2; ++bj) { const u32x4 gr = *(const u32x4*)(gp + bj * HALF); u32x4 w;
#pragma unroll
                        for (int q = 0; q < 4; ++q) { const float s0 = fast_sigmoid(bf_lo(gr[q])), s1 = fast_sigmoid(bf_hi(gr[q]));
                            w[q] = cvt_pk_bf16(acc[ai][bj][m][q >> 1][(q & 1) * 2] * s0, acc[ai][bj][m][q >> 1][(q & 1) * 2 + 1] * s1); }
                        *(u32x4*)(op + bj * HALF) = w; } }
        }
    }
};
struct EpiResF32 {
    static constexpr bool PERM = false;
    const float* X; bf16* O;
    __device__ __forceinline__ bool keep(const pg8::Unit&) const { return false; }
    __device__ __forceinline__ void operator()(pg8::f32x4 (&acc)[2][2][4][2], const pg8::Unit& u, int wr, int wc, int fr, int fq) const {
        using namespace pg8;
        const int row0 = u.pm * BM + wr * 64 + fr, col0 = u.pn * BM + wc * 32 + 4 * fq;
#pragma unroll
        for (int ai = 0; ai < 2; ++ai)
#pragma unroll
            for (int m = 0; m < 4; ++m) { const size_t off = (size_t)(row0 + ai * HALF + m * 16) * D + col0;
#pragma unroll
                for (int bj = 0; bj < 2; ++bj)
#pragma unroll
                    for (int n = 0; n < 2; ++n) { const f32x4 v = __builtin_nontemporal_load((const f32x4*)(X + off + bj * HALF + n * 16)) + acc[ai][bj][m][n];
                        *(u32x2*)(O + off + bj * HALF + n * 16) = (u32x2){cvt_pk_bf16(v[0], v[1]), cvt_pk_bf16(v[2], v[3])}; } }
    }
};
struct EpiSwiGLU {
    static constexpr bool PERM = true;
    const LAS float* etab; unsigned char* ACT;
    __device__ __forceinline__ bool keep(const pg8::Unit&) const { return false; }
    __device__ __forceinline__ void operator()(pg8::f32x4 (&acc)[2][2][4][2], const pg8::Unit& u, int wr, int wc, int fr, int fq) const {
        using namespace pg8;
        const int cl = wc * 32 + 8 * fq, col0 = u.pn * 128 + cl, row0 = u.pm * BM + wr * 64 + fr;
        const LAS float* bp = etab + u.ui * 256 + cl;
        const f32x4 bg0 = *(const LAS f32x4*)(bp), bg1 = *(const LAS f32x4*)(bp + 4), bu0 = *(const LAS f32x4*)(bp + 128), bu1 = *(const LAS f32x4*)(bp + 132);
#pragma unroll
        for (int ai = 0; ai < 2; ++ai)
#pragma unroll
            for (int m = 0; m < 4; ++m) { u32x2 w;
#pragma unroll
                for (int n = 0; n < 2; ++n) { const f32x4 g = acc[ai][0][m][n] * WSCALE_INV + (n ? bg1 : bg0), uu = acc[ai][1][m][n] * WSCALE_INV + (n ? bu1 : bu0); float a[4];
#pragma unroll
                    for (int j = 0; j < 4; ++j) { const float gg = fminf(g[j], 7.0f), uc = fminf(fmaxf(uu[j], -7.0f), 7.0f);
                        a[j] = gg * __builtin_amdgcn_rcpf(1.0f + __builtin_amdgcn_exp2f(-1.702f * 1.4426950408889634f * gg)) * (uc + 1.0f); }
                    int pk = 0; pk = __builtin_amdgcn_cvt_pk_fp8_f32(a[0], a[1], pk, false); pk = __builtin_amdgcn_cvt_pk_fp8_f32(a[2], a[3], pk, true); w[n] = (unsigned)pk; }
                *(u32x2*)(ACT + (size_t)(row0 + ai * HALF + m * 16) * DFF + col0) = w; }
    }
};
struct EpiDown {
    static constexpr bool PERM = true;
    const LAS float* etab; const LAS float* gtab2; bf16* Y;
    __device__ __forceinline__ bool keep(const pg8::Unit& u) const { return PROBE_K2X && ((u.aux >> 30) & 1) == 0; }
    __device__ __forceinline__ void operator()(pg8::f32x4 (&acc)[2][2][4][2], const pg8::Unit& u, int wr, int wc, int fr, int fq) const {
        using namespace pg8;
        if (PROBE_K2X && ((u.aux >> 30) & 1) == 0) return;
        const int tui = PROBE_K2X ? (u.ui >> 1) : u.ui; const float ksc = PROBE_K2X ? 0.5f * WSCALE_INV : WSCALE_INV;
        const int col0 = u.pn * BM + wc * 32 + 8 * fq, rl0 = wr * 64 + fr;
        const LAS float* bias = etab + tui * 256 + wc * 32 + 8 * fq;
        f32x4 bv[2][2];
#pragma unroll
        for (int bj = 0; bj < 2; ++bj)
#pragma unroll
            for (int n = 0; n < 2; ++n) bv[bj][n] = *(const LAS f32x4*)(bias + bj * HALF + 4 * n);
        const LAS float* gl = gtab2 + tui * 256;
#pragma unroll
        for (int ai = 0; ai < 2; ++ai)
#pragma unroll
            for (int m = 0; m < 4; ++m) { const int rl = rl0 + ai * HALF + m * 16; const float gt = gl[rl]; bf16* rowp = Y + (size_t)(u.pm * BM + rl) * D + col0;
#pragma unroll
                for (int bj = 0; bj < 2; ++bj) { const f32x4 v0 = (acc[ai][bj][m][0] * ksc + bv[bj][0]) * gt, v1 = (acc[ai][bj][m][1] * ksc + bv[bj][1]) * gt;
                    u32x4 w; w.x = cvt_pk_bf16(v0[0], v0[1]); w.y = cvt_pk_bf16(v0[2], v0[3]); w.z = cvt_pk_bf16(v1[0], v1[1]); w.w = cvt_pk_bf16(v1[2], v1[3]);
                    *(u32x4*)(rowp + bj * HALF) = w; } }
    }
};

__device__ __forceinline__ v4u fix_vals(const v4u raw, const float* g8, float scale, int c, int prow, int pcol, const LAS f32x2* tab) {
    float v[8];
#pragma unroll
    for (int q = 0; q < 4; ++q) { v[2 * q] = bflo(raw[q]); v[2 * q + 1] = bfhi(raw[q]); }
    float ss = 0.f;
#pragma unroll
    for (int j = 0; j < 8; ++j) ss += v[j] * v[j];
    ss += __shfl_xor(ss, 1); ss += __shfl_xor(ss, 2); ss += __shfl_xor(ss, 4);
    const float rstd = 1.0f / sqrtf(ss * (1.0f / HD) + NORM_EPS);
    const int pos = (c >> 2) ? pcol : prow; const bool second = (c >> 1) & 1; const int f0 = (c & 1) * 8;
    float o[8];
#pragma unroll
    for (int j = 0; j < 8; ++j) { const float y = v[j] * rstd * g8[j]; const float pr = __shfl_xor(y, 2); const f32x2 cs = tab[pos * 16 + f0 + j];
        o[j] = (second ? (y * cs.x + pr * cs.y) : (y * cs.x - pr * cs.y)) * scale; }
    v4u w; w.x = pk2(o[0], o[1]); w.y = pk2(o[2], o[3]); w.z = pk2(o[4], o[5]); w.w = pk2(o[6], o[7]);
    return w;
}
__device__ __forceinline__ void p2_fixup(Frame& F) {
    LAS f32x2* tab = (LAS f32x2*)(F.lds);
    for (int idx = F.tid; idx < 1024; idx += NWAVES * 64) { const int pos = idx >> 4, f = idx & 15; const float inv = powf(10000.0f, -(float)f / 16.0f); const float ang = (float)pos * inv;
        tab[idx] = (f32x2){cosf(ang), sinf(ang)}; }
    __syncthreads();
    const int gw = F.vcu * NWAVES + F.wave, NGW = F.G * NWAVES, c = F.lane & 7;
    float gq[8], gk[8];
#pragma unroll
    for (int j = 0; j < 8; ++j) { gq[j] = F.in[I_QNG][8 * c + j]; gk[j] = F.in[I_KNG][8 * c + j]; }
    bf16* Q = (bf16*)(F.ws + WS_Q); bf16* KV = (bf16*)(F.ws + WS_KV);
    for (int t0 = gw; t0 < T; t0 += 4 * NGW) {
        v4u rq[4], rk[4]; int tt[4];
#pragma unroll
        for (int i = 0; i < 4; ++i) { const int t = t0 + i * NGW; tt[i] = t < T ? t : t0;
            rq[i] = *(const GAS v4u*)(Q + (size_t)tt[i] * QW + F.lane * 8); rk[i] = *(const GAS v4u*)(KV + (size_t)tt[i] * (2 * KVW) + (F.lane & 15) * 8); }
#pragma unroll
        for (int i = 0; i < 4; ++i) { const int t = tt[i], s = t & (SEQ - 1), prow = s >> 6, pcol = s & 63;
            const v4u wq = fix_vals(rq[i], gq, attn_body::C2, c, prow, pcol, tab);
            const v4u wk = fix_vals(rk[i], gk, 1.0f, c, prow, pcol, tab);
            if (t0 + i * NGW < T) { *(GAS v4u*)(Q + (size_t)t * QW + F.lane * 8) = wq; if (F.lane < 16) *(GAS v4u*)(KV + (size_t)t * (2 * KVW) + F.lane * 8) = wk; } }
    }
    __syncthreads();
}
constexpr int LRU_CH = 256;
constexpr int LRU_XC_STRIDE = 144;
constexpr int LRU_BUF = LRU_CH * LRU_XC_STRIDE;
constexpr int LRU_WT = 4 * LRU_BUF;
static_assert(LRU_BUF >= 256 * 33 * 4 && LRU_WT + 2048 + 5 * 64 * 4 <= MISC_OFF, "lru lds");

__device__ __forceinline__ float gelu_tanh(float y) { const float z = 0.7978845608028654f * (y + 0.044715f * y * y * y); return y * sigmoidf_fast(2.0f * z); }

#ifndef LRU_DUP
#define LRU_DUP 0
#endif
template <int DIR> __device__ __forceinline__ void lru_dir(Frame& F, int b, int n, int half) {
    LAS unsigned char* lds = F.lds;
    int tid_ = F.tid; asm volatile("" : "+v"(tid_));
    unsigned char* ws_ = F.ws; asm volatile("" : "+s"(ws_));
    const int tid = tid_, lane = tid & 63, wave = __builtin_amdgcn_readfirstlane(tid >> 6);
    constexpr int g = DIR; const int w = wave & 3, tl = tid & 255;
#define PHY(p_) (DIR ? 255 - (p_) : (p_))
    const int ch16 = lane & 15, q = lane >> 4, ct = w & 1, th = w >> 1;
    const int cl = 16 * ct + ch16, co_l = 32 * half + cl, cgl = 64 * n + co_l;
    constexpr float NL2E = -1.4426950408889634f;
    bf16x8 Ba[2], Bi[2], Bid;
    { const float* wa = F.in[I_WA] + ((size_t)(g * LRU_NB + n) * 64) * 64 + co_l; const float* wi = F.in[I_WI] + ((size_t)(g * LRU_NB + n) * 64) * 64 + co_l;
#pragma unroll
      for (int ks = 0; ks < 2; ++ks)
#pragma unroll
          for (int j = 0; j < 8; ++j) { const int k = 32 * ks + 8 * q + j; Ba[ks][j] = (short)f2bf(NL2E * wa[(size_t)k * 64]); Bi[ks][j] = (short)f2bf(NL2E * wi[(size_t)k * 64]); }
#pragma unroll
      for (int j = 0; j < 8; ++j) Bid[j] = (short)((8 * q + j == 16 * ct + ch16) ? 0x3F80 : 0); }
    const float ba = NL2E * F.in[I_BA][(g * LRU_NB + n) * 64 + co_l], bi = NL2E * F.in[I_BI][(g * LRU_NB + n) * 64 + co_l];
    const float lam = F.in[I_LAM][g * LRU_W + cgl];
    const float clam = -8.0f * log1pf(expf(-lam)) * 1.4426950408889634f;
    const int c8 = tl & 7, tg = tl >> 3;
    LAS float* cwl = (LAS float*)(lds + LRU_WT + 2048);
    for (int i = tid; i < 5 * 64; i += NWAVES * 64) { const int j = i >> 6, c = i & 63; cwl[i] = (j < 4) ? F.in[I_CONVW][j * LRU_W + 64 * n + c] : F.in[I_CONVB][64 * n + c]; }
    __syncthreads();
    const bf16* XR = (const bf16*)(ws_ + WS_XR) + (size_t)b * SEQ * LRU_W + 64 * n + 8 * c8;
    const bf16* YR = (const bf16*)(ws_ + WS_YR) + (size_t)b * SEQ * LRU_W + 64 * n + 32 * half;
    bf16* AR = (bf16*)(ws_ + WS_AR) + (size_t)b * SEQ * ARW + QW + 64 * n + 32 * half;
    constexpr int NST = SEQ / LRU_CH;
    v4u xrp[11];
#define LRU_LOADX(pc_) do { const int s0_ = (pc_) * LRU_CH + 8 * tg - 1; _Pragma("unroll") for (int i_ = 0; i_ < 11; ++i_) { const int s_ = s0_ + i_; \
        const int sc_ = s_ < 0 ? 0 : (s_ >= SEQ ? SEQ - 1 : s_); const v4u t_ = *(const GAS v4u*)(XR + (size_t)sc_ * LRU_W); const unsigned m_ = (s_ >= 0 && s_ < SEQ) ? 0xffffffffu : 0u; \
        xrp[i_] = (v4u){t_.x & m_, t_.y & m_, t_.z & m_, t_.w & m_}; } } while (0)
    LRU_LOADX(g ? NST - 1 : 0);
    float hcarry = 0.f;
    for (int k = 0; k < NST; ++k) {
        const int pc = g ? (NST - 1 - k) : k, par = k & 1;
        LAS unsigned char* buf = lds + (g * 2 + par) * LRU_BUF;
        unsigned aA = (unsigned)((DIR ? (255 - 128 * th - ch16 - 112) : (128 * th + ch16)) * LRU_XC_STRIDE + q * 16);
        unsigned aX = (unsigned)((DIR ? (255 - 128 * th - 4 * q - 115) : (128 * th + 4 * q)) * LRU_XC_STRIDE + co_l * 2);
        unsigned aH = (unsigned)(((DIR ? (255 - 128 * th - 4 * q - 115) : (128 * th + 4 * q)) * 33 + cl) * 4);
        asm volatile("" : "+v"(aA), "+v"(aX), "+v"(aH));
#define OFS(c_, m_) (DIR ? ((m_) - (c_)) : (c_))
#pragma unroll 1
        for (int dup_ = 0; dup_ < 1 + (LRU_DUP & 1); ++dup_) { asm volatile("" : "+v"(xrp[0].x));
        { f32x2 cw[4][4], cb[4];
#pragma unroll
          for (int j = 0; j < 4; ++j) { const f32x4 c0 = *(const LAS f32x4*)(cwl + j * 64 + 8 * c8), c1 = *(const LAS f32x4*)(cwl + j * 64 + 8 * c8 + 4);
              cw[j][0] = (f32x2){c0.x, c0.y}; cw[j][1] = (f32x2){c0.z, c0.w}; cw[j][2] = (f32x2){c1.x, c1.y}; cw[j][3] = (f32x2){c1.z, c1.w}; }
          { const f32x4 c0 = *(const LAS f32x4*)(cwl + 256 + 8 * c8), c1 = *(const LAS f32x4*)(cwl + 256 + 8 * c8 + 4); cb[0] = (f32x2){c0.x, c0.y}; cb[1] = (f32x2){c0.z, c0.w}; cb[2] = (f32x2){c1.x, c1.y}; cb[3] = (f32x2){c1.z, c1.w}; }
#pragma unroll
          for (int tt = 0; tt < 8; ++tt) { f32x2 o[4];
#pragma unroll
            for (int i = 0; i < 4; ++i) o[i] = cb[i];
#pragma unroll
            for (int j = 0; j < 4; ++j) { const v4u raw = xrp[tt + j];
#pragma unroll
                for (int qq = 0; qq < 4; ++qq) { const f32x2 xv = (f32x2){bflo(raw[qq]), bfhi(raw[qq])}; o[qq] = __builtin_elementwise_fma(cw[j][qq], xv, o[qq]); } }
            v4u wv; wv.x = pk2(o[0].x, o[0].y); wv.y = pk2(o[1].x, o[1].y); wv.z = pk2(o[2].x, o[2].y); wv.w = pk2(o[3].x, o[3].y);
            *(LAS v4u*)(buf + (8 * tg + tt) * LRU_XC_STRIDE + c8 * 16) = wv; } } }
        if (k + 1 < NST) LRU_LOADX(g ? (NST - 2 - k) : (k + 1));
        const size_t trow = (size_t)pc * LRU_CH + tl;
        if (k == NST / 2) asm volatile("s_waitcnt vmcnt(0)" ::: "memory");
        __syncthreads();
        float Aloc[8][4], Hloc[8][4]; float AR_ = 1.f, HR_ = 0.f;
#pragma unroll 1
        for (int dup_ = 0; dup_ < 1 + ((LRU_DUP >> 1) & 1); ++dup_) { asm volatile("" : "+v"(aA), "+v"(aX));
#pragma unroll
        for (int rt = 0; rt < 8; ++rt) {
            const bf16x8 a0 = *(const LAS bf16x8*)(buf + aA + OFS(16 * rt, 112) * LRU_XC_STRIDE), a1 = *(const LAS bf16x8*)(buf + aA + OFS(16 * rt, 112) * LRU_XC_STRIDE + 64);
            f32x4 Da = (f32x4){ba, ba, ba, ba}, Di = (f32x4){bi, bi, bi, bi}, Dx = (f32x4){0.f, 0.f, 0.f, 0.f};
            Da = __builtin_amdgcn_mfma_f32_16x16x32_bf16(a0, Ba[0], Da, 0, 0, 0); Da = __builtin_amdgcn_mfma_f32_16x16x32_bf16(a1, Ba[1], Da, 0, 0, 0);
            Di = __builtin_amdgcn_mfma_f32_16x16x32_bf16(a0, Bi[0], Di, 0, 0, 0); Di = __builtin_amdgcn_mfma_f32_16x16x32_bf16(a1, Bi[1], Di, 0, 0, 0);
            Dx = __builtin_amdgcn_mfma_f32_16x16x32_bf16(half ? a1 : a0, Bid, Dx, 0, 0, 0);
#pragma unroll
            for (int j = 0; j < 4; ++j) {
                const float r = __builtin_amdgcn_rcpf(1.0f + __builtin_amdgcn_exp2f(Da[j])), ig = __builtin_amdgcn_rcpf(1.0f + __builtin_amdgcn_exp2f(Di[j]));
                const float a = __builtin_amdgcn_exp2f(clam * r);
                Aloc[rt][j] = a; Hloc[rt][j] = __builtin_amdgcn_sqrtf(__builtin_fmaf(-a, a, 1.0f)) * (ig * Dx[j]); }
        }
        float Ai[8], Hi[8], Ae[8], He[8];
#pragma unroll
        for (int rt = 0; rt < 8; ++rt) {
#pragma unroll
            for (int j = 1; j < 4; ++j) { Hloc[rt][j] = Aloc[rt][j] * Hloc[rt][j - 1] + Hloc[rt][j]; Aloc[rt][j] = Aloc[rt][j - 1] * Aloc[rt][j]; }
            Ai[rt] = Aloc[rt][3]; Hi[rt] = Hloc[rt][3]; }
#pragma unroll
        for (int rt = 0; rt < 8; ++rt) { const float An = __shfl(Ai[rt], (lane - 16) & 63), Hn = __shfl(Hi[rt], (lane - 16) & 63); if (q >= 1) { Hi[rt] = Ai[rt] * Hn + Hi[rt]; Ai[rt] = An * Ai[rt]; } }
#pragma unroll
        for (int rt = 0; rt < 8; ++rt) { const float An = __shfl(Ai[rt], (lane - 32) & 63), Hn = __shfl(Hi[rt], (lane - 32) & 63); if (q >= 2) { Hi[rt] = Ai[rt] * Hn + Hi[rt]; Ai[rt] = An * Ai[rt]; } }
#pragma unroll
        for (int rt = 0; rt < 8; ++rt) { Ae[rt] = __shfl(Ai[rt], (lane - 16) & 63); He[rt] = __shfl(Hi[rt], (lane - 16) & 63); if (q == 0) { Ae[rt] = 1.f; He[rt] = 0.f; }
            Ai[rt] = __shfl(Ai[rt], ch16 + 48); Hi[rt] = __shfl(Hi[rt], ch16 + 48); }
        AR_ = 1.f; HR_ = 0.f;
#pragma unroll
        for (int rt = 0; rt < 8; ++rt) {
            const float Ap = AR_ * Ae[rt], Hp = Ae[rt] * HR_ + He[rt];
#pragma unroll
            for (int j = 0; j < 4; ++j) { Hloc[rt][j] = Aloc[rt][j] * Hp + Hloc[rt][j]; Aloc[rt][j] = Ap * Aloc[rt][j]; }
            HR_ = Ai[rt] * HR_ + Hi[rt]; AR_ = AR_ * Ai[rt]; }
        }
        LAS f32x2* WT = (LAS f32x2*)(lds + LRU_WT) + (g * 2 + par) * 64;
        if (q == 0) WT[th * 32 + cl] = (f32x2){AR_, HR_};
        __syncthreads();
        v4u yv[4], ov[4];
        if (k >= NST / 2) {
#pragma unroll
            for (int i = 0; i < 4; ++i) { yv[i] = __builtin_nontemporal_load((const GAS v4u*)(YR + trow * LRU_W) + i); ov[i] = *((const GAS v4u*)(AR + trow * ARW) + i); } }
        const f32x2 w0 = WT[cl], w1 = WT[32 + cl];
        const float hmid = w0.x * hcarry + w0.y;
        const float hin = th ? hmid : hcarry;
        hcarry = w1.x * hmid + w1.y;
        LAS float* HS = (LAS float*)buf;
#pragma unroll
        for (int rt = 0; rt < 8; ++rt)
#pragma unroll
            for (int j = 0; j < 4; ++j) *(LAS float*)(buf + aH + OFS(16 * rt + j, 115) * 132) = Hloc[rt][j] + Aloc[rt][j] * hin;
        __syncthreads();
#pragma unroll 1
        for (int dup_ = 0; dup_ < 1 + ((LRU_DUP >> 2) & 1); ++dup_) { asm volatile("" : "+v"(yv[0].x));
          float hv[32];
#pragma unroll
          for (int i = 0; i < 32; ++i) hv[i] = HS[tl * 33 + i];
          v4u wv[4];
          if (k < NST / 2) {
#pragma unroll
              for (int i = 0; i < 4; ++i) { wv[i].x = pk2(hv[8 * i], hv[8 * i + 1]); wv[i].y = pk2(hv[8 * i + 2], hv[8 * i + 3]); wv[i].z = pk2(hv[8 * i + 4], hv[8 * i + 5]); wv[i].w = pk2(hv[8 * i + 6], hv[8 * i + 7]); }
          } else {
#pragma unroll
              for (int i = 0; i < 4; ++i)
#pragma unroll
                  for (int qq = 0; qq < 4; ++qq) wv[i][qq] = pk2((hv[8 * i + 2 * qq] + bflo(ov[i][qq])) * bflo(yv[i][qq]), (hv[8 * i + 2 * qq + 1] + bfhi(ov[i][qq])) * bfhi(yv[i][qq]));
          }
          GAS v4u* op = (GAS v4u*)(AR + trow * ARW);
#pragma unroll
          for (int i = 0; i < 4; ++i) op[i] = wv[i]; }
    }
#undef LRU_LOADX
#undef PHY
#undef OFS
    __syncthreads();
}
__device__ __forceinline__ void p2_lru(Frame& F) {
    for (int it = F.vcu; it < BATCH * LRU_NB * 2; it += F.G) { if (F.wave < 4) lru_dir<0>(F, it >> 5, (it & 31) >> 1, it & 1); else lru_dir<1>(F, it >> 5, (it & 31) >> 1, it & 1); }
}

constexpr int RT_STRIDE = 1028;
constexpr int ROWINFO_OFF = GTAB_OFF + 1024;
__device__ __forceinline__ void p6_router(Frame& F, const bool dry) {
    LAS float* wT = (LAS float*)F.lds;
    LAS unsigned* misc = (LAS unsigned*)(F.lds + MISC_OFF);
    LAS unsigned* hist = misc + 128; LAS unsigned* basew = misc + 160;
    LAS v2u* rowinfo = (LAS v2u*)(F.lds + ROWINFO_OFF);
    const int tid = F.tid, lane = F.lane, wave = F.wave;
    for (int idx = tid; idx < D * NE; idx += NWAVES * 64) { const int k = idx >> 5, e = idx & 31; wT[e * RT_STRIDE + k] = F.in[I_WR][idx]; }
    if (tid < 32) hist[tid] = 0u;
    f32x4 g2[4];
#pragma unroll
    for (int j = 0; j < 4; ++j) g2[j] = *((const GAS f32x4*)F.in[I_N2G] + lane + 64 * j);
    const float brl = F.in[I_BR][lane >> 1];
    __syncthreads();
    const bf16* X1B = (const bf16*)(F.ws + WS_X1B);
    unsigned char* H2 = (unsigned char*)(F.ws + WS_XN);
    unsigned* gcnt = (unsigned*)(F.ws + WS_CTL) + CW_CNT;
    int* TOKL = (int*)(F.ws + WS_TOKL); float* GATEL = (float*)(F.ws + WS_GATEL); int* TOKREC = (int*)(F.ws + WS_TOKREC);
    for (int bi = F.vcu; bi < T / 128; bi += F.G) {
        const int rbase = bi * 128;
        for (int p = 0; p < 8; ++p) {
            const int rl0 = 16 * wave + 2 * p; const size_t r0 = (size_t)rbase + rl0;
            f32x4 h0[4], h1[4];
            { const GAS v2u* x0 = (const GAS v2u*)(X1B + r0 * D) + lane; const GAS v2u* x1 = (const GAS v2u*)(X1B + (r0 + 1) * D) + lane;
              float s0 = 0.f, s1 = 0.f;
#pragma unroll
              for (int j = 0; j < 4; ++j) { const v2u w0 = x0[64 * j], w1 = x1[64 * j]; h0[j] = (f32x4){bflo(w0.x), bfhi(w0.x), bflo(w0.y), bfhi(w0.y)}; h1[j] = (f32x4){bflo(w1.x), bfhi(w1.x), bflo(w1.y), bfhi(w1.y)};
                  s0 += (h0[j].x * h0[j].x + h0[j].y * h0[j].y) + (h0[j].z * h0[j].z + h0[j].w * h0[j].w); s1 += (h1[j].x * h1[j].x + h1[j].y * h1[j].y) + (h1[j].z * h1[j].z + h1[j].w * h1[j].w); }
              const float rs0 = 1.0f / sqrtf(wave_sum(s0) * (1.f / D) + NORM_EPS), rs1 = 1.0f / sqrtf(wave_sum(s1) * (1.f / D) + NORM_EPS);
              GAS unsigned* o0 = (GAS unsigned*)(H2 + r0 * D) + lane; GAS unsigned* o1 = (GAS unsigned*)(H2 + (r0 + 1) * D) + lane;
#pragma unroll
              for (int j = 0; j < 4; ++j) { h0[j] = h0[j] * rs0 * g2[j]; h1[j] = h1[j] * rs1 * g2[j];
                  int p0 = 0, p1 = 0; p0 = __builtin_amdgcn_cvt_pk_fp8_f32(h0[j].x, h0[j].y, p0, false); p0 = __builtin_amdgcn_cvt_pk_fp8_f32(h0[j].z, h0[j].w, p0, true);
                  p1 = __builtin_amdgcn_cvt_pk_fp8_f32(h1[j].x, h1[j].y, p1, false); p1 = __builtin_amdgcn_cvt_pk_fp8_f32(h1[j].z, h1[j].w, p1, true);
                  o0[64 * j] = (unsigned)p0; o1[64 * j] = (unsigned)p1; } }
            float a0[32], a1[32];
#pragma unroll
            for (int e = 0; e < 32; ++e) { float s0 = 0.f, s1 = 0.f;
#pragma unroll
                for (int j = 0; j < 4; ++j) { const f32x4 w = *(const LAS f32x4*)(wT + e * RT_STRIDE + 256 * j + 4 * lane);
                    s0 += (h0[j].x * w.x + h0[j].y * w.y) + (h0[j].z * w.z + h0[j].w * w.w); s1 += (h1[j].x * w.x + h1[j].y * w.y) + (h1[j].z * w.z + h1[j].w * w.w); }
                a0[e] = s0; a1[e] = s1; }
#define TRED(arr, N, MASK) _Pragma("unroll") for (int i = 0; i < (N); ++i) { const bool up = (lane & (MASK)) != 0; const float snd = up ? arr[i] : arr[i + (N)]; const float kp = up ? arr[i + (N)] : arr[i]; arr[i] = kp + __shfl_xor(snd, (MASK)); }
            TRED(a0, 16, 32) TRED(a0, 8, 16) TRED(a0, 4, 8) TRED(a0, 2, 4) TRED(a0, 1, 2)
            TRED(a1, 16, 32) TRED(a1, 8, 16) TRED(a1, 4, 8) TRED(a1, 2, 4) TRED(a1, 1, 2)
#undef TRED
            float lg[2]; lg[0] = a0[0] + __shfl_xor(a0[0], 1) + brl; lg[1] = a1[0] + __shfl_xor(a1[0], 1) + brl;
#pragma unroll
            for (int rr2 = 0; rr2 < 2; ++rr2) {
                float val = lg[rr2]; int te[4]; float tv[4];
#pragma unroll
                for (int k = 0; k < 4; ++k) { float m = val;
#pragma unroll
                    for (int o = 1; o < 64; o <<= 1) m = fmaxf(m, __shfl_xor(m, o));
                    const unsigned long long bal = __ballot(val == m); const int src = __builtin_ctzll(bal); te[k] = src >> 1; tv[k] = m; if ((lane >> 1) == te[k]) val = -INFINITY; }
                const float p1 = __expf(tv[1] - tv[0]), p2 = __expf(tv[2] - tv[0]), p3 = __expf(tv[3] - tv[0]); const float inv = 1.0f / (1.0f + p1 + p2 + p3);
                if (lane < 4) { const int e = lane == 0 ? te[0] : lane == 1 ? te[1] : lane == 2 ? te[2] : te[3]; const float gt = (lane == 0 ? 1.0f : lane == 1 ? p1 : lane == 2 ? p2 : p3) * inv;
                    const unsigned rank = atomicAdd((unsigned*)(hist + e), 1u);
                    rowinfo[(rl0 + rr2) * 4 + lane] = (v2u){(unsigned)e | (rank << 8), __float_as_uint(gt)}; }
            }
        }
        __syncthreads();
        if (tid < 32) basew[tid] = dry ? 0u : __hip_atomic_fetch_add(gcnt + tid, hist[tid], __ATOMIC_RELAXED, __HIP_MEMORY_SCOPE_AGENT);
        __syncthreads();
        { const int rl = tid >> 2, k = tid & 3; const v2u inf = rowinfo[rl * 4 + k]; const int e = inf.x & 0xff; const unsigned slot = basew[e] + (inf.x >> 8); const int t = rbase + rl;
          if (!dry) { TOKL[(size_t)e * ECAP + slot] = t; GATEL[(size_t)e * ECAP + slot] = __uint_as_float(inf.y); TOKREC[t * 4 + k] = (int)(((unsigned)e << 20) | slot); } }
        __syncthreads();
        if (tid < 32) hist[tid] = 0u;
        __syncthreads();
    }
}

__device__ __forceinline__ void moe_tables(Frame& F) {
    LAS int* misc = (LAS int*)(F.lds + MISC_OFF);
    const unsigned* gcnt = (const unsigned*)(F.ws + WS_CTL) + CW_CNT;
    if (F.tid < 32) misc[F.tid] = (int)__hip_atomic_load(gcnt + F.tid, __ATOMIC_RELAXED, __HIP_MEMORY_SCOPE_AGENT);
    __syncthreads();
    if (F.tid == 0) { int s = 0; for (int e = 0; e < NE; ++e) { misc[32 + e] = s; s += (misc[e] + 255) >> 8; } misc[32 + NE] = s; }
    __syncthreads();
}
constexpr int UDESC_WORD = 208;
template <class Sched> __device__ __forceinline__ int resolve_units(Frame& F, const Sched& S, int maxu, int stride) {
    LAS int* misc = (LAS int*)(F.lds + MISC_OFF);
    if (F.tid == 0) misc[UDESC_WORD - 1] = 0;
    __syncthreads();
    pg8::Unit u;
    for (int ui = F.wave; ui < maxu; ui += NWAVES) { if (!S.next(ui * stride, u)) break;
        if (F.lane == 0) { misc[UDESC_WORD + 3 * ui] = u.aux; misc[UDESC_WORD + 3 * ui + 1] = u.pn; misc[UDESC_WORD + 3 * ui + 2] = u.pm; atomicMax((int*)(misc + UDESC_WORD - 1), ui + 1); } }
    __syncthreads();
    return misc[UDESC_WORD - 1];
}
template <class Base> struct TabSched : Base {
    const LAS int* desc; int nu;
    __device__ __forceinline__ TabSched(const Base& b, const LAS int* d, int n) : Base(b), desc(d), nu(n) {}
    __device__ __forceinline__ bool next(int i, pg8::Unit& u) const { if (i >= nu) return false; u.aux = desc[3 * i]; u.pn = desc[3 * i + 1]; u.pm = desc[3 * i + 2]; return true; }
};
__device__ __forceinline__ int moe_gather_table(Frame& F, const MoeSched<8>& S) {
    LAS int* misc = (LAS int*)(F.lds + MISC_OFF); LAS unsigned short* gtab = (LAS unsigned short*)(F.lds + GTAB_OFF); LAS float* etab = (LAS float*)(F.lds + ETAB_OFF);
    const int* TOKL = (const int*)(F.ws + WS_TOKL);
    const int nu = resolve_units(F, S, MAX_GUNITS, 1);
    int tv[MAX_GUNITS / 2]; float bv[MAX_GUNITS / 2];
#pragma unroll
    for (int j = 0; j < MAX_GUNITS / 2; ++j) { const int idx = F.tid + 512 * j, ui = idx >> 8, r = idx & 255; tv[j] = 0; bv[j] = 0.f;
        if (ui < nu) { const int aux = misc[UDESC_WORD + 3 * ui], pn = misc[UDESC_WORD + 3 * ui + 1], e = aux & 0xff, rb = aux >> 8, slot = rb * 256 + r;
            tv[j] = TOKL[(size_t)e * ECAP + (slot < misc[e] ? slot : 0)]; if (slot >= misc[e]) tv[j] = 0;
            bv[j] = F.in[I_BGU][(size_t)e * (2 * DFF) + (r < 128 ? 0 : DFF - 128) + pn * 128 + r]; } }
#pragma unroll
    for (int j = 0; j < MAX_GUNITS / 2; ++j) { const int idx = F.tid + 512 * j; if ((idx >> 8) < nu) { gtab[idx] = (unsigned short)tv[j]; etab[idx] = bv[j]; } }
    __syncthreads();
    return nu;
}
__device__ __forceinline__ int moe_down_table(Frame& F, const MoeDownSched& S) {
    LAS int* misc = (LAS int*)(F.lds + MISC_OFF); LAS float* etab = (LAS float*)(F.lds + ETAB_OFF); LAS float* gt2 = (LAS float*)(F.lds + GTAB_OFF);
    const float* GATEL = (const float*)(F.ws + WS_GATEL);
    const int nu = resolve_units(F, S, 9, PROBE_K2X ? 2 : 1);
    float bv[5], gv[5];
#pragma unroll
    for (int j = 0; j < 5; ++j) { const int idx = F.tid + 512 * j, ui = idx >> 8, r = idx & 255; bv[j] = 0.f; gv[j] = 0.f;
        if (ui < nu) { const int aux = misc[UDESC_WORD + 3 * ui], pn = misc[UDESC_WORD + 3 * ui + 1], e = aux & 0xff, rb = (aux >> 8) & 0xffff;
            bv[j] = F.in[I_BDN][(size_t)e * D + pn * 256 + r]; gv[j] = GATEL[(size_t)e * ECAP + rb * 256 + r]; } }
#pragma unroll
    for (int j = 0; j < 5; ++j) { const int idx = F.tid + 512 * j; if ((idx >> 8) < nu) { etab[idx] = bv[j]; gt2[idx] = gv[j]; } }
    __syncthreads();
    return nu;
}
__device__ __forceinline__ int inproj_table(Frame& F, const DenseSched& S) {
    LAS int* misc = (LAS int*)(F.lds + MISC_OFF); LAS float* etab = (LAS float*)(F.lds + ETAB_OFF);
    const int nu = resolve_units(F, S, MAX_GUNITS, 1);
    float bv[MAX_GUNITS / 2];
#pragma unroll
    for (int j = 0; j < MAX_GUNITS / 2; ++j) { const int idx = F.tid + 512 * j, ui = idx >> 8, r = idx & 255; bv[j] = 0.f; if (ui < nu) bv[j] = F.in[I_BIN][misc[UDESC_WORD + 3 * ui + 1] * 256 + r]; }
#pragma unroll
    for (int j = 0; j < MAX_GUNITS / 2; ++j) { const int idx = F.tid + 512 * j; if ((idx >> 8) < nu) etab[idx] = bv[j]; }
    __syncthreads();
    return nu;
}

__device__ __forceinline__ void p1_fixup_own(Frame& F, int nu) {
    LAS int* misc = (LAS int*)(F.lds + MISC_OFF);
    bool any = false;
    for (int ui = 0; ui < nu; ++ui) any |= (misc[UDESC_WORD + 3 * ui + 1] <= 2);
    if (!any) return;
    asm volatile("s_waitcnt vmcnt(0)" ::: "memory"); __syncthreads();
    LAS f32x2* tab = (LAS f32x2*)(F.lds);
    for (int idx = F.tid; idx < 1024; idx += NWAVES * 64) { const int pos = idx >> 4, f = idx & 15; const float inv = powf(10000.0f, -(float)f / 16.0f); const float ang = (float)pos * inv;
        tab[idx] = (f32x2){cosf(ang), sinf(ang)}; }
    __syncthreads();
    const int c = F.lane & 7;
    float gq[8], gk[8];
#pragma unroll
    for (int j = 0; j < 8; ++j) { gq[j] = F.in[I_QNG][8 * c + j]; gk[j] = F.in[I_KNG][8 * c + j]; }
    bf16* Q = (bf16*)(F.ws + WS_Q); bf16* KV = (bf16*)(F.ws + WS_KV);
    for (int ui = 0; ui < nu; ++ui) {
        const int pn = misc[UDESC_WORD + 3 * ui + 1], pm = misc[UDESC_WORD + 3 * ui + 2];
        if (pn > 2) continue;
        if (pn < 2) {
            for (int it = 0; it < 16; it += 4) { v4u rq[4]; bf16* pp[4]; int tt[4];
#pragma unroll
                for (int i = 0; i < 4; ++i) { tt[i] = pm * 256 + 2 * (F.wave + 8 * (it + i)) + (F.lane >> 5); pp[i] = Q + (size_t)tt[i] * QW + pn * 256 + (F.lane & 31) * 8; rq[i] = *(const GAS v4u*)pp[i]; }
#pragma unroll
                for (int i = 0; i < 4; ++i) { const int sq = tt[i] & (SEQ - 1); *(GAS v4u*)pp[i] = fix_vals(rq[i], gq, attn_body::C2, c, sq >> 6, sq & 63, tab); } }
        } else {
            for (int it = 0; it < 8; it += 4) { v4u rk[4]; bf16* pp[4]; int tt[4];
#pragma unroll
                for (int i = 0; i < 4; ++i) { tt[i] = pm * 256 + 4 * (F.wave + 8 * (it + i)) + (F.lane >> 4); pp[i] = KV + (size_t)tt[i] * (2 * KVW) + (F.lane & 15) * 8; rk[i] = *(const GAS v4u*)pp[i]; }
#pragma unroll
                for (int i = 0; i < 4; ++i) { const int sq = tt[i] & (SEQ - 1); *(GAS v4u*)pp[i] = fix_vals(rk[i], gk, 1.0f, c, sq >> 6, sq & 63, tab); } }
        }
    }
    __syncthreads();
}

__device__ __forceinline__ void p10_final(Frame& F, float* dst) {
    LAS int* misc = (LAS int*)(F.lds + MISC_OFF);
    const int gw = F.vcu * NWAVES + F.wave, NGW = F.G * NWAVES, lane = F.lane;
    f32x4 g[4];
#pragma unroll
    for (int j = 0; j < 4; ++j) g[j] = *((const GAS f32x4*)F.in[I_FG] + lane + 64 * j);
    const int* TOKREC = (const int*)(F.ws + WS_TOKREC); const bf16* Y = (const bf16*)(F.ws + WS_Y); const bf16* X1B = (const bf16*)(F.ws + WS_X1B);
    typedef int v4i __attribute__((ext_vector_type(4)));
    v4i rec = (gw < T) ? *(const GAS v4i*)(TOKREC + (size_t)gw * 4) : (v4i){0, 0, 0, 0};
    for (int t = gw; t < T; t += NGW) {
        const int tn = t + NGW;
        const v4i recn = (tn < T) ? *(const GAS v4i*)(TOKREC + (size_t)tn * 4) : rec;
        const GAS v2u* xp = (const GAS v2u*)(X1B + (size_t)t * D) + lane;
        f32x4 v[4]; v2u yv[4][4];
#pragma unroll
        for (int k = 0; k < 4; ++k) { const unsigned rk = (unsigned)rec[k]; const int e = rk >> 20, slot = rk & 0xfffff;
            const GAS v2u* yp = (const GAS v2u*)(Y + ((size_t)misc[32 + e] * 256 + slot) * D) + lane;
#pragma unroll
            for (int j = 0; j < 4; ++j) yv[k][j] = __builtin_nontemporal_load(yp + 64 * j); }
#pragma unroll
        for (int j = 0; j < 4; ++j) { const v2u w = __builtin_nontemporal_load(xp + 64 * j); v[j] = (f32x4){bflo(w.x), bfhi(w.x), bflo(w.y), bfhi(w.y)}; }
#pragma unroll
        for (int k = 0; k < 4; ++k)
#pragma unroll
            for (int j = 0; j < 4; ++j) { const v2u w = yv[k][j]; v[j].x += bflo(w.x); v[j].y += bfhi(w.x); v[j].z += bflo(w.y); v[j].w += bfhi(w.y); }
        float s = 0.f;
#pragma unroll
        for (int j = 0; j < 4; ++j) s += (v[j].x * v[j].x + v[j].y * v[j].y) + (v[j].z * v[j].z + v[j].w * v[j].w);
        const float rstd = 1.0f / sqrtf(wave_sum(s) * (1.f / D) + NORM_EPS);
        GAS f32x4* op = (GAS f32x4*)(dst + (size_t)t * D) + lane;
#pragma unroll
        for (int j = 0; j < 4; ++j) __builtin_nontemporal_store(v[j] * rstd * g[j], op + 64 * j);
        rec = recn;
    }
}
typedef GAS unsigned gu32;
#define RLX_AGENT __ATOMIC_RELAXED, __HIP_MEMORY_SCOPE_AGENT
#define XB_TMO      128
#define XB_XCNT(j)  (256  + 64 * (j))
#define XB_XSUB(j)  (1280 + 64 * (j))
#define XB_XGEN(j)  (2304 + 64 * (j))
#define XB_TOP      3328
#define XB_TOPGEN   3392
#define XCD_BAR_WORDS 3456
#define XB_SPIN_CAP (1u << 18)

__device__ __forceinline__ unsigned xb_ld(unsigned* p)              { return __hip_atomic_load(p, __ATOMIC_RELAXED, __HIP_MEMORY_SCOPE_AGENT); }
__device__ __forceinline__ unsigned xb_add(unsigned* p, unsigned v) { return __hip_atomic_fetch_add(p, v, __ATOMIC_RELAXED, __HIP_MEMORY_SCOPE_AGENT); }
__device__ __forceinline__ unsigned xb_xcc_id() { return (unsigned)__builtin_amdgcn_s_getreg((3 << 11) | 20) & 0xFu; }
#define XB_SPIN(cond, bar) do { unsigned _sp = 0; while (cond) { __builtin_amdgcn_s_sleep(1); \
    if ((++_sp & 255u) == 0u) { if (xb_ld(&(bar)[XB_TMO])) break; if (_sp > XB_SPIN_CAP) { atomicAdd(&(bar)[XB_TMO], 1u); break; } } } } while (0)

struct XcdBarrier {
    unsigned* bar; unsigned x;
    volatile LAS unsigned* st;
};

__device__ __forceinline__ XcdBarrier xcd_barrier_post(unsigned* bar, volatile LAS unsigned* st) {
    XcdBarrier b; b.bar = bar; b.x = xb_xcc_id(); b.st = st;
    if (threadIdx.x == 0) (void)xb_add(&bar[XB_XCNT(b.x)], 1u);
    return b;
}
__device__ __forceinline__ void xcd_barrier_complete(unsigned* bar, unsigned x, unsigned& nloc, unsigned& nx) {
    const unsigned G = gridDim.x * gridDim.y * gridDim.z;
    unsigned sum, cnt, mine, sp = 0u;
    for (;;) {
        sum = 0u; cnt = 0u; mine = 0u;
#pragma unroll
        for (unsigned j = 0; j < 16; ++j) { const unsigned c = xb_ld(&bar[XB_XCNT(j)]); sum += c; cnt += (c > 0u) ? 1u : 0u; mine = (j == x) ? c : mine; }
        if (sum == G) break;
        __builtin_amdgcn_s_sleep(1);
        if ((++sp & 255u) == 0u) { if (xb_ld(&bar[XB_TMO])) break; if (sp > XB_SPIN_CAP) { atomicAdd(&bar[XB_TMO], 1u); break; } }
    }
    nloc = mine > 0u ? mine : 1u; nx = cnt > 0u ? cnt : 1u;
}

__device__ __forceinline__ void xcd_barrier(const XcdBarrier& b) {
    asm volatile("s_waitcnt vmcnt(0)" ::: "memory");
    __syncthreads();
    if (threadIdx.x == 0) {
        unsigned* bar = b.bar;
        __builtin_amdgcn_s_waitcnt(0);
        unsigned nloc = b.st[0], nx = b.st[1];
        if (nloc == 0u) { xcd_barrier_complete(bar, b.x, nloc, nx); b.st[0] = nloc; b.st[1] = nx; }
        const unsigned old = xb_add(&bar[XB_XSUB(b.x)], 1u);
        const unsigned gen = old / nloc;
        if (old + 1u == (gen + 1u) * nloc) {
            __builtin_amdgcn_fence(__ATOMIC_RELEASE, "agent");
            asm volatile("s_waitcnt vmcnt(0)" ::: "memory");
            const unsigned og = xb_add(&bar[XB_TOP], 1u);
            const unsigned tg = og / nx;
            if (og + 1u == (tg + 1u) * nx) xb_add(&bar[XB_TOPGEN], 1u);
            else XB_SPIN(xb_ld(&bar[XB_TOPGEN]) == tg, bar);
            __builtin_amdgcn_fence(__ATOMIC_ACQUIRE, "agent");
            xb_add(&bar[XB_XGEN(b.x)], 1u);
            asm volatile("s_waitcnt vmcnt(0)" ::: "memory");
        } else {
            XB_SPIN(xb_ld(&bar[XB_XGEN(b.x)]) == gen, bar);
            __builtin_amdgcn_fence(__ATOMIC_ACQUIRE, "agent");
            asm volatile("s_waitcnt vmcnt(0)" ::: "memory");
        }
    }
    __syncthreads();
}

constexpr int N_PHASES = 10;
struct Args { const float* in[24]; float* out; unsigned char* ws; int ph_lo, ph_hi; };
__global__ void __launch_bounds__(NWAVES * 64, 2) mk_fwd(Args args) {
    extern __shared__ __attribute__((aligned(16))) unsigned char lds[];
#define MKFRAME() Frame F; { int t_ = threadIdx.x; asm volatile("" : "+v"(t_)); F.lds = (LAS unsigned char*)lds; F.tid = t_; F.lane = t_ & 63; F.wave = __builtin_amdgcn_readfirstlane(t_ >> 6); \
        F.G = gridDim.x; const int bx = blockIdx.x; F.vcu = (F.G % 8 == 0) ? (bx % 8) * (F.G / 8) + bx / 8 : bx; F.in = args.in; F.out = args.out; F.ws = args.ws; }
    unsigned char* ws = args.ws;
    const int lo = args.ph_lo, hi = args.ph_hi;
#ifndef PH_MASK
#define PH_MASK 0x3ff
#endif
#define IN(k) (((PH_MASK >> (k)) & 1) && lo <= (k) && (k) < hi)
#ifndef REP_MASK
#define REP_MASK 0
#endif
#define REPS(k) for (int rep_ = 0; rep_ < ((((REP_MASK) >> (k)) & 1) ? 2 : 1); ++rep_)
#ifndef XTRA_BAR
#define XTRA_BAR 0
#endif
#define SEAM(k) do { if (IN(k) && IN((k) + 1)) { xcd_barrier(bar); for (int xb_ = 0; xb_ < XTRA_BAR; ++xb_) xcd_barrier(bar); } } while (0)

    XcdBarrier bar;
    { volatile LAS unsigned* st = (volatile LAS unsigned*)(lds + MISC_OFF) + 200; if (threadIdx.x == 0) { st[0] = 0u; st[1] = 0u; } __syncthreads(); bar = xcd_barrier_post((unsigned*)(ws + WS_CTL) + CW_BAR, st); }
    if (IN(0)) { MKFRAME(); REPS(0) p0_prologue(F); }
    SEAM(0);
    if (IN(1)) { MKFRAME();
        DenseSched S{(const char*)(ws + WS_XN), (const char*)(ws + WS_WIN), T / 256, INW / 256, D / 64, F.G, (int)blockIdx.x, (size_t)256 * D * 2, (size_t)256 * D * 2, (REP_MASK >> 1) & 1};
        const int nu = inproj_table(F, S);
        const TabSched<DenseSched> TS(S, (const LAS int*)(F.lds + MISC_OFF) + UDESC_WORD, nu);
        EpiInProj E{ws, (const LAS float*)(F.lds + ETAB_OFF)};
        pg8::gemm_phase<EpiInProj, TabSched<DenseSched>, true, false>(F.lds, D * 2, D * 2, TS, E, nullptr);
        p1_fixup_own(F, nu);
    }
    SEAM(1);
    if (IN(3)) { { MKFRAME(); REPS(2) p2_lru(F); }
      MKFRAME();
        const attn_body::AttnTensors AT{(const attn_body::bf16*)(ws + WS_Q), (const attn_body::bf16*)(ws + WS_KV), (const attn_body::bf16*)(ws + WS_KV) + KVW, (attn_body::bf16*)(ws + WS_AR)};
        const attn_body::StaticOrder S((int)F.G, F.vcu);
        REPS(3) attn_body::attn_phase<attn_body::StaticOrder>((char*)lds, AT, S);
    }
    SEAM(3);
    if (IN(4)) { MKFRAME();
        MergeSched S{(const char*)(ws + WS_AR), (const char*)(ws + WS_WCAT), F.G, (int)blockIdx.x};
        EpiMerge E{(const bf16*)(ws + WS_GL), (bf16*)(ws + WS_MERGED)};
        pg8::gemm_phase<EpiMerge, MergeSched, true, false>(F.lds, ARW * 2, ARW * 2, S, E, nullptr);
    }
    SEAM(4);
    if (IN(5)) { MKFRAME();
        DenseSched S{(const char*)(ws + WS_MERGED), (const char*)(ws + WS_WO), T / 256, D / 256, D / 64, F.G, (int)blockIdx.x, (size_t)256 * D * 2, (size_t)256 * D * 2, (REP_MASK >> 5) & 1};
        EpiResF32 E{F.in[I_X], (bf16*)(ws + WS_X1B)};
        pg8::gemm_phase<EpiResF32, DenseSched, true, false>(F.lds, D * 2, D * 2, S, E, nullptr);
    }
    SEAM(5);
    if (IN(6)) { MKFRAME(); if ((REP_MASK >> 6) & 1) p6_router(F, true); p6_router(F, false); }
    SEAM(6);
    if (IN(7)) { MKFRAME();
        moe_tables(F);
        MoeSched<8> S{(const char*)(ws + WS_XN), (const char*)(ws + WS_WGU), (const LAS int*)(F.lds + MISC_OFF) + 32, F.G, (int)blockIdx.x, (size_t)2 * DFF * D};
        const int nu = moe_gather_table(F, S);
        const TabSched<MoeSched<8>> TS(S, (const LAS int*)(F.lds + MISC_OFF) + UDESC_WORD, nu);
        EpiSwiGLU E{(const LAS float*)(F.lds + ETAB_OFF), (unsigned char*)(ws + WS_ACT)};
        REPS(7) pg8::gemm_phase<EpiSwiGLU, TabSched<MoeSched<8>>, true, true, true>(F.lds, D, D, TS, E, (const LAS unsigned short*)(F.lds + GTAB_OFF));
    }
    SEAM(7);
    if (IN(8)) { MKFRAME();
        moe_tables(F);
        MoeDownSched S; S.A = (const char*)(ws + WS_ACT); S.B = (const char*)(ws + WS_WD); S.nbp = (const LAS int*)(F.lds + MISC_OFF) + 32; S.G = F.G; S.c = (int)blockIdx.x; S.estepB = (size_t)D * DFF;
        const int nu = moe_down_table(F, S);
        const TabSched<MoeDownSched> TS(S, (const LAS int*)(F.lds + MISC_OFF) + UDESC_WORD, nu);
        EpiDown E{(const LAS float*)(F.lds + ETAB_OFF), (const LAS float*)(F.lds + GTAB_OFF), (bf16*)(ws + WS_Y)};
        REPS(8) pg8::gemm_phase<EpiDown, TabSched<MoeDownSched>, true, false, true>(F.lds, DFF, DFF, TS, E, nullptr);
    }
    SEAM(8);
    if (IN(9)) { MKFRAME(); moe_tables(F); if ((REP_MASK >> 9) & 1) p10_final(F, (float*)(ws + WS_ACT)); p10_final(F, F.out); }
#undef IN
#undef SEAM
}

#ifndef MK_N_LAUNCHES
#define MK_N_LAUNCHES 1
#endif
extern "C" void kernel_launch(void* const* d_in, const int* in_sizes, int n_in, void* d_out, int out_size, void* d_ws, size_t ws_size, hipStream_t stream) {
    static int grid = 0;
    if (grid == 0) {
        if (n_in != 24 || in_sizes[0] != T * D || out_size != T * D || ws_size < WS_END) { fprintf(stderr, "kernel_launch: unexpected shapes (n_in %d, in0 %d, out %d, ws %zu < %zu)\n", n_in, n_in > 0 ? in_sizes[0] : -1, out_size, ws_size, (size_t)WS_END); grid = -1; return; }
        int dev = 0, cus = 0, per_cu = 0;
        if (hipGetDevice(&dev) != hipSuccess || hipDeviceGetAttribute(&cus, hipDeviceAttributeMultiprocessorCount, dev) != hipSuccess) { grid = -1; return; }
        if (hipFuncSetAttribute((const void*)mk_fwd, hipFuncAttributeMaxDynamicSharedMemorySize, LDS_BYTES) != hipSuccess) { fprintf(stderr, "kernel_launch: hipFuncSetAttribute failed\n"); grid = -1; return; }
        if (hipOccupancyMaxActiveBlocksPerMultiprocessor(&per_cu, (const void*)mk_fwd, NWAVES * 64, LDS_BYTES) != hipSuccess || per_cu < 1) { fprintf(stderr, "kernel_launch: occupancy query reports %d\n", per_cu); per_cu = 1; }
        (void)hipGetLastError();
        grid = cus;
    }
    if (grid < 0) return;
    Args a{};
    for (int i = 0; i < 24; ++i) a.in[i] = (const float*)d_in[i];
    a.out = (float*)d_out; a.ws = (unsigned char*)d_ws;
    const int nl = 1;
    for (int li = 0; li < nl; ++li) {
        a.ph_lo = (nl == 1) ? 0 : li; a.ph_hi = (nl == 1) ? N_PHASES : li + 1;
        void* kargs[] = {&a};
        if (hipMemsetAsync((char*)d_ws + WS_CTL, 0, CTL_ZERO_BYTES, stream) != hipSuccess) { fprintf(stderr, "kernel_launch: hipMemsetAsync failed\n"); return; }
        const hipError_t le = hipLaunchCooperativeKernel((const void*)mk_fwd, dim3(grid), dim3(NWAVES * 64), kargs, LDS_BYTES, stream);
        if (le != hipSuccess) { fprintf(stderr, "kernel_launch: launch %d failed: %s (grid %d)\n", li, hipGetErrorName(le), grid); break; }
    }
}
```

```cpp
#include <hip/hip_runtime.h>
#include <hip/hip_cooperative_groups.h>
#include <cstdio>
#include <cstdint>
namespace pg8 {
#define PG8_LAS __attribute__((address_space(3)))
typedef unsigned short bf16_t;
typedef short bf16x8 __attribute__((ext_vector_type(8)));
typedef float f32x4 __attribute__((ext_vector_type(4)));
typedef float f32x2 __attribute__((ext_vector_type(2)));
typedef unsigned u32x4 __attribute__((ext_vector_type(4)));
typedef unsigned u32x2 __attribute__((ext_vector_type(2)));
typedef int v8i32 __attribute__((ext_vector_type(8)));
typedef int v4i32 __attribute__((ext_vector_type(4)));
constexpr int BM = 256, BK = 64, HALF = 128, HTB = HALF * BK * 2  , STAGE_BYTES = 8 * HTB, NXCD = 8, WGM = 8;

__host__ __device__ __forceinline__ int lds_byte(int r, int c) { const int st = (r >> 4) * 2 + (c >> 5), rr = r & 15, cc = c & 31, ob = rr * 64 + cc * 2; return st * 1024 + (ob ^ (((ob >> 9) & 1) << 5)); }
__host__ __device__ __forceinline__ void stage_rc(int b, int& R, int& C) { const int st = b / 1024, sb = b % 1024, swz = sb ^ (((sb >> 9) & 1) << 5); R = (st >> 1) * 16 + swz / 64; C = (st & 1) * 32 + (swz % 64) / 2; }
__host__ __device__ __forceinline__ int perm32(int rho) { const int n = rho >> 4, i = rho & 15; return 8 * (i >> 2) + 4 * n + (i & 3); }

struct Unit { int pm, pn, aux, ui; };

__device__ __forceinline__ void dense_tile(int L, int nM, int nN, int& pm, int& pn) {
    const int nwg = nM * nN; int wgid = L;
    { const int q = nwg / NXCD, r = nwg % NXCD, xcd = wgid % NXCD, off = wgid / NXCD; wgid = (xcd < r ? xcd * (q + 1) : r * (q + 1) + (xcd - r) * q) + off; }
    const int nig = WGM * nN, gid = wgid / nig, fm = gid * WGM, gsz = (nM - fm) < WGM ? (nM - fm) : WGM;
    pm = fm + ((wgid % nig) % gsz); pn = (wgid % nig) / gsz;
}

__device__ __forceinline__ unsigned cvt_pk_bf16(float lo, float hi) { unsigned r; asm volatile("v_cvt_pk_bf16_f32 %0, %1, %2" : "=v"(r) : "v"(lo), "v"(hi)); return r; }
__device__ __forceinline__ float bf_lo(unsigned w) { return __uint_as_float(w << 16); }
__device__ __forceinline__ float bf_hi(unsigned w) { return __uint_as_float(w & 0xffff0000u); }
__device__ __forceinline__ float fast_sigmoid(float x) { return __builtin_amdgcn_rcpf(1.0f + __builtin_amdgcn_exp2f(-1.4426950408889634f * x)); }

template <class Epi, class Sched, bool ALIGN_EPI, bool GATHER, bool FP8 = false>
__device__ __forceinline__ void gemm_phase(PG8_LAS unsigned char* lds, const int lda, const int ldb, const Sched& S, const Epi& E, const PG8_LAS unsigned short* gtab) {
    const int tid = threadIdx.x, wid = __builtin_amdgcn_readfirstlane(tid >> 6), lane = tid & 63, wr = wid >> 2, wc = wid & 3, fr = lane & 15, fq = lane >> 4;
    unsigned voffA[2], voffB[2]; int RA[2];
#pragma unroll
    for (int i = 0; i < 2; ++i) { int R, C; stage_rc(tid * 16 + i * 8192, R, C); const int Rb = Epi::PERM ? ((R & ~31) + perm32(R & 31)) : R;
        voffA[i] = GATHER ? (unsigned)(C * 2) : (unsigned)(R * lda + C * 2); voffB[i] = (unsigned)(Rb * ldb + C * 2); RA[i] = R; }
    const size_t kstep = (size_t)(BK * 2);
    const size_t hstepA = GATHER ? 0 : (size_t)HALF * lda;
    const size_t hstepB = (size_t)HALF * ldb;
    const unsigned ldsw = (unsigned)wid * 1024u;
    const int aoff = lds_byte(wr * 64 + fr, fq * 8), boff = lds_byte(wc * 32 + fr, fq * 8);
    const int aoff8 = lds_byte(wr * 64 + fr, (fq >> 1) * 32 + (fq & 1) * 16), boff8 = lds_byte(wc * 32 + fr, (fq >> 1) * 32 + (fq & 1) * 16);
    unsigned gC[2][2], gN[2][2];
#define PG8_SA(b, h) (((b) * 2 + (h)) * HTB)
#define PG8_SB(b, h) ((4 + (b) * 2 + (h)) * HTB)
#define PG8_GLDS(gp, bufoff, i) __builtin_amdgcn_global_load_lds((const unsigned*)(gp), (PG8_LAS unsigned*)(lds + (bufoff) + ldsw + (i) * 8192), 16, 0, 0)
#define PG8_STAGE_B(bufoff, gbase) do { _Pragma("unroll") for (int _i = 0; _i < 2; ++_i) PG8_GLDS((const char*)(gbase) + voffB[_i], bufoff, _i); } while (0)
#define PG8_STAGE_A(bufoff, gbase, h, nx) do { _Pragma("unroll") for (int _i = 0; _i < 2; ++_i) { \
        if constexpr (GATHER) PG8_GLDS((const char*)(gbase) + ((nx) ? gN[h][_i] : gC[h][_i]) + voffA[_i], bufoff, _i); \
        else PG8_GLDS((const char*)(gbase) + voffA[_i], bufoff, _i); } } while (0)
#define PG8_LDA(dst, b, h) do { if constexpr (FP8) { _Pragma("unroll") for (int m = 0; m < 4; ++m) dst##8[m] = __builtin_shufflevector(*(const PG8_LAS v4i32*)(lds + PG8_SA(b, h) + aoff + m * 2048), *(const PG8_LAS v4i32*)(lds + PG8_SA(b, h) + aoff + m * 2048 + 1024), 0, 1, 2, 3, 4, 5, 6, 7); } \
        else { _Pragma("unroll") for (int m = 0; m < 4; ++m) _Pragma("unroll") for (int k = 0; k < 2; ++k) dst[m][k] = *(const PG8_LAS bf16x8*)(lds + PG8_SA(b, h) + aoff + m * 2048 + k * 1024); } } while (0)
#define PG8_LDB(dst, b, h) do { if constexpr (FP8) { _Pragma("unroll") for (int n = 0; n < 2; ++n) dst##8[n] = __builtin_shufflevector(*(const PG8_LAS v4i32*)(lds + PG8_SB(b, h) + boff + n * 2048), *(const PG8_LAS v4i32*)(lds + PG8_SB(b, h) + boff + n * 2048 + 1024), 0, 1, 2, 3, 4, 5, 6, 7); } \
        else { _Pragma("unroll") for (int n = 0; n < 2; ++n) _Pragma("unroll") for (int k = 0; k < 2; ++k) dst[n][k] = *(const PG8_LAS bf16x8*)(lds + PG8_SB(b, h) + boff + n * 2048 + k * 1024); } } while (0)
#define PG8_MMA(ai, bj, At, Bt) do { __builtin_amdgcn_s_setprio(1); _Pragma("unroll") for (int m = 0; m < 4; ++m) _Pragma("unroll") for (int n = 0; n < 2; ++n) { \
        if constexpr (FP8) { asm volatile("v_mfma_scale_f32_16x16x128_f8f6f4 %0, %1, %2, %0, %3, %3 op_sel_hi:[0,0,0]" : "+v"(acc[ai][bj][m][n]) : "v"(Bt##8[n]), "v"(At##8[m]), "v"(scale1)); } \
        else { _Pragma("unroll") for (int k = 0; k < 2; ++k) acc[ai][bj][m][n] = __builtin_amdgcn_mfma_f32_16x16x32_bf16(Bt[n][k], At[m][k], acc[ai][bj][m][n], 0, 0, 0); } } \
        __builtin_amdgcn_s_setprio(0); } while (0)
#define PG8_WAIT_V(n) asm volatile("s_waitcnt vmcnt(" #n ")" ::: "memory")
#define PG8_WAIT_L(n) asm volatile("s_waitcnt lgkmcnt(" #n ")" ::: "memory")
#define PG8_BAR __builtin_amdgcn_s_barrier()
#define PG8_SCHED __builtin_amdgcn_sched_barrier(0)
#define PG8_GOFF(dst, ui_) do { if constexpr (GATHER) { _Pragma("unroll") for (int _h = 0; _h < 2; ++_h) _Pragma("unroll") for (int _i = 0; _i < 2; ++_i) \
        dst[_h][_i] = (unsigned)gtab[(ui_) * 256 + _h * HALF + RA[_i]] * (unsigned)lda; } } while (0)
    Unit cur, nxt; int ui = 0;
    if (!S.next(0, cur)) return;
    cur.ui = 0;
    f32x4 acc[2][2][4][2];
#pragma unroll
    for (int a = 0; a < 2; ++a)
#pragma unroll
        for (int b = 0; b < 2; ++b)
#pragma unroll
            for (int m = 0; m < 4; ++m)
#pragma unroll
                for (int n = 0; n < 2; ++n) acc[a][b][m][n] = (f32x4){0.f, 0.f, 0.f, 0.f};
    bf16x8 At[4][2], B0[2][2], B1[2][2]; v8i32 At8[4], B08[2], B18[2];
    int scale1 = 0x7f7f7f7f; asm volatile("" : "+v"(scale1));
    const char* cA = S.a_ptr(cur); const char* cB = S.b_ptr(cur);
    PG8_GOFF(gC, 0);
#pragma unroll
    for (int _h = 0; _h < 2; ++_h)
#pragma unroll
        for (int _i = 0; _i < 2; ++_i) gN[_h][_i] = gC[_h][_i];
    PG8_STAGE_B(PG8_SB(0, 0), cB); PG8_STAGE_B(PG8_SB(0, 1), cB + hstepB); PG8_STAGE_A(PG8_SA(0, 0), cA, 0, false); PG8_STAGE_A(PG8_SA(0, 1), cA + hstepA, 1, false);
    if (wr == 1) PG8_BAR;
    PG8_WAIT_V(2); PG8_BAR;
    PG8_STAGE_B(PG8_SB(1, 0), cB + kstep); PG8_STAGE_A(PG8_SA(1, 0), cA + kstep, 0, false); PG8_STAGE_B(PG8_SB(1, 1), cB + hstepB + kstep);
    PG8_WAIT_V(6); PG8_BAR;
    for (;;) {
        const bool has_next = S.next(ui + 1, nxt); nxt.ui = ui + 1;
        const int nt = S.ntiles(cur);
        const char* nA = has_next ? S.a_ptr(nxt) : cA; const char* nB = has_next ? S.b_ptr(nxt) : cB;
        if (has_next) PG8_GOFF(gN, ui + 1);
#pragma unroll 1
        for (int t = 0; t < nt; t += 2) {
            const bool last = (t == nt - 2);
            const char* a1 = cA + (size_t)(t + 1) * kstep;
            const char* a2 = last ? nA : cA + (size_t)(t + 2) * kstep; const char* b2 = last ? nB : cB + (size_t)(t + 2) * kstep;
            const char* a3 = a2 + kstep; const char* b3 = b2 + kstep;
            PG8_LDB(B0, 0, 0); PG8_LDB(B1, 0, 1); PG8_SCHED; PG8_LDA(At, 0, 0); PG8_STAGE_A(PG8_SA(1, 1), a1 + hstepA, 1, false);
            PG8_WAIT_V(8); PG8_WAIT_L(0); PG8_BAR; PG8_MMA(0, 0, At, B0); PG8_MMA(0, 1, At, B1); PG8_BAR; PG8_SCHED;
            PG8_LDA(At, 0, 1); PG8_STAGE_B(PG8_SB(0, 0), b2); PG8_STAGE_B(PG8_SB(0, 1), b2 + hstepB); PG8_STAGE_A(PG8_SA(0, 0), a2, 0, last);
            PG8_WAIT_V(8); PG8_WAIT_L(0); PG8_BAR; PG8_MMA(1, 0, At, B0); PG8_MMA(1, 1, At, B1); PG8_BAR; PG8_SCHED;
            PG8_LDB(B0, 1, 0); PG8_LDB(B1, 1, 1); PG8_SCHED; PG8_LDA(At, 1, 0); PG8_STAGE_A(PG8_SA(0, 1), a2 + hstepA, 1, last);
            PG8_WAIT_V(8); PG8_WAIT_L(0); PG8_BAR; PG8_MMA(0, 0, At, B0); PG8_MMA(0, 1, At, B1); PG8_BAR; PG8_SCHED;
            PG8_LDA(At, 1, 1); PG8_STAGE_B(PG8_SB(1, 0), b3); PG8_STAGE_B(PG8_SB(1, 1), b3 + hstepB); PG8_STAGE_A(PG8_SA(1, 0), a3, 0, last);
            PG8_WAIT_V(8); PG8_WAIT_L(0); PG8_BAR; PG8_MMA(1, 0, At, B0); PG8_MMA(1, 1, At, B1); PG8_BAR; PG8_SCHED;
        }
        if constexpr (ALIGN_EPI) { if (wr == 0) PG8_BAR; }
        if constexpr (FP8) asm volatile("s_nop 15\n\ts_nop 15" ::: "memory");
        { int fr_ = fr, fq_ = fq; asm volatile("" : "+v"(fr_), "+v"(fq_));
          E(acc, cur, wr, wc, fr_, fq_); }
        if (!E.keep(cur)) {
#pragma unroll
        for (int a = 0; a < 2; ++a)
#pragma unroll
            for (int b = 0; b < 2; ++b)
#pragma unroll
                for (int m = 0; m < 4; ++m)
#pragma unroll
                    for (int n = 0; n < 2; ++n) acc[a][b][m][n] = (f32x4){0.f, 0.f, 0.f, 0.f};
        }
        if (!has_next) break;
        cur = nxt; cA = nA; cB = nB; ++ui;
#pragma unroll
        for (int _h = 0; _h < 2; ++_h)
#pragma unroll
            for (int _i = 0; _i < 2; ++_i) gC[_h][_i] = gN[_h][_i];
        if constexpr (ALIGN_EPI) { if (wr == 1) PG8_BAR; }
    }
    PG8_WAIT_V(0);
    if constexpr (!ALIGN_EPI) { if (wr == 0) PG8_BAR; }
    PG8_BAR;
#undef PG8_SA
#undef PG8_SB
#undef PG8_GLDS
#undef PG8_STAGE_A
#undef PG8_STAGE_B
#undef PG8_LDA
#undef PG8_LDB
#undef PG8_MMA
#undef PG8_WAIT_V
#undef PG8_WAIT_L
#undef PG8_BAR
#undef PG8_SCHED
#undef PG8_GOFF
}
}
#include <hip/hip_bf16.h>
#include <cmath>
namespace attn_body {
using bf16=__hip_bfloat16;
using bf16x8=__attribute__((ext_vector_type(8)))short;
using s16x4=__attribute__((ext_vector_type(4)))short;
using f32x16=__attribute__((ext_vector_type(16)))float;
using u32x4=__attribute__((ext_vector_type(4)))unsigned;
constexpr int BATCH=8,NHEAD=8,NKV=2,SEQ=4096,D=64;
constexpr int QP=512,KVP=256,OP=1536;
constexpr int NW=8,QBLK=32,QB=QBLK*NW,KVBLK=64,NQB=SEQ/QB;
constexpr int ATTN_UNIT_ROWS=QB;
__device__ __forceinline__ int crow(int r,int hi){return (r&3)+8*(r>>2)+4*hi;}
#define SBAR() __builtin_amdgcn_sched_barrier(0)
constexpr int NSLOT=3, SLOTB=8192;
constexpr int LDS_K=0, LDS_V=NSLOT*SLOTB, LDS_WS=2*NSLOT*SLOTB, LDS_OST=LDS_WS+NW*64*4, LDS_BYTES=LDS_OST+NW*4096;
constexpr float C2=0.125f*1.4426950408889634f;
__device__ __forceinline__ void glds16(const void*gsrc,unsigned lds_dst){unsigned keep;
  asm volatile("s_mov_b32 %0, m0\n\ts_mov_b32 m0, %2\n\ts_nop 0\n\tglobal_load_lds_dwordx4 %1, off\n\ts_mov_b32 m0, %0":"=&s"(keep):"v"(gsrc),"s"(lds_dst):"memory");}
__device__ __forceinline__ float max3f(float a,float b,float c){float r;asm("v_max3_f32 %0, %1, %2, %3":"=v"(r):"v"(a),"v"(b),"v"(c));return r;}
__device__ __forceinline__ float max2f(float a,float b){float r;asm("v_max_f32_e32 %0, %1, %2":"=v"(r):"v"(a),"v"(b));return r;}
__device__ __forceinline__ float fadd_s(float a,float b){float r;asm("v_add_f32_e32 %0, %1, %2":"=v"(r):"v"(a),"v"(b));return r;}
__device__ __forceinline__ float fsub_s(float a,float b){float r;asm("v_sub_f32_e32 %0, %1, %2":"=v"(r):"v"(a),"v"(b));return r;}
typedef float f32x2_t __attribute__((ext_vector_type(2))); typedef __bf16 bf16x2_t __attribute__((ext_vector_type(2)));
__device__ __forceinline__ unsigned cvtpk_s(float lo,float hi){f32x2_t v={lo,hi};bf16x2_t b=__builtin_convertvector(v,bf16x2_t);return __builtin_bit_cast(unsigned,b);}
#define WAIT_BAR(N) asm volatile("s_waitcnt vmcnt(" #N ") lgkmcnt(0)\n\ts_barrier":::"memory")

__device__ __forceinline__ void qkt(f32x16&p0,f32x16&p1,const char*Kslot,const bf16x8*qr,const f32x16&negm,int r32,int hi){
  const char*kb=Kslot+hi*1024+r32*16;
  #pragma unroll
  for(int d0=0;d0<4;++d0){
    const bf16x8 b0=*reinterpret_cast<const bf16x8*>(kb+d0*2048);
    const bf16x8 b1=*reinterpret_cast<const bf16x8*>(kb+d0*2048+512);
    if(d0==0){p0=__builtin_amdgcn_mfma_f32_32x32x16_bf16(b0,qr[0],negm,0,0,0);p1=__builtin_amdgcn_mfma_f32_32x32x16_bf16(b1,qr[0],negm,0,0,0);}
    else{p0=__builtin_amdgcn_mfma_f32_32x32x16_bf16(b0,qr[d0],p0,0,0,0);p1=__builtin_amdgcn_mfma_f32_32x32x16_bf16(b1,qr[d0],p1,0,0,0);}}
}
typedef __attribute__((address_space(3))) const char* lds_cptr;
typedef short v4i16_t __attribute__((ext_vector_type(4)));
__device__ __forceinline__ void kload8(bf16x8*kf,lds_cptr kp){
  kf[0]=*(const __attribute__((address_space(3))) bf16x8*)(kp);      kf[1]=*(const __attribute__((address_space(3))) bf16x8*)(kp+512);
  kf[2]=*(const __attribute__((address_space(3))) bf16x8*)(kp+2048); kf[3]=*(const __attribute__((address_space(3))) bf16x8*)(kp+2560);
  kf[4]=*(const __attribute__((address_space(3))) bf16x8*)(kp+4096); kf[5]=*(const __attribute__((address_space(3))) bf16x8*)(kp+4608);
  kf[6]=*(const __attribute__((address_space(3))) bf16x8*)(kp+6144); kf[7]=*(const __attribute__((address_space(3))) bf16x8*)(kp+6656);
}
__device__ __forceinline__ void kload2(bf16x8*kf,lds_cptr kp,int j){ kf[2*j]=*(const __attribute__((address_space(3))) bf16x8*)(kp+j*2048); kf[2*j+1]=*(const __attribute__((address_space(3))) bf16x8*)(kp+j*2048+512); }
__device__ __forceinline__ s16x4 vtr(lds_cptr p){ return __builtin_bit_cast(s16x4,__builtin_amdgcn_ds_read_tr16_b64_v4i16((__attribute__((address_space(3))) v4i16_t*)p)); }
__device__ __forceinline__ float rowmax(const f32x16&p0,const f32x16&p1){
  float a=max3f(p0[0],p0[1],p1[0]),b=max3f(p0[2],p0[3],p1[1]);a=max3f(a,p1[2],p1[3]);
  #pragma unroll
  for(int r=4;r<16;r+=4){a=max3f(a,p0[r],p0[r+1]);b=max3f(b,p0[r+2],p0[r+3]);a=max3f(a,p1[r],p1[r+1]);b=max3f(b,p1[r+2],p1[r+3]);}
  const float m=max2f(a,b);
  auto rr=__builtin_amdgcn_permlane32_swap(__float_as_uint(m),__float_as_uint(m),false,false);
  return max2f(__uint_as_float(rr[0]),__uint_as_float(rr[1]));
}
__device__ __forceinline__ void pv(f32x16*o,int vb,bf16x8 pa0,bf16x8 pa1,bf16x8 pa2,bf16x8 pa3){
  #pragma unroll
  for(int d0=0;d0<2;++d0){s16x4 lo[4],hi[4];
    #pragma unroll
    for(int ks=0;ks<4;++ks){
      asm volatile("ds_read_b64_tr_b16 %0,%1 offset:%c2":"=&v"(lo[ks]):"v"(vb),"i"(d0*4096+ks*1024):"memory");
      asm volatile("ds_read_b64_tr_b16 %0,%1 offset:%c2":"=&v"(hi[ks]):"v"(vb),"i"(d0*4096+ks*1024+512):"memory");}
    asm volatile("s_waitcnt lgkmcnt(0)":::"memory");SBAR();
    #define PK(k) (bf16x8){lo[k][0],lo[k][1],lo[k][2],lo[k][3],hi[k][0],hi[k][1],hi[k][2],hi[k][3]}
    o[d0]=__builtin_amdgcn_mfma_f32_32x32x16_bf16(pa0,PK(0),o[d0],0,0,0);
    o[d0]=__builtin_amdgcn_mfma_f32_32x32x16_bf16(pa1,PK(1),o[d0],0,0,0);
    o[d0]=__builtin_amdgcn_mfma_f32_32x32x16_bf16(pa2,PK(2),o[d0],0,0,0);
    o[d0]=__builtin_amdgcn_mfma_f32_32x32x16_bf16(pa3,PK(3),o[d0],0,0,0);
    #undef PK
  }
}

#ifndef ATTN_STORE16
#define ATTN_STORE16(p,v) (*(u32x4*)(p)=(v))
#endif
template<int THRL> __device__ __forceinline__ void attn_unit(int b,int h,int qb,const bf16*Q,const bf16*__restrict__ K,const bf16*__restrict__ V,bf16*O,char*shm){
  const int tid=threadIdx.x,lane=tid&63,r32=lane&31,hi=lane>>5; const int wid=__builtin_amdgcn_readfirstlane(tid>>6);
  const long rowbase=(long)b*SEQ; const int q0=qb*QB;
  const bf16*Qw=Q+(rowbase+q0+wid*QBLK)*QP+h*D; const int kvh=h/(NHEAD/NKV);
  const bf16*Kh=K+rowbase*KVP+kvh*D,*Vh=V+rowbase*KVP+kvh*D;
  const unsigned lds0=(unsigned)(uintptr_t)shm;
  float*wsf=(float*)(shm+LDS_WS)+wid*64;
  const bf16*ksrc=Kh+(long)lane*KVP+wid*8;
  const bf16*vsrc=Vh+(long)(16*(wid&3)+(lane>>2))*KVP+(wid>>2)*32+(lane&3)*8;
  const unsigned kdst=lds0+LDS_K+wid*1024, vdst=lds0+LDS_V+wid*1024;
  #define DMA_K(t,slot) glds16(ksrc+(long)(t)*KVBLK*KVP,(unsigned)__builtin_amdgcn_readfirstlane(kdst+(slot)))
  #define DMA_V(t,slot) glds16(vsrc+(long)(t)*KVBLK*KVP,(unsigned)__builtin_amdgcn_readfirstlane(vdst+(slot)))
  const int vb0=(int)(lds0+LDS_V)+((lane>>4)&1)*32+(lane&3)*8+(4*hi+((lane&15)>>2))*64;
  const char*Kbase=shm+LDS_K; bf16x8 kf[8];
  const lds_cptr shm3=(lds_cptr)shm; const lds_cptr kp0=shm3+LDS_K+hi*1024+r32*16; const lds_cptr vp0=shm3+LDS_V+((lane>>4)&1)*32+(lane&3)*8+(4*hi+((lane&15)>>2))*64;
  constexpr int NT=SEQ/KVBLK;
  DMA_K(0,0);DMA_V(0,0);DMA_K(1,SLOTB);
  bf16x8 qr[4];
  #pragma unroll
  for(int d0=0;d0<4;++d0)qr[d0]=*reinterpret_cast<const bf16x8*>(&Qw[(long)r32*QP+d0*16+hi*8]);
  float mhat=0.f,l_reg=0.f;f32x16 o[2];o[0]=f32x16{};o[1]=f32x16{};f32x16 negm=f32x16{};asm volatile("":"+v"(negm));
  #define CMASK(P0,P1,t) do{}while(0)
  bool resc=false;
  #define START(P0,P1) do{ const float rm=rowmax(P0,P1); resc=false; \
    { const float dl=rm; mhat=fadd_s(mhat,dl); \
      _Pragma("unroll") for(int r=0;r<16;++r){P0[r]=fsub_s(P0[r],dl);P1[r]=fsub_s(P1[r],dl);} \
      _Pragma("unroll") for(int r=0;r<16;++r)negm[r]=-mhat; asm volatile("":"+v"(negm)); } \
    _Pragma("unroll") for(int r=0;r<16;++r)P0[r]=__builtin_amdgcn_exp2f(P0[r]); }while(0)
  #define RESC() do{ if(resc){ asm volatile("s_waitcnt lgkmcnt(0)":::"memory"); \
      _Pragma("unroll") for(int d_=0;d_<2;++d_) _Pragma("unroll") for(int r=0;r<16;++r)o[d_][r]*=wsf[crow(r,hi)]; } }while(0)
  f32x16 pA0,pA1,pB0,pB1;
  int sl_prev=0,sl_cur=0,sl_next=SLOTB;
  #define ROT() do{sl_prev=sl_cur;sl_cur=sl_next;sl_next=(sl_next==(NSLOT-1)*SLOTB)?0:sl_next+SLOTB;}while(0)
  DMA_K(2,2*SLOTB);
  WAIT_BAR(3);
  qkt(pA0,pA1,Kbase,qr,negm,r32,hi);asm volatile("s_nop 15\n\ts_nop 7":"+v"(pA0),"+v"(pA1));CMASK(pA0,pA1,0);
  START(pA0,pA1);
  _Pragma("unroll") for(int r=0;r<16;++r)pA1[r]=__builtin_amdgcn_exp2f(pA1[r]);
  WAIT_BAR(0);
  DMA_K(3,0);DMA_V(1,SLOTB);
  ROT();
  kload8(kf,kp0+sl_cur);
  WAIT_BAR(2);
  s16x4 vlo[8],vhi[8]; u32x4 pw0,pw1,pw2,pw3;
  #define PKW(P,B) cvtpk_s(P[B],P[B+1])
  #define PAF(k) __builtin_bit_cast(bf16x8,pw##k)
  #define VFR(i) (bf16x8){vlo[i][0],vlo[i][1],vlo[i][2],vlo[i][3],vhi[i][0],vhi[i][1],vhi[i][2],vhi[i][3]}
  #define PIN(x) asm volatile("":"+v"(x))
  #define MX3(a,b,c) __builtin_fmaxf(__builtin_fmaxf((a),(b)),(c))
  #define GAPA(MF,A0,A1,A2,A3,W0,W1,PW) do{ MF; sacc+=A0; sacc+=A1; sacc+=A2; sacc+=A3; PIN(sacc); W0; W1; PIN(PW); SBAR(); }while(0)
  #define EX(v) __builtin_amdgcn_exp2f(v)
  #define GAPB(MF,X,B) do{ MF; X[B]=EX(X[B]); X[B+1]=EX(X[B+1]); X[B+2]=EX(X[B+2]); X[B+3]=EX(X[B+3]); PIN(X); SBAR(); }while(0)
  #define VRD(i) do{ vlo[i]=vtr(vp_+(((i)>>2)*4096+((i)&3)*1024)); vhi[i]=vtr(vp_+(((i)>>2)*4096+((i)&3)*1024+512)); }while(0)
  #define KRD(G,j) do{ if(G){ kload2(kf,kp0+sl_next,j); SBAR(); } }while(0)
  #define STEP(C0,C1,P0,P1,t,GK,GV,GL) do{ SBAR(); \
    const lds_cptr vp_=vp0+sl_prev; \
    VRD(0); SBAR(); float sacc=(P0[0]+P0[1]); \
    GAPA(C0=__builtin_amdgcn_mfma_f32_32x32x16_bf16(kf[0],qr[0],negm,0,0,0), P0[2],P0[3],P0[4],P0[5],     pw0[0]=PKW(P0,0), pw0[1]=PKW(P0,2), pw0); \
    VRD(4); SBAR(); GAPA(C1=__builtin_amdgcn_mfma_f32_32x32x16_bf16(kf[1],qr[0],negm,0,0,0), P0[6],P0[7],P0[8],P0[9],     pw0[2]=PKW(P0,4), pw0[3]=PKW(P0,6), pw0); \
    VRD(1); SBAR(); GAPA(C0=__builtin_amdgcn_mfma_f32_32x32x16_bf16(kf[2],qr[1],C0,0,0,0),   P0[10],P0[11],P0[12],P0[13], pw1[0]=PKW(P0,8), pw1[1]=PKW(P0,10), pw1); \
    VRD(5); SBAR(); GAPA(C1=__builtin_amdgcn_mfma_f32_32x32x16_bf16(kf[3],qr[1],C1,0,0,0),   P0[14],P0[15],P1[0],P1[1],   pw1[2]=PKW(P0,12),pw1[3]=PKW(P0,14), pw1); \
    VRD(2); SBAR(); GAPA(C0=__builtin_amdgcn_mfma_f32_32x32x16_bf16(kf[4],qr[2],C0,0,0,0),   P1[2],P1[3],P1[4],P1[5],     pw2[0]=PKW(P1,0), pw2[1]=PKW(P1,2), pw2); \
    VRD(6); SBAR(); GAPA(C1=__builtin_amdgcn_mfma_f32_32x32x16_bf16(kf[5],qr[2],C1,0,0,0),   P1[6],P1[7],P1[8],P1[9],     pw2[2]=PKW(P1,4), pw2[3]=PKW(P1,6), pw2); \
    VRD(3); SBAR(); GAPA(C0=__builtin_amdgcn_mfma_f32_32x32x16_bf16(kf[6],qr[3],C0,0,0,0),   P1[10],P1[11],P1[12],P1[13], pw3[0]=PKW(P1,8), pw3[1]=PKW(P1,10), pw3); \
    VRD(7); SBAR(); GAPA(C1=__builtin_amdgcn_mfma_f32_32x32x16_bf16(kf[7],qr[3],C1,0,0,0),   P1[14],P1[15],0.f,0.f,       pw3[2]=PKW(P1,12),pw3[3]=PKW(P1,14), pw3); \
    l_reg+=sacc; \
    if(GK){DMA_K((t)+3,sl_cur);} if(GV){DMA_V((t)+1,sl_next);} \
    CMASK(C0,C1,t); \
    { float a=MX3(C0[0],C0[1],C1[0]),b=MX3(C0[2],C0[3],C1[1]); a=MX3(a,C1[2],C1[3]); \
      _Pragma("unroll") for(int r=4;r<16;r+=4){a=MX3(a,C0[r],C0[r+1]);b=MX3(b,C0[r+2],C0[r+3]);a=MX3(a,C1[r],C1[r+1]);b=MX3(b,C1[r+2],C1[r+3]);} \
      float rm=__builtin_fmaxf(a,b); { auto rr=__builtin_amdgcn_permlane32_swap(__float_as_uint(rm),__float_as_uint(rm),false,false); rm=__builtin_fmaxf(__uint_as_float(rr[0]),__uint_as_float(rr[1])); } \
      resc=false; \
      if(__builtin_expect(__any(rm>(float)THRL),0)){ const float dl=__builtin_fmaxf(rm,0.f); mhat+=dl; \
        _Pragma("unroll") for(int r=0;r<16;++r){C0[r]-=dl;C1[r]-=dl;} \
        _Pragma("unroll") for(int r=0;r<16;++r)negm[r]=-mhat; asm volatile("":"+v"(negm)); \
        const float f=__builtin_amdgcn_exp2f(-dl); l_reg*=f; if(hi==0)wsf[r32]=f; resc=true; } } \
    SBAR(); \
    GAPB(o[0]=__builtin_amdgcn_mfma_f32_32x32x16_bf16(PAF(0),VFR(0),o[0],0,0,0), C0,0); \
    GAPB(o[1]=__builtin_amdgcn_mfma_f32_32x32x16_bf16(PAF(0),VFR(4),o[1],0,0,0), C0,4); \
    KRD(GL,0); GAPB(o[0]=__builtin_amdgcn_mfma_f32_32x32x16_bf16(PAF(1),VFR(1),o[0],0,0,0), C0,8); \
    KRD(GL,1); GAPB(o[1]=__builtin_amdgcn_mfma_f32_32x32x16_bf16(PAF(1),VFR(5),o[1],0,0,0), C0,12); \
    KRD(GL,2); GAPB(o[0]=__builtin_amdgcn_mfma_f32_32x32x16_bf16(PAF(2),VFR(2),o[0],0,0,0), C1,0); \
    KRD(GL,3); GAPB(o[1]=__builtin_amdgcn_mfma_f32_32x32x16_bf16(PAF(2),VFR(6),o[1],0,0,0), C1,4); \
    GAPB(o[0]=__builtin_amdgcn_mfma_f32_32x32x16_bf16(PAF(3),VFR(3),o[0],0,0,0), C1,8); \
    GAPB(o[1]=__builtin_amdgcn_mfma_f32_32x32x16_bf16(PAF(3),VFR(7),o[1],0,0,0), C1,12); \
    }while(0)
  int t=1;
  for(;t+5<NT;t+=2){
    STEP(pB0,pB1,pA0,pA1,t,true,true,true);     WAIT_BAR(2); RESC(); ROT();
    STEP(pA0,pA1,pB0,pB1,t+1,true,true,true);   WAIT_BAR(2); RESC(); ROT();
  }
  #define ENDW(tt) do{ if((tt)+3<NT){WAIT_BAR(2);} else if((tt)+2<NT){WAIT_BAR(1);} else {WAIT_BAR(0);} }while(0)
  for(;t+1<NT;t+=2){
    STEP(pB0,pB1,pA0,pA1,t,(t+3<NT),(t+1<NT),(t+1<NT));       ENDW(t);   RESC(); ROT();
    STEP(pA0,pA1,pB0,pB1,t+1,(t+4<NT),(t+2<NT),(t+2<NT));     ENDW(t+1); RESC(); ROT();
  }
  STEP(pB0,pB1,pA0,pA1,NT-1,false,false,false); RESC();
  { float sacc=pB0[0]+pB0[1]; _Pragma("unroll") for(int r=2;r<16;++r)sacc+=pB0[r]; _Pragma("unroll") for(int r=0;r<16;++r)sacc+=pB1[r]; l_reg+=sacc;
    pw0=(u32x4){PKW(pB0,0),PKW(pB0,2),PKW(pB0,4),PKW(pB0,6)};pw1=(u32x4){PKW(pB0,8),PKW(pB0,10),PKW(pB0,12),PKW(pB0,14)};pw2=(u32x4){PKW(pB1,0),PKW(pB1,2),PKW(pB1,4),PKW(pB1,6)};pw3=(u32x4){PKW(pB1,8),PKW(pB1,10),PKW(pB1,12),PKW(pB1,14)};
    SBAR(); pv(o,vb0+sl_cur,PAF(0),PAF(1),PAF(2),PAF(3)); }
  #undef PKW
  #undef PAF
  #undef VFR
  #undef PIN
  #undef MX3
  #undef GAPA
  #undef GAPB
  #undef EX
  #undef VRD
  #undef KRD
  #undef STEP
  #undef ENDW
  {auto rr=__builtin_amdgcn_permlane32_swap(__float_as_uint(l_reg),__float_as_uint(l_reg),false,false);l_reg=__uint_as_float(rr[0])+__uint_as_float(rr[1]);}
  if(hi==0)wsf[32+r32]=l_reg;asm volatile("s_waitcnt lgkmcnt(0)":::"memory");
  float rli[16];
  #pragma unroll
  for(int r=0;r<16;++r)rli[r]=__builtin_amdgcn_rcpf(wsf[32+crow(r,hi)]);
  bf16*Ow=O+(rowbase+q0+wid*QBLK)*OP+h*D;
  { bf16*stg=(bf16*)(shm+LDS_OST)+wid*2048;
    #pragma unroll
    for(int r=0;r<16;++r){const int orow=crow(r,hi);
      #pragma unroll
      for(int d0=0;d0<2;++d0)stg[orow*64+d0*32+r32]=__float2bfloat16(o[d0][r]*rli[r]);}
    asm volatile("s_waitcnt lgkmcnt(0)":::"memory");
    #pragma unroll
    for(int i=0;i<4;++i){const int row=i*8+(lane>>3),ch=lane&7; const u32x4 v=*(const u32x4*)(stg+row*64+ch*8); ATTN_STORE16(Ow+(long)row*OP+ch*8,v);} }
  asm volatile("s_waitcnt lgkmcnt(0)\n\ts_barrier":::"memory");
  #undef DMA_K
  #undef DMA_V
  #undef CMASK
  #undef START
  #undef RESC
  #undef ROT
}
constexpr int ATTN_LDS_BYTES=LDS_BYTES;
struct AttnTensors { const bf16* Q; const bf16* K; const bf16* V; bf16* O; };
struct AttnUnit { int bh; int qb; };
struct StaticOrder {
  int vcu,G;
  __device__ __forceinline__ explicit StaticOrder(int grid,int v):vcu(v),G(grid){}
  __device__ __forceinline__ bool next(int i,AttnUnit&u)const{ const int L=i*G+vcu; if(L>=BATCH*NHEAD*NQB)return false;
    const int pairhalf=L>>5,l=L&31; const int pair=pairhalf>>1,uu=l+32*(pairhalf&1); const int b=pair>>1,kvh=pair&1; u.bh=b*NHEAD+kvh*(NHEAD/NKV)+(uu>>4); u.qb=uu&15; return true; }
  __device__ __forceinline__ void a_ready(const AttnUnit&)const{}
  __device__ __forceinline__ void done(const AttnUnit&)const{}
};
template<class Sched,int THRL=8> __device__ __forceinline__ void attn_phase(char*lds,const AttnTensors&T,const Sched&S){
  AttnUnit u;
  for(int i=0;S.next(i,u);++i){ S.a_ready(u); attn_unit<THRL>(u.bh/NHEAD,u.bh%NHEAD,u.qb,T.Q,T.K,T.V,T.O,lds); S.done(u); }
}
#undef SBAR
#undef WAIT_BAR
}
namespace cg = cooperative_groups;
constexpr int NWAVES = 8;
constexpr int BATCH = 8, SEQ = 4096, D = 1024, T = BATCH * SEQ;
constexpr int HD = 64, NQH = 8, NKVH = 2, QW = NQH * HD, KVW = NKVH * HD;
constexpr int LRU_W = 1024, LRU_NB = 16, LRU_BW = 64;
constexpr int INW = QW + 2 * KVW + 2 * LRU_W + 2 * D;
constexpr int NE = 32, TOPK = 4, DFF = 1024;
constexpr float NORM_EPS = 1e-6f;
constexpr int ARW = QW + LRU_W;
constexpr int ECAP = T;
constexpr int MAXBLK = (T * TOPK) / 256 + NE;
constexpr int MAX_GUNITS = 18;

constexpr size_t MiB = 1u << 20;
constexpr size_t WS_CTL = 0, CTL_ZERO_BYTES = 64 * 1024;
constexpr size_t WS_TOKL = 1 * MiB, WS_GATEL = 5 * MiB, WS_TOKREC = 9 * MiB, WS_RSTDT = 9 * MiB + 512 * 1024;
constexpr size_t WS_WIN = 10 * MiB, WS_WCAT = 20 * MiB, WS_WO = 23 * MiB, WS_WGU = 26 * MiB, WS_WD = 154 * MiB;
constexpr size_t WS_XN = 218 * MiB;
constexpr size_t WS_Q = 282 * MiB, WS_KV = 314 * MiB, WS_AR = 330 * MiB, WS_XR = 426 * MiB, WS_YR = 490 * MiB, WS_GL = 554 * MiB;
constexpr size_t WS_MERGED = WS_XR;
constexpr size_t WS_MIXB = WS_YR;
constexpr size_t WS_X1B = WS_XR;
constexpr size_t WS_ACT = 282 * MiB, WS_Y = 554 * MiB, WS_END = 826 * MiB;
static_assert(WS_ACT + (size_t)MAXBLK * 256 * DFF * 2 <= WS_Y && WS_Y + (size_t)MAXBLK * 256 * D * 2 <= WS_END, "ws map");
constexpr int CW_CNT = 0;
constexpr int CW_BAR = 1024;

constexpr int RING_BYTES = 131072;
constexpr int GTAB_OFF = RING_BYTES;
constexpr int ETAB_OFF = GTAB_OFF + MAX_GUNITS * 512;
constexpr int MISC_OFF = ETAB_OFF + MAX_GUNITS * 1024;
constexpr int LDS_BYTES = MISC_OFF + 2048;
static_assert(LDS_BYTES <= 163840, "LDS");

#define GAS __attribute__((address_space(1)))
#define LAS __attribute__((address_space(3)))
typedef unsigned short bf16;
typedef unsigned v4u __attribute__((ext_vector_type(4)));
typedef unsigned v2u __attribute__((ext_vector_type(2)));
typedef float f32x4 __attribute__((ext_vector_type(4)));
typedef float f32x2 __attribute__((ext_vector_type(2)));
typedef short bf16x8 __attribute__((ext_vector_type(8)));
#define LDS_WAIT() asm volatile("s_waitcnt lgkmcnt(0)" ::: "memory")
__device__ __forceinline__ unsigned f2bf(float f) { unsigned u = __builtin_bit_cast(unsigned, f); return (u + 0x7fffu + ((u >> 16) & 1u)) >> 16; }
__device__ __forceinline__ unsigned pk2(float lo, float hi) { unsigned r; asm("v_cvt_pk_bf16_f32 %0, %1, %2" : "=v"(r) : "v"(lo), "v"(hi)); return r; }
__device__ __forceinline__ float bflo(unsigned w) { return __uint_as_float(w << 16); }
__device__ __forceinline__ float bfhi(unsigned w) { return __uint_as_float(w & 0xffff0000u); }
__device__ __forceinline__ float wave_sum(float v) {
#pragma unroll
    for (int o = 1; o < 64; o <<= 1) v += __shfl_xor(v, o);
    return v;
}
__device__ __forceinline__ float sigmoidf_fast(float x) { return __builtin_amdgcn_rcpf(1.0f + __builtin_amdgcn_exp2f(-1.4426950408889634f * x)); }

constexpr float YSCALE = 16.0f, YSCALE_INV = 1.0f / 16.0f;
constexpr float WSCALE = 32.0f, WSCALE_INV = 1.0f / 32.0f;
struct Frame {
    LAS unsigned char* lds;
    int tid, lane, wave, vcu, G;
    const float* const* in;
    float* out; unsigned char* ws;
};
enum { I_X = 0, I_N1G, I_WIN, I_BIN, I_QNG, I_KNG, I_CONVW, I_CONVB, I_WA, I_BA, I_WI, I_BI, I_LAM, I_WAO, I_WLO, I_WOUT, I_N2G, I_WR, I_BR, I_WGU, I_BGU, I_WDN, I_BDN, I_FG };

constexpr int P0_MIXER_ITEMS = 16 * (INW / 32) + 8 * 32 + 16 * 32 + 16 * 32, P0_NITEMS = P0_MIXER_ITEMS + NE * 16 * 64 + NE * 16 * 32;
struct P0Item { const float* src; int N; unsigned char* dst; int ldtB; int fp8; };
__device__ __forceinline__ P0Item p0_decode(const Frame& F, int it) {
    constexpr int I_IN = 16 * (INW / 32), I_AO = 8 * 32, I_LO = 16 * 32, I_OUT = 16 * 32, I_GU1 = 16 * 64, I_DN1 = 16 * 32;
    unsigned char* ws = F.ws; P0Item d; int r = it;
    if (r < I_IN) { const int nblk = INW / 32, kb = r / nblk, nb = r % nblk; d.src = F.in[I_WIN] + (size_t)(64 * kb) * INW + 32 * nb; d.N = INW; d.dst = ws + WS_WIN + ((size_t)(32 * nb) * D + 64 * kb) * 2; d.ldtB = D * 2; d.fp8 = 0; return d; } r -= I_IN;
    if (r < I_AO) { const int kb = r / 32, nb = r % 32; d.src = F.in[I_WAO] + (size_t)(64 * kb) * D + 32 * nb; d.N = D; d.dst = ws + WS_WCAT + ((size_t)(32 * nb) * ARW + 64 * kb) * 2; d.ldtB = ARW * 2; d.fp8 = 0; return d; } r -= I_AO;
    if (r < I_LO) { const int kb = r / 32, nb = r % 32; d.src = F.in[I_WLO] + (size_t)(64 * kb) * D + 32 * nb; d.N = D; d.dst = ws + WS_WCAT + ((size_t)(32 * nb) * ARW + QW + 64 * kb) * 2; d.ldtB = ARW * 2; d.fp8 = 0; return d; } r -= I_LO;
    if (r < I_OUT) { const int kb = r / 32, nb = r % 32; d.src = F.in[I_WOUT] + (size_t)(64 * kb) * D + 32 * nb; d.N = D; d.dst = ws + WS_WO + ((size_t)(32 * nb) * D + 64 * kb) * 2; d.ldtB = D * 2; d.fp8 = 0; return d; } r -= I_OUT;
    if (r < NE * I_GU1) { const int e = r / I_GU1, q = r % I_GU1, kb = q / 64, nb = q % 64, n0 = 32 * nb;
        const int cc = n0 & 1023, isu = n0 >> 10, rowb = 256 * (cc >> 7) + 128 * isu + (cc & 127);
        d.src = F.in[I_WGU] + (size_t)e * D * 2 * DFF + (size_t)(64 * kb) * (2 * DFF) + n0; d.N = 2 * DFF; d.dst = ws + WS_WGU + (size_t)e * 2 * DFF * D + (size_t)rowb * D + 64 * kb; d.ldtB = D; d.fp8 = 1; return d; } r -= NE * I_GU1;
    { const int e = r / I_DN1, q = r % I_DN1, kb = q / 32, nb = q % 32;
        d.src = F.in[I_WDN] + (size_t)e * DFF * D + (size_t)(64 * kb) * D + 32 * nb; d.N = D; d.dst = ws + WS_WD + (size_t)e * D * DFF + (size_t)(32 * nb) * DFF + 64 * kb; d.ldtB = DFF; d.fp8 = 1; return d; }
}
__device__ __forceinline__ void p0_prologue(Frame& F, const int it_lo, const int it_hi, const bool do_norm) {
    LAS float* scr = (LAS float*)(F.lds + F.wave * 16384);
    const int gw = F.vcu * NWAVES + F.wave, NGW = F.G * NWAVES, lane = F.lane;
    unsigned char* ws = F.ws;
    float v[32];
    P0Item cur = p0_decode(F, it_lo + gw < it_hi ? it_lo + gw : it_lo);
#define P0_LOAD(dst_, item_) do { const float* p_ = (item_).src + (size_t)(lane >> 5) * (item_).N + (lane & 31); const size_t st_ = (size_t)2 * (item_).N; _Pragma("unroll") for (int i_ = 0; i_ < 32; ++i_) dst_[i_] = __builtin_nontemporal_load(p_ + i_ * st_); } while (0)
    if (it_lo + gw < it_hi) P0_LOAD(v, cur);
    for (int it = it_lo + gw; it < it_hi; it += NGW) {
        const int nit = it + NGW; const bool hn = nit < it_hi;
        const P0Item nxt = p0_decode(F, hn ? nit : it);
        float vn[32];
        if (hn) P0_LOAD(vn, nxt);
#pragma unroll
        for (int i = 0; i < 32; ++i) scr[(2 * i + (lane >> 5)) * 33 + (lane & 31)] = v[i];
        LDS_WAIT(); asm volatile("" ::: "memory");
        const int c = lane & 7;
#pragma unroll
        for (int j = 0; j < 4; ++j) { const int n = (lane >> 3) + 8 * j; const LAS float* s = scr + (8 * c) * 33 + n;
            if (cur.fp8) { int lo = 0, hi = 0;
                lo = __builtin_amdgcn_cvt_pk_fp8_f32(s[0 * 33] * WSCALE, s[1 * 33] * WSCALE, lo, false); lo = __builtin_amdgcn_cvt_pk_fp8_f32(s[2 * 33] * WSCALE, s[3 * 33] * WSCALE, lo, true);
                hi = __builtin_amdgcn_cvt_pk_fp8_f32(s[4 * 33] * WSCALE, s[5 * 33] * WSCALE, hi, false); hi = __builtin_amdgcn_cvt_pk_fp8_f32(s[6 * 33] * WSCALE, s[7 * 33] * WSCALE, hi, true);
                *(GAS v2u*)(cur.dst + (size_t)n * cur.ldtB + 8 * c) = (v2u){(unsigned)lo, (unsigned)hi};
            } else { v4u o; o.x = pk2(s[0 * 33], s[1 * 33]); o.y = pk2(s[2 * 33], s[3 * 33]); o.z = pk2(s[4 * 33], s[5 * 33]); o.w = pk2(s[6 * 33], s[7 * 33]);
                *(GAS v4u*)(cur.dst + (size_t)n * cur.ldtB + 16 * c) = o; } }
        LDS_WAIT(); asm volatile("" ::: "memory");
        cur = nxt;
#pragma unroll
        for (int i = 0; i < 32; ++i) v[i] = vn[i];
    }
#undef P0_LOAD
    if (!do_norm) return;
    const GAS f32x4* gp = (const GAS f32x4*)F.in[I_N1G] + lane;
    f32x4 g[4];
#pragma unroll
    for (int j = 0; j < 4; ++j) g[j] = gp[64 * j];
    bf16* XN = (bf16*)(ws + WS_XN);
    for (int m = gw; m < T; m += 2 * NGW) {
        const int m2 = (m + NGW < T) ? m + NGW : m;
        const GAS f32x4* xr = (const GAS f32x4*)(F.in[I_X] + (size_t)m * D) + lane; const GAS f32x4* xr2 = (const GAS f32x4*)(F.in[I_X] + (size_t)m2 * D) + lane;
        f32x4 va[4], vb[4]; float sa = 0.f, sb = 0.f;
#pragma unroll
        for (int j = 0; j < 4; ++j) { va[j] = __builtin_nontemporal_load(xr + 64 * j); vb[j] = __builtin_nontemporal_load(xr2 + 64 * j); }
#pragma unroll
        for (int j = 0; j < 4; ++j) { sa += (va[j].x * va[j].x + va[j].y * va[j].y) + (va[j].z * va[j].z + va[j].w * va[j].w); sb += (vb[j].x * vb[j].x + vb[j].y * vb[j].y) + (vb[j].z * vb[j].z + vb[j].w * vb[j].w); }
        const float ra = 1.0f / sqrtf(wave_sum(sa) * (1.f / D) + NORM_EPS), rb = 1.0f / sqrtf(wave_sum(sb) * (1.f / D) + NORM_EPS);
        GAS unsigned long long* oa = (GAS unsigned long long*)(XN + (size_t)m * D) + lane; GAS unsigned long long* ob = (GAS unsigned long long*)(XN + (size_t)m2 * D) + lane;
#pragma unroll
        for (int j = 0; j < 4; ++j) { const f32x4 ya = va[j] * ra * g[j], yb = vb[j] * rb * g[j];
            oa[64 * j] = (unsigned long long)pk2(ya.x, ya.y) | ((unsigned long long)pk2(ya.z, ya.w) << 32); ob[64 * j] = (unsigned long long)pk2(yb.x, yb.y) | ((unsigned long long)pk2(yb.z, yb.w) << 32); }
    }
}

#ifndef REP_MASK
#define REP_MASK 0
#endif
#ifndef PROBE_K2X
#define PROBE_K2X 0
#endif
#ifndef DOWN_REVERSE
#define DOWN_REVERSE 0
#endif
struct DenseSched {
    const char* A; const char* B; int nM, nN, nt, G, c; size_t tstepA, tstepB; int rs; int rot;
    __device__ __forceinline__ bool next(int i, pg8::Unit& u) const { const long L = (long)(i >> rs) * G + c; if (L >= (long)nM * nN) return false; pg8::dense_tile((int)L, nM, nN, u.pm, u.pn); u.pn = (u.pn + rot) % nN; u.aux = 0; return true; }
    __device__ __forceinline__ const char* a_ptr(const pg8::Unit& u) const { return A + (size_t)u.pm * tstepA; }
    __device__ __forceinline__ const char* b_ptr(const pg8::Unit& u) const { return B + (size_t)u.pn * tstepB; }
    __device__ __forceinline__ int ntiles(const pg8::Unit&) const { return nt; }
};
struct MergeSched {
    const char* A; const char* B; int G, c;
    __device__ __forceinline__ bool next(int i, pg8::Unit& u) const { const long L = (long)(i >> (1 + ((REP_MASK >> 4) & 1))) * G + c; if (L >= 128 * 4) return false; pg8::dense_tile((int)L, 128, 4, u.pm, u.pn); u.aux = i & 1; return true; }
    __device__ __forceinline__ const char* a_ptr(const pg8::Unit& u) const { return A + (size_t)u.pm * (256 * ARW * 2) + (u.aux ? QW * 2 : 0); }
    __device__ __forceinline__ const char* b_ptr(const pg8::Unit& u) const { return B + (size_t)u.pn * (256 * ARW * 2) + (u.aux ? QW * 2 : 0); }
    __device__ __forceinline__ int ntiles(const pg8::Unit& u) const { return u.aux ? (LRU_W / 64) : (QW / 64); }
};
template <int NTN> struct MoeSched {
    const char* A; const char* B; const LAS int* nbp; int G, c; size_t estepB;
    __device__ __forceinline__ bool next(int i, pg8::Unit& u) const {
        const int NB = nbp[NE], U = NB * NTN; const long L = (long)(i >> ((NTN == 4) ? ((REP_MASK >> 8) & 1) : 0)) * G + c; if (L >= U) return false; const int seg_ = i & 1;
        int w = (int)L; { const int q = U / 8, r = U % 8, xcd = w % 8, off = w / 8; w = (xcd < r ? xcd * (q + 1) : r * (q + 1) + (xcd - r) * q) + off; }
        if (NTN == 4 && DOWN_REVERSE) w = U - 1 - w;
        int e = 0;
        for (int k = 1; k < NE; ++k) e += (w >= nbp[k] * NTN) ? 1 : 0;
        const int b0 = nbp[e], nM = nbp[e + 1] - b0, wl = w - b0 * NTN;
        const int nig = 8 * NTN, gid = wl / nig, fm = gid * 8, gsz = (nM - fm) < 8 ? (nM - fm) : 8;
        const int rb = fm + ((wl % nig) % gsz); u.pn = (wl % nig) / gsz; u.pm = b0 + rb; u.aux = e | (rb << 8) | ((PROBE_K2X && NTN == 4) ? (seg_ << 30) : 0); return true;
    }
    __device__ __forceinline__ const char* a_ptr(const pg8::Unit& u) const { return A; }
    __device__ __forceinline__ const char* b_ptr(const pg8::Unit& u) const { return B + (size_t)(u.aux & 0xff) * estepB + (size_t)u.pn * (256 * D); }
    __device__ __forceinline__ int ntiles(const pg8::Unit&) const { return D / 128; }
};
struct MoeDownSched : MoeSched<4> {
    __device__ __forceinline__ const char* a_ptr(const pg8::Unit& u) const { return A + (size_t)u.pm * (256 * DFF); }
};

__device__ __forceinline__ float gelu_tanh_f(float y) { const float z = y * (0.7978845608028654f + 0.035677408136300125f * y * y); return y * __builtin_amdgcn_rcpf(1.0f + __builtin_amdgcn_exp2f(-2.0f * 1.4426950408889634f * z)); }
__device__ __forceinline__ pg8::bf16_t* glf_ptr(pg8::bf16_t* GLF, int pm, int gt, int wave, int ai, int m, int bj, int lane) {
    return GLF + ((((((size_t)pm * 8 + gt) * 8 + wave) * 2 + ai) * 4 + m) * 2 + bj) * 512 + lane * 8; }
struct EpiInProj {
    static constexpr bool PERM = true;
    unsigned char* ws; const LAS float* etab;
    __device__ __forceinline__ bool keep(const pg8::Unit&) const { return false; }
    __device__ __forceinline__ void operator()(pg8::f32x4 (&acc)[2][2][4][2], const pg8::Unit& u, int wr, int wc, int fr, int fq) const {
        using namespace pg8;
        const int pn = u.pn; bf16_t* base; int ldc, colt;
        if (pn < 2) { base = (bf16_t*)(ws + WS_Q); ldc = QW; colt = pn * 256; }
        else if (pn == 2) { base = (bf16_t*)(ws + WS_KV); ldc = 2 * KVW; colt = 0; }
        else if (pn < 7) { base = (bf16_t*)(ws + WS_XR); ldc = LRU_W; colt = (pn - 3) * 256; }
        else if (pn < 11) { base = (bf16_t*)(ws + WS_YR); ldc = LRU_W; colt = (pn - 7) * 256; }
        else { base = (bf16_t*)(ws + WS_GL); ldc = 2 * D; colt = (pn - 11) * 256; }
        const int row0 = u.pm * BM + wr * 64 + fr, col0 = colt + wc * 32 + 8 * fq; const bool isyr = (pn >= 7 && pn < 11);
        const LAS float* bias = etab + u.ui * 256 + wc * 32 + 8 * fq;
        f32x4 bv[2][2];
#pragma unroll
        for (int bj = 0; bj < 2; ++bj)
#pragma unroll
            for (int n = 0; n < 2; ++n) bv[bj][n] = *(const LAS f32x4*)(bias + bj * HALF + 4 * n);
#pragma unroll
        for (int ai = 0; ai < 2; ++ai)
#pragma unroll
            for (int m = 0; m < 4; ++m) { bf16_t* rowp = base + (size_t)(row0 + ai * HALF + m * 16) * ldc + col0;
#pragma unroll
                for (int bj = 0; bj < 2; ++bj) { f32x4 v0 = acc[ai][bj][m][0] + bv[bj][0], v1 = acc[ai][bj][m][1] + bv[bj][1];
                    if (isyr) {
#pragma unroll
                        for (int j = 0; j < 4; ++j) { v0[j] = gelu_tanh_f(v0[j]); v1[j] = gelu_tanh_f(v1[j]); } }
                    u32x4 w; w.x = cvt_pk_bf16(v0[0], v0[1]); w.y = cvt_pk_bf16(v0[2], v0[3]); w.z = cvt_pk_bf16(v1[0], v1[1]); w.w = cvt_pk_bf16(v1[2], v1[3]);
                    if (pn >= 11) *(u32x4*)(glf_ptr((bf16_t*)(ws + WS_GL), u.pm, pn - 11, wr * 4 + wc, ai, m, bj, fq * 16 + fr)) = w;
                    else *(u32x4*)(rowp + bj * HALF) = w; } }
    }
};
struct EpiMerge {
    static constexpr bool PERM = true;
    const bf16* GL; bf16* MG;
    __device__ __forceinline__ bool keep(const pg8::Unit& u) const { return u.aux == 0; }
    __device__ __forceinline__ void operator()(pg8::f32x4 (&acc)[2][2][4][2], const pg8::Unit& u, int wr, int wc, int fr, int fq) const {
        using namespace pg8;
        const int row0 = u.pm * BM + wr * 64 + fr, col0 = u.pn * BM + wc * 32 + 8 * fq;
        if (u.aux == 0) {
#pragma unroll
            for (int ai = 0; ai < 2; ++ai)
#pragma unroll
                for (int m = 0; m < 4; ++m) {
#pragma unroll
                    for (int bj = 0; bj < 2; ++bj) { const u32x4 ga = *(const u32x4*)glf_ptr((bf16_t*)GL, u.pm, u.pn, wr * 4 + wc, ai, m, bj, fq * 16 + fr), gr = *(const u32x4*)glf_ptr((bf16_t*)GL, u.pm, u.pn + 4, wr * 4 + wc, ai, m, bj, fq * 16 + fr);
#pragma unroll
                        for (int q = 0; q < 4; ++q) { const float a0 = bf_lo(ga[q]), a1 = bf_hi(ga[q]), r0 = bf_lo(gr[q]), r1 = bf_hi(gr[q]);
                            const float f0 = (1.0f + __builtin_amdgcn_exp2f(-1.4426950408889634f * r0)) * __builtin_amdgcn_rcpf(1.0f + __builtin_amdgcn_exp2f(-1.4426950408889634f * a0));
                            const float f1 = (1.0f + __builtin_amdgcn_exp2f(-1.4426950408889634f * r1)) * __builtin_amdgcn_rcpf(1.0f + __builtin_amdgcn_exp2f(-1.4426950408889634f * a1));
                            acc[ai][bj][m][q >> 1][(q & 1) * 2] *= f0; acc[ai][bj][m][q >> 1][(q & 1) * 2 + 1] *= f1; } } }
        } else {
#pragma unroll
            for (int ai = 0; ai < 2; ++ai) { u32x4 grv[4][2];
#pragma unroll
                for (int m = 0; m < 4; ++m) {
#pragma unroll
                    for (int bj = 0; bj < 2; ++bj) grv[m][bj] = *(const u32x4*)glf_ptr((bf16_t*)GL, u.pm, u.pn + 4, wr * 4 + wc, ai, m, bj, fq * 16 + fr); }
#pragma unroll
                for (int m = 0; m < 4; ++m) { bf16* op = MG + (size_t)(row0 + ai * HALF + m * 16) * D + col0;
#pragma unroll
                    for (int bj = 0; bj < 2; ++bj) { const u32x4 gr = grv[m][bj]; u32x4 w;
#pragma unroll
                        for (int q = 0; q < 4; ++q) { const float s0 = fast_sigmoid(bf_lo(gr[q])), s1 = fast_sigmoid(bf_hi(gr[q]));
                            w[q] = cvt_pk_bf16(acc[ai][bj][m][q >> 1][(q & 1) * 2] * s0, acc[ai][bj][m][q >> 1][(q & 1) * 2 + 1] * s1); }
                        *(u32x4*)(op + bj * HALF) = w; } } }
        }
    }
};
struct EpiResF32 {
    static constexpr bool PERM = true;
    bf16* O;
    __device__ __forceinline__ bool keep(const pg8::Unit&) const { return false; }
    __device__ __forceinline__ void operator()(pg8::f32x4 (&acc)[2][2][4][2], const pg8::Unit& u, int wr, int wc, int fr, int fq) const {
        using namespace pg8;
        const int row0 = u.pm * BM + wr * 64 + fr, col0 = u.pn * BM + wc * 32 + 8 * fq;
#pragma unroll
        for (int ai = 0; ai < 2; ++ai)
#pragma unroll
            for (int m = 0; m < 4; ++m) { bf16* rowp = O + (size_t)(row0 + ai * HALF + m * 16) * D + col0;
#pragma unroll
                for (int bj = 0; bj < 2; ++bj) { const f32x4 v0 = acc[ai][bj][m][0], v1 = acc[ai][bj][m][1];
                    u32x4 w; w.x = cvt_pk_bf16(v0[0], v0[1]); w.y = cvt_pk_bf16(v0[2], v0[3]); w.z = cvt_pk_bf16(v1[0], v1[1]); w.w = cvt_pk_bf16(v1[2], v1[3]);
                    *(u32x4*)(rowp + bj * HALF) = w; } }
    }
};
struct EpiSwiGLU {
    static constexpr bool PERM = true;
    const LAS unsigned short* etab; const LAS unsigned short* rtab; unsigned char* ACT;
    __device__ __forceinline__ bool keep(const pg8::Unit&) const { return false; }
    __device__ __forceinline__ void operator()(pg8::f32x4 (&acc)[2][2][4][2], const pg8::Unit& u, int wr, int wc, int fr, int fq) const {
        using namespace pg8;
        const int cl = wc * 32 + 8 * fq, col0 = u.pn * 128 + cl, row0 = u.pm * BM + wr * 64 + fr;
        const LAS unsigned short* bp = etab + u.ui * 256 + cl; const LAS unsigned short* rp = rtab + u.ui * 256 + wr * 64 + fr;
        const u32x4 bgw = *(const LAS u32x4*)(bp), buw = *(const LAS u32x4*)(bp + 128);
        const f32x4 bg0 = (f32x4){bf_lo(bgw.x), bf_hi(bgw.x), bf_lo(bgw.y), bf_hi(bgw.y)}, bg1 = (f32x4){bf_lo(bgw.z), bf_hi(bgw.z), bf_lo(bgw.w), bf_hi(bgw.w)};
        const f32x4 bu0 = (f32x4){bf_lo(buw.x), bf_hi(buw.x), bf_lo(buw.y), bf_hi(buw.y)}, bu1 = (f32x4){bf_lo(buw.z), bf_hi(buw.z), bf_lo(buw.w), bf_hi(buw.w)};
#pragma unroll
        for (int ai = 0; ai < 2; ++ai)
#pragma unroll
            for (int m = 0; m < 4; ++m) { u32x2 w; const float rs = __uint_as_float((unsigned)rp[ai * HALF + m * 16] << 16) * WSCALE_INV;
#pragma unroll
                for (int n = 0; n < 2; ++n) { const f32x4 g = acc[ai][0][m][n] * rs + (n ? bg1 : bg0), uu = acc[ai][1][m][n] * rs + (n ? bu1 : bu0); float a[4];
#pragma unroll
                    for (int j = 0; j < 4; ++j) { const float gg = fminf(g[j], 7.0f), uc = fminf(fmaxf(uu[j], -7.0f), 7.0f);
                        a[j] = gg * __builtin_amdgcn_rcpf(1.0f + __builtin_amdgcn_exp2f(-1.702f * 1.4426950408889634f * gg)) * (uc + 1.0f); }
                    int pk = 0; pk = __builtin_amdgcn_cvt_pk_fp8_f32(a[0], a[1], pk, false); pk = __builtin_amdgcn_cvt_pk_fp8_f32(a[2], a[3], pk, true); w[n] = (unsigned)pk; }
                *(u32x2*)(ACT + (size_t)(row0 + ai * HALF + m * 16) * DFF + col0) = w; }
    }
};
struct EpiDown {
    static constexpr bool PERM = true;
    const LAS float* etab; const LAS float* gtab2; unsigned char* Y;
    __device__ __forceinline__ bool keep(const pg8::Unit& u) const { return PROBE_K2X && ((u.aux >> 30) & 1) == 0; }
    __device__ __forceinline__ void operator()(pg8::f32x4 (&acc)[2][2][4][2], const pg8::Unit& u, int wr, int wc, int fr, int fq) const {
        using namespace pg8;
        if (PROBE_K2X && ((u.aux >> 30) & 1) == 0) return;
        const int tui = PROBE_K2X ? (u.ui >> 1) : u.ui; const float ksc = PROBE_K2X ? 0.5f * WSCALE_INV : WSCALE_INV;
        const int col0 = u.pn * BM + wc * 32 + 8 * fq, rl0 = wr * 64 + fr;
        const LAS float* bias = etab + tui * 256 + wc * 32 + 8 * fq;
        f32x4 bv[2][2];
#pragma unroll
        for (int bj = 0; bj < 2; ++bj)
#pragma unroll
            for (int n = 0; n < 2; ++n) bv[bj][n] = *(const LAS f32x4*)(bias + bj * HALF + 4 * n);
        const LAS float* gl = gtab2 + tui * 256;
#pragma unroll
        for (int ai = 0; ai < 2; ++ai)
#pragma unroll
            for (int m = 0; m < 4; ++m) { const int rl = rl0 + ai * HALF + m * 16; const float gt = gl[rl] * YSCALE; unsigned char* rowp = Y + (size_t)(u.pm * BM + rl) * D + col0;
#pragma unroll
                for (int bj = 0; bj < 2; ++bj) { const f32x4 v0 = (acc[ai][bj][m][0] * ksc + bv[bj][0]) * gt, v1 = (acc[ai][bj][m][1] * ksc + bv[bj][1]) * gt;
                    int p0 = 0, p1 = 0; p0 = __builtin_amdgcn_cvt_pk_fp8_f32(v0[0], v0[1], p0, false); p0 = __builtin_amdgcn_cvt_pk_fp8_f32(v0[2], v0[3], p0, true);
                    p1 = __builtin_amdgcn_cvt_pk_fp8_f32(v1[0], v1[1], p1, false); p1 = __builtin_amdgcn_cvt_pk_fp8_f32(v1[2], v1[3], p1, true);
                    *(u32x2*)(rowp + bj * HALF) = (u32x2){(unsigned)p0, (unsigned)p1}; } }
    }
};

__device__ __forceinline__ v4u fix_vals(const v4u raw, const float* g8, float scale, int c, int prow, int pcol, const LAS f32x2* tab) {
    float v[8];
#pragma unroll
    for (int q = 0; q < 4; ++q) { v[2 * q] = bflo(raw[q]); v[2 * q + 1] = bfhi(raw[q]); }
    float ss = 0.f;
#pragma unroll
    for (int j = 0; j < 8; ++j) ss += v[j] * v[j];
    ss += __shfl_xor(ss, 1); ss += __shfl_xor(ss, 2); ss += __shfl_xor(ss, 4);
    const float rstd = 1.0f / sqrtf(ss * (1.0f / HD) + NORM_EPS);
    const int pos = (c >> 2) ? pcol : prow; const bool second = (c >> 1) & 1; const int f0 = (c & 1) * 8;
    float o[8];
#pragma unroll
    for (int j = 0; j < 8; ++j) { const float y = v[j] * rstd * g8[j]; const float pr = __shfl_xor(y, 2); const f32x2 cs = tab[pos * 16 + f0 + j];
        o[j] = (second ? (y * cs.x + pr * cs.y) : (y * cs.x - pr * cs.y)) * scale; }
    v4u w; w.x = pk2(o[0], o[1]); w.y = pk2(o[2], o[3]); w.z = pk2(o[4], o[5]); w.w = pk2(o[6], o[7]);
    return w;
}
__device__ __forceinline__ void p2_fixup(Frame& F) {
    LAS f32x2* tab = (LAS f32x2*)(F.lds);
    for (int idx = F.tid; idx < 1024; idx += NWAVES * 64) { const int pos = idx >> 4, f = idx & 15; const float inv = powf(10000.0f, -(float)f / 16.0f); const float ang = (float)pos * inv;
        tab[idx] = (f32x2){cosf(ang), sinf(ang)}; }
    __syncthreads();
    const int gw = F.vcu * NWAVES + F.wave, NGW = F.G * NWAVES, c = F.lane & 7;
    float gq[8], gk[8];
#pragma unroll
    for (int j = 0; j < 8; ++j) { gq[j] = F.in[I_QNG][8 * c + j]; gk[j] = F.in[I_KNG][8 * c + j]; }
    bf16* Q = (bf16*)(F.ws + WS_Q); bf16* KV = (bf16*)(F.ws + WS_KV);
    for (int t0 = gw; t0 < T; t0 += 4 * NGW) {
        v4u rq[4], rk[4]; int tt[4];
#pragma unroll
        for (int i = 0; i < 4; ++i) { const int t = t0 + i * NGW; tt[i] = t < T ? t : t0;
            rq[i] = *(const GAS v4u*)(Q + (size_t)tt[i] * QW + F.lane * 8); rk[i] = *(const GAS v4u*)(KV + (size_t)tt[i] * (2 * KVW) + (F.lane & 15) * 8); }
#pragma unroll
        for (int i = 0; i < 4; ++i) { const int t = tt[i], s = t & (SEQ - 1), prow = s >> 6, pcol = s & 63;
            const v4u wq = fix_vals(rq[i], gq, attn_body::C2, c, prow, pcol, tab);
            const v4u wk = fix_vals(rk[i], gk, 1.0f, c, prow, pcol, tab);
            if (t0 + i * NGW < T) { *(GAS v4u*)(Q + (size_t)t * QW + F.lane * 8) = wq; if (F.lane < 16) *(GAS v4u*)(KV + (size_t)t * (2 * KVW) + F.lane * 8) = wk; } }
    }
    __syncthreads();
}
constexpr int LRU_CH = 256;
constexpr int LRU_XC_STRIDE = 144;
constexpr int LRU_BUF = LRU_CH * LRU_XC_STRIDE;
constexpr int LRU_WT = 4 * LRU_BUF;
static_assert(LRU_BUF >= 256 * 33 * 4 && LRU_WT + 2048 + 5 * 64 * 4 <= MISC_OFF, "lru lds");

__device__ __forceinline__ float gelu_tanh(float y) { const float z = 0.7978845608028654f * (y + 0.044715f * y * y * y); return y * sigmoidf_fast(2.0f * z); }

#ifndef LRU_DUP
#define LRU_DUP 0
#endif
#ifndef LRU_TP
#define LRU_TP 0
#endif
template <int DIR> __device__ __forceinline__ void lru_dir(Frame& F, int b, int n, int half) {
    LAS unsigned char* lds = F.lds;
    int tid_ = F.tid; asm volatile("" : "+v"(tid_));
    unsigned char* ws_ = F.ws; asm volatile("" : "+s"(ws_));
    const int tid = tid_, lane = tid & 63, wave = __builtin_amdgcn_readfirstlane(tid >> 6);
    constexpr int g = DIR; const int w = wave & 3, tl = tid & 255;
#define PHY(p_) (DIR ? 255 - (p_) : (p_))
    const int ch16 = lane & 15, q = lane >> 4, ct = w & 1, th = w >> 1;
    const int cl = 16 * ct + ch16, co_l = 32 * half + cl, cgl = 64 * n + co_l;
    constexpr float NL2E = -1.4426950408889634f;
    bf16x8 Ba[2], Bi[2], Bid;
    { const float* wa = F.in[I_WA] + ((size_t)(g * LRU_NB + n) * 64) * 64 + co_l; const float* wi = F.in[I_WI] + ((size_t)(g * LRU_NB + n) * 64) * 64 + co_l;
      float ta[16], ti[16];
#pragma unroll
      for (int ks = 0; ks < 2; ++ks)
#pragma unroll
          for (int j = 0; j < 8; ++j) { const int k = 32 * ks + 8 * q + j; ta[8 * ks + j] = wa[(size_t)k * 64]; ti[8 * ks + j] = wi[(size_t)k * 64]; }
#pragma unroll
      for (int ks = 0; ks < 2; ++ks)
#pragma unroll
          for (int j = 0; j < 8; ++j) { Ba[ks][j] = (short)f2bf(NL2E * ta[8 * ks + j]); Bi[ks][j] = (short)f2bf(NL2E * ti[8 * ks + j]); }
#pragma unroll
      for (int j = 0; j < 8; ++j) Bid[j] = (short)((8 * q + j == 16 * ct + ch16) ? 0x3F80 : 0); }
    const float ba = NL2E * F.in[I_BA][(g * LRU_NB + n) * 64 + co_l], bi = NL2E * F.in[I_BI][(g * LRU_NB + n) * 64 + co_l];
    const float lam = F.in[I_LAM][g * LRU_W + cgl];
    const float clam = -8.0f * log1pf(expf(-lam)) * 1.4426950408889634f;
    const int c8 = tl & 7, tg = tl >> 3;
    LAS float* cwl = (LAS float*)(lds + LRU_WT + 2048);
    if (tid < 5 * 64) { const int j = tid >> 6, c = tid & 63; const float* src = (j < 4) ? (F.in[I_CONVW] + j * LRU_W) : F.in[I_CONVB]; cwl[tid] = src[64 * n + c]; }
    __syncthreads();
    const bf16* XR = (const bf16*)(ws_ + WS_XR) + (size_t)b * SEQ * LRU_W + 64 * n + 8 * c8;
    const bf16* YR = (const bf16*)(ws_ + WS_YR) + (size_t)b * SEQ * LRU_W + 64 * n + 32 * half;
    bf16* AR = (bf16*)(ws_ + WS_AR) + (size_t)b * SEQ * ARW + QW + 64 * n + 32 * half;
    constexpr int NST = SEQ / LRU_CH;
    v4u xrp[11];
#define LRU_LOADX(pc_) do { const int s0_ = (pc_) * LRU_CH + 8 * tg - 1; _Pragma("unroll") for (int i_ = 0; i_ < 11; ++i_) { const int s_ = s0_ + i_; \
        const int sc_ = s_ < 0 ? 0 : (s_ >= SEQ ? SEQ - 1 : s_); xrp[i_] = *(const GAS v4u*)(XR + (size_t)sc_ * LRU_W); } } while (0)
    LRU_LOADX(g ? NST - 1 : 0);
    float hcarry = 0.f;
    unsigned long long tpacc_ = 0, tps_ = 0;
    v4u dwv[4]; size_t dtrow = 0;
#pragma unroll
    for (int i = 0; i < 4; ++i) dwv[i] = (v4u){0u, 0u, 0u, 0u};
    for (int k = 0; k < NST; ++k) {
        if (LRU_TP == 1 || LRU_TP == 5) tps_ = __builtin_amdgcn_s_memrealtime();
        const int pc = g ? (NST - 1 - k) : k, par = k & 1;
        LAS unsigned char* buf = lds + (g * 2 + par) * LRU_BUF;
        unsigned aA = (unsigned)((DIR ? (255 - 128 * th - ch16 - 112) : (128 * th + ch16)) * LRU_XC_STRIDE + q * 16);
        unsigned aX = (unsigned)((DIR ? (255 - 128 * th - 4 * q - 115) : (128 * th + 4 * q)) * LRU_XC_STRIDE + co_l * 2);
        unsigned aH = (unsigned)(((DIR ? (255 - 128 * th - 4 * q - 115) : (128 * th + 4 * q)) * 33 + cl) * 4);
        asm volatile("" : "+v"(aA), "+v"(aX), "+v"(aH));
#define OFS(c_, m_) (DIR ? ((m_) - (c_)) : (c_))
#pragma unroll 1
        for (int dup_ = 0; dup_ < 1 + (LRU_DUP & 1); ++dup_) { asm volatile("" : "+v"(xrp[0].x));
        { const int s0c = pc * LRU_CH + 8 * tg - 1;
#pragma unroll
          for (int i = 0; i < 11; ++i) { const unsigned m_ = ((unsigned)(s0c + i) < (unsigned)SEQ) ? 0xffffffffu : 0u; xrp[i] = (v4u){xrp[i].x & m_, xrp[i].y & m_, xrp[i].z & m_, xrp[i].w & m_}; } }
        { f32x2 cw[4][4], cb[4];
#pragma unroll
          for (int j = 0; j < 4; ++j) { const f32x4 c0 = *(const LAS f32x4*)(cwl + j * 64 + 8 * c8), c1 = *(const LAS f32x4*)(cwl + j * 64 + 8 * c8 + 4);
              cw[j][0] = (f32x2){c0.x, c0.y}; cw[j][1] = (f32x2){c0.z, c0.w}; cw[j][2] = (f32x2){c1.x, c1.y}; cw[j][3] = (f32x2){c1.z, c1.w}; }
          { const f32x4 c0 = *(const LAS f32x4*)(cwl + 256 + 8 * c8), c1 = *(const LAS f32x4*)(cwl + 256 + 8 * c8 + 4); cb[0] = (f32x2){c0.x, c0.y}; cb[1] = (f32x2){c0.z, c0.w}; cb[2] = (f32x2){c1.x, c1.y}; cb[3] = (f32x2){c1.z, c1.w}; }
#pragma unroll
          for (int tt = 0; tt < 8; ++tt) { f32x2 o[4];
#pragma unroll
            for (int i = 0; i < 4; ++i) o[i] = cb[i];
#pragma unroll
            for (int j = 0; j < 4; ++j) { const v4u raw = xrp[tt + j];
#pragma unroll
                for (int qq = 0; qq < 4; ++qq) { const f32x2 xv = (f32x2){bflo(raw[qq]), bfhi(raw[qq])}; o[qq] = __builtin_elementwise_fma(cw[j][qq], xv, o[qq]); } }
            v4u wv; wv.x = pk2(o[0].x, o[0].y); wv.y = pk2(o[1].x, o[1].y); wv.z = pk2(o[2].x, o[2].y); wv.w = pk2(o[3].x, o[3].y);
            *(LAS v4u*)(buf + (8 * tg + tt) * LRU_XC_STRIDE + c8 * 16) = wv; } } }
        if (LRU_TP == 5) tpacc_ += __builtin_amdgcn_s_memrealtime() - tps_; if (LRU_TP == 6) tps_ = __builtin_amdgcn_s_memrealtime();
        if (k > 0) { GAS v4u* dop = (GAS v4u*)(AR + dtrow * ARW);
#pragma unroll
            for (int i = 0; i < 4; ++i) dop[i] = dwv[i]; }
        if (k + 1 < NST) LRU_LOADX(g ? (NST - 2 - k) : (k + 1));
        const size_t trow = (size_t)pc * LRU_CH + tl;
        if (LRU_TP == 6) tpacc_ += __builtin_amdgcn_s_memrealtime() - tps_;
        if (k == NST / 2) asm volatile("s_waitcnt vmcnt(0)" ::: "memory");
        __syncthreads();
        if (LRU_TP == 1) tpacc_ += __builtin_amdgcn_s_memrealtime() - tps_; if (LRU_TP == 2) tps_ = __builtin_amdgcn_s_memrealtime();
        float Aloc[8][4], Hloc[8][4]; float AR_ = 1.f, HR_ = 0.f;
#pragma unroll 1
        for (int dup_ = 0; dup_ < 1 + ((LRU_DUP >> 1) & 1); ++dup_) { asm volatile("" : "+v"(aA), "+v"(aX));
#pragma unroll
        for (int rt = 0; rt < 8; ++rt) {
            const bf16x8 a0 = *(const LAS bf16x8*)(buf + aA + OFS(16 * rt, 112) * LRU_XC_STRIDE), a1 = *(const LAS bf16x8*)(buf + aA + OFS(16 * rt, 112) * LRU_XC_STRIDE + 64);
            f32x4 Da = (f32x4){ba, ba, ba, ba}, Di = (f32x4){bi, bi, bi, bi}, Dx = (f32x4){0.f, 0.f, 0.f, 0.f};
            Da = __builtin_amdgcn_mfma_f32_16x16x32_bf16(a0, Ba[0], Da, 0, 0, 0); Da = __builtin_amdgcn_mfma_f32_16x16x32_bf16(a1, Ba[1], Da, 0, 0, 0);
            Di = __builtin_amdgcn_mfma_f32_16x16x32_bf16(a0, Bi[0], Di, 0, 0, 0); Di = __builtin_amdgcn_mfma_f32_16x16x32_bf16(a1, Bi[1], Di, 0, 0, 0);
            Dx = __builtin_amdgcn_mfma_f32_16x16x32_bf16(half ? a1 : a0, Bid, Dx, 0, 0, 0);
#pragma unroll
            for (int j = 0; j < 4; ++j) {
                const float r = __builtin_amdgcn_rcpf(1.0f + __builtin_amdgcn_exp2f(Da[j])), ig = __builtin_amdgcn_rcpf(1.0f + __builtin_amdgcn_exp2f(Di[j]));
                const float a = __builtin_amdgcn_exp2f(clam * r);
                Aloc[rt][j] = a; Hloc[rt][j] = __builtin_amdgcn_sqrtf(__builtin_fmaf(-a, a, 1.0f)) * (ig * Dx[j]); }
        }
        float Ai[8], Hi[8], Ae[8], He[8];
#pragma unroll
        for (int rt = 0; rt < 8; ++rt) {
#pragma unroll
            for (int j = 1; j < 4; ++j) { Hloc[rt][j] = Aloc[rt][j] * Hloc[rt][j - 1] + Hloc[rt][j]; Aloc[rt][j] = Aloc[rt][j - 1] * Aloc[rt][j]; }
            Ai[rt] = Aloc[rt][3]; Hi[rt] = Hloc[rt][3]; }
#pragma unroll
        for (int rt = 0; rt < 8; ++rt) { const float An = __shfl(Ai[rt], (lane - 16) & 63), Hn = __shfl(Hi[rt], (lane - 16) & 63); if (q >= 1) { Hi[rt] = Ai[rt] * Hn + Hi[rt]; Ai[rt] = An * Ai[rt]; } }
#pragma unroll
        for (int rt = 0; rt < 8; ++rt) { const float An = __shfl(Ai[rt], (lane - 32) & 63), Hn = __shfl(Hi[rt], (lane - 32) & 63); if (q >= 2) { Hi[rt] = Ai[rt] * Hn + Hi[rt]; Ai[rt] = An * Ai[rt]; } }
#pragma unroll
        for (int rt = 0; rt < 8; ++rt) { Ae[rt] = __shfl(Ai[rt], (lane - 16) & 63); He[rt] = __shfl(Hi[rt], (lane - 16) & 63); if (q == 0) { Ae[rt] = 1.f; He[rt] = 0.f; }
            Ai[rt] = __shfl(Ai[rt], ch16 + 48); Hi[rt] = __shfl(Hi[rt], ch16 + 48); }
        AR_ = 1.f; HR_ = 0.f;
#pragma unroll
        for (int rt = 0; rt < 8; ++rt) {
            const float Ap = AR_ * Ae[rt], Hp = Ae[rt] * HR_ + He[rt];
#pragma unroll
            for (int j = 0; j < 4; ++j) { Hloc[rt][j] = Aloc[rt][j] * Hp + Hloc[rt][j]; Aloc[rt][j] = Ap * Aloc[rt][j]; }
            HR_ = Ai[rt] * HR_ + Hi[rt]; AR_ = AR_ * Ai[rt]; }
        }
        LAS f32x2* WT = (LAS f32x2*)(lds + LRU_WT) + (g * 2 + par) * 64;
        if (q == 0) WT[th * 32 + cl] = (f32x2){AR_, HR_};
        __syncthreads();
        if (LRU_TP == 2) tpacc_ += __builtin_amdgcn_s_memrealtime() - tps_; if (LRU_TP == 3) tps_ = __builtin_amdgcn_s_memrealtime();
        v4u yv[4], ov[4];
        if (k >= NST / 2) {
#pragma unroll
            for (int i = 0; i < 4; ++i) { yv[i] = __builtin_nontemporal_load((const GAS v4u*)(YR + trow * LRU_W) + i); ov[i] = *((const GAS v4u*)(AR + trow * ARW) + i); } }
        const f32x2 w0 = WT[cl], w1 = WT[32 + cl];
        const float hmid = w0.x * hcarry + w0.y;
        const float hin = th ? hmid : hcarry;
        hcarry = w1.x * hmid + w1.y;
        LAS float* HS = (LAS float*)buf;
#pragma unroll
        for (int rt = 0; rt < 8; ++rt)
#pragma unroll
            for (int j = 0; j < 4; ++j) *(LAS float*)(buf + aH + OFS(16 * rt + j, 115) * 132) = Hloc[rt][j] + Aloc[rt][j] * hin;
        __syncthreads();
        if (LRU_TP == 3) tpacc_ += __builtin_amdgcn_s_memrealtime() - tps_; if (LRU_TP == 4) tps_ = __builtin_amdgcn_s_memrealtime();
#pragma unroll 1
        for (int dup_ = 0; dup_ < 1 + ((LRU_DUP >> 2) & 1); ++dup_) { asm volatile("" : "+v"(yv[0].x));
          float hv[32];
#pragma unroll
          for (int i = 0; i < 32; ++i) hv[i] = HS[tl * 33 + i];
          v4u wv[4];
          if (k < NST / 2) {
#pragma unroll
              for (int i = 0; i < 4; ++i) { wv[i].x = pk2(hv[8 * i], hv[8 * i + 1]); wv[i].y = pk2(hv[8 * i + 2], hv[8 * i + 3]); wv[i].z = pk2(hv[8 * i + 4], hv[8 * i + 5]); wv[i].w = pk2(hv[8 * i + 6], hv[8 * i + 7]); }
          } else {
#pragma unroll
              for (int i = 0; i < 4; ++i)
#pragma unroll
                  for (int qq = 0; qq < 4; ++qq) wv[i][qq] = pk2((hv[8 * i + 2 * qq] + bflo(ov[i][qq])) * bflo(yv[i][qq]), (hv[8 * i + 2 * qq + 1] + bfhi(ov[i][qq])) * bfhi(yv[i][qq]));
          }
#pragma unroll
          for (int i = 0; i < 4; ++i) dwv[i] = wv[i];
          dtrow = trow; }
        if (LRU_TP == 4) tpacc_ += __builtin_amdgcn_s_memrealtime() - tps_;
    }
    { GAS v4u* dop = (GAS v4u*)(AR + dtrow * ARW);
#pragma unroll
      for (int i = 0; i < 4; ++i) dop[i] = dwv[i]; }
#undef LRU_LOADX
#undef PHY
#undef OFS
    if (LRU_TP > 0 && blockIdx.x == 0 && tid == 0) *(LAS unsigned*)(F.lds + MISC_OFF + 4 * 204) = (unsigned)tpacc_;
    __syncthreads();
}
__device__ __forceinline__ void p2_lru(Frame& F) {
    for (int it = F.vcu; it < BATCH * LRU_NB * 2; it += F.G) { if (F.wave < 4) lru_dir<0>(F, it >> 5, (it & 31) >> 1, it & 1); else lru_dir<1>(F, it >> 5, (it & 31) >> 1, it & 1); }
}

constexpr int RW_STRIDE = 1032;
constexpr int RT_WBH = 0, RT_WBL = 32 * RW_STRIDE * 2, RT_G2 = 2 * RT_WBL, RT_LG = RT_G2 + 4096, RT_ROWINFO = RT_LG + 8 * 16 * 33 * 4, RT_RS = RT_ROWINFO + 4096;
static_assert(RT_RS + 512 <= MISC_OFF, "router lds");
__device__ __forceinline__ void p6_router(Frame& F, const bool dry) {
    LAS unsigned char* lds = F.lds;
    LAS unsigned short* WBH = (LAS unsigned short*)(lds + RT_WBH); LAS unsigned short* WBL = (LAS unsigned short*)(lds + RT_WBL);
    LAS float* G2 = (LAS float*)(lds + RT_G2); LAS float* LG = (LAS float*)(lds + RT_LG); LAS v2u* rowinfo = (LAS v2u*)(lds + RT_ROWINFO); LAS float* RS = (LAS float*)(lds + RT_RS);
    LAS unsigned* misc = (LAS unsigned*)(lds + MISC_OFF);
    LAS unsigned* hist = misc + 128; LAS unsigned* basew = misc + 160;
    const int tid = F.tid, lane = F.lane, wave = F.wave;
    for (int i0 = 0; i0 < (D * NE) / (NWAVES * 64); i0 += 16) {
        float tw[16];
#pragma unroll
        for (int i = 0; i < 16; ++i) tw[i] = F.in[I_WR][tid + (NWAVES * 64) * (i0 + i)];
        asm volatile("" ::: "memory");
#pragma unroll
        for (int i = 0; i < 16; ++i) { const int idx = tid + (NWAVES * 64) * (i0 + i), k = idx >> 5, e = idx & 31; const unsigned hi = f2bf(tw[i]); const unsigned lo = f2bf(tw[i] - __uint_as_float(hi << 16));
            WBH[e * RW_STRIDE + k] = (unsigned short)hi; WBL[e * RW_STRIDE + k] = (unsigned short)lo; } }
    for (int i = tid; i < D; i += NWAVES * 64) G2[i] = F.in[I_N2G][i];
    if (tid < 32) hist[tid] = 0u;
    const float brl0 = F.in[I_BR][lane & 15], brl1 = F.in[I_BR][16 + (lane & 15)];
    __syncthreads();
    bf16* X1B = (bf16*)(F.ws + WS_X1B); const bf16* MIXB = (const bf16*)(F.ws + WS_MIXB);
    unsigned char* H2 = (unsigned char*)(F.ws + WS_XN);
    unsigned* gcnt = (unsigned*)(F.ws + WS_CTL) + CW_CNT;
    int* TOKL = (int*)(F.ws + WS_TOKL); float* GATEL = (float*)(F.ws + WS_GATEL); int* TOKREC = (int*)(F.ws + WS_TOKREC); float* RSTDT = (float*)(F.ws + WS_RSTDT);
    const int r16 = lane & 15, kq = lane >> 4;
    for (int bi = F.vcu; bi < T / 128; bi += F.G) {
        const int rbase = bi * 128; const size_t row = (size_t)rbase + 16 * wave + r16;
        const float* xp = F.in[I_X] + row * D + 8 * kq; const bf16* mp = MIXB + row * D + 8 * kq; bf16* x1p = X1B + row * D + 8 * kq; unsigned char* hp = H2 + row * D + 8 * kq;
        f32x4 acc0 = (f32x4){0.f, 0.f, 0.f, 0.f}, acc1 = (f32x4){0.f, 0.f, 0.f, 0.f}; float ss = 0.f;
        const LAS unsigned char* bh0 = lds + RT_WBH + (r16 * RW_STRIDE + 8 * kq) * 2; const LAS unsigned char* bl0 = lds + RT_WBL + (r16 * RW_STRIDE + 8 * kq) * 2;
#pragma unroll 1
        for (int s4 = 0; s4 < 32; s4 += 4) {
            f32x4 xa[4], xb[4]; v4u mw[4];
#pragma unroll
            for (int u = 0; u < 4; ++u) { const int k0 = 32 * (s4 + u); xa[u] = __builtin_nontemporal_load((const GAS f32x4*)(xp + k0)); xb[u] = __builtin_nontemporal_load((const GAS f32x4*)(xp + k0 + 4)); mw[u] = __builtin_nontemporal_load((const GAS v4u*)(mp + k0)); }
#pragma unroll
            for (int u = 0; u < 4; ++u) { const int k0 = 32 * (s4 + u);
                const f32x4 ga = *(const LAS f32x4*)(G2 + k0 + 8 * kq), gb = *(const LAS f32x4*)(G2 + k0 + 8 * kq + 4);
                float x1[8]; x1[0] = xa[u].x + bflo(mw[u].x); x1[1] = xa[u].y + bfhi(mw[u].x); x1[2] = xa[u].z + bflo(mw[u].y); x1[3] = xa[u].w + bfhi(mw[u].y);
                x1[4] = xb[u].x + bflo(mw[u].z); x1[5] = xb[u].y + bfhi(mw[u].z); x1[6] = xb[u].z + bflo(mw[u].w); x1[7] = xb[u].w + bfhi(mw[u].w);
#pragma unroll
                for (int j = 0; j < 8; ++j) ss += x1[j] * x1[j];
                *(GAS v4u*)(x1p + k0) = (v4u){pk2(x1[0], x1[1]), pk2(x1[2], x1[3]), pk2(x1[4], x1[5]), pk2(x1[6], x1[7])};
                float h[8]; h[0] = x1[0] * ga.x; h[1] = x1[1] * ga.y; h[2] = x1[2] * ga.z; h[3] = x1[3] * ga.w; h[4] = x1[4] * gb.x; h[5] = x1[5] * gb.y; h[6] = x1[6] * gb.z; h[7] = x1[7] * gb.w;
                { int p0 = 0, p1 = 0; p0 = __builtin_amdgcn_cvt_pk_fp8_f32(h[0], h[1], p0, false); p0 = __builtin_amdgcn_cvt_pk_fp8_f32(h[2], h[3], p0, true);
                  p1 = __builtin_amdgcn_cvt_pk_fp8_f32(h[4], h[5], p1, false); p1 = __builtin_amdgcn_cvt_pk_fp8_f32(h[6], h[7], p1, true); *(GAS v2u*)(hp + k0) = (v2u){(unsigned)p0, (unsigned)p1}; }
                v4u ahi, alo;
#pragma unroll
                for (int q2 = 0; q2 < 4; ++q2) { ahi[q2] = pk2(h[2 * q2], h[2 * q2 + 1]); alo[q2] = pk2(h[2 * q2] - bflo(ahi[q2]), h[2 * q2 + 1] - bfhi(ahi[q2])); }
                const bf16x8 Ahi = __builtin_bit_cast(bf16x8, ahi), Alo = __builtin_bit_cast(bf16x8, alo);
                const bf16x8 Bh0 = *(const LAS bf16x8*)(bh0 + k0 * 2), Bh1 = *(const LAS bf16x8*)(bh0 + 16 * RW_STRIDE * 2 + k0 * 2), Bl0 = *(const LAS bf16x8*)(bl0 + k0 * 2), Bl1 = *(const LAS bf16x8*)(bl0 + 16 * RW_STRIDE * 2 + k0 * 2);
                acc0 = __builtin_amdgcn_mfma_f32_16x16x32_bf16(Ahi, Bh0, acc0, 0, 0, 0); acc1 = __builtin_amdgcn_mfma_f32_16x16x32_bf16(Ahi, Bh1, acc1, 0, 0, 0);
                acc0 = __builtin_amdgcn_mfma_f32_16x16x32_bf16(Alo, Bh0, acc0, 0, 0, 0); acc1 = __builtin_amdgcn_mfma_f32_16x16x32_bf16(Alo, Bh1, acc1, 0, 0, 0);
                acc0 = __builtin_amdgcn_mfma_f32_16x16x32_bf16(Ahi, Bl0, acc0, 0, 0, 0); acc1 = __builtin_amdgcn_mfma_f32_16x16x32_bf16(Ahi, Bl1, acc1, 0, 0, 0); }
        }
        ss += __shfl_xor(ss, 16); ss += __shfl_xor(ss, 32);
        const float rstd = 1.0f / sqrtf(ss * (1.f / D) + NORM_EPS);
        LAS float* lgw = LG + wave * (16 * 33);
#pragma unroll
        for (int i = 0; i < 4; ++i) { const float rsi = __shfl(rstd, 4 * kq + i);
            lgw[(4 * kq + i) * 33 + r16] = acc0[i] * rsi + brl0; lgw[(4 * kq + i) * 33 + 16 + r16] = acc1[i] * rsi + brl1; }
        LDS_WAIT(); asm volatile("" ::: "memory");
        if (lane < 16) {
            LAS float* lr = lgw + lane * 33; int te[4]; float tv[4];
#pragma unroll
            for (int k = 0; k < 4; ++k) { float best = -INFINITY; int bi2 = 0;
#pragma unroll
                for (int e = 0; e < 32; ++e) { const float v = lr[e]; if (v > best) { best = v; bi2 = e; } }
                te[k] = bi2; tv[k] = best; lr[bi2] = -INFINITY; LDS_WAIT(); asm volatile("" ::: "memory"); }
            const float p1 = __expf(tv[1] - tv[0]), p2 = __expf(tv[2] - tv[0]), p3 = __expf(tv[3] - tv[0]); const float inv = 1.0f / (1.0f + p1 + p2 + p3);
            const float gts[4] = {inv, p1 * inv, p2 * inv, p3 * inv};
            const int rl = 16 * wave + lane;
#pragma unroll
            for (int k = 0; k < 4; ++k) { const unsigned rank = atomicAdd((unsigned*)(hist + te[k]), 1u); rowinfo[rl * 4 + k] = (v2u){(unsigned)te[k] | (rank << 8), __float_as_uint(gts[k])}; }
            RS[rl] = rstd;
        }
        __syncthreads();
        if (tid < 32) basew[tid] = dry ? 0u : __hip_atomic_fetch_add(gcnt + tid, hist[tid], __ATOMIC_RELAXED, __HIP_MEMORY_SCOPE_AGENT);
        __syncthreads();
        { const int rl = tid >> 2, k = tid & 3; const v2u inf = rowinfo[rl * 4 + k]; const int e = inf.x & 0xff; const unsigned slot = basew[e] + (inf.x >> 8); const int t = rbase + rl;
          if (!dry) { TOKL[(size_t)e * ECAP + slot] = t; GATEL[(size_t)e * ECAP + slot] = __uint_as_float(inf.y); TOKREC[t * 4 + k] = (int)(((unsigned)e << 20) | slot); if (k == 0) RSTDT[t] = RS[rl]; } }
        __syncthreads();
        if (tid < 32) hist[tid] = 0u;
        __syncthreads();
    }
}

__device__ __forceinline__ void moe_tables(Frame& F) {
    LAS int* misc = (LAS int*)(F.lds + MISC_OFF);
    const unsigned* gcnt = (const unsigned*)(F.ws + WS_CTL) + CW_CNT;
    if (F.tid < 32) misc[F.tid] = (int)__hip_atomic_load(gcnt + F.tid, __ATOMIC_RELAXED, __HIP_MEMORY_SCOPE_AGENT);
    __syncthreads();
    if (F.tid == 0) { int s = 0; for (int e = 0; e < NE; ++e) { misc[32 + e] = s; s += (misc[e] + 255) >> 8; } misc[32 + NE] = s; }
    __syncthreads();
}
constexpr int UDESC_WORD = 208;
template <class Sched> __device__ __forceinline__ int resolve_units(Frame& F, const Sched& S, int maxu, int stride) {
    LAS int* misc = (LAS int*)(F.lds + MISC_OFF);
    if (F.tid == 0) misc[UDESC_WORD - 1] = 0;
    __syncthreads();
    pg8::Unit u;
    for (int ui = F.wave; ui < maxu; ui += NWAVES) { if (!S.next(ui * stride, u)) break;
        if (F.lane == 0) { misc[UDESC_WORD + 3 * ui] = u.aux; misc[UDESC_WORD + 3 * ui + 1] = u.pn; misc[UDESC_WORD + 3 * ui + 2] = u.pm; atomicMax((int*)(misc + UDESC_WORD - 1), ui + 1); } }
    __syncthreads();
    return misc[UDESC_WORD - 1];
}
template <class Base> struct TabSched : Base {
    const LAS int* desc; int nu;
    __device__ __forceinline__ TabSched(const Base& b, const LAS int* d, int n) : Base(b), desc(d), nu(n) {}
    __device__ __forceinline__ bool next(int i, pg8::Unit& u) const { if (i >= nu) return false; u.aux = desc[3 * i]; u.pn = desc[3 * i + 1]; u.pm = desc[3 * i + 2]; return true; }
};
__device__ __forceinline__ int moe_gather_table(Frame& F, const MoeSched<8>& S) {
    LAS int* misc = (LAS int*)(F.lds + MISC_OFF); LAS unsigned short* gtab = (LAS unsigned short*)(F.lds + GTAB_OFF);
    LAS unsigned short* etab = (LAS unsigned short*)(F.lds + ETAB_OFF); LAS unsigned short* rtab = etab + MAX_GUNITS * 256;
    const int* TOKL = (const int*)(F.ws + WS_TOKL); const float* RSTDT = (const float*)(F.ws + WS_RSTDT);
    const int nu = resolve_units(F, S, MAX_GUNITS, 1);
    if (nu == 0) return 0;
    int tv[MAX_GUNITS / 2]; float bv[MAX_GUNITS / 2], rv[MAX_GUNITS / 2];
#pragma unroll
    for (int j = 0; j < MAX_GUNITS / 2; ++j) { const int idx = F.tid + 512 * j, uiu = idx >> 8, ui = uiu < nu ? uiu : nu - 1, r = idx & 255;
        const int aux = misc[UDESC_WORD + 3 * ui], pn = misc[UDESC_WORD + 3 * ui + 1], e = aux & 0xff, rb = aux >> 8, slot = rb * 256 + r; const bool ok = slot < misc[e];
        tv[j] = TOKL[(size_t)e * ECAP + (ok ? slot : 0)]; tv[j] = ok ? tv[j] : 0;
        bv[j] = F.in[I_BGU][(size_t)e * (2 * DFF) + (r < 128 ? 0 : DFF - 128) + pn * 128 + r]; }
    asm volatile("" ::: "memory");
#pragma unroll
    for (int j = 0; j < MAX_GUNITS / 2; ++j) rv[j] = RSTDT[tv[j]];
    asm volatile("" ::: "memory");
#pragma unroll
    for (int j = 0; j < MAX_GUNITS / 2; ++j) { const int idx = F.tid + 512 * j; if ((idx >> 8) < nu) { gtab[idx] = (unsigned short)tv[j]; etab[idx] = (unsigned short)f2bf(bv[j]); rtab[idx] = (unsigned short)f2bf(rv[j]); } }
    __syncthreads();
    return nu;
}
__device__ __forceinline__ int moe_down_table(Frame& F, const MoeDownSched& S) {
    LAS int* misc = (LAS int*)(F.lds + MISC_OFF); LAS float* etab = (LAS float*)(F.lds + ETAB_OFF); LAS float* gt2 = (LAS float*)(F.lds + GTAB_OFF);
    const float* GATEL = (const float*)(F.ws + WS_GATEL);
    const int nu = resolve_units(F, S, 9, PROBE_K2X ? 2 : 1);
    if (nu == 0) return 0;
    float bv[5], gv[5];
#pragma unroll
    for (int j = 0; j < 5; ++j) { const int idx = F.tid + 512 * j, uiu = idx >> 8, ui = uiu < nu ? uiu : nu - 1, r = idx & 255;
        const int aux = misc[UDESC_WORD + 3 * ui], pn = misc[UDESC_WORD + 3 * ui + 1], e = aux & 0xff, rb = (aux >> 8) & 0xffff;
        bv[j] = F.in[I_BDN][(size_t)e * D + pn * 256 + r]; gv[j] = GATEL[(size_t)e * ECAP + rb * 256 + r]; }
    asm volatile("" ::: "memory");
#pragma unroll
    for (int j = 0; j < 5; ++j) { const int idx = F.tid + 512 * j; if ((idx >> 8) < nu) { etab[idx] = bv[j]; gt2[idx] = gv[j]; } }
    __syncthreads();
    return nu;
}
__device__ __forceinline__ int inproj_table(Frame& F, const DenseSched& S) {
    LAS int* misc = (LAS int*)(F.lds + MISC_OFF); LAS float* etab = (LAS float*)(F.lds + ETAB_OFF);
    const int nu = resolve_units(F, S, MAX_GUNITS, 1);
    if (nu == 0) return 0;
    float bv[MAX_GUNITS / 2];
#pragma unroll
    for (int j = 0; j < MAX_GUNITS / 2; ++j) { const int idx = F.tid + 512 * j, uiu = idx >> 8, ui = uiu < nu ? uiu : nu - 1, r = idx & 255; bv[j] = F.in[I_BIN][misc[UDESC_WORD + 3 * ui + 1] * 256 + r]; }
    asm volatile("" ::: "memory");
#pragma unroll
    for (int j = 0; j < MAX_GUNITS / 2; ++j) { const int idx = F.tid + 512 * j; if ((idx >> 8) < nu) etab[idx] = bv[j]; }
    __syncthreads();
    return nu;
}

__device__ __forceinline__ void p1_fixup_own(Frame& F, int nu) {
    LAS int* misc = (LAS int*)(F.lds + MISC_OFF);
    bool any = false;
    for (int ui = 0; ui < nu; ++ui) any |= (misc[UDESC_WORD + 3 * ui + 1] <= 2);
    if (!any) return;
    asm volatile("s_waitcnt vmcnt(0)" ::: "memory"); __syncthreads();
    LAS f32x2* tab = (LAS f32x2*)(F.lds);
    for (int idx = F.tid; idx < 1024; idx += NWAVES * 64) { const int pos = idx >> 4, f = idx & 15; const float inv = powf(10000.0f, -(float)f / 16.0f); const float ang = (float)pos * inv;
        tab[idx] = (f32x2){cosf(ang), sinf(ang)}; }
    __syncthreads();
    const int c = F.lane & 7;
    float gq[8], gk[8];
#pragma unroll
    for (int j = 0; j < 8; ++j) { gq[j] = F.in[I_QNG][8 * c + j]; gk[j] = F.in[I_KNG][8 * c + j]; }
    bf16* Q = (bf16*)(F.ws + WS_Q); bf16* KV = (bf16*)(F.ws + WS_KV);
    for (int ui = 0; ui < nu; ++ui) {
        const int pn = misc[UDESC_WORD + 3 * ui + 1], pm = misc[UDESC_WORD + 3 * ui + 2];
        if (pn > 2) continue;
        if (pn < 2) {
            for (int it = 0; it < 16; it += 4) { v4u rq[4]; bf16* pp[4]; int tt[4];
#pragma unroll
                for (int i = 0; i < 4; ++i) { tt[i] = pm * 256 + 2 * (F.wave + 8 * (it + i)) + (F.lane >> 5); pp[i] = Q + (size_t)tt[i] * QW + pn * 256 + (F.lane & 31) * 8; rq[i] = *(const GAS v4u*)pp[i]; }
#pragma unroll
                for (int i = 0; i < 4; ++i) { const int sq = tt[i] & (SEQ - 1); *(GAS v4u*)pp[i] = fix_vals(rq[i], gq, attn_body::C2, c, sq >> 6, sq & 63, tab); } }
        } else {
            for (int it = 0; it < 8; it += 4) { v4u rk[4]; bf16* pp[4]; int tt[4];
#pragma unroll
                for (int i = 0; i < 4; ++i) { tt[i] = pm * 256 + 4 * (F.wave + 8 * (it + i)) + (F.lane >> 4); pp[i] = KV + (size_t)tt[i] * (2 * KVW) + (F.lane & 15) * 8; rk[i] = *(const GAS v4u*)pp[i]; }
#pragma unroll
                for (int i = 0; i < 4; ++i) { const int sq = tt[i] & (SEQ - 1); *(GAS v4u*)pp[i] = fix_vals(rk[i], gk, 1.0f, c, sq >> 6, sq & 63, tab); } }
        }
    }
    __syncthreads();
}

__device__ __forceinline__ void p10_final(Frame& F, float* dst) {
    LAS int* misc = (LAS int*)(F.lds + MISC_OFF);
    const int gw = F.vcu * NWAVES + F.wave, NGW = F.G * NWAVES, lane = F.lane;
    f32x4 g[4];
#pragma unroll
    for (int j = 0; j < 4; ++j) g[j] = *((const GAS f32x4*)F.in[I_FG] + lane + 64 * j);
    const int* TOKREC = (const int*)(F.ws + WS_TOKREC); const unsigned char* Y = (const unsigned char*)(F.ws + WS_Y); const bf16* X1B = (const bf16*)(F.ws + WS_X1B);
    typedef int v4i __attribute__((ext_vector_type(4)));
    v4i rec = (gw < T) ? *(const GAS v4i*)(TOKREC + (size_t)gw * 4) : (v4i){0, 0, 0, 0};
    for (int t = gw; t < T; t += NGW) {
        const int tn = t + NGW;
        const v4i recn = (tn < T) ? *(const GAS v4i*)(TOKREC + (size_t)tn * 4) : rec;
        const GAS v2u* xp = (const GAS v2u*)(X1B + (size_t)t * D) + lane;
        f32x4 v[4]; unsigned yv[4][4];
#pragma unroll
        for (int k = 0; k < 4; ++k) { const unsigned rk = (unsigned)rec[k]; const int e = rk >> 20, slot = rk & 0xfffff;
            const GAS unsigned* yp = (const GAS unsigned*)(Y + ((size_t)misc[32 + e] * 256 + slot) * D) + lane;
#pragma unroll
            for (int j = 0; j < 4; ++j) yv[k][j] = __builtin_nontemporal_load(yp + 64 * j); }
#pragma unroll
        for (int j = 0; j < 4; ++j) { const v2u w = __builtin_nontemporal_load(xp + 64 * j); v[j] = (f32x4){bflo(w.x), bfhi(w.x), bflo(w.y), bfhi(w.y)}; }
        f32x4 ys[4];
#pragma unroll
        for (int j = 0; j < 4; ++j) ys[j] = (f32x4){0.f, 0.f, 0.f, 0.f};
#pragma unroll
        for (int k = 0; k < 4; ++k)
#pragma unroll
            for (int j = 0; j < 4; ++j) { const f32x2 lo = __builtin_amdgcn_cvt_pk_f32_fp8((int)yv[k][j], false), hi = __builtin_amdgcn_cvt_pk_f32_fp8((int)yv[k][j], true);
                ys[j].x += lo.x; ys[j].y += lo.y; ys[j].z += hi.x; ys[j].w += hi.y; }
#pragma unroll
        for (int j = 0; j < 4; ++j) v[j] = v[j] + ys[j] * YSCALE_INV;
        float s = 0.f;
#pragma unroll
        for (int j = 0; j < 4; ++j) s += (v[j].x * v[j].x + v[j].y * v[j].y) + (v[j].z * v[j].z + v[j].w * v[j].w);
        const float rstd = 1.0f / sqrtf(wave_sum(s) * (1.f / D) + NORM_EPS);
        GAS f32x4* op = (GAS f32x4*)(dst + (size_t)t * D) + lane;
#pragma unroll
        for (int j = 0; j < 4; ++j) __builtin_nontemporal_store(v[j] * rstd * g[j], op + 64 * j);
        rec = recn;
    }
}
typedef GAS unsigned gu32;
#define RLX_AGENT __ATOMIC_RELAXED, __HIP_MEMORY_SCOPE_AGENT
#define XB_TMO      128
#define XB_XCNT(j)  (256  + 64 * (j))
#define XB_XSUB(j)  (1280 + 64 * (j))
#define XB_XGEN(j)  (2304 + 64 * (j))
#define XB_TOP      3328
#define XB_TOPGEN   3392
#define XCD_BAR_WORDS 3456
#define XB_SPIN_CAP (1u << 18)

__device__ __forceinline__ unsigned xb_ld(unsigned* p)              { return __hip_atomic_load(p, __ATOMIC_RELAXED, __HIP_MEMORY_SCOPE_AGENT); }
__device__ __forceinline__ unsigned xb_add(unsigned* p, unsigned v) { return __hip_atomic_fetch_add(p, v, __ATOMIC_RELAXED, __HIP_MEMORY_SCOPE_AGENT); }
__device__ __forceinline__ unsigned xb_xcc_id() { return (unsigned)__builtin_amdgcn_s_getreg((3 << 11) | 20) & 0xFu; }
#define XB_SPIN(cond, bar) do { unsigned _sp = 0; while (cond) { __builtin_amdgcn_s_sleep(1); \
    if ((++_sp & 255u) == 0u) { if (xb_ld(&(bar)[XB_TMO])) break; if (_sp > XB_SPIN_CAP) { atomicAdd(&(bar)[XB_TMO], 1u); break; } } } } while (0)

struct XcdBarrier {
    unsigned* bar; unsigned x;
    volatile LAS unsigned* st;
};

__device__ __forceinline__ XcdBarrier xcd_barrier_post(unsigned* bar, volatile LAS unsigned* st) {
    XcdBarrier b; b.bar = bar; b.x = xb_xcc_id(); b.st = st;
    if (threadIdx.x == 0) (void)xb_add(&bar[XB_XCNT(b.x)], 1u);
    return b;
}
__device__ __forceinline__ void xcd_barrier_complete(unsigned* bar, unsigned x, unsigned& nloc, unsigned& nx) {
    const unsigned G = gridDim.x * gridDim.y * gridDim.z;
    unsigned sum, cnt, mine, sp = 0u;
    for (;;) {
        sum = 0u; cnt = 0u; mine = 0u;
#pragma unroll
        for (unsigned j = 0; j < 16; ++j) { const unsigned c = xb_ld(&bar[XB_XCNT(j)]); sum += c; cnt += (c > 0u) ? 1u : 0u; mine = (j == x) ? c : mine; }
        if (sum == G) break;
        __builtin_amdgcn_s_sleep(1);
        if ((++sp & 255u) == 0u) { if (xb_ld(&bar[XB_TMO])) break; if (sp > XB_SPIN_CAP) { atomicAdd(&bar[XB_TMO], 1u); break; } }
    }
    nloc = mine > 0u ? mine : 1u; nx = cnt > 0u ? cnt : 1u;
}

__device__ __forceinline__ void xcd_barrier(const XcdBarrier& b) {
    asm volatile("s_waitcnt vmcnt(0)" ::: "memory");
    __syncthreads();
    if (threadIdx.x == 0) {
        unsigned* bar = b.bar;
        __builtin_amdgcn_s_waitcnt(0);
        unsigned nloc = b.st[0], nx = b.st[1];
        if (nloc == 0u) { xcd_barrier_complete(bar, b.x, nloc, nx); b.st[0] = nloc; b.st[1] = nx; }
        const unsigned old = xb_add(&bar[XB_XSUB(b.x)], 1u);
        const unsigned gen = old / nloc;
        if (old + 1u == (gen + 1u) * nloc) {
            __builtin_amdgcn_fence(__ATOMIC_RELEASE, "agent");
            asm volatile("s_waitcnt vmcnt(0)" ::: "memory");
            const unsigned og = xb_add(&bar[XB_TOP], 1u);
            const unsigned tg = og / nx;
            if (og + 1u == (tg + 1u) * nx) xb_add(&bar[XB_TOPGEN], 1u);
            else XB_SPIN(xb_ld(&bar[XB_TOPGEN]) == tg, bar);
            __builtin_amdgcn_fence(__ATOMIC_ACQUIRE, "agent");
            xb_add(&bar[XB_XGEN(b.x)], 1u);
            asm volatile("s_waitcnt vmcnt(0)" ::: "memory");
        } else {
            XB_SPIN(xb_ld(&bar[XB_XGEN(b.x)]) == gen, bar);
            __builtin_amdgcn_fence(__ATOMIC_ACQUIRE, "agent");
            asm volatile("s_waitcnt vmcnt(0)" ::: "memory");
        }
    }
    __syncthreads();
}

constexpr int N_PHASES = 10;
struct Args { const float* in[24]; float* out; unsigned char* ws; int ph_lo, ph_hi; };
__global__ void __launch_bounds__(NWAVES * 64, 2) mk_fwd(Args args) {
    extern __shared__ __attribute__((aligned(16))) unsigned char lds[];
#define MKFRAME() Frame F; { int t_ = threadIdx.x; asm volatile("" : "+v"(t_)); F.lds = (LAS unsigned char*)lds; F.tid = t_; F.lane = t_ & 63; F.wave = __builtin_amdgcn_readfirstlane(t_ >> 6); \
        F.G = gridDim.x; const int bx = blockIdx.x; F.vcu = (F.G % 8 == 0) ? (bx % 8) * (F.G / 8) + bx / 8 : bx; F.in = args.in; F.out = args.out; F.ws = args.ws; }
    unsigned char* ws = args.ws;
    const int lo = args.ph_lo, hi = args.ph_hi;
#ifndef TP_SEAM
#define TP_SEAM -1
#endif
    unsigned long long tp0_ = 0, tp1_ = 0; if (TP_SEAM >= 0) tp0_ = __builtin_amdgcn_s_memrealtime();
#ifndef PH_MASK
#define PH_MASK 0x3ff
#endif
#define IN(k) (((PH_MASK >> (k)) & 1) && lo <= (k) && (k) < hi)
#ifndef REP_MASK
#define REP_MASK 0
#endif
#define REPS(k) for (int rep_ = 0; rep_ < ((((REP_MASK) >> (k)) & 1) ? 2 : 1); ++rep_)
#ifndef XTRA_BAR
#define XTRA_BAR 0
#endif
#define SEAM(k) do { if (IN(k) && IN((k) + 1)) { xcd_barrier(bar); for (int xb_ = 0; xb_ < XTRA_BAR; ++xb_) xcd_barrier(bar); if (TP_SEAM == (k)) tp1_ = __builtin_amdgcn_s_memrealtime(); } } while (0)

    XcdBarrier bar;
    { volatile LAS unsigned* st = (volatile LAS unsigned*)(lds + MISC_OFF) + 200; if (threadIdx.x == 0) { st[0] = 0u; st[1] = 0u; } __syncthreads(); bar = xcd_barrier_post((unsigned*)(ws + WS_CTL) + CW_BAR, st); }
#ifndef LATE_EXPERT_CONV
#define LATE_EXPERT_CONV 2
#endif
    if (IN(0)) { MKFRAME(); REPS(0) p0_prologue(F, 0, LATE_EXPERT_CONV ? P0_MIXER_ITEMS : P0_NITEMS, true); }
    SEAM(0);
    if (IN(1)) { MKFRAME();
        DenseSched S{(const char*)(ws + WS_XN), (const char*)(ws + WS_WIN), T / 256, INW / 256, D / 64, F.G, (int)blockIdx.x, (size_t)256 * D * 2, (size_t)256 * D * 2, (REP_MASK >> 1) & 1, 16};
        const int nu = inproj_table(F, S);
        const TabSched<DenseSched> TS(S, (const LAS int*)(F.lds + MISC_OFF) + UDESC_WORD, nu);
        EpiInProj E{ws, (const LAS float*)(F.lds + ETAB_OFF)};
        pg8::gemm_phase<EpiInProj, TabSched<DenseSched>, true, false>(F.lds, D * 2, D * 2, TS, E, nullptr);
        p1_fixup_own(F, nu);
    }
    SEAM(1);
    if (IN(3)) { { MKFRAME(); REPS(2) p2_lru(F); }
      MKFRAME();
        const attn_body::AttnTensors AT{(const attn_body::bf16*)(ws + WS_Q), (const attn_body::bf16*)(ws + WS_KV), (const attn_body::bf16*)(ws + WS_KV) + KVW, (attn_body::bf16*)(ws + WS_AR)};
        const attn_body::StaticOrder S((int)F.G, F.vcu);
        REPS(3) attn_body::attn_phase<attn_body::StaticOrder>((char*)lds, AT, S);
    }
    SEAM(3);
    if (IN(4)) { MKFRAME();
        MergeSched S{(const char*)(ws + WS_AR), (const char*)(ws + WS_WCAT), F.G, (int)blockIdx.x};
        EpiMerge E{(const bf16*)(ws + WS_GL), (bf16*)(ws + WS_MERGED)};
        pg8::gemm_phase<EpiMerge, MergeSched, true, false>(F.lds, ARW * 2, ARW * 2, S, E, nullptr);
    }
    SEAM(4);
    if (IN(5)) { MKFRAME();
        DenseSched S{(const char*)(ws + WS_MERGED), (const char*)(ws + WS_WO), T / 256, D / 256, D / 64, F.G, (int)blockIdx.x, (size_t)256 * D * 2, (size_t)256 * D * 2, (REP_MASK >> 5) & 1, 0};
        EpiResF32 E{(bf16*)(ws + WS_MIXB)};
        pg8::gemm_phase<EpiResF32, DenseSched, true, false>(F.lds, D * 2, D * 2, S, E, nullptr);
    }
    SEAM(5);
    if (IN(6)) { MKFRAME(); if (LATE_EXPERT_CONV == 2) { p0_prologue(F, P0_MIXER_ITEMS, P0_NITEMS, false); __syncthreads(); }
        if ((REP_MASK >> 6) & 1) p6_router(F, true); p6_router(F, false);
        if (LATE_EXPERT_CONV == 1) { __syncthreads(); p0_prologue(F, P0_MIXER_ITEMS, P0_NITEMS, false); } }
    SEAM(6);
    if (IN(7)) { MKFRAME();
        moe_tables(F);
        MoeSched<8> S{(const char*)(ws + WS_XN), (const char*)(ws + WS_WGU), (const LAS int*)(F.lds + MISC_OFF) + 32, F.G, (int)blockIdx.x, (size_t)2 * DFF * D};
        const int nu = moe_gather_table(F, S);
        const TabSched<MoeSched<8>> TS(S, (const LAS int*)(F.lds + MISC_OFF) + UDESC_WORD, nu);
        EpiSwiGLU E{(const LAS unsigned short*)(F.lds + ETAB_OFF), (const LAS unsigned short*)(F.lds + ETAB_OFF) + MAX_GUNITS * 256, (unsigned char*)(ws + WS_ACT)};
        REPS(7) pg8::gemm_phase<EpiSwiGLU, TabSched<MoeSched<8>>, true, true, true>(F.lds, D, D, TS, E, (const LAS unsigned short*)(F.lds + GTAB_OFF));
    }
    SEAM(7);
    if (IN(8)) { MKFRAME();
        moe_tables(F);
        MoeDownSched S; S.A = (const char*)(ws + WS_ACT); S.B = (const char*)(ws + WS_WD); S.nbp = (const LAS int*)(F.lds + MISC_OFF) + 32; S.G = F.G; S.c = (int)blockIdx.x; S.estepB = (size_t)D * DFF;
        const int nu = moe_down_table(F, S);
        const TabSched<MoeDownSched> TS(S, (const LAS int*)(F.lds + MISC_OFF) + UDESC_WORD, nu);
        EpiDown E{(const LAS float*)(F.lds + ETAB_OFF), (const LAS float*)(F.lds + GTAB_OFF), (unsigned char*)(ws + WS_Y)};
        REPS(8) pg8::gemm_phase<EpiDown, TabSched<MoeDownSched>, true, false, true>(F.lds, DFF, DFF, TS, E, nullptr);
    }
    SEAM(8);
    if (IN(9)) { MKFRAME(); moe_tables(F); if ((REP_MASK >> 9) & 1) p10_final(F, (float*)(ws + WS_ACT)); p10_final(F, F.out); }
    if ((TP_SEAM >= 0 || LRU_TP > 0) && blockIdx.x == 0) { const unsigned long long te_ = __builtin_amdgcn_s_memrealtime(); if (TP_SEAM == 9) tp1_ = te_; unsigned long long w_ = 4ull * (tp1_ - tp0_); if (LRU_TP > 0) w_ = 4ull * *(volatile LAS unsigned*)(lds + MISC_OFF + 4 * 204); while (__builtin_amdgcn_s_memrealtime() - te_ < w_) __builtin_amdgcn_s_sleep(8); }
#undef IN
#undef SEAM
}

#ifndef MK_N_LAUNCHES
#define MK_N_LAUNCHES 1
#endif
extern "C" void kernel_launch(void* const* d_in, const int* in_sizes, int n_in, void* d_out, int out_size, void* d_ws, size_t ws_size, hipStream_t stream) {
    static int grid = 0;
    if (grid == 0) {
        if (n_in != 24 || in_sizes[0] != T * D || out_size != T * D || ws_size < WS_END) { fprintf(stderr, "kernel_launch: unexpected shapes (n_in %d, in0 %d, out %d, ws %zu < %zu)\n", n_in, n_in > 0 ? in_sizes[0] : -1, out_size, ws_size, (size_t)WS_END); grid = -1; return; }
        int dev = 0, cus = 0, per_cu = 0;
        if (hipGetDevice(&dev) != hipSuccess || hipDeviceGetAttribute(&cus, hipDeviceAttributeMultiprocessorCount, dev) != hipSuccess) { grid = -1; return; }
        if (hipFuncSetAttribute((const void*)mk_fwd, hipFuncAttributeMaxDynamicSharedMemorySize, LDS_BYTES) != hipSuccess) { fprintf(stderr, "kernel_launch: hipFuncSetAttribute failed\n"); grid = -1; return; }
        if (hipOccupancyMaxActiveBlocksPerMultiprocessor(&per_cu, (const void*)mk_fwd, NWAVES * 64, LDS_BYTES) != hipSuccess || per_cu < 1) { fprintf(stderr, "kernel_launch: occupancy query reports %d\n", per_cu); per_cu = 1; }
        (void)hipGetLastError();
        grid = cus;
    }
    if (grid < 0) return;
    Args a{};
    for (int i = 0; i < 24; ++i) a.in[i] = (const float*)d_in[i];
    a.out = (float*)d_out; a.ws = (unsigned char*)d_ws;
    const int nl = 1;
    for (int li = 0; li < nl; ++li) {
        a.ph_lo = (nl == 1) ? 0 : li; a.ph_hi = (nl == 1) ? N_PHASES : li + 1;
        void* kargs[] = {&a};
        if (hipMemsetAsync((char*)d_ws + WS_CTL, 0, CTL_ZERO_BYTES, stream) != hipSuccess) { fprintf(stderr, "kernel_launch: hipMemsetAsync failed\n"); return; }
        const hipError_t le = hipLaunchCooperativeKernel((const void*)mk_fwd, dim3(grid), dim3(NWAVES * 64), kargs, LDS_BYTES, stream);
        if (le != hipSuccess) { fprintf(stderr, "kernel_launch: launch %d failed: %s (grid %d)\n", li, hipGetErrorName(le), grid); break; }
    }
}
```

```cpp
#include <hip/hip_runtime.h>
#include <hip/hip_cooperative_groups.h>
#include <cstdio>
#include <cstdint>
namespace pg8 {
#define PG8_LAS __attribute__((address_space(3)))
typedef unsigned short bf16_t;
typedef short bf16x8 __attribute__((ext_vector_type(8)));
typedef float f32x4 __attribute__((ext_vector_type(4)));
typedef float f32x2 __attribute__((ext_vector_type(2)));
typedef unsigned u32x4 __attribute__((ext_vector_type(4)));
typedef unsigned u32x2 __attribute__((ext_vector_type(2)));
typedef int v8i32 __attribute__((ext_vector_type(8)));
typedef int v4i32 __attribute__((ext_vector_type(4)));
constexpr int BM = 256, BK = 64, HALF = 128, HTB = HALF * BK * 2  , STAGE_BYTES = 8 * HTB, NXCD = 8, WGM = 8;

__host__ __device__ __forceinline__ int lds_byte(int r, int c) { const int st = (r >> 4) * 2 + (c >> 5), rr = r & 15, cc = c & 31, ob = rr * 64 + cc * 2; return st * 1024 + (ob ^ (((ob >> 9) & 1) << 5)); }
__host__ __device__ __forceinline__ void stage_rc(int b, int& R, int& C) { const int st = b / 1024, sb = b % 1024, swz = sb ^ (((sb >> 9) & 1) << 5); R = (st >> 1) * 16 + swz / 64; C = (st & 1) * 32 + (swz % 64) / 2; }
__host__ __device__ __forceinline__ int perm32(int rho) { const int n = rho >> 4, i = rho & 15; return 8 * (i >> 2) + 4 * n + (i & 3); }

struct Unit { int pm, pn, aux, ui; };

__device__ __forceinline__ void dense_tile(int L, int nM, int nN, int& pm, int& pn) {
    const int nwg = nM * nN; int wgid = L;
    { const int q = nwg / NXCD, r = nwg % NXCD, xcd = wgid % NXCD, off = wgid / NXCD; wgid = (xcd < r ? xcd * (q + 1) : r * (q + 1) + (xcd - r) * q) + off; }
    const int nig = WGM * nN, gid = wgid / nig, fm = gid * WGM, gsz = (nM - fm) < WGM ? (nM - fm) : WGM;
    pm = fm + ((wgid % nig) % gsz); pn = (wgid % nig) / gsz;
}

__device__ __forceinline__ unsigned cvt_pk_bf16(float lo, float hi) { unsigned r; asm volatile("v_cvt_pk_bf16_f32 %0, %1, %2" : "=v"(r) : "v"(lo), "v"(hi)); return r; }
__device__ __forceinline__ float bf_lo(unsigned w) { return __uint_as_float(w << 16); }
__device__ __forceinline__ float bf_hi(unsigned w) { return __uint_as_float(w & 0xffff0000u); }
__device__ __forceinline__ float fast_sigmoid(float x) { return __builtin_amdgcn_rcpf(1.0f + __builtin_amdgcn_exp2f(-1.4426950408889634f * x)); }

template <class Epi, class Sched, bool ALIGN_EPI, bool GATHER, bool FP8 = false>
__device__ __forceinline__ void gemm_phase(PG8_LAS unsigned char* lds, const int lda, const int ldb, const Sched& S, const Epi& E, const PG8_LAS unsigned short* gtab) {
    const int tid = threadIdx.x, wid = __builtin_amdgcn_readfirstlane(tid >> 6), lane = tid & 63, wr = wid >> 2, wc = wid & 3, fr = lane & 15, fq = lane >> 4;
    unsigned voffA[2], voffB[2]; int RA[2];
#pragma unroll
    for (int i = 0; i < 2; ++i) { int R, C; stage_rc(tid * 16 + i * 8192, R, C); const int Rb = Epi::PERM ? ((R & ~31) + perm32(R & 31)) : R;
        voffA[i] = GATHER ? (unsigned)(C * 2) : (unsigned)(R * lda + C * 2); voffB[i] = (unsigned)(Rb * ldb + C * 2); RA[i] = R; }
    const size_t kstep = (size_t)(BK * 2);
    const size_t hstepA = GATHER ? 0 : (size_t)HALF * lda;
    const size_t hstepB = (size_t)HALF * ldb;
    const unsigned ldsw = (unsigned)wid * 1024u;
    const int aoff = lds_byte(wr * 64 + fr, fq * 8), boff = lds_byte(wc * 32 + fr, fq * 8);
    const int aoff8 = lds_byte(wr * 64 + fr, (fq >> 1) * 32 + (fq & 1) * 16), boff8 = lds_byte(wc * 32 + fr, (fq >> 1) * 32 + (fq & 1) * 16);
    unsigned gC[2][2], gN[2][2];
#define PG8_SA(b, h) (((b) * 2 + (h)) * HTB)
#define PG8_SB(b, h) ((4 + (b) * 2 + (h)) * HTB)
#define PG8_GLDS(gp, bufoff, i) __builtin_amdgcn_global_load_lds((const unsigned*)(gp), (PG8_LAS unsigned*)(lds + (bufoff) + ldsw + (i) * 8192), 16, 0, 0)
#define PG8_STAGE_B(bufoff, gbase) do { _Pragma("unroll") for (int _i = 0; _i < 2; ++_i) PG8_GLDS((const char*)(gbase) + voffB[_i], bufoff, _i); } while (0)
#define PG8_STAGE_A(bufoff, gbase, h, nx) do { _Pragma("unroll") for (int _i = 0; _i < 2; ++_i) { \
        if constexpr (GATHER) PG8_GLDS((const char*)(gbase) + ((nx) ? gN[h][_i] : gC[h][_i]) + voffA[_i], bufoff, _i); \
        else PG8_GLDS((const char*)(gbase) + voffA[_i], bufoff, _i); } } while (0)
#define PG8_LDA(dst, b, h) do { if constexpr (FP8) { _Pragma("unroll") for (int m = 0; m < 4; ++m) dst##8[m] = __builtin_shufflevector(*(const PG8_LAS v4i32*)(lds + PG8_SA(b, h) + aoff + m * 2048), *(const PG8_LAS v4i32*)(lds + PG8_SA(b, h) + aoff + m * 2048 + 1024), 0, 1, 2, 3, 4, 5, 6, 7); } \
        else { _Pragma("unroll") for (int m = 0; m < 4; ++m) _Pragma("unroll") for (int k = 0; k < 2; ++k) dst[m][k] = *(const PG8_LAS bf16x8*)(lds + PG8_SA(b, h) + aoff + m * 2048 + k * 1024); } } while (0)
#define PG8_LDB(dst, b, h) do { if constexpr (FP8) { _Pragma("unroll") for (int n = 0; n < 2; ++n) dst##8[n] = __builtin_shufflevector(*(const PG8_LAS v4i32*)(lds + PG8_SB(b, h) + boff + n * 2048), *(const PG8_LAS v4i32*)(lds + PG8_SB(b, h) + boff + n * 2048 + 1024), 0, 1, 2, 3, 4, 5, 6, 7); } \
        else { _Pragma("unroll") for (int n = 0; n < 2; ++n) _Pragma("unroll") for (int k = 0; k < 2; ++k) dst[n][k] = *(const PG8_LAS bf16x8*)(lds + PG8_SB(b, h) + boff + n * 2048 + k * 1024); } } while (0)
#define PG8_MMA(ai, bj, At, Bt) do { __builtin_amdgcn_s_setprio(1); _Pragma("unroll") for (int m = 0; m < 4; ++m) _Pragma("unroll") for (int n = 0; n < 2; ++n) { \
        if constexpr (FP8) { asm volatile("v_mfma_scale_f32_16x16x128_f8f6f4 %0, %1, %2, %0, %3, %3 op_sel_hi:[0,0,0]" : "+v"(acc[ai][bj][m][n]) : "v"(Bt##8[n]), "v"(At##8[m]), "v"(scale1)); } \
        else { _Pragma("unroll") for (int k = 0; k < 2; ++k) acc[ai][bj][m][n] = __builtin_amdgcn_mfma_f32_16x16x32_bf16(Bt[n][k], At[m][k], acc[ai][bj][m][n], 0, 0, 0); } } \
        __builtin_amdgcn_s_setprio(0); } while (0)
#define PG8_WAIT_V(n) asm volatile("s_waitcnt vmcnt(" #n ")" ::: "memory")
#define PG8_WAIT_L(n) asm volatile("s_waitcnt lgkmcnt(" #n ")" ::: "memory")
#define PG8_BAR __builtin_amdgcn_s_barrier()
#define PG8_SCHED __builtin_amdgcn_sched_barrier(0)
#define PG8_GOFF(dst, ui_) do { if constexpr (GATHER) { _Pragma("unroll") for (int _h = 0; _h < 2; ++_h) _Pragma("unroll") for (int _i = 0; _i < 2; ++_i) \
        dst[_h][_i] = (unsigned)gtab[(ui_) * 256 + _h * HALF + RA[_i]] * (unsigned)lda; } } while (0)
    Unit cur, nxt; int ui = 0;
    if (!S.next(0, cur)) return;
    cur.ui = 0;
    f32x4 acc[2][2][4][2];
#pragma unroll
    for (int a = 0; a < 2; ++a)
#pragma unroll
        for (int b = 0; b < 2; ++b)
#pragma unroll
            for (int m = 0; m < 4; ++m)
#pragma unroll
                for (int n = 0; n < 2; ++n) acc[a][b][m][n] = (f32x4){0.f, 0.f, 0.f, 0.f};
    bf16x8 At[4][2], B0[2][2], B1[2][2]; v8i32 At8[4], B08[2], B18[2];
    int scale1 = 0x7f7f7f7f; asm volatile("" : "+v"(scale1));
    const char* cA = S.a_ptr(cur); const char* cB = S.b_ptr(cur);
    PG8_GOFF(gC, 0);
#pragma unroll
    for (int _h = 0; _h < 2; ++_h)
#pragma unroll
        for (int _i = 0; _i < 2; ++_i) gN[_h][_i] = gC[_h][_i];
    PG8_STAGE_B(PG8_SB(0, 0), cB); PG8_STAGE_B(PG8_SB(0, 1), cB + hstepB); PG8_STAGE_A(PG8_SA(0, 0), cA, 0, false); PG8_STAGE_A(PG8_SA(0, 1), cA + hstepA, 1, false);
    if (wr == 1) PG8_BAR;
    PG8_WAIT_V(2); PG8_BAR;
    PG8_STAGE_B(PG8_SB(1, 0), cB + kstep); PG8_STAGE_A(PG8_SA(1, 0), cA + kstep, 0, false); PG8_STAGE_B(PG8_SB(1, 1), cB + hstepB + kstep);
    PG8_WAIT_V(6); PG8_BAR;
    for (;;) {
        const bool has_next = S.next(ui + 1, nxt); nxt.ui = ui + 1;
        const int nt = S.ntiles(cur);
        const char* nA = has_next ? S.a_ptr(nxt) : cA; const char* nB = has_next ? S.b_ptr(nxt) : cB;
        if (has_next) PG8_GOFF(gN, ui + 1);
#pragma unroll 1
        for (int t = 0; t < nt; t += 2) {
            const bool last = (t == nt - 2);
            const char* a1 = cA + (size_t)(t + 1) * kstep;
            const char* a2 = last ? nA : cA + (size_t)(t + 2) * kstep; const char* b2 = last ? nB : cB + (size_t)(t + 2) * kstep;
            const char* a3 = a2 + kstep; const char* b3 = b2 + kstep;
            PG8_LDB(B0, 0, 0); PG8_LDB(B1, 0, 1); PG8_SCHED; PG8_LDA(At, 0, 0); PG8_STAGE_A(PG8_SA(1, 1), a1 + hstepA, 1, false);
            PG8_WAIT_V(8); PG8_WAIT_L(0); PG8_BAR; PG8_MMA(0, 0, At, B0); PG8_MMA(0, 1, At, B1); PG8_BAR; PG8_SCHED;
            PG8_LDA(At, 0, 1); PG8_STAGE_B(PG8_SB(0, 0), b2); PG8_STAGE_B(PG8_SB(0, 1), b2 + hstepB); PG8_STAGE_A(PG8_SA(0, 0), a2, 0, last);
            PG8_WAIT_V(8); PG8_WAIT_L(0); PG8_BAR; PG8_MMA(1, 0, At, B0); PG8_MMA(1, 1, At, B1); PG8_BAR; PG8_SCHED;
            PG8_LDB(B0, 1, 0); PG8_LDB(B1, 1, 1); PG8_SCHED; PG8_LDA(At, 1, 0); PG8_STAGE_A(PG8_SA(0, 1), a2 + hstepA, 1, last);
            PG8_WAIT_V(8); PG8_WAIT_L(0); PG8_BAR; PG8_MMA(0, 0, At, B0); PG8_MMA(0, 1, At, B1); PG8_BAR; PG8_SCHED;
            PG8_LDA(At, 1, 1); PG8_STAGE_B(PG8_SB(1, 0), b3); PG8_STAGE_B(PG8_SB(1, 1), b3 + hstepB); PG8_STAGE_A(PG8_SA(1, 0), a3, 0, last);
            PG8_WAIT_V(8); PG8_WAIT_L(0); PG8_BAR; PG8_MMA(1, 0, At, B0); PG8_MMA(1, 1, At, B1); PG8_BAR; PG8_SCHED;
        }
        if constexpr (ALIGN_EPI) { if (wr == 0) PG8_BAR; }
        if constexpr (FP8) asm volatile("s_nop 15\n\ts_nop 15" ::: "memory");
        { int fr_ = fr, fq_ = fq; asm volatile("" : "+v"(fr_), "+v"(fq_));
          E(acc, cur, wr, wc, fr_, fq_); }
        if (!E.keep(cur)) {
#pragma unroll
        for (int a = 0; a < 2; ++a)
#pragma unroll
            for (int b = 0; b < 2; ++b)
#pragma unroll
                for (int m = 0; m < 4; ++m)
#pragma unroll
                    for (int n = 0; n < 2; ++n) acc[a][b][m][n] = (f32x4){0.f, 0.f, 0.f, 0.f};
        }
        if (!has_next) break;
        cur = nxt; cA = nA; cB = nB; ++ui;
#pragma unroll
        for (int _h = 0; _h < 2; ++_h)
#pragma unroll
            for (int _i = 0; _i < 2; ++_i) gC[_h][_i] = gN[_h][_i];
        if constexpr (ALIGN_EPI) { if (wr == 1) PG8_BAR; }
    }
    PG8_WAIT_V(0);
    if constexpr (!ALIGN_EPI) { if (wr == 0) PG8_BAR; }
    PG8_BAR;
#undef PG8_SA
#undef PG8_SB
#undef PG8_GLDS
#undef PG8_STAGE_A
#undef PG8_STAGE_B
#undef PG8_LDA
#undef PG8_LDB
#undef PG8_MMA
#undef PG8_WAIT_V
#undef PG8_WAIT_L
#undef PG8_BAR
#undef PG8_SCHED
#undef PG8_GOFF
}
}
#include <hip/hip_bf16.h>
#include <cmath>
namespace attn_body {
using bf16=__hip_bfloat16;
using bf16x8=__attribute__((ext_vector_type(8)))short;
using s16x4=__attribute__((ext_vector_type(4)))short;
using f32x16=__attribute__((ext_vector_type(16)))float;
using u32x4=__attribute__((ext_vector_type(4)))unsigned;
constexpr int BATCH=8,NHEAD=8,NKV=2,SEQ=4096,D=64;
constexpr int QP=512,KVP=256,OP=1536;
constexpr int NW=8,QBLK=32,QB=QBLK*NW,KVBLK=64,NQB=SEQ/QB;
constexpr int ATTN_UNIT_ROWS=QB;
__device__ __forceinline__ int crow(int r,int hi){return (r&3)+8*(r>>2)+4*hi;}
#define SBAR() __builtin_amdgcn_sched_barrier(0)
constexpr int NSLOT=3, SLOTB=8192;
constexpr int LDS_K=0, LDS_V=NSLOT*SLOTB, LDS_WS=2*NSLOT*SLOTB, LDS_OST=LDS_WS+NW*64*4, LDS_BYTES=LDS_OST+NW*4096;
constexpr float C2=0.125f*1.4426950408889634f;
__device__ __forceinline__ void glds16(const void*gsrc,unsigned lds_dst){unsigned keep;
  asm volatile("s_mov_b32 %0, m0\n\ts_mov_b32 m0, %2\n\ts_nop 0\n\tglobal_load_lds_dwordx4 %1, off\n\ts_mov_b32 m0, %0":"=&s"(keep):"v"(gsrc),"s"(lds_dst):"memory");}
__device__ __forceinline__ float max3f(float a,float b,float c){float r;asm("v_max3_f32 %0, %1, %2, %3":"=v"(r):"v"(a),"v"(b),"v"(c));return r;}
__device__ __forceinline__ float max2f(float a,float b){float r;asm("v_max_f32_e32 %0, %1, %2":"=v"(r):"v"(a),"v"(b));return r;}
__device__ __forceinline__ float fadd_s(float a,float b){float r;asm("v_add_f32_e32 %0, %1, %2":"=v"(r):"v"(a),"v"(b));return r;}
__device__ __forceinline__ float fsub_s(float a,float b){float r;asm("v_sub_f32_e32 %0, %1, %2":"=v"(r):"v"(a),"v"(b));return r;}
typedef float f32x2_t __attribute__((ext_vector_type(2))); typedef __bf16 bf16x2_t __attribute__((ext_vector_type(2)));
__device__ __forceinline__ unsigned cvtpk_s(float lo,float hi){f32x2_t v={lo,hi};bf16x2_t b=__builtin_convertvector(v,bf16x2_t);return __builtin_bit_cast(unsigned,b);}
#define WAIT_BAR(N) asm volatile("s_waitcnt vmcnt(" #N ") lgkmcnt(0)\n\ts_barrier":::"memory")

__device__ __forceinline__ void qkt(f32x16&p0,f32x16&p1,const char*Kslot,const bf16x8*qr,const f32x16&negm,int r32,int hi){
  const char*kb=Kslot+hi*1024+r32*16;
  #pragma unroll
  for(int d0=0;d0<4;++d0){
    const bf16x8 b0=*reinterpret_cast<const bf16x8*>(kb+d0*2048);
    const bf16x8 b1=*reinterpret_cast<const bf16x8*>(kb+d0*2048+512);
    if(d0==0){p0=__builtin_amdgcn_mfma_f32_32x32x16_bf16(b0,qr[0],negm,0,0,0);p1=__builtin_amdgcn_mfma_f32_32x32x16_bf16(b1,qr[0],negm,0,0,0);}
    else{p0=__builtin_amdgcn_mfma_f32_32x32x16_bf16(b0,qr[d0],p0,0,0,0);p1=__builtin_amdgcn_mfma_f32_32x32x16_bf16(b1,qr[d0],p1,0,0,0);}}
}
typedef __attribute__((address_space(3))) const char* lds_cptr;
typedef short v4i16_t __attribute__((ext_vector_type(4)));
__device__ __forceinline__ void kload8(bf16x8*kf,lds_cptr kp){
  kf[0]=*(const __attribute__((address_space(3))) bf16x8*)(kp);      kf[1]=*(const __attribute__((address_space(3))) bf16x8*)(kp+512);
  kf[2]=*(const __attribute__((address_space(3))) bf16x8*)(kp+2048); kf[3]=*(const __attribute__((address_space(3))) bf16x8*)(kp+2560);
  kf[4]=*(const __attribute__((address_space(3))) bf16x8*)(kp+4096); kf[5]=*(const __attribute__((address_space(3))) bf16x8*)(kp+4608);
  kf[6]=*(const __attribute__((address_space(3))) bf16x8*)(kp+6144); kf[7]=*(const __attribute__((address_space(3))) bf16x8*)(kp+6656);
}
__device__ __forceinline__ void kload2(bf16x8*kf,lds_cptr kp,int j){ kf[2*j]=*(const __attribute__((address_space(3))) bf16x8*)(kp+j*2048); kf[2*j+1]=*(const __attribute__((address_space(3))) bf16x8*)(kp+j*2048+512); }
__device__ __forceinline__ s16x4 vtr(lds_cptr p){ return __builtin_bit_cast(s16x4,__builtin_amdgcn_ds_read_tr16_b64_v4i16((__attribute__((address_space(3))) v4i16_t*)p)); }
__device__ __forceinline__ float rowmax(const f32x16&p0,const f32x16&p1){
  float a=max3f(p0[0],p0[1],p1[0]),b=max3f(p0[2],p0[3],p1[1]);a=max3f(a,p1[2],p1[3]);
  #pragma unroll
  for(int r=4;r<16;r+=4){a=max3f(a,p0[r],p0[r+1]);b=max3f(b,p0[r+2],p0[r+3]);a=max3f(a,p1[r],p1[r+1]);b=max3f(b,p1[r+2],p1[r+3]);}
  const float m=max2f(a,b);
  auto rr=__builtin_amdgcn_permlane32_swap(__float_as_uint(m),__float_as_uint(m),false,false);
  return max2f(__uint_as_float(rr[0]),__uint_as_float(rr[1]));
}
__device__ __forceinline__ void pv(f32x16*o,int vb,bf16x8 pa0,bf16x8 pa1,bf16x8 pa2,bf16x8 pa3){
  #pragma unroll
  for(int d0=0;d0<2;++d0){s16x4 lo[4],hi[4];
    #pragma unroll
    for(int ks=0;ks<4;++ks){
      asm volatile("ds_read_b64_tr_b16 %0,%1 offset:%c2":"=&v"(lo[ks]):"v"(vb),"i"(d0*4096+ks*1024):"memory");
      asm volatile("ds_read_b64_tr_b16 %0,%1 offset:%c2":"=&v"(hi[ks]):"v"(vb),"i"(d0*4096+ks*1024+512):"memory");}
    asm volatile("s_waitcnt lgkmcnt(0)":::"memory");SBAR();
    #define PK(k) (bf16x8){lo[k][0],lo[k][1],lo[k][2],lo[k][3],hi[k][0],hi[k][1],hi[k][2],hi[k][3]}
    o[d0]=__builtin_amdgcn_mfma_f32_32x32x16_bf16(pa0,PK(0),o[d0],0,0,0);
    o[d0]=__builtin_amdgcn_mfma_f32_32x32x16_bf16(pa1,PK(1),o[d0],0,0,0);
    o[d0]=__builtin_amdgcn_mfma_f32_32x32x16_bf16(pa2,PK(2),o[d0],0,0,0);
    o[d0]=__builtin_amdgcn_mfma_f32_32x32x16_bf16(pa3,PK(3),o[d0],0,0,0);
    #undef PK
  }
}

#ifndef ATTN_STORE16
#define ATTN_STORE16(p,v) (*(u32x4*)(p)=(v))
#endif
template<int THRL,bool NOMAX> __device__ __forceinline__ void attn_unit(int b,int h,int qb,const bf16*Q,const bf16*__restrict__ K,const bf16*__restrict__ V,bf16*O,char*shm){
  const int tid=threadIdx.x,lane=tid&63,r32=lane&31,hi=lane>>5; const int wid=__builtin_amdgcn_readfirstlane(tid>>6);
  const long rowbase=(long)b*SEQ; const int q0=qb*QB;
  const bf16*Qw=Q+(rowbase+q0+wid*QBLK)*QP+h*D; const int kvh=h/(NHEAD/NKV);
  const bf16*Kh=K+rowbase*KVP+kvh*D,*Vh=V+rowbase*KVP+kvh*D;
  const unsigned lds0=(unsigned)(uintptr_t)shm;
  float*wsf=(float*)(shm+LDS_WS)+wid*64;
  const bf16*ksrc=Kh+(long)lane*KVP+wid*8;
  const bf16*vsrc=Vh+(long)(16*(wid&3)+(lane>>2))*KVP+(wid>>2)*32+(lane&3)*8;
  const unsigned kdst=lds0+LDS_K+wid*1024, vdst=lds0+LDS_V+wid*1024;
  #define DMA_K(t,slot) glds16(ksrc+(long)(t)*KVBLK*KVP,(unsigned)__builtin_amdgcn_readfirstlane(kdst+(slot)))
  #define DMA_V(t,slot) glds16(vsrc+(long)(t)*KVBLK*KVP,(unsigned)__builtin_amdgcn_readfirstlane(vdst+(slot)))
  const int vb0=(int)(lds0+LDS_V)+((lane>>4)&1)*32+(lane&3)*8+(4*hi+((lane&15)>>2))*64;
  const char*Kbase=shm+LDS_K; bf16x8 kf[8];
  const lds_cptr shm3=(lds_cptr)shm; const lds_cptr kp0=shm3+LDS_K+hi*1024+r32*16; const lds_cptr vp0=shm3+LDS_V+((lane>>4)&1)*32+(lane&3)*8+(4*hi+((lane&15)>>2))*64;
  constexpr int NT=SEQ/KVBLK;
  DMA_K(0,0);DMA_V(0,0);DMA_K(1,SLOTB);
  bf16x8 qr[4];
  #pragma unroll
  for(int d0=0;d0<4;++d0)qr[d0]=*reinterpret_cast<const bf16x8*>(&Qw[(long)r32*QP+d0*16+hi*8]);
  float mhat=0.f,l_reg=0.f;f32x16 o[2];o[0]=f32x16{};o[1]=f32x16{};f32x16 negm=f32x16{};if(!NOMAX)asm volatile("":"+v"(negm));
  f32x16 o2=f32x16{}; bf16x8 ones=(bf16x8){0x3F80,0x3F80,0x3F80,0x3F80,0x3F80,0x3F80,0x3F80,0x3F80}; asm volatile("":"+v"(ones));
  #define CMASK(P0,P1,t) do{}while(0)
  bool resc=false;
  #define START(P0,P1) do{ if(!NOMAX){ const float rm=rowmax(P0,P1); resc=false; \
    { const float dl=rm; mhat=fadd_s(mhat,dl); \
      _Pragma("unroll") for(int r=0;r<16;++r){P0[r]=fsub_s(P0[r],dl);P1[r]=fsub_s(P1[r],dl);} \
      _Pragma("unroll") for(int r=0;r<16;++r)negm[r]=-mhat; asm volatile("":"+v"(negm)); } } \
    _Pragma("unroll") for(int r=0;r<16;++r)P0[r]=__builtin_amdgcn_exp2f(P0[r]); }while(0)
  #define RESC() do{ if(!NOMAX&&resc){ asm volatile("s_waitcnt lgkmcnt(0)":::"memory"); \
      _Pragma("unroll") for(int d_=0;d_<2;++d_) _Pragma("unroll") for(int r=0;r<16;++r)o[d_][r]*=wsf[crow(r,hi)]; } }while(0)
  f32x16 pA0,pA1,pB0,pB1;
  int sl_prev=0,sl_cur=0,sl_next=SLOTB;
  #define ROT() do{sl_prev=sl_cur;sl_cur=sl_next;sl_next=(sl_next==(NSLOT-1)*SLOTB)?0:sl_next+SLOTB;}while(0)
  DMA_K(2,2*SLOTB);
  WAIT_BAR(3);
  qkt(pA0,pA1,Kbase,qr,negm,r32,hi);asm volatile("s_nop 15\n\ts_nop 7":"+v"(pA0),"+v"(pA1));CMASK(pA0,pA1,0);
  START(pA0,pA1);
  _Pragma("unroll") for(int r=0;r<16;++r)pA1[r]=__builtin_amdgcn_exp2f(pA1[r]);
  WAIT_BAR(0);
  DMA_K(3,0);DMA_V(1,SLOTB);
  ROT();
  kload8(kf,kp0+sl_cur);
  WAIT_BAR(2);
  s16x4 vlo[8],vhi[8]; u32x4 pw0,pw1,pw2,pw3;
  #define PKW(P,B) cvtpk_s(P[B],P[B+1])
  #define PAF(k) __builtin_bit_cast(bf16x8,pw##k)
  #define VFR(i) (bf16x8){vlo[i][0],vlo[i][1],vlo[i][2],vlo[i][3],vhi[i][0],vhi[i][1],vhi[i][2],vhi[i][3]}
  #define PIN(x) asm volatile("":"+v"(x))
  #define MX3(a,b,c) __builtin_fmaxf(__builtin_fmaxf((a),(b)),(c))
  #define GAPA(MF,A0,A1,A2,A3,W0,W1,PW) do{ MF; sacc+=A0; sacc+=A1; sacc+=A2; sacc+=A3; PIN(sacc); W0; W1; PIN(PW); SBAR(); }while(0)
  #define EX(v) __builtin_amdgcn_exp2f(v)
  #define GAPB(MF,X,B) do{ MF; X[B]=EX(X[B]); X[B+1]=EX(X[B+1]); X[B+2]=EX(X[B+2]); X[B+3]=EX(X[B+3]); PIN(X); SBAR(); }while(0)
  #define VRD(i) do{ vlo[i]=vtr(vp_+(((i)>>2)*4096+((i)&3)*1024)); vhi[i]=vtr(vp_+(((i)>>2)*4096+((i)&3)*1024+512)); }while(0)
  #define KRD(G,j) do{ if(G){ kload2(kf,kp0+sl_next,j); SBAR(); } }while(0)
  #define STEP(C0,C1,P0,P1,t,GK,GV,GL) do{ SBAR(); \
    const lds_cptr vp_=vp0+sl_prev; \
    VRD(0); SBAR(); float sacc=(P0[0]+P0[1]); \
    GAPA(C0=__builtin_amdgcn_mfma_f32_32x32x16_bf16(kf[0],qr[0],negm,0,0,0), P0[2],P0[3],P0[4],P0[5],     pw0[0]=PKW(P0,0), pw0[1]=PKW(P0,2), pw0); \
    VRD(4); SBAR(); GAPA(C1=__builtin_amdgcn_mfma_f32_32x32x16_bf16(kf[1],qr[0],negm,0,0,0), P0[6],P0[7],P0[8],P0[9],     pw0[2]=PKW(P0,4), pw0[3]=PKW(P0,6), pw0); \
    VRD(1); SBAR(); GAPA(C0=__builtin_amdgcn_mfma_f32_32x32x16_bf16(kf[2],qr[1],C0,0,0,0),   P0[10],P0[11],P0[12],P0[13], pw1[0]=PKW(P0,8), pw1[1]=PKW(P0,10), pw1); \
    VRD(5); SBAR(); GAPA(C1=__builtin_amdgcn_mfma_f32_32x32x16_bf16(kf[3],qr[1],C1,0,0,0),   P0[14],P0[15],P1[0],P1[1],   pw1[2]=PKW(P0,12),pw1[3]=PKW(P0,14), pw1); \
    VRD(2); SBAR(); GAPA(C0=__builtin_amdgcn_mfma_f32_32x32x16_bf16(kf[4],qr[2],C0,0,0,0),   P1[2],P1[3],P1[4],P1[5],     pw2[0]=PKW(P1,0), pw2[1]=PKW(P1,2), pw2); \
    VRD(6); SBAR(); GAPA(C1=__builtin_amdgcn_mfma_f32_32x32x16_bf16(kf[5],qr[2],C1,0,0,0),   P1[6],P1[7],P1[8],P1[9],     pw2[2]=PKW(P1,4), pw2[3]=PKW(P1,6), pw2); \
    VRD(3); SBAR(); GAPA(C0=__builtin_amdgcn_mfma_f32_32x32x16_bf16(kf[6],qr[3],C0,0,0,0),   P1[10],P1[11],P1[12],P1[13], pw3[0]=PKW(P1,8), pw3[1]=PKW(P1,10), pw3); \
    VRD(7); SBAR(); GAPA(C1=__builtin_amdgcn_mfma_f32_32x32x16_bf16(kf[7],qr[3],C1,0,0,0),   P1[14],P1[15],0.f,0.f,       pw3[2]=PKW(P1,12),pw3[3]=PKW(P1,14), pw3); \
    l_reg+=sacc; \
    if(GK){DMA_K((t)+3,sl_cur);} if(GV){DMA_V((t)+1,sl_next);} \
    CMASK(C0,C1,t); \
    { float a=MX3(C0[0],C0[1],C1[0]),b=MX3(C0[2],C0[3],C1[1]); a=MX3(a,C1[2],C1[3]); \
      _Pragma("unroll") for(int r=4;r<16;r+=4){a=MX3(a,C0[r],C0[r+1]);b=MX3(b,C0[r+2],C0[r+3]);a=MX3(a,C1[r],C1[r+1]);b=MX3(b,C1[r+2],C1[r+3]);} \
      float rm=__builtin_fmaxf(a,b); { auto rr=__builtin_amdgcn_permlane32_swap(__float_as_uint(rm),__float_as_uint(rm),false,false); rm=__builtin_fmaxf(__uint_as_float(rr[0]),__uint_as_float(rr[1])); } \
      resc=false; \
      if(__builtin_expect(__any(rm>(float)THRL),0)){ const float dl=__builtin_fmaxf(rm,0.f); mhat+=dl; \
        _Pragma("unroll") for(int r=0;r<16;++r){C0[r]-=dl;C1[r]-=dl;} \
        _Pragma("unroll") for(int r=0;r<16;++r)negm[r]=-mhat; asm volatile("":"+v"(negm)); \
        const float f=__builtin_amdgcn_exp2f(-dl); l_reg*=f; if(hi==0)wsf[r32]=f; resc=true; } } \
    SBAR(); \
    GAPB(o[0]=__builtin_amdgcn_mfma_f32_32x32x16_bf16(PAF(0),VFR(0),o[0],0,0,0), C0,0); \
    GAPB(o[1]=__builtin_amdgcn_mfma_f32_32x32x16_bf16(PAF(0),VFR(4),o[1],0,0,0), C0,4); \
    KRD(GL,0); GAPB(o[0]=__builtin_amdgcn_mfma_f32_32x32x16_bf16(PAF(1),VFR(1),o[0],0,0,0), C0,8); \
    KRD(GL,1); GAPB(o[1]=__builtin_amdgcn_mfma_f32_32x32x16_bf16(PAF(1),VFR(5),o[1],0,0,0), C0,12); \
    KRD(GL,2); GAPB(o[0]=__builtin_amdgcn_mfma_f32_32x32x16_bf16(PAF(2),VFR(2),o[0],0,0,0), C1,0); \
    KRD(GL,3); GAPB(o[1]=__builtin_amdgcn_mfma_f32_32x32x16_bf16(PAF(2),VFR(6),o[1],0,0,0), C1,4); \
    GAPB(o[0]=__builtin_amdgcn_mfma_f32_32x32x16_bf16(PAF(3),VFR(3),o[0],0,0,0), C1,8); \
    GAPB(o[1]=__builtin_amdgcn_mfma_f32_32x32x16_bf16(PAF(3),VFR(7),o[1],0,0,0), C1,12); \
    }while(0)
  #define GAPAN(MF,W0,W1,PW) do{ MF; W0; W1; PIN(PW); SBAR(); }while(0)
  #define GAPBN3(MF,X,B) do{ MF; X[B]=EX(X[B]); X[B+1]=EX(X[B+1]); X[B+2]=EX(X[B+2]); PIN(X); SBAR(); }while(0)
  #define GAPBN2(MF,X,B) do{ MF; X[B]=EX(X[B]); X[B+1]=EX(X[B+1]); PIN(X); SBAR(); }while(0)
  #define MF32(a,b,c) __builtin_amdgcn_mfma_f32_32x32x16_bf16(a,b,c,0,0,0)
  #define STEPN(C0,C1,P0,P1,t,GK,GV,GL) do{ SBAR(); \
    const lds_cptr vp_=vp0+sl_prev; \
    VRD(0); SBAR(); \
    GAPAN(C0=MF32(kf[0],qr[0],negm), pw0[0]=PKW(P0,0), pw0[1]=PKW(P0,2), pw0); \
    VRD(4); SBAR(); GAPAN(C1=MF32(kf[1],qr[0],negm), pw0[2]=PKW(P0,4), pw0[3]=PKW(P0,6), pw0); \
    VRD(1); SBAR(); GAPAN(C0=MF32(kf[2],qr[1],C0),   pw1[0]=PKW(P0,8), pw1[1]=PKW(P0,10), pw1); \
    VRD(5); SBAR(); GAPAN(C1=MF32(kf[3],qr[1],C1),   pw1[2]=PKW(P0,12),pw1[3]=PKW(P0,14), pw1); \
    VRD(2); SBAR(); GAPAN(C0=MF32(kf[4],qr[2],C0),   pw2[0]=PKW(P1,0), pw2[1]=PKW(P1,2), pw2); \
    VRD(6); SBAR(); GAPAN(C1=MF32(kf[5],qr[2],C1),   pw2[2]=PKW(P1,4), pw2[3]=PKW(P1,6), pw2); \
    VRD(3); SBAR(); GAPAN(C0=MF32(kf[6],qr[3],C0),   pw3[0]=PKW(P1,8), pw3[1]=PKW(P1,10), pw3); \
    VRD(7); SBAR(); GAPAN(C1=MF32(kf[7],qr[3],C1),   pw3[2]=PKW(P1,12),pw3[3]=PKW(P1,14), pw3); \
    if(GK){DMA_K((t)+3,sl_cur);} if(GV){DMA_V((t)+1,sl_next);} \
    SBAR(); \
    GAPBN3(o[0]=MF32(PAF(0),VFR(0),o[0]), C0,0); \
    GAPBN3(o[1]=MF32(PAF(0),VFR(4),o[1]), C0,3); \
    GAPBN2(o2=MF32(PAF(0),ones,o2), C0,6); \
    KRD(GL,0); GAPBN3(o[0]=MF32(PAF(1),VFR(1),o[0]), C0,8); \
    KRD(GL,1); GAPBN3(o[1]=MF32(PAF(1),VFR(5),o[1]), C0,11); \
    GAPBN2(o2=MF32(PAF(1),ones,o2), C0,14); \
    KRD(GL,2); GAPBN3(o[0]=MF32(PAF(2),VFR(2),o[0]), C1,0); \
    KRD(GL,3); GAPBN3(o[1]=MF32(PAF(2),VFR(6),o[1]), C1,3); \
    GAPBN2(o2=MF32(PAF(2),ones,o2), C1,6); \
    GAPBN3(o[0]=MF32(PAF(3),VFR(3),o[0]), C1,8); \
    GAPBN3(o[1]=MF32(PAF(3),VFR(7),o[1]), C1,11); \
    GAPBN2(o2=MF32(PAF(3),ones,o2), C1,14); \
    }while(0)
  #define STEPX(C0,C1,P0,P1,t,GK,GV,GL) do{ if(NOMAX){ STEPN(C0,C1,P0,P1,t,GK,GV,GL); } else { STEP(C0,C1,P0,P1,t,GK,GV,GL); } }while(0)
  int t=1;
  for(;t+5<NT;t+=2){
    STEPX(pB0,pB1,pA0,pA1,t,true,true,true);     WAIT_BAR(2); RESC(); ROT();
    STEPX(pA0,pA1,pB0,pB1,t+1,true,true,true);   WAIT_BAR(2); RESC(); ROT();
  }
  #define ENDW(tt) do{ if((tt)+3<NT){WAIT_BAR(2);} else if((tt)+2<NT){WAIT_BAR(1);} else {WAIT_BAR(0);} }while(0)
  for(;t+1<NT;t+=2){
    STEPX(pB0,pB1,pA0,pA1,t,(t+3<NT),(t+1<NT),(t+1<NT));       ENDW(t);   RESC(); ROT();
    STEPX(pA0,pA1,pB0,pB1,t+1,(t+4<NT),(t+2<NT),(t+2<NT));     ENDW(t+1); RESC(); ROT();
  }
  STEPX(pB0,pB1,pA0,pA1,NT-1,false,false,false); RESC();
  { if(!NOMAX){ float sacc=pB0[0]+pB0[1]; _Pragma("unroll") for(int r=2;r<16;++r)sacc+=pB0[r]; _Pragma("unroll") for(int r=0;r<16;++r)sacc+=pB1[r]; l_reg+=sacc; }
    pw0=(u32x4){PKW(pB0,0),PKW(pB0,2),PKW(pB0,4),PKW(pB0,6)};pw1=(u32x4){PKW(pB0,8),PKW(pB0,10),PKW(pB0,12),PKW(pB0,14)};pw2=(u32x4){PKW(pB1,0),PKW(pB1,2),PKW(pB1,4),PKW(pB1,6)};pw3=(u32x4){PKW(pB1,8),PKW(pB1,10),PKW(pB1,12),PKW(pB1,14)};
    SBAR(); pv(o,vb0+sl_cur,PAF(0),PAF(1),PAF(2),PAF(3));
    if(NOMAX){ o2=MF32(PAF(0),ones,o2); o2=MF32(PAF(1),ones,o2); o2=MF32(PAF(2),ones,o2); o2=MF32(PAF(3),ones,o2); } }
  #undef PKW
  #undef PAF
  #undef VFR
  #undef PIN
  #undef MX3
  #undef GAPA
  #undef GAPB
  #undef EX
  #undef VRD
  #undef KRD
  #undef STEP
  #undef STEPN
  #undef STEPX
  #undef GAPAN
  #undef GAPBN3
  #undef GAPBN2
  #undef MF32
  #undef ENDW
  float rli[16];
  if(NOMAX){
    #pragma unroll
    for(int r=0;r<16;++r)rli[r]=__builtin_amdgcn_rcpf(o2[r]);
  } else {
  {auto rr=__builtin_amdgcn_permlane32_swap(__float_as_uint(l_reg),__float_as_uint(l_reg),false,false);l_reg=__uint_as_float(rr[0])+__uint_as_float(rr[1]);}
  if(hi==0)wsf[32+r32]=l_reg;asm volatile("s_waitcnt lgkmcnt(0)":::"memory");
  #pragma unroll
  for(int r=0;r<16;++r)rli[r]=__builtin_amdgcn_rcpf(wsf[32+crow(r,hi)]);
  }
  bf16*Ow=O+(rowbase+q0+wid*QBLK)*OP+h*D;
  { bf16*stg=(bf16*)(shm+LDS_OST)+wid*2048;
    #pragma unroll
    for(int r=0;r<16;++r){const int orow=crow(r,hi);
      #pragma unroll
      for(int d0=0;d0<2;++d0)stg[orow*64+d0*32+r32]=__float2bfloat16(o[d0][r]*rli[r]);}
    asm volatile("s_waitcnt lgkmcnt(0)":::"memory");
    #pragma unroll
    for(int i=0;i<4;++i){const int row=i*8+(lane>>3),ch=lane&7; const u32x4 v=*(const u32x4*)(stg+row*64+ch*8); ATTN_STORE16(Ow+(long)row*OP+ch*8,v);} }
  asm volatile("s_waitcnt lgkmcnt(0)\n\ts_barrier":::"memory");
  #undef DMA_K
  #undef DMA_V
  #undef CMASK
  #undef START
  #undef RESC
  #undef ROT
}
constexpr int ATTN_LDS_BYTES=LDS_BYTES;
struct AttnTensors { const bf16* Q; const bf16* K; const bf16* V; bf16* O; };
struct AttnUnit { int bh; int qb; };
struct StaticOrder {
  int vcu,G;
  __device__ __forceinline__ explicit StaticOrder(int grid,int v):vcu(v),G(grid){}
  __device__ __forceinline__ bool next(int i,AttnUnit&u)const{ const int L=i*G+vcu; if(L>=BATCH*NHEAD*NQB)return false;
    const int pairhalf=L>>5,l=L&31; const int pair=pairhalf>>1,uu=l+32*(pairhalf&1); const int b=pair>>1,kvh=pair&1; u.bh=b*NHEAD+kvh*(NHEAD/NKV)+(uu>>4); u.qb=uu&15; return true; }
  __device__ __forceinline__ void a_ready(const AttnUnit&)const{}
  __device__ __forceinline__ void done(const AttnUnit&)const{}
};
template<class Sched,int THRL=8> __device__ __forceinline__ void attn_phase(char*lds,const AttnTensors&T,const Sched&S,bool nomax){
  AttnUnit u;
  if(nomax){ for(int i=0;S.next(i,u);++i){ S.a_ready(u); attn_unit<THRL,true>(u.bh/NHEAD,u.bh%NHEAD,u.qb,T.Q,T.K,T.V,T.O,lds); S.done(u); } }
  else     { for(int i=0;S.next(i,u);++i){ S.a_ready(u); attn_unit<THRL,false>(u.bh/NHEAD,u.bh%NHEAD,u.qb,T.Q,T.K,T.V,T.O,lds); S.done(u); } }
}
#undef SBAR
#undef WAIT_BAR
}
namespace cg = cooperative_groups;
constexpr int NWAVES = 8;
constexpr int BATCH = 8, SEQ = 4096, D = 1024, T = BATCH * SEQ;
constexpr int HD = 64, NQH = 8, NKVH = 2, QW = NQH * HD, KVW = NKVH * HD;
constexpr int LRU_W = 1024, LRU_NB = 16, LRU_BW = 64;
constexpr int INW = QW + 2 * KVW + 2 * LRU_W + 2 * D;
constexpr int NE = 32, TOPK = 4, DFF = 1024;
constexpr float NORM_EPS = 1e-6f;
constexpr int ARW = QW + LRU_W;
constexpr int ECAP = T;
constexpr int MAXBLK = (T * TOPK) / 256 + NE;
constexpr int MAX_GUNITS = 18;

constexpr size_t MiB = 1u << 20;
constexpr size_t WS_CTL = 0, CTL_ZERO_BYTES = 64 * 1024;
constexpr size_t WS_TOKL = 1 * MiB, WS_GATEL = 5 * MiB, WS_TOKREC = 9 * MiB, WS_RSTDT = 9 * MiB + 512 * 1024;
constexpr size_t WS_WIN = 10 * MiB, WS_WCAT = 20 * MiB, WS_WO = 23 * MiB, WS_WGU = 26 * MiB, WS_WD = 154 * MiB;
constexpr size_t WS_XN = 218 * MiB;
constexpr size_t WS_Q = 282 * MiB, WS_KV = 314 * MiB, WS_AR = 330 * MiB, WS_XR = 426 * MiB, WS_YR = 490 * MiB, WS_GL = 554 * MiB;
constexpr size_t WS_MERGED = WS_XR;
constexpr size_t WS_MIXB = WS_YR;
constexpr size_t WS_X1B = WS_XR;
constexpr size_t WS_ACT = 282 * MiB, WS_Y = 554 * MiB, WS_END = 826 * MiB;
static_assert(WS_ACT + (size_t)MAXBLK * 256 * DFF * 2 <= WS_Y && WS_Y + (size_t)MAXBLK * 256 * D * 2 <= WS_END, "ws map");
constexpr int CW_CNT = 0;
constexpr int CW_BAR = 1024;

constexpr int RING_BYTES = 131072;
constexpr int GTAB_OFF = RING_BYTES;
constexpr int ETAB_OFF = GTAB_OFF + MAX_GUNITS * 512;
constexpr int MISC_OFF = ETAB_OFF + MAX_GUNITS * 1024;
constexpr int LDS_BYTES = MISC_OFF + 2048;
static_assert(LDS_BYTES <= 163840, "LDS");

#define GAS __attribute__((address_space(1)))
#define LAS __attribute__((address_space(3)))
typedef unsigned short bf16;
typedef unsigned v4u __attribute__((ext_vector_type(4)));
typedef unsigned v2u __attribute__((ext_vector_type(2)));
typedef float f32x4 __attribute__((ext_vector_type(4)));
typedef float f32x2 __attribute__((ext_vector_type(2)));
typedef short bf16x8 __attribute__((ext_vector_type(8)));
#define LDS_WAIT() asm volatile("s_waitcnt lgkmcnt(0)" ::: "memory")
__device__ __forceinline__ unsigned f2bf(float f) { unsigned u = __builtin_bit_cast(unsigned, f); return (u + 0x7fffu + ((u >> 16) & 1u)) >> 16; }
__device__ __forceinline__ unsigned pk2(float lo, float hi) { unsigned r; asm("v_cvt_pk_bf16_f32 %0, %1, %2" : "=v"(r) : "v"(lo), "v"(hi)); return r; }
__device__ __forceinline__ float bflo(unsigned w) { return __uint_as_float(w << 16); }
__device__ __forceinline__ float bfhi(unsigned w) { return __uint_as_float(w & 0xffff0000u); }
__device__ __forceinline__ float wave_sum(float v) {
#pragma unroll
    for (int o = 1; o < 64; o <<= 1) v += __shfl_xor(v, o);
    return v;
}
__device__ __forceinline__ float sigmoidf_fast(float x) { return __builtin_amdgcn_rcpf(1.0f + __builtin_amdgcn_exp2f(-1.4426950408889634f * x)); }

constexpr float YSCALE = 16.0f, YSCALE_INV = 1.0f / 16.0f;
constexpr float WSCALE = 32.0f, WSCALE_INV = 1.0f / 32.0f;
struct Frame {
    LAS unsigned char* lds;
    int tid, lane, wave, vcu, G;
    const float* const* in;
    float* out; unsigned char* ws;
};
enum { I_X = 0, I_N1G, I_WIN, I_BIN, I_QNG, I_KNG, I_CONVW, I_CONVB, I_WA, I_BA, I_WI, I_BI, I_LAM, I_WAO, I_WLO, I_WOUT, I_N2G, I_WR, I_BR, I_WGU, I_BGU, I_WDN, I_BDN, I_FG };

constexpr int P0_MIXER_ITEMS = 16 * (INW / 32) + 8 * 32 + 16 * 32 + 16 * 32, P0_NITEMS = P0_MIXER_ITEMS + NE * 16 * 64 + NE * 16 * 32;
struct P0Item { const float* src; int N; unsigned char* dst; int ldtB; int fp8; };
__device__ __forceinline__ P0Item p0_decode(const Frame& F, int it) {
    constexpr int I_IN = 16 * (INW / 32), I_AO = 8 * 32, I_LO = 16 * 32, I_OUT = 16 * 32, I_GU1 = 16 * 64, I_DN1 = 16 * 32;
    unsigned char* ws = F.ws; P0Item d; int r = it;
    if (r < I_IN) { const int nblk = INW / 32, kb = r / nblk, nb = r % nblk; d.src = F.in[I_WIN] + (size_t)(64 * kb) * INW + 32 * nb; d.N = INW; d.dst = ws + WS_WIN + ((size_t)(32 * nb) * D + 64 * kb) * 2; d.ldtB = D * 2; d.fp8 = 0; return d; } r -= I_IN;
    if (r < I_AO) { const int kb = r / 32, nb = r % 32; d.src = F.in[I_WAO] + (size_t)(64 * kb) * D + 32 * nb; d.N = D; d.dst = ws + WS_WCAT + ((size_t)(32 * nb) * ARW + 64 * kb) * 2; d.ldtB = ARW * 2; d.fp8 = 0; return d; } r -= I_AO;
    if (r < I_LO) { const int kb = r / 32, nb = r % 32; d.src = F.in[I_WLO] + (size_t)(64 * kb) * D + 32 * nb; d.N = D; d.dst = ws + WS_WCAT + ((size_t)(32 * nb) * ARW + QW + 64 * kb) * 2; d.ldtB = ARW * 2; d.fp8 = 0; return d; } r -= I_LO;
    if (r < I_OUT) { const int kb = r / 32, nb = r % 32; d.src = F.in[I_WOUT] + (size_t)(64 * kb) * D + 32 * nb; d.N = D; d.dst = ws + WS_WO + ((size_t)(32 * nb) * D + 64 * kb) * 2; d.ldtB = D * 2; d.fp8 = 0; return d; } r -= I_OUT;
    if (r < NE * I_GU1) { const int e = r / I_GU1, q = r % I_GU1, kb = q / 64, nb = q % 64, n0 = 32 * nb;
        const int cc = n0 & 1023, isu = n0 >> 10, rowb = 256 * (cc >> 7) + 128 * isu + (cc & 127);
        d.src = F.in[I_WGU] + (size_t)e * D * 2 * DFF + (size_t)(64 * kb) * (2 * DFF) + n0; d.N = 2 * DFF; d.dst = ws + WS_WGU + (size_t)e * 2 * DFF * D + (size_t)rowb * D + 64 * kb; d.ldtB = D; d.fp8 = 1; return d; } r -= NE * I_GU1;
    { const int e = r / I_DN1, q = r % I_DN1, kb = q / 32, nb = q % 32;
        d.src = F.in[I_WDN] + (size_t)e * DFF * D + (size_t)(64 * kb) * D + 32 * nb; d.N = D; d.dst = ws + WS_WD + (size_t)e * D * DFF + (size_t)(32 * nb) * DFF + 64 * kb; d.ldtB = DFF; d.fp8 = 1; return d; }
}
__device__ __forceinline__ void p0_prologue(Frame& F, const int it_lo, const int it_hi, const bool do_norm) {
    LAS float* scr = (LAS float*)(F.lds + F.wave * 16384);
    const int gw = F.vcu * NWAVES + F.wave, NGW = F.G * NWAVES, lane = F.lane;
    unsigned char* ws = F.ws;
    float v[32];
    P0Item cur = p0_decode(F, it_lo + gw < it_hi ? it_lo + gw : it_lo);
#define P0_LOAD(dst_, item_) do { const float* p_ = (item_).src + (size_t)(lane >> 5) * (item_).N + (lane & 31); const size_t st_ = (size_t)2 * (item_).N; _Pragma("unroll") for (int i_ = 0; i_ < 32; ++i_) dst_[i_] = __builtin_nontemporal_load(p_ + i_ * st_); } while (0)
    if (it_lo + gw < it_hi) P0_LOAD(v, cur);
    for (int it = it_lo + gw; it < it_hi; it += NGW) {
        const int nit = it + NGW; const bool hn = nit < it_hi;
        const P0Item nxt = p0_decode(F, hn ? nit : it);
        float vn[32];
        if (hn) P0_LOAD(vn, nxt);
#pragma unroll
        for (int i = 0; i < 32; ++i) scr[(2 * i + (lane >> 5)) * 33 + (lane & 31)] = v[i];
        LDS_WAIT(); asm volatile("" ::: "memory");
        const int c = lane & 7;
#pragma unroll
        for (int j = 0; j < 4; ++j) { const int n = (lane >> 3) + 8 * j; const LAS float* s = scr + (8 * c) * 33 + n;
            if (cur.fp8) { int lo = 0, hi = 0;
                lo = __builtin_amdgcn_cvt_pk_fp8_f32(s[0 * 33] * WSCALE, s[1 * 33] * WSCALE, lo, false); lo = __builtin_amdgcn_cvt_pk_fp8_f32(s[2 * 33] * WSCALE, s[3 * 33] * WSCALE, lo, true);
                hi = __builtin_amdgcn_cvt_pk_fp8_f32(s[4 * 33] * WSCALE, s[5 * 33] * WSCALE, hi, false); hi = __builtin_amdgcn_cvt_pk_fp8_f32(s[6 * 33] * WSCALE, s[7 * 33] * WSCALE, hi, true);
                *(GAS v2u*)(cur.dst + (size_t)n * cur.ldtB + 8 * c) = (v2u){(unsigned)lo, (unsigned)hi};
            } else { v4u o; o.x = pk2(s[0 * 33], s[1 * 33]); o.y = pk2(s[2 * 33], s[3 * 33]); o.z = pk2(s[4 * 33], s[5 * 33]); o.w = pk2(s[6 * 33], s[7 * 33]);
                *(GAS v4u*)(cur.dst + (size_t)n * cur.ldtB + 16 * c) = o; } }
        LDS_WAIT(); asm volatile("" ::: "memory");
        cur = nxt;
#pragma unroll
        for (int i = 0; i < 32; ++i) v[i] = vn[i];
    }
#undef P0_LOAD
    if (!do_norm) return;
    const GAS f32x4* gp = (const GAS f32x4*)F.in[I_N1G] + lane;
    f32x4 g[4];
#pragma unroll
    for (int j = 0; j < 4; ++j) g[j] = gp[64 * j];
    bf16* XN = (bf16*)(ws + WS_XN);
    for (int m = gw; m < T; m += 2 * NGW) {
        const int m2 = (m + NGW < T) ? m + NGW : m;
        const GAS f32x4* xr = (const GAS f32x4*)(F.in[I_X] + (size_t)m * D) + lane; const GAS f32x4* xr2 = (const GAS f32x4*)(F.in[I_X] + (size_t)m2 * D) + lane;
        f32x4 va[4], vb[4]; float sa = 0.f, sb = 0.f;
#pragma unroll
        for (int j = 0; j < 4; ++j) { va[j] = __builtin_nontemporal_load(xr + 64 * j); vb[j] = __builtin_nontemporal_load(xr2 + 64 * j); }
#pragma unroll
        for (int j = 0; j < 4; ++j) { sa += (va[j].x * va[j].x + va[j].y * va[j].y) + (va[j].z * va[j].z + va[j].w * va[j].w); sb += (vb[j].x * vb[j].x + vb[j].y * vb[j].y) + (vb[j].z * vb[j].z + vb[j].w * vb[j].w); }
        const float ra = 1.0f / sqrtf(wave_sum(sa) * (1.f / D) + NORM_EPS), rb = 1.0f / sqrtf(wave_sum(sb) * (1.f / D) + NORM_EPS);
        GAS unsigned long long* oa = (GAS unsigned long long*)(XN + (size_t)m * D) + lane; GAS unsigned long long* ob = (GAS unsigned long long*)(XN + (size_t)m2 * D) + lane;
#pragma unroll
        for (int j = 0; j < 4; ++j) { const f32x4 ya = va[j] * ra * g[j], yb = vb[j] * rb * g[j];
            oa[64 * j] = (unsigned long long)pk2(ya.x, ya.y) | ((unsigned long long)pk2(ya.z, ya.w) << 32); ob[64 * j] = (unsigned long long)pk2(yb.x, yb.y) | ((unsigned long long)pk2(yb.z, yb.w) << 32); }
    }
}

#ifndef REP_MASK
#define REP_MASK 0
#endif
#ifndef PROBE_K2X
#define PROBE_K2X 0
#endif
#ifndef DOWN_REVERSE
#define DOWN_REVERSE 0
#endif
struct DenseSched {
    const char* A; const char* B; int nM, nN, nt, G, c; size_t tstepA, tstepB; int rs; int rot;
    __device__ __forceinline__ bool next(int i, pg8::Unit& u) const { const long L = (long)(i >> rs) * G + c; if (L >= (long)nM * nN) return false; pg8::dense_tile((int)L, nM, nN, u.pm, u.pn); u.pn = (u.pn + rot) % nN; u.aux = 0; return true; }
    __device__ __forceinline__ const char* a_ptr(const pg8::Unit& u) const { return A + (size_t)u.pm * tstepA; }
    __device__ __forceinline__ const char* b_ptr(const pg8::Unit& u) const { return B + (size_t)u.pn * tstepB; }
    __device__ __forceinline__ int ntiles(const pg8::Unit&) const { return nt; }
};
struct MergeSched {
    const char* A; const char* B; int G, c;
    __device__ __forceinline__ bool next(int i, pg8::Unit& u) const { const long L = (long)(i >> (1 + ((REP_MASK >> 4) & 1))) * G + c; if (L >= 128 * 4) return false; pg8::dense_tile((int)L, 128, 4, u.pm, u.pn); u.aux = i & 1; return true; }
    __device__ __forceinline__ const char* a_ptr(const pg8::Unit& u) const { return A + (size_t)u.pm * (256 * ARW * 2) + (u.aux ? QW * 2 : 0); }
    __device__ __forceinline__ const char* b_ptr(const pg8::Unit& u) const { return B + (size_t)u.pn * (256 * ARW * 2) + (u.aux ? QW * 2 : 0); }
    __device__ __forceinline__ int ntiles(const pg8::Unit& u) const { return u.aux ? (LRU_W / 64) : (QW / 64); }
};
template <int NTN> struct MoeSched {
    const char* A; const char* B; const LAS int* nbp; int G, c; size_t estepB;
    __device__ __forceinline__ bool next(int i, pg8::Unit& u) const {
        const int NB = nbp[NE], U = NB * NTN; const long L = (long)(i >> ((NTN == 4) ? ((REP_MASK >> 8) & 1) : 0)) * G + c; if (L >= U) return false; const int seg_ = i & 1;
        int w = (int)L; { const int q = U / 8, r = U % 8, xcd = w % 8, off = w / 8; w = (xcd < r ? xcd * (q + 1) : r * (q + 1) + (xcd - r) * q) + off; }
        if (NTN == 4 && DOWN_REVERSE) w = U - 1 - w;
        int e = 0;
        for (int k = 1; k < NE; ++k) e += (w >= nbp[k] * NTN) ? 1 : 0;
        const int b0 = nbp[e], nM = nbp[e + 1] - b0, wl = w - b0 * NTN;
        const int nig = 8 * NTN, gid = wl / nig, fm = gid * 8, gsz = (nM - fm) < 8 ? (nM - fm) : 8;
        const int rb = fm + ((wl % nig) % gsz); u.pn = (wl % nig) / gsz; u.pm = b0 + rb; u.aux = e | (rb << 8) | ((PROBE_K2X && NTN == 4) ? (seg_ << 30) : 0); return true;
    }
    __device__ __forceinline__ const char* a_ptr(const pg8::Unit& u) const { return A; }
    __device__ __forceinline__ const char* b_ptr(const pg8::Unit& u) const { return B + (size_t)(u.aux & 0xff) * estepB + (size_t)u.pn * (256 * D); }
    __device__ __forceinline__ int ntiles(const pg8::Unit&) const { return D / 128; }
};
struct MoeDownSched : MoeSched<4> {
    __device__ __forceinline__ const char* a_ptr(const pg8::Unit& u) const { return A + (size_t)u.pm * (256 * DFF); }
};

__device__ __forceinline__ float gelu_tanh_f(float y) { const float z = y * (0.7978845608028654f + 0.035677408136300125f * y * y); return y * __builtin_amdgcn_rcpf(1.0f + __builtin_amdgcn_exp2f(-2.0f * 1.4426950408889634f * z)); }
__device__ __forceinline__ pg8::bf16_t* glf_ptr(pg8::bf16_t* GLF, int pm, int gt, int wave, int ai, int m, int bj, int lane) {
    return GLF + ((((((size_t)pm * 8 + gt) * 8 + wave) * 2 + ai) * 4 + m) * 2 + bj) * 512 + lane * 8; }
struct EpiInProj {
    static constexpr bool PERM = true;
    unsigned char* ws; const LAS float* etab;
    __device__ __forceinline__ bool keep(const pg8::Unit&) const { return false; }
    __device__ __forceinline__ void operator()(pg8::f32x4 (&acc)[2][2][4][2], const pg8::Unit& u, int wr, int wc, int fr, int fq) const {
        using namespace pg8;
        const int pn = u.pn; bf16_t* base; int ldc, colt;
        if (pn < 2) { base = (bf16_t*)(ws + WS_Q); ldc = QW; colt = pn * 256; }
        else if (pn == 2) { base = (bf16_t*)(ws + WS_KV); ldc = 2 * KVW; colt = 0; }
        else if (pn < 7) { base = (bf16_t*)(ws + WS_XR); ldc = LRU_W; colt = (pn - 3) * 256; }
        else if (pn < 11) { base = (bf16_t*)(ws + WS_YR); ldc = LRU_W; colt = (pn - 7) * 256; }
        else { base = (bf16_t*)(ws + WS_GL); ldc = 2 * D; colt = (pn - 11) * 256; }
        const int row0 = u.pm * BM + wr * 64 + fr, col0 = colt + wc * 32 + 8 * fq; const bool isyr = (pn >= 7 && pn < 11);
        const LAS float* bias = etab + u.ui * 256 + wc * 32 + 8 * fq;
        f32x4 bv[2][2];
#pragma unroll
        for (int bj = 0; bj < 2; ++bj)
#pragma unroll
            for (int n = 0; n < 2; ++n) bv[bj][n] = *(const LAS f32x4*)(bias + bj * HALF + 4 * n);
#pragma unroll
        for (int ai = 0; ai < 2; ++ai)
#pragma unroll
            for (int m = 0; m < 4; ++m) { bf16_t* rowp = base + (size_t)(row0 + ai * HALF + m * 16) * ldc + col0;
#pragma unroll
                for (int bj = 0; bj < 2; ++bj) { f32x4 v0 = acc[ai][bj][m][0] + bv[bj][0], v1 = acc[ai][bj][m][1] + bv[bj][1];
                    if (isyr) {
#pragma unroll
                        for (int j = 0; j < 4; ++j) { v0[j] = gelu_tanh_f(v0[j]); v1[j] = gelu_tanh_f(v1[j]); } }
                    u32x4 w; w.x = cvt_pk_bf16(v0[0], v0[1]); w.y = cvt_pk_bf16(v0[2], v0[3]); w.z = cvt_pk_bf16(v1[0], v1[1]); w.w = cvt_pk_bf16(v1[2], v1[3]);
                    if (pn >= 11) *(u32x4*)(glf_ptr((bf16_t*)(ws + WS_GL), u.pm, pn - 11, wr * 4 + wc, ai, m, bj, fq * 16 + fr)) = w;
                    else *(u32x4*)(rowp + bj * HALF) = w; } }
    }
};
struct EpiMerge {
    static constexpr bool PERM = true;
    const bf16* GL; bf16* MG;
    __device__ __forceinline__ bool keep(const pg8::Unit& u) const { return u.aux == 0; }
    __device__ __forceinline__ void operator()(pg8::f32x4 (&acc)[2][2][4][2], const pg8::Unit& u, int wr, int wc, int fr, int fq) const {
        using namespace pg8;
        const int row0 = u.pm * BM + wr * 64 + fr, col0 = u.pn * BM + wc * 32 + 8 * fq;
        if (u.aux == 0) {
#pragma unroll
            for (int ai = 0; ai < 2; ++ai)
#pragma unroll
                for (int m = 0; m < 4; ++m) {
#pragma unroll
                    for (int bj = 0; bj < 2; ++bj) { const u32x4 ga = *(const u32x4*)glf_ptr((bf16_t*)GL, u.pm, u.pn, wr * 4 + wc, ai, m, bj, fq * 16 + fr), gr = *(const u32x4*)glf_ptr((bf16_t*)GL, u.pm, u.pn + 4, wr * 4 + wc, ai, m, bj, fq * 16 + fr);
#pragma unroll
                        for (int q = 0; q < 4; ++q) { const float a0 = bf_lo(ga[q]), a1 = bf_hi(ga[q]), r0 = bf_lo(gr[q]), r1 = bf_hi(gr[q]);
                            const float f0 = (1.0f + __builtin_amdgcn_exp2f(-1.4426950408889634f * r0)) * __builtin_amdgcn_rcpf(1.0f + __builtin_amdgcn_exp2f(-1.4426950408889634f * a0));
                            const float f1 = (1.0f + __builtin_amdgcn_exp2f(-1.4426950408889634f * r1)) * __builtin_amdgcn_rcpf(1.0f + __builtin_amdgcn_exp2f(-1.4426950408889634f * a1));
                            acc[ai][bj][m][q >> 1][(q & 1) * 2] *= f0; acc[ai][bj][m][q >> 1][(q & 1) * 2 + 1] *= f1; } } }
        } else {
#pragma unroll
            for (int ai = 0; ai < 2; ++ai) { u32x4 grv[4][2];
#pragma unroll
                for (int m = 0; m < 4; ++m) {
#pragma unroll
                    for (int bj = 0; bj < 2; ++bj) grv[m][bj] = *(const u32x4*)glf_ptr((bf16_t*)GL, u.pm, u.pn + 4, wr * 4 + wc, ai, m, bj, fq * 16 + fr); }
#pragma unroll
                for (int m = 0; m < 4; ++m) { bf16* op = MG + (size_t)(row0 + ai * HALF + m * 16) * D + col0;
#pragma unroll
                    for (int bj = 0; bj < 2; ++bj) { const u32x4 gr = grv[m][bj]; u32x4 w;
#pragma unroll
                        for (int q = 0; q < 4; ++q) { const float s0 = fast_sigmoid(bf_lo(gr[q])), s1 = fast_sigmoid(bf_hi(gr[q]));
                            w[q] = cvt_pk_bf16(acc[ai][bj][m][q >> 1][(q & 1) * 2] * s0, acc[ai][bj][m][q >> 1][(q & 1) * 2 + 1] * s1); }
                        *(u32x4*)(op + bj * HALF) = w; } } }
        }
    }
};
struct EpiResF32 {
    static constexpr bool PERM = true;
    bf16* O;
    __device__ __forceinline__ bool keep(const pg8::Unit&) const { return false; }
    __device__ __forceinline__ void operator()(pg8::f32x4 (&acc)[2][2][4][2], const pg8::Unit& u, int wr, int wc, int fr, int fq) const {
        using namespace pg8;
        const int row0 = u.pm * BM + wr * 64 + fr, col0 = u.pn * BM + wc * 32 + 8 * fq;
#pragma unroll
        for (int ai = 0; ai < 2; ++ai)
#pragma unroll
            for (int m = 0; m < 4; ++m) { bf16* rowp = O + (size_t)(row0 + ai * HALF + m * 16) * D + col0;
#pragma unroll
                for (int bj = 0; bj < 2; ++bj) { const f32x4 v0 = acc[ai][bj][m][0], v1 = acc[ai][bj][m][1];
                    u32x4 w; w.x = cvt_pk_bf16(v0[0], v0[1]); w.y = cvt_pk_bf16(v0[2], v0[3]); w.z = cvt_pk_bf16(v1[0], v1[1]); w.w = cvt_pk_bf16(v1[2], v1[3]);
                    *(u32x4*)(rowp + bj * HALF) = w; } }
    }
};
struct EpiSwiGLU {
    static constexpr bool PERM = true;
    const LAS unsigned short* etab; const LAS unsigned short* rtab; unsigned char* ACT;
    __device__ __forceinline__ bool keep(const pg8::Unit&) const { return false; }
    __device__ __forceinline__ void operator()(pg8::f32x4 (&acc)[2][2][4][2], const pg8::Unit& u, int wr, int wc, int fr, int fq) const {
        using namespace pg8;
        const int cl = wc * 32 + 8 * fq, col0 = u.pn * 128 + cl, row0 = u.pm * BM + wr * 64 + fr;
        const LAS unsigned short* bp = etab + u.ui * 256 + cl; const LAS unsigned short* rp = rtab + u.ui * 256 + wr * 64 + fr;
        const u32x4 bgw = *(const LAS u32x4*)(bp), buw = *(const LAS u32x4*)(bp + 128);
        const f32x4 bg0 = (f32x4){bf_lo(bgw.x), bf_hi(bgw.x), bf_lo(bgw.y), bf_hi(bgw.y)}, bg1 = (f32x4){bf_lo(bgw.z), bf_hi(bgw.z), bf_lo(bgw.w), bf_hi(bgw.w)};
        const f32x4 bu0 = (f32x4){bf_lo(buw.x), bf_hi(buw.x), bf_lo(buw.y), bf_hi(buw.y)}, bu1 = (f32x4){bf_lo(buw.z), bf_hi(buw.z), bf_lo(buw.w), bf_hi(buw.w)};
#pragma unroll
        for (int ai = 0; ai < 2; ++ai)
#pragma unroll
            for (int m = 0; m < 4; ++m) { u32x2 w; const float rs = __uint_as_float((unsigned)rp[ai * HALF + m * 16] << 16) * WSCALE_INV;
#pragma unroll
                for (int n = 0; n < 2; ++n) { const f32x4 g = acc[ai][0][m][n] * rs + (n ? bg1 : bg0), uu = acc[ai][1][m][n] * rs + (n ? bu1 : bu0); float a[4];
#pragma unroll
                    for (int j = 0; j < 4; ++j) { const float gg = fminf(g[j], 7.0f), uc = fminf(fmaxf(uu[j], -7.0f), 7.0f);
                        a[j] = gg * __builtin_amdgcn_rcpf(1.0f + __builtin_amdgcn_exp2f(-1.702f * 1.4426950408889634f * gg)) * (uc + 1.0f); }
                    int pk = 0; pk = __builtin_amdgcn_cvt_pk_fp8_f32(a[0], a[1], pk, false); pk = __builtin_amdgcn_cvt_pk_fp8_f32(a[2], a[3], pk, true); w[n] = (unsigned)pk; }
                *(u32x2*)(ACT + (size_t)(row0 + ai * HALF + m * 16) * DFF + col0) = w; }
    }
};
struct EpiDown {
    static constexpr bool PERM = true;
    const LAS float* etab; const LAS float* gtab2; unsigned char* Y;
    __device__ __forceinline__ bool keep(const pg8::Unit& u) const { return PROBE_K2X && ((u.aux >> 30) & 1) == 0; }
    __device__ __forceinline__ void operator()(pg8::f32x4 (&acc)[2][2][4][2], const pg8::Unit& u, int wr, int wc, int fr, int fq) const {
        using namespace pg8;
        if (PROBE_K2X && ((u.aux >> 30) & 1) == 0) return;
        const int tui = PROBE_K2X ? (u.ui >> 1) : u.ui; const float ksc = PROBE_K2X ? 0.5f * WSCALE_INV : WSCALE_INV;
        const int col0 = u.pn * BM + wc * 32 + 8 * fq, rl0 = wr * 64 + fr;
        const LAS float* bias = etab + tui * 256 + wc * 32 + 8 * fq;
        f32x4 bv[2][2];
#pragma unroll
        for (int bj = 0; bj < 2; ++bj)
#pragma unroll
            for (int n = 0; n < 2; ++n) bv[bj][n] = *(const LAS f32x4*)(bias + bj * HALF + 4 * n);
        const LAS float* gl = gtab2 + tui * 256;
#pragma unroll
        for (int ai = 0; ai < 2; ++ai)
#pragma unroll
            for (int m = 0; m < 4; ++m) { const int rl = rl0 + ai * HALF + m * 16; const float gt = gl[rl] * YSCALE; unsigned char* rowp = Y + (size_t)(u.pm * BM + rl) * D + col0;
#pragma unroll
                for (int bj = 0; bj < 2; ++bj) { const f32x4 v0 = (acc[ai][bj][m][0] * ksc + bv[bj][0]) * gt, v1 = (acc[ai][bj][m][1] * ksc + bv[bj][1]) * gt;
                    int p0 = 0, p1 = 0; p0 = __builtin_amdgcn_cvt_pk_fp8_f32(v0[0], v0[1], p0, false); p0 = __builtin_amdgcn_cvt_pk_fp8_f32(v0[2], v0[3], p0, true);
                    p1 = __builtin_amdgcn_cvt_pk_fp8_f32(v1[0], v1[1], p1, false); p1 = __builtin_amdgcn_cvt_pk_fp8_f32(v1[2], v1[3], p1, true);
                    *(u32x2*)(rowp + bj * HALF) = (u32x2){(unsigned)p0, (unsigned)p1}; } }
    }
};

__device__ __forceinline__ v4u fix_vals(const v4u raw, const float* g8, float scale, int c, int prow, int pcol, const LAS f32x2* tab) {
    float v[8];
#pragma unroll
    for (int q = 0; q < 4; ++q) { v[2 * q] = bflo(raw[q]); v[2 * q + 1] = bfhi(raw[q]); }
    float ss = 0.f;
#pragma unroll
    for (int j = 0; j < 8; ++j) ss += v[j] * v[j];
    ss += __shfl_xor(ss, 1); ss += __shfl_xor(ss, 2); ss += __shfl_xor(ss, 4);
    const float rstd = 1.0f / sqrtf(ss * (1.0f / HD) + NORM_EPS);
    const int pos = (c >> 2) ? pcol : prow; const bool second = (c >> 1) & 1; const int f0 = (c & 1) * 8;
    float o[8];
#pragma unroll
    for (int j = 0; j < 8; ++j) { const float y = v[j] * rstd * g8[j]; const float pr = __shfl_xor(y, 2); const f32x2 cs = tab[pos * 16 + f0 + j];
        o[j] = (second ? (y * cs.x + pr * cs.y) : (y * cs.x - pr * cs.y)) * scale; }
    v4u w; w.x = pk2(o[0], o[1]); w.y = pk2(o[2], o[3]); w.z = pk2(o[4], o[5]); w.w = pk2(o[6], o[7]);
    return w;
}
__device__ __forceinline__ void p2_fixup(Frame& F) {
    LAS f32x2* tab = (LAS f32x2*)(F.lds);
    for (int idx = F.tid; idx < 1024; idx += NWAVES * 64) { const int pos = idx >> 4, f = idx & 15; const float inv = powf(10000.0f, -(float)f / 16.0f); const float ang = (float)pos * inv;
        tab[idx] = (f32x2){cosf(ang), sinf(ang)}; }
    __syncthreads();
    const int gw = F.vcu * NWAVES + F.wave, NGW = F.G * NWAVES, c = F.lane & 7;
    float gq[8], gk[8];
#pragma unroll
    for (int j = 0; j < 8; ++j) { gq[j] = F.in[I_QNG][8 * c + j]; gk[j] = F.in[I_KNG][8 * c + j]; }
    bf16* Q = (bf16*)(F.ws + WS_Q); bf16* KV = (bf16*)(F.ws + WS_KV);
    for (int t0 = gw; t0 < T; t0 += 4 * NGW) {
        v4u rq[4], rk[4]; int tt[4];
#pragma unroll
        for (int i = 0; i < 4; ++i) { const int t = t0 + i * NGW; tt[i] = t < T ? t : t0;
            rq[i] = *(const GAS v4u*)(Q + (size_t)tt[i] * QW + F.lane * 8); rk[i] = *(const GAS v4u*)(KV + (size_t)tt[i] * (2 * KVW) + (F.lane & 15) * 8); }
#pragma unroll
        for (int i = 0; i < 4; ++i) { const int t = tt[i], s = t & (SEQ - 1), prow = s >> 6, pcol = s & 63;
            const v4u wq = fix_vals(rq[i], gq, attn_body::C2, c, prow, pcol, tab);
            const v4u wk = fix_vals(rk[i], gk, 1.0f, c, prow, pcol, tab);
            if (t0 + i * NGW < T) { *(GAS v4u*)(Q + (size_t)t * QW + F.lane * 8) = wq; if (F.lane < 16) *(GAS v4u*)(KV + (size_t)t * (2 * KVW) + F.lane * 8) = wk; } }
    }
    __syncthreads();
}
constexpr int LRU_CH = 256;
constexpr int LRU_XC_STRIDE = 144;
constexpr int LRU_BUF = LRU_CH * LRU_XC_STRIDE;
constexpr int LRU_WT = 4 * LRU_BUF;
static_assert(LRU_BUF >= 256 * 33 * 4 && LRU_WT + 2048 + 5 * 64 * 4 <= MISC_OFF, "lru lds");

__device__ __forceinline__ float gelu_tanh(float y) { const float z = 0.7978845608028654f * (y + 0.044715f * y * y * y); return y * sigmoidf_fast(2.0f * z); }

#ifndef LRU_DUP
#define LRU_DUP 0
#endif
#ifndef LRU_TP
#define LRU_TP 0
#endif
template <int DIR> __device__ __forceinline__ void lru_dir(Frame& F, int b, int n, int half) {
    LAS unsigned char* lds = F.lds;
    int tid_ = F.tid; asm volatile("" : "+v"(tid_));
    unsigned char* ws_ = F.ws; asm volatile("" : "+s"(ws_));
    const int tid = tid_, lane = tid & 63, wave = __builtin_amdgcn_readfirstlane(tid >> 6);
    constexpr int g = DIR; const int w = wave & 3, tl = tid & 255;
#define PHY(p_) (DIR ? 255 - (p_) : (p_))
    const int ch16 = lane & 15, q = lane >> 4, ct = w & 1, th = w >> 1;
    const int cl = 16 * ct + ch16, co_l = 32 * half + cl, cgl = 64 * n + co_l;
    constexpr float NL2E = -1.4426950408889634f;
    bf16x8 Ba[2], Bi[2], Bid;
    { const float* wa = F.in[I_WA] + ((size_t)(g * LRU_NB + n) * 64) * 64 + co_l; const float* wi = F.in[I_WI] + ((size_t)(g * LRU_NB + n) * 64) * 64 + co_l;
      float ta[16], ti[16];
#pragma unroll
      for (int ks = 0; ks < 2; ++ks)
#pragma unroll
          for (int j = 0; j < 8; ++j) { const int k = 32 * ks + 8 * q + j; ta[8 * ks + j] = wa[(size_t)k * 64]; ti[8 * ks + j] = wi[(size_t)k * 64]; }
#pragma unroll
      for (int ks = 0; ks < 2; ++ks)
#pragma unroll
          for (int j = 0; j < 8; ++j) { Ba[ks][j] = (short)f2bf(NL2E * ta[8 * ks + j]); Bi[ks][j] = (short)f2bf(NL2E * ti[8 * ks + j]); }
#pragma unroll
      for (int j = 0; j < 8; ++j) Bid[j] = (short)((8 * q + j == 16 * ct + ch16) ? 0x3F80 : 0); }
    const float ba = NL2E * F.in[I_BA][(g * LRU_NB + n) * 64 + co_l], bi = NL2E * F.in[I_BI][(g * LRU_NB + n) * 64 + co_l];
    const float lam = F.in[I_LAM][g * LRU_W + cgl];
    const float clam = -8.0f * log1pf(expf(-lam)) * 1.4426950408889634f;
    const int c8 = tl & 7, tg = tl >> 3;
    LAS float* cwl = (LAS float*)(lds + LRU_WT + 2048);
    if (tid < 5 * 64) { const int j = tid >> 6, c = tid & 63; const float* src = (j < 4) ? (F.in[I_CONVW] + j * LRU_W) : F.in[I_CONVB]; cwl[tid] = src[64 * n + c]; }
    __syncthreads();
    const bf16* XR = (const bf16*)(ws_ + WS_XR) + (size_t)b * SEQ * LRU_W + 64 * n + 8 * c8;
    const bf16* YR = (const bf16*)(ws_ + WS_YR) + (size_t)b * SEQ * LRU_W + 64 * n + 32 * half;
    bf16* AR = (bf16*)(ws_ + WS_AR) + (size_t)b * SEQ * ARW + QW + 64 * n + 32 * half;
    constexpr int NST = SEQ / LRU_CH;
    v4u xrp[11];
#define LRU_LOADX(pc_) do { const int s0_ = (pc_) * LRU_CH + 8 * tg - 1; _Pragma("unroll") for (int i_ = 0; i_ < 11; ++i_) { const int s_ = s0_ + i_; \
        const int sc_ = s_ < 0 ? 0 : (s_ >= SEQ ? SEQ - 1 : s_); xrp[i_] = *(const GAS v4u*)(XR + (size_t)sc_ * LRU_W); } } while (0)
    LRU_LOADX(g ? NST - 1 : 0);
    float hcarry = 0.f;
    unsigned long long tpacc_ = 0, tps_ = 0;
    v4u dwv[4]; size_t dtrow = 0;
#pragma unroll
    for (int i = 0; i < 4; ++i) dwv[i] = (v4u){0u, 0u, 0u, 0u};
    for (int k = 0; k < NST; ++k) {
        if (LRU_TP == 1 || LRU_TP == 5) tps_ = __builtin_amdgcn_s_memrealtime();
        const int pc = g ? (NST - 1 - k) : k, par = k & 1;
        LAS unsigned char* buf = lds + (g * 2 + par) * LRU_BUF;
        unsigned aA = (unsigned)((DIR ? (255 - 128 * th - ch16 - 112) : (128 * th + ch16)) * LRU_XC_STRIDE + q * 16);
        unsigned aX = (unsigned)((DIR ? (255 - 128 * th - 4 * q - 115) : (128 * th + 4 * q)) * LRU_XC_STRIDE + co_l * 2);
        unsigned aH = (unsigned)(((DIR ? (255 - 128 * th - 4 * q - 115) : (128 * th + 4 * q)) * 33 + cl) * 4);
        asm volatile("" : "+v"(aA), "+v"(aX), "+v"(aH));
#define OFS(c_, m_) (DIR ? ((m_) - (c_)) : (c_))
#pragma unroll 1
        for (int dup_ = 0; dup_ < 1 + (LRU_DUP & 1); ++dup_) { asm volatile("" : "+v"(xrp[0].x));
        { const int s0c = pc * LRU_CH + 8 * tg - 1;
#pragma unroll
          for (int i = 0; i < 11; ++i) { const unsigned m_ = ((unsigned)(s0c + i) < (unsigned)SEQ) ? 0xffffffffu : 0u; xrp[i] = (v4u){xrp[i].x & m_, xrp[i].y & m_, xrp[i].z & m_, xrp[i].w & m_}; } }
        { f32x2 cw[4][4], cb[4];
#pragma unroll
          for (int j = 0; j < 4; ++j) { const f32x4 c0 = *(const LAS f32x4*)(cwl + j * 64 + 8 * c8), c1 = *(const LAS f32x4*)(cwl + j * 64 + 8 * c8 + 4);
              cw[j][0] = (f32x2){c0.x, c0.y}; cw[j][1] = (f32x2){c0.z, c0.w}; cw[j][2] = (f32x2){c1.x, c1.y}; cw[j][3] = (f32x2){c1.z, c1.w}; }
          { const f32x4 c0 = *(const LAS f32x4*)(cwl + 256 + 8 * c8), c1 = *(const LAS f32x4*)(cwl + 256 + 8 * c8 + 4); cb[0] = (f32x2){c0.x, c0.y}; cb[1] = (f32x2){c0.z, c0.w}; cb[2] = (f32x2){c1.x, c1.y}; cb[3] = (f32x2){c1.z, c1.w}; }
#pragma unroll
          for (int tt = 0; tt < 8; ++tt) { f32x2 o[4];
#pragma unroll
            for (int i = 0; i < 4; ++i) o[i] = cb[i];
#pragma unroll
            for (int j = 0; j < 4; ++j) { const v4u raw = xrp[tt + j];
#pragma unroll
                for (int qq = 0; qq < 4; ++qq) { const f32x2 xv = (f32x2){bflo(raw[qq]), bfhi(raw[qq])}; o[qq] = __builtin_elementwise_fma(cw[j][qq], xv, o[qq]); } }
            v4u wv; wv.x = pk2(o[0].x, o[0].y); wv.y = pk2(o[1].x, o[1].y); wv.z = pk2(o[2].x, o[2].y); wv.w = pk2(o[3].x, o[3].y);
            *(LAS v4u*)(buf + (8 * tg + tt) * LRU_XC_STRIDE + c8 * 16) = wv; } } }
        if (LRU_TP == 5) tpacc_ += __builtin_amdgcn_s_memrealtime() - tps_; if (LRU_TP == 6) tps_ = __builtin_amdgcn_s_memrealtime();
        if (k > 0) { GAS v4u* dop = (GAS v4u*)(AR + dtrow * ARW);
#pragma unroll
            for (int i = 0; i < 4; ++i) dop[i] = dwv[i]; }
        if (k + 1 < NST) LRU_LOADX(g ? (NST - 2 - k) : (k + 1));
        const size_t trow = (size_t)pc * LRU_CH + tl;
        if (LRU_TP == 6) tpacc_ += __builtin_amdgcn_s_memrealtime() - tps_;
        if (k == NST / 2) asm volatile("s_waitcnt vmcnt(0)" ::: "memory");
        __syncthreads();
        if (LRU_TP == 1) tpacc_ += __builtin_amdgcn_s_memrealtime() - tps_; if (LRU_TP == 2) tps_ = __builtin_amdgcn_s_memrealtime();
        float Aloc[8][4], Hloc[8][4]; float AR_ = 1.f, HR_ = 0.f;
#pragma unroll 1
        for (int dup_ = 0; dup_ < 1 + ((LRU_DUP >> 1) & 1); ++dup_) { asm volatile("" : "+v"(aA), "+v"(aX));
#pragma unroll
        for (int rt = 0; rt < 8; ++rt) {
            const bf16x8 a0 = *(const LAS bf16x8*)(buf + aA + OFS(16 * rt, 112) * LRU_XC_STRIDE), a1 = *(const LAS bf16x8*)(buf + aA + OFS(16 * rt, 112) * LRU_XC_STRIDE + 64);
            f32x4 Da = (f32x4){ba, ba, ba, ba}, Di = (f32x4){bi, bi, bi, bi}, Dx = (f32x4){0.f, 0.f, 0.f, 0.f};
            Da = __builtin_amdgcn_mfma_f32_16x16x32_bf16(a0, Ba[0], Da, 0, 0, 0); Da = __builtin_amdgcn_mfma_f32_16x16x32_bf16(a1, Ba[1], Da, 0, 0, 0);
            Di = __builtin_amdgcn_mfma_f32_16x16x32_bf16(a0, Bi[0], Di, 0, 0, 0); Di = __builtin_amdgcn_mfma_f32_16x16x32_bf16(a1, Bi[1], Di, 0, 0, 0);
            Dx = __builtin_amdgcn_mfma_f32_16x16x32_bf16(half ? a1 : a0, Bid, Dx, 0, 0, 0);
#pragma unroll
            for (int j = 0; j < 4; ++j) {
                const float r = __builtin_amdgcn_rcpf(1.0f + __builtin_amdgcn_exp2f(Da[j])), ig = __builtin_amdgcn_rcpf(1.0f + __builtin_amdgcn_exp2f(Di[j]));
                const float a = __builtin_amdgcn_exp2f(clam * r);
                Aloc[rt][j] = a; Hloc[rt][j] = __builtin_amdgcn_sqrtf(__builtin_fmaf(-a, a, 1.0f)) * (ig * Dx[j]); }
        }
        float Ai[8], Hi[8], Ae[8], He[8];
#pragma unroll
        for (int rt = 0; rt < 8; ++rt) {
#pragma unroll
            for (int j = 1; j < 4; ++j) { Hloc[rt][j] = Aloc[rt][j] * Hloc[rt][j - 1] + Hloc[rt][j]; Aloc[rt][j] = Aloc[rt][j - 1] * Aloc[rt][j]; }
            Ai[rt] = Aloc[rt][3]; Hi[rt] = Hloc[rt][3]; }
#pragma unroll
        for (int rt = 0; rt < 8; ++rt) { const float An = __shfl(Ai[rt], (lane - 16) & 63), Hn = __shfl(Hi[rt], (lane - 16) & 63); if (q >= 1) { Hi[rt] = Ai[rt] * Hn + Hi[rt]; Ai[rt] = An * Ai[rt]; } }
#pragma unroll
        for (int rt = 0; rt < 8; ++rt) { const float An = __shfl(Ai[rt], (lane - 32) & 63), Hn = __shfl(Hi[rt], (lane - 32) & 63); if (q >= 2) { Hi[rt] = Ai[rt] * Hn + Hi[rt]; Ai[rt] = An * Ai[rt]; } }
#pragma unroll
        for (int rt = 0; rt < 8; ++rt) { Ae[rt] = __shfl(Ai[rt], (lane - 16) & 63); He[rt] = __shfl(Hi[rt], (lane - 16) & 63); if (q == 0) { Ae[rt] = 1.f; He[rt] = 0.f; }
            Ai[rt] = __shfl(Ai[rt], ch16 + 48); Hi[rt] = __shfl(Hi[rt], ch16 + 48); }
        AR_ = 1.f; HR_ = 0.f;
#pragma unroll
        for (int rt = 0; rt < 8; ++rt) {
            const float Ap = AR_ * Ae[rt], Hp = Ae[rt] * HR_ + He[rt];
#pragma unroll
            for (int j = 0; j < 4; ++j) { Hloc[rt][j] = Aloc[rt][j] * Hp + Hloc[rt][j]; Aloc[rt][j] = Ap * Aloc[rt][j]; }
            HR_ = Ai[rt] * HR_ + Hi[rt]; AR_ = AR_ * Ai[rt]; }
        }
        LAS f32x2* WT = (LAS f32x2*)(lds + LRU_WT) + (g * 2 + par) * 64;
        if (q == 0) WT[th * 32 + cl] = (f32x2){AR_, HR_};
        __syncthreads();
        if (LRU_TP == 2) tpacc_ += __builtin_amdgcn_s_memrealtime() - tps_; if (LRU_TP == 3) tps_ = __builtin_amdgcn_s_memrealtime();
        v4u yv[4], ov[4];
        if (k >= NST / 2) {
#pragma unroll
            for (int i = 0; i < 4; ++i) { yv[i] = __builtin_nontemporal_load((const GAS v4u*)(YR + trow * LRU_W) + i); ov[i] = *((const GAS v4u*)(AR + trow * ARW) + i); } }
        const f32x2 w0 = WT[cl], w1 = WT[32 + cl];
        const float hmid = w0.x * hcarry + w0.y;
        const float hin = th ? hmid : hcarry;
        hcarry = w1.x * hmid + w1.y;
        LAS float* HS = (LAS float*)buf;
#pragma unroll
        for (int rt = 0; rt < 8; ++rt)
#pragma unroll
            for (int j = 0; j < 4; ++j) *(LAS float*)(buf + aH + OFS(16 * rt + j, 115) * 132) = Hloc[rt][j] + Aloc[rt][j] * hin;
        __syncthreads();
        if (LRU_TP == 3) tpacc_ += __builtin_amdgcn_s_memrealtime() - tps_; if (LRU_TP == 4) tps_ = __builtin_amdgcn_s_memrealtime();
#pragma unroll 1
        for (int dup_ = 0; dup_ < 1 + ((LRU_DUP >> 2) & 1); ++dup_) { asm volatile("" : "+v"(yv[0].x));
          float hv[32];
#pragma unroll
          for (int i = 0; i < 32; ++i) hv[i] = HS[tl * 33 + i];
          v4u wv[4];
          if (k < NST / 2) {
#pragma unroll
              for (int i = 0; i < 4; ++i) { wv[i].x = pk2(hv[8 * i], hv[8 * i + 1]); wv[i].y = pk2(hv[8 * i + 2], hv[8 * i + 3]); wv[i].z = pk2(hv[8 * i + 4], hv[8 * i + 5]); wv[i].w = pk2(hv[8 * i + 6], hv[8 * i + 7]); }
          } else {
#pragma unroll
              for (int i = 0; i < 4; ++i)
#pragma unroll
                  for (int qq = 0; qq < 4; ++qq) wv[i][qq] = pk2((hv[8 * i + 2 * qq] + bflo(ov[i][qq])) * bflo(yv[i][qq]), (hv[8 * i + 2 * qq + 1] + bfhi(ov[i][qq])) * bfhi(yv[i][qq]));
          }
#pragma unroll
          for (int i = 0; i < 4; ++i) dwv[i] = wv[i];
          dtrow = trow; }
        if (LRU_TP == 4) tpacc_ += __builtin_amdgcn_s_memrealtime() - tps_;
    }
    { GAS v4u* dop = (GAS v4u*)(AR + dtrow * ARW);
#pragma unroll
      for (int i = 0; i < 4; ++i) dop[i] = dwv[i]; }
#undef LRU_LOADX
#undef PHY
#undef OFS
    if (LRU_TP > 0 && blockIdx.x == 0 && tid == 0) *(LAS unsigned*)(F.lds + MISC_OFF + 4 * 204) = (unsigned)tpacc_;
    __syncthreads();
}
__device__ __forceinline__ void p2_lru(Frame& F) {
    for (int it = F.vcu; it < BATCH * LRU_NB * 2; it += F.G) { if (F.wave < 4) lru_dir<0>(F, it >> 5, (it & 31) >> 1, it & 1); else lru_dir<1>(F, it >> 5, (it & 31) >> 1, it & 1); }
}

constexpr int RW_STRIDE = 1032;
constexpr int RT_WBH = 0, RT_WBL = 32 * RW_STRIDE * 2, RT_G2 = 2 * RT_WBL, RT_LG = RT_G2 + 4096, RT_ROWINFO = RT_LG + 8 * 16 * 33 * 4, RT_RS = RT_ROWINFO + 4096;
static_assert(RT_RS + 512 <= MISC_OFF, "router lds");
__device__ __forceinline__ void p6_router(Frame& F, const bool dry) {
    LAS unsigned char* lds = F.lds;
    LAS unsigned short* WBH = (LAS unsigned short*)(lds + RT_WBH); LAS unsigned short* WBL = (LAS unsigned short*)(lds + RT_WBL);
    LAS float* G2 = (LAS float*)(lds + RT_G2); LAS float* LG = (LAS float*)(lds + RT_LG); LAS v2u* rowinfo = (LAS v2u*)(lds + RT_ROWINFO); LAS float* RS = (LAS float*)(lds + RT_RS);
    LAS unsigned* misc = (LAS unsigned*)(lds + MISC_OFF);
    LAS unsigned* hist = misc + 128; LAS unsigned* basew = misc + 160;
    const int tid = F.tid, lane = F.lane, wave = F.wave;
    for (int i0 = 0; i0 < (D * NE) / (NWAVES * 64); i0 += 16) {
        float tw[16];
#pragma unroll
        for (int i = 0; i < 16; ++i) tw[i] = F.in[I_WR][tid + (NWAVES * 64) * (i0 + i)];
        asm volatile("" ::: "memory");
#pragma unroll
        for (int i = 0; i < 16; ++i) { const int idx = tid + (NWAVES * 64) * (i0 + i), k = idx >> 5, e = idx & 31; const unsigned hi = f2bf(tw[i]); const unsigned lo = f2bf(tw[i] - __uint_as_float(hi << 16));
            WBH[e * RW_STRIDE + k] = (unsigned short)hi; WBL[e * RW_STRIDE + k] = (unsigned short)lo; } }
    for (int i = tid; i < D; i += NWAVES * 64) G2[i] = F.in[I_N2G][i];
    if (tid < 32) hist[tid] = 0u;
    const float brl0 = F.in[I_BR][lane & 15], brl1 = F.in[I_BR][16 + (lane & 15)];
    __syncthreads();
    bf16* X1B = (bf16*)(F.ws + WS_X1B); const bf16* MIXB = (const bf16*)(F.ws + WS_MIXB);
    unsigned char* H2 = (unsigned char*)(F.ws + WS_XN);
    unsigned* gcnt = (unsigned*)(F.ws + WS_CTL) + CW_CNT;
    int* TOKL = (int*)(F.ws + WS_TOKL); float* GATEL = (float*)(F.ws + WS_GATEL); int* TOKREC = (int*)(F.ws + WS_TOKREC); float* RSTDT = (float*)(F.ws + WS_RSTDT);
    const int r16 = lane & 15, kq = lane >> 4;
    for (int bi = F.vcu; bi < T / 128; bi += F.G) {
        const int rbase = bi * 128; const size_t row = (size_t)rbase + 16 * wave + r16;
        const float* xp = F.in[I_X] + row * D + 8 * kq; const bf16* mp = MIXB + row * D + 8 * kq; bf16* x1p = X1B + row * D + 8 * kq; unsigned char* hp = H2 + row * D + 8 * kq;
        f32x4 acc0 = (f32x4){0.f, 0.f, 0.f, 0.f}, acc1 = (f32x4){0.f, 0.f, 0.f, 0.f}; float ss = 0.f;
        const LAS unsigned char* bh0 = lds + RT_WBH + (r16 * RW_STRIDE + 8 * kq) * 2; const LAS unsigned char* bl0 = lds + RT_WBL + (r16 * RW_STRIDE + 8 * kq) * 2;
#pragma unroll 1
        for (int s4 = 0; s4 < 32; s4 += 4) {
            f32x4 xa[4], xb[4]; v4u mw[4];
#pragma unroll
            for (int u = 0; u < 4; ++u) { const int k0 = 32 * (s4 + u); xa[u] = __builtin_nontemporal_load((const GAS f32x4*)(xp + k0)); xb[u] = __builtin_nontemporal_load((const GAS f32x4*)(xp + k0 + 4)); mw[u] = __builtin_nontemporal_load((const GAS v4u*)(mp + k0)); }
#pragma unroll
            for (int u = 0; u < 4; ++u) { const int k0 = 32 * (s4 + u);
                const f32x4 ga = *(const LAS f32x4*)(G2 + k0 + 8 * kq), gb = *(const LAS f32x4*)(G2 + k0 + 8 * kq + 4);
                float x1[8]; x1[0] = xa[u].x + bflo(mw[u].x); x1[1] = xa[u].y + bfhi(mw[u].x); x1[2] = xa[u].z + bflo(mw[u].y); x1[3] = xa[u].w + bfhi(mw[u].y);
                x1[4] = xb[u].x + bflo(mw[u].z); x1[5] = xb[u].y + bfhi(mw[u].z); x1[6] = xb[u].z + bflo(mw[u].w); x1[7] = xb[u].w + bfhi(mw[u].w);
#pragma unroll
                for (int j = 0; j < 8; ++j) ss += x1[j] * x1[j];
                *(GAS v4u*)(x1p + k0) = (v4u){pk2(x1[0], x1[1]), pk2(x1[2], x1[3]), pk2(x1[4], x1[5]), pk2(x1[6], x1[7])};
                float h[8]; h[0] = x1[0] * ga.x; h[1] = x1[1] * ga.y; h[2] = x1[2] * ga.z; h[3] = x1[3] * ga.w; h[4] = x1[4] * gb.x; h[5] = x1[5] * gb.y; h[6] = x1[6] * gb.z; h[7] = x1[7] * gb.w;
                { int p0 = 0, p1 = 0; p0 = __builtin_amdgcn_cvt_pk_fp8_f32(h[0], h[1], p0, false); p0 = __builtin_amdgcn_cvt_pk_fp8_f32(h[2], h[3], p0, true);
                  p1 = __builtin_amdgcn_cvt_pk_fp8_f32(h[4], h[5], p1, false); p1 = __builtin_amdgcn_cvt_pk_fp8_f32(h[6], h[7], p1, true); *(GAS v2u*)(hp + k0) = (v2u){(unsigned)p0, (unsigned)p1}; }
                v4u ahi, alo;
#pragma unroll
                for (int q2 = 0; q2 < 4; ++q2) { ahi[q2] = pk2(h[2 * q2], h[2 * q2 + 1]); alo[q2] = pk2(h[2 * q2] - bflo(ahi[q2]), h[2 * q2 + 1] - bfhi(ahi[q2])); }
                const bf16x8 Ahi = __builtin_bit_cast(bf16x8, ahi), Alo = __builtin_bit_cast(bf16x8, alo);
                const bf16x8 Bh0 = *(const LAS bf16x8*)(bh0 + k0 * 2), Bh1 = *(const LAS bf16x8*)(bh0 + 16 * RW_STRIDE * 2 + k0 * 2), Bl0 = *(const LAS bf16x8*)(bl0 + k0 * 2), Bl1 = *(const LAS bf16x8*)(bl0 + 16 * RW_STRIDE * 2 + k0 * 2);
                acc0 = __builtin_amdgcn_mfma_f32_16x16x32_bf16(Ahi, Bh0, acc0, 0, 0, 0); acc1 = __builtin_amdgcn_mfma_f32_16x16x32_bf16(Ahi, Bh1, acc1, 0, 0, 0);
                acc0 = __builtin_amdgcn_mfma_f32_16x16x32_bf16(Alo, Bh0, acc0, 0, 0, 0); acc1 = __builtin_amdgcn_mfma_f32_16x16x32_bf16(Alo, Bh1, acc1, 0, 0, 0);
                acc0 = __builtin_amdgcn_mfma_f32_16x16x32_bf16(Ahi, Bl0, acc0, 0, 0, 0); acc1 = __builtin_amdgcn_mfma_f32_16x16x32_bf16(Ahi, Bl1, acc1, 0, 0, 0); }
        }
        ss += __shfl_xor(ss, 16); ss += __shfl_xor(ss, 32);
        const float rstd = 1.0f / sqrtf(ss * (1.f / D) + NORM_EPS);
        LAS float* lgw = LG + wave * (16 * 33);
#pragma unroll
        for (int i = 0; i < 4; ++i) { const float rsi = __shfl(rstd, 4 * kq + i);
            lgw[(4 * kq + i) * 33 + r16] = acc0[i] * rsi + brl0; lgw[(4 * kq + i) * 33 + 16 + r16] = acc1[i] * rsi + brl1; }
        LDS_WAIT(); asm volatile("" ::: "memory");
        if (lane < 16) {
            LAS float* lr = lgw + lane * 33; int te[4]; float tv[4];
#pragma unroll
            for (int k = 0; k < 4; ++k) { float best = -INFINITY; int bi2 = 0;
#pragma unroll
                for (int e = 0; e < 32; ++e) { const float v = lr[e]; if (v > best) { best = v; bi2 = e; } }
                te[k] = bi2; tv[k] = best; lr[bi2] = -INFINITY; LDS_WAIT(); asm volatile("" ::: "memory"); }
            const float p1 = __expf(tv[1] - tv[0]), p2 = __expf(tv[2] - tv[0]), p3 = __expf(tv[3] - tv[0]); const float inv = 1.0f / (1.0f + p1 + p2 + p3);
            const float gts[4] = {inv, p1 * inv, p2 * inv, p3 * inv};
            const int rl = 16 * wave + lane;
#pragma unroll
            for (int k = 0; k < 4; ++k) { const unsigned rank = atomicAdd((unsigned*)(hist + te[k]), 1u); rowinfo[rl * 4 + k] = (v2u){(unsigned)te[k] | (rank << 8), __float_as_uint(gts[k])}; }
            RS[rl] = rstd;
        }
        __syncthreads();
        if (tid < 32) basew[tid] = dry ? 0u : __hip_atomic_fetch_add(gcnt + tid, hist[tid], __ATOMIC_RELAXED, __HIP_MEMORY_SCOPE_AGENT);
        __syncthreads();
        { const int rl = tid >> 2, k = tid & 3; const v2u inf = rowinfo[rl * 4 + k]; const int e = inf.x & 0xff; const unsigned slot = basew[e] + (inf.x >> 8); const int t = rbase + rl;
          if (!dry) { TOKL[(size_t)e * ECAP + slot] = t; GATEL[(size_t)e * ECAP + slot] = __uint_as_float(inf.y); TOKREC[t * 4 + k] = (int)(((unsigned)e << 20) | slot); if (k == 0) RSTDT[t] = RS[rl]; } }
        __syncthreads();
        if (tid < 32) hist[tid] = 0u;
        __syncthreads();
    }
}

__device__ __forceinline__ void moe_tables(Frame& F) {
    LAS int* misc = (LAS int*)(F.lds + MISC_OFF);
    const unsigned* gcnt = (const unsigned*)(F.ws + WS_CTL) + CW_CNT;
    if (F.tid < 32) misc[F.tid] = (int)__hip_atomic_load(gcnt + F.tid, __ATOMIC_RELAXED, __HIP_MEMORY_SCOPE_AGENT);
    __syncthreads();
    if (F.tid == 0) { int s = 0; for (int e = 0; e < NE; ++e) { misc[32 + e] = s; s += (misc[e] + 255) >> 8; } misc[32 + NE] = s; }
    __syncthreads();
}
constexpr int UDESC_WORD = 208;
template <class Sched> __device__ __forceinline__ int resolve_units(Frame& F, const Sched& S, int maxu, int stride) {
    LAS int* misc = (LAS int*)(F.lds + MISC_OFF);
    if (F.tid == 0) misc[UDESC_WORD - 1] = 0;
    __syncthreads();
    pg8::Unit u;
    for (int ui = F.wave; ui < maxu; ui += NWAVES) { if (!S.next(ui * stride, u)) break;
        if (F.lane == 0) { misc[UDESC_WORD + 3 * ui] = u.aux; misc[UDESC_WORD + 3 * ui + 1] = u.pn; misc[UDESC_WORD + 3 * ui + 2] = u.pm; atomicMax((int*)(misc + UDESC_WORD - 1), ui + 1); } }
    __syncthreads();
    return misc[UDESC_WORD - 1];
}
template <class Base> struct TabSched : Base {
    const LAS int* desc; int nu;
    __device__ __forceinline__ TabSched(const Base& b, const LAS int* d, int n) : Base(b), desc(d), nu(n) {}
    __device__ __forceinline__ bool next(int i, pg8::Unit& u) const { if (i >= nu) return false; u.aux = desc[3 * i]; u.pn = desc[3 * i + 1]; u.pm = desc[3 * i + 2]; return true; }
};
__device__ __forceinline__ int moe_gather_table(Frame& F, const MoeSched<8>& S) {
    LAS int* misc = (LAS int*)(F.lds + MISC_OFF); LAS unsigned short* gtab = (LAS unsigned short*)(F.lds + GTAB_OFF);
    LAS unsigned short* etab = (LAS unsigned short*)(F.lds + ETAB_OFF); LAS unsigned short* rtab = etab + MAX_GUNITS * 256;
    const int* TOKL = (const int*)(F.ws + WS_TOKL); const float* RSTDT = (const float*)(F.ws + WS_RSTDT);
    const int nu = resolve_units(F, S, MAX_GUNITS, 1);
    if (nu == 0) return 0;
    int tv[MAX_GUNITS / 2]; float bv[MAX_GUNITS / 2], rv[MAX_GUNITS / 2];
#pragma unroll
    for (int j = 0; j < MAX_GUNITS / 2; ++j) { const int idx = F.tid + 512 * j, uiu = idx >> 8, ui = uiu < nu ? uiu : nu - 1, r = idx & 255;
        const int aux = misc[UDESC_WORD + 3 * ui], pn = misc[UDESC_WORD + 3 * ui + 1], e = aux & 0xff, rb = aux >> 8, slot = rb * 256 + r; const bool ok = slot < misc[e];
        tv[j] = TOKL[(size_t)e * ECAP + (ok ? slot : 0)]; tv[j] = ok ? tv[j] : 0;
        bv[j] = F.in[I_BGU][(size_t)e * (2 * DFF) + (r < 128 ? 0 : DFF - 128) + pn * 128 + r]; }
    asm volatile("" ::: "memory");
#pragma unroll
    for (int j = 0; j < MAX_GUNITS / 2; ++j) rv[j] = RSTDT[tv[j]];
    asm volatile("" ::: "memory");
#pragma unroll
    for (int j = 0; j < MAX_GUNITS / 2; ++j) { const int idx = F.tid + 512 * j; if ((idx >> 8) < nu) { gtab[idx] = (unsigned short)tv[j]; etab[idx] = (unsigned short)f2bf(bv[j]); rtab[idx] = (unsigned short)f2bf(rv[j]); } }
    __syncthreads();
    return nu;
}
__device__ __forceinline__ int moe_down_table(Frame& F, const MoeDownSched& S) {
    LAS int* misc = (LAS int*)(F.lds + MISC_OFF); LAS float* etab = (LAS float*)(F.lds + ETAB_OFF); LAS float* gt2 = (LAS float*)(F.lds + GTAB_OFF);
    const float* GATEL = (const float*)(F.ws + WS_GATEL);
    const int nu = resolve_units(F, S, 9, PROBE_K2X ? 2 : 1);
    if (nu == 0) return 0;
    float bv[5], gv[5];
#pragma unroll
    for (int j = 0; j < 5; ++j) { const int idx = F.tid + 512 * j, uiu = idx >> 8, ui = uiu < nu ? uiu : nu - 1, r = idx & 255;
        const int aux = misc[UDESC_WORD + 3 * ui], pn = misc[UDESC_WORD + 3 * ui + 1], e = aux & 0xff, rb = (aux >> 8) & 0xffff;
        bv[j] = F.in[I_BDN][(size_t)e * D + pn * 256 + r]; gv[j] = GATEL[(size_t)e * ECAP + rb * 256 + r]; }
    asm volatile("" ::: "memory");
#pragma unroll
    for (int j = 0; j < 5; ++j) { const int idx = F.tid + 512 * j; if ((idx >> 8) < nu) { etab[idx] = bv[j]; gt2[idx] = gv[j]; } }
    __syncthreads();
    return nu;
}
__device__ __forceinline__ int inproj_table(Frame& F, const DenseSched& S) {
    LAS int* misc = (LAS int*)(F.lds + MISC_OFF); LAS float* etab = (LAS float*)(F.lds + ETAB_OFF);
    const int nu = resolve_units(F, S, MAX_GUNITS, 1);
    if (nu == 0) return 0;
    float bv[MAX_GUNITS / 2];
#pragma unroll
    for (int j = 0; j < MAX_GUNITS / 2; ++j) { const int idx = F.tid + 512 * j, uiu = idx >> 8, ui = uiu < nu ? uiu : nu - 1, r = idx & 255; bv[j] = F.in[I_BIN][misc[UDESC_WORD + 3 * ui + 1] * 256 + r]; }
    asm volatile("" ::: "memory");
#pragma unroll
    for (int j = 0; j < MAX_GUNITS / 2; ++j) { const int idx = F.tid + 512 * j; if ((idx >> 8) < nu) etab[idx] = bv[j]; }
    __syncthreads();
    return nu;
}

__device__ __forceinline__ void p1_fixup_own(Frame& F, int nu) {
    LAS int* misc = (LAS int*)(F.lds + MISC_OFF);
    bool any = false;
    for (int ui = 0; ui < nu; ++ui) any |= (misc[UDESC_WORD + 3 * ui + 1] <= 2);
    if (!any) return;
    asm volatile("s_waitcnt vmcnt(0)" ::: "memory"); __syncthreads();
    LAS f32x2* tab = (LAS f32x2*)(F.lds);
    for (int idx = F.tid; idx < 1024; idx += NWAVES * 64) { const int pos = idx >> 4, f = idx & 15; const float inv = powf(10000.0f, -(float)f / 16.0f); const float ang = (float)pos * inv;
        tab[idx] = (f32x2){cosf(ang), sinf(ang)}; }
    __syncthreads();
    const int c = F.lane & 7;
    float gq[8], gk[8];
#pragma unroll
    for (int j = 0; j < 8; ++j) { gq[j] = F.in[I_QNG][8 * c + j]; gk[j] = F.in[I_KNG][8 * c + j]; }
    bf16* Q = (bf16*)(F.ws + WS_Q); bf16* KV = (bf16*)(F.ws + WS_KV);
    for (int ui = 0; ui < nu; ++ui) {
        const int pn = misc[UDESC_WORD + 3 * ui + 1], pm = misc[UDESC_WORD + 3 * ui + 2];
        if (pn > 2) continue;
        if (pn < 2) {
            for (int it = 0; it < 16; it += 4) { v4u rq[4]; bf16* pp[4]; int tt[4];
#pragma unroll
                for (int i = 0; i < 4; ++i) { tt[i] = pm * 256 + 2 * (F.wave + 8 * (it + i)) + (F.lane >> 5); pp[i] = Q + (size_t)tt[i] * QW + pn * 256 + (F.lane & 31) * 8; rq[i] = *(const GAS v4u*)pp[i]; }
#pragma unroll
                for (int i = 0; i < 4; ++i) { const int sq = tt[i] & (SEQ - 1); *(GAS v4u*)pp[i] = fix_vals(rq[i], gq, attn_body::C2, c, sq >> 6, sq & 63, tab); } }
        } else {
            for (int it = 0; it < 8; it += 4) { v4u rk[4]; bf16* pp[4]; int tt[4];
#pragma unroll
                for (int i = 0; i < 4; ++i) { tt[i] = pm * 256 + 4 * (F.wave + 8 * (it + i)) + (F.lane >> 4); pp[i] = KV + (size_t)tt[i] * (2 * KVW) + (F.lane & 15) * 8; rk[i] = *(const GAS v4u*)pp[i]; }
#pragma unroll
                for (int i = 0; i < 4; ++i) { const int sq = tt[i] & (SEQ - 1); *(GAS v4u*)pp[i] = fix_vals(rk[i], gk, 1.0f, c, sq >> 6, sq & 63, tab); } }
        }
    }
    __syncthreads();
}

__device__ __forceinline__ void p10_final(Frame& F, float* dst) {
    LAS int* misc = (LAS int*)(F.lds + MISC_OFF);
    const int gw = F.vcu * NWAVES + F.wave, NGW = F.G * NWAVES, lane = F.lane;
    f32x4 g[4];
#pragma unroll
    for (int j = 0; j < 4; ++j) g[j] = *((const GAS f32x4*)F.in[I_FG] + lane + 64 * j);
    const int* TOKREC = (const int*)(F.ws + WS_TOKREC); const unsigned char* Y = (const unsigned char*)(F.ws + WS_Y); const bf16* X1B = (const bf16*)(F.ws + WS_X1B);
    typedef int v4i __attribute__((ext_vector_type(4)));
    v4i rec = (gw < T) ? *(const GAS v4i*)(TOKREC + (size_t)gw * 4) : (v4i){0, 0, 0, 0};
    for (int t = gw; t < T; t += NGW) {
        const int tn = t + NGW;
        const v4i recn = (tn < T) ? *(const GAS v4i*)(TOKREC + (size_t)tn * 4) : rec;
        const GAS v2u* xp = (const GAS v2u*)(X1B + (size_t)t * D) + lane;
        f32x4 v[4]; unsigned yv[4][4];
#pragma unroll
        for (int k = 0; k < 4; ++k) { const unsigned rk = (unsigned)rec[k]; const int e = rk >> 20, slot = rk & 0xfffff;
            const GAS unsigned* yp = (const GAS unsigned*)(Y + ((size_t)misc[32 + e] * 256 + slot) * D) + lane;
#pragma unroll
            for (int j = 0; j < 4; ++j) yv[k][j] = __builtin_nontemporal_load(yp + 64 * j); }
#pragma unroll
        for (int j = 0; j < 4; ++j) { const v2u w = __builtin_nontemporal_load(xp + 64 * j); v[j] = (f32x4){bflo(w.x), bfhi(w.x), bflo(w.y), bfhi(w.y)}; }
        f32x4 ys[4];
#pragma unroll
        for (int j = 0; j < 4; ++j) ys[j] = (f32x4){0.f, 0.f, 0.f, 0.f};
#pragma unroll
        for (int k = 0; k < 4; ++k)
#pragma unroll
            for (int j = 0; j < 4; ++j) { const f32x2 lo = __builtin_amdgcn_cvt_pk_f32_fp8((int)yv[k][j], false), hi = __builtin_amdgcn_cvt_pk_f32_fp8((int)yv[k][j], true);
                ys[j].x += lo.x; ys[j].y += lo.y; ys[j].z += hi.x; ys[j].w += hi.y; }
#pragma unroll
        for (int j = 0; j < 4; ++j) v[j] = v[j] + ys[j] * YSCALE_INV;
        float s = 0.f;
#pragma unroll
        for (int j = 0; j < 4; ++j) s += (v[j].x * v[j].x + v[j].y * v[j].y) + (v[j].z * v[j].z + v[j].w * v[j].w);
        const float rstd = 1.0f / sqrtf(wave_sum(s) * (1.f / D) + NORM_EPS);
        GAS f32x4* op = (GAS f32x4*)(dst + (size_t)t * D) + lane;
#pragma unroll
        for (int j = 0; j < 4; ++j) __builtin_nontemporal_store(v[j] * rstd * g[j], op + 64 * j);
        rec = recn;
    }
}
typedef GAS unsigned gu32;
#define RLX_AGENT __ATOMIC_RELAXED, __HIP_MEMORY_SCOPE_AGENT
#define XB_TMO      128
#define XB_XCNT(j)  (256  + 64 * (j))
#define XB_XSUB(j)  (1280 + 64 * (j))
#define XB_XGEN(j)  (2304 + 64 * (j))
#define XB_TOP      3328
#define XB_TOPGEN   3392
#define XCD_BAR_WORDS 3456
#define XB_SPIN_CAP (1u << 18)

__device__ __forceinline__ unsigned xb_ld(unsigned* p)              { return __hip_atomic_load(p, __ATOMIC_RELAXED, __HIP_MEMORY_SCOPE_AGENT); }
__device__ __forceinline__ unsigned xb_add(unsigned* p, unsigned v) { return __hip_atomic_fetch_add(p, v, __ATOMIC_RELAXED, __HIP_MEMORY_SCOPE_AGENT); }
__device__ __forceinline__ unsigned xb_xcc_id() { return (unsigned)__builtin_amdgcn_s_getreg((3 << 11) | 20) & 0xFu; }
#define XB_SPIN(cond, bar) do { unsigned _sp = 0; while (cond) { __builtin_amdgcn_s_sleep(1); \
    if ((++_sp & 255u) == 0u) { if (xb_ld(&(bar)[XB_TMO])) break; if (_sp > XB_SPIN_CAP) { atomicAdd(&(bar)[XB_TMO], 1u); break; } } } } while (0)

struct XcdBarrier {
    unsigned* bar; unsigned x;
    volatile LAS unsigned* st;
};

__device__ __forceinline__ XcdBarrier xcd_barrier_post(unsigned* bar, volatile LAS unsigned* st) {
    XcdBarrier b; b.bar = bar; b.x = xb_xcc_id(); b.st = st;
    if (threadIdx.x == 0) (void)xb_add(&bar[XB_XCNT(b.x)], 1u);
    return b;
}
__device__ __forceinline__ void xcd_barrier_complete(unsigned* bar, unsigned x, unsigned& nloc, unsigned& nx) {
    const unsigned G = gridDim.x * gridDim.y * gridDim.z;
    unsigned sum, cnt, mine, sp = 0u;
    for (;;) {
        sum = 0u; cnt = 0u; mine = 0u;
#pragma unroll
        for (unsigned j = 0; j < 16; ++j) { const unsigned c = xb_ld(&bar[XB_XCNT(j)]); sum += c; cnt += (c > 0u) ? 1u : 0u; mine = (j == x) ? c : mine; }
        if (sum == G) break;
        __builtin_amdgcn_s_sleep(1);
        if ((++sp & 255u) == 0u) { if (xb_ld(&bar[XB_TMO])) break; if (sp > XB_SPIN_CAP) { atomicAdd(&bar[XB_TMO], 1u); break; } }
    }
    nloc = mine > 0u ? mine : 1u; nx = cnt > 0u ? cnt : 1u;
}

__device__ __forceinline__ void xcd_barrier(const XcdBarrier& b) {
    asm volatile("s_waitcnt vmcnt(0)" ::: "memory");
    __syncthreads();
    if (threadIdx.x == 0) {
        unsigned* bar = b.bar;
        __builtin_amdgcn_s_waitcnt(0);
        unsigned nloc = b.st[0], nx = b.st[1];
        if (nloc == 0u) { xcd_barrier_complete(bar, b.x, nloc, nx); b.st[0] = nloc; b.st[1] = nx; }
        const unsigned old = xb_add(&bar[XB_XSUB(b.x)], 1u);
        const unsigned gen = old / nloc;
        if (old + 1u == (gen + 1u) * nloc) {
            __builtin_amdgcn_fence(__ATOMIC_RELEASE, "agent");
            asm volatile("s_waitcnt vmcnt(0)" ::: "memory");
            const unsigned og = xb_add(&bar[XB_TOP], 1u);
            const unsigned tg = og / nx;
            if (og + 1u == (tg + 1u) * nx) xb_add(&bar[XB_TOPGEN], 1u);
            else XB_SPIN(xb_ld(&bar[XB_TOPGEN]) == tg, bar);
            __builtin_amdgcn_fence(__ATOMIC_ACQUIRE, "agent");
            xb_add(&bar[XB_XGEN(b.x)], 1u);
            asm volatile("s_waitcnt vmcnt(0)" ::: "memory");
        } else {
            XB_SPIN(xb_ld(&bar[XB_XGEN(b.x)]) == gen, bar);
            __builtin_amdgcn_fence(__ATOMIC_ACQUIRE, "agent");
            asm volatile("s_waitcnt vmcnt(0)" ::: "memory");
        }
    }
    __syncthreads();
}

constexpr int N_PHASES = 10;
struct Args { const float* in[24]; float* out; unsigned char* ws; int ph_lo, ph_hi; };
__global__ void __launch_bounds__(NWAVES * 64, 2) mk_fwd(Args args) {
    extern __shared__ __attribute__((aligned(16))) unsigned char lds[];
#define MKFRAME() Frame F; { int t_ = threadIdx.x; asm volatile("" : "+v"(t_)); F.lds = (LAS unsigned char*)lds; F.tid = t_; F.lane = t_ & 63; F.wave = __builtin_amdgcn_readfirstlane(t_ >> 6); \
        F.G = gridDim.x; const int bx = blockIdx.x; F.vcu = (F.G % 8 == 0) ? (bx % 8) * (F.G / 8) + bx / 8 : bx; F.in = args.in; F.out = args.out; F.ws = args.ws; }
    unsigned char* ws = args.ws;
    const int lo = args.ph_lo, hi = args.ph_hi;
#ifndef TP_SEAM
#define TP_SEAM -1
#endif
    unsigned long long tp0_ = 0, tp1_ = 0; if (TP_SEAM >= 0) tp0_ = __builtin_amdgcn_s_memrealtime();
#ifndef PH_MASK
#define PH_MASK 0x3ff
#endif
#define IN(k) (((PH_MASK >> (k)) & 1) && lo <= (k) && (k) < hi)
#ifndef REP_MASK
#define REP_MASK 0
#endif
#define REPS(k) for (int rep_ = 0; rep_ < ((((REP_MASK) >> (k)) & 1) ? 2 : 1); ++rep_)
#ifndef XTRA_BAR
#define XTRA_BAR 0
#endif
#define SEAM(k) do { if (IN(k) && IN((k) + 1)) { xcd_barrier(bar); for (int xb_ = 0; xb_ < XTRA_BAR; ++xb_) xcd_barrier(bar); if (TP_SEAM == (k)) tp1_ = __builtin_amdgcn_s_memrealtime(); } } while (0)

    XcdBarrier bar;
    { volatile LAS unsigned* st = (volatile LAS unsigned*)(lds + MISC_OFF) + 200; if (threadIdx.x == 0) { st[0] = 0u; st[1] = 0u; } __syncthreads(); bar = xcd_barrier_post((unsigned*)(ws + WS_CTL) + CW_BAR, st); }
#ifndef LATE_EXPERT_CONV
#define LATE_EXPERT_CONV 2
#endif
    if (IN(0)) { MKFRAME(); REPS(0) p0_prologue(F, 0, LATE_EXPERT_CONV ? P0_MIXER_ITEMS : P0_NITEMS, true); }
    SEAM(0);
    if (IN(1)) { MKFRAME();
        DenseSched S{(const char*)(ws + WS_XN), (const char*)(ws + WS_WIN), T / 256, INW / 256, D / 64, F.G, (int)blockIdx.x, (size_t)256 * D * 2, (size_t)256 * D * 2, (REP_MASK >> 1) & 1, 16};
        const int nu = inproj_table(F, S);
        const TabSched<DenseSched> TS(S, (const LAS int*)(F.lds + MISC_OFF) + UDESC_WORD, nu);
        EpiInProj E{ws, (const LAS float*)(F.lds + ETAB_OFF)};
        pg8::gemm_phase<EpiInProj, TabSched<DenseSched>, true, false>(F.lds, D * 2, D * 2, TS, E, nullptr);
        p1_fixup_own(F, nu);
    }
    SEAM(1);
    if (IN(3)) { { MKFRAME(); REPS(2) p2_lru(F); } if (TP_SEAM == 2) tp1_ = __builtin_amdgcn_s_memrealtime();
      MKFRAME();
        const attn_body::AttnTensors AT{(const attn_body::bf16*)(ws + WS_Q), (const attn_body::bf16*)(ws + WS_KV), (const attn_body::bf16*)(ws + WS_KV) + KVW, (attn_body::bf16*)(ws + WS_AR)};
        const attn_body::StaticOrder S((int)F.G, F.vcu);
        bool nomax; { const int l_ = F.lane; float mq = fabsf(F.in[I_QNG][l_]), mk = fabsf(F.in[I_KNG][l_]);
#pragma unroll
          for (int m_ = 32; m_ >= 1; m_ >>= 1) { mq = fmaxf(mq, __shfl_xor(mq, m_)); mk = fmaxf(mk, __shfl_xor(mk, m_)); }
          const float bound = 1.02f * 64.f * attn_body::C2 * mq * mk; nomax = __builtin_amdgcn_readfirstlane((int)(bound <= 60.f)) != 0; }
        REPS(3) attn_body::attn_phase<attn_body::StaticOrder>((char*)lds, AT, S, nomax);
    }
    SEAM(3);
    if (IN(4)) { MKFRAME();
        MergeSched S{(const char*)(ws + WS_AR), (const char*)(ws + WS_WCAT), F.G, (int)blockIdx.x};
        EpiMerge E{(const bf16*)(ws + WS_GL), (bf16*)(ws + WS_MERGED)};
        pg8::gemm_phase<EpiMerge, MergeSched, true, false>(F.lds, ARW * 2, ARW * 2, S, E, nullptr);
    }
    SEAM(4);
    if (IN(5)) { MKFRAME();
        DenseSched S{(const char*)(ws + WS_MERGED), (const char*)(ws + WS_WO), T / 256, D / 256, D / 64, F.G, (int)blockIdx.x, (size_t)256 * D * 2, (size_t)256 * D * 2, (REP_MASK >> 5) & 1, 0};
        EpiResF32 E{(bf16*)(ws + WS_MIXB)};
        pg8::gemm_phase<EpiResF32, DenseSched, true, false>(F.lds, D * 2, D * 2, S, E, nullptr);
    }
    SEAM(5);
    if (IN(6)) { MKFRAME(); if (LATE_EXPERT_CONV == 2) { p0_prologue(F, P0_MIXER_ITEMS, P0_NITEMS, false); __syncthreads(); }
        if ((REP_MASK >> 6) & 1) p6_router(F, true); p6_router(F, false);
        if (LATE_EXPERT_CONV == 1) { __syncthreads(); p0_prologue(F, P0_MIXER_ITEMS, P0_NITEMS, false); } }
    SEAM(6);
    if (IN(7)) { MKFRAME();
        moe_tables(F);
        MoeSched<8> S{(const char*)(ws + WS_XN), (const char*)(ws + WS_WGU), (const LAS int*)(F.lds + MISC_OFF) + 32, F.G, (int)blockIdx.x, (size_t)2 * DFF * D};
        const int nu = moe_gather_table(F, S);
        const TabSched<MoeSched<8>> TS(S, (const LAS int*)(F.lds + MISC_OFF) + UDESC_WORD, nu);
        EpiSwiGLU E{(const LAS unsigned short*)(F.lds + ETAB_OFF), (const LAS unsigned short*)(F.lds + ETAB_OFF) + MAX_GUNITS * 256, (unsigned char*)(ws + WS_ACT)};
        REPS(7) pg8::gemm_phase<EpiSwiGLU, TabSched<MoeSched<8>>, true, true, true>(F.lds, D, D, TS, E, (const LAS unsigned short*)(F.lds + GTAB_OFF));
    }
    SEAM(7);
    if (IN(8)) { MKFRAME();
        moe_tables(F);
        MoeDownSched S; S.A = (const char*)(ws + WS_ACT); S.B = (const char*)(ws + WS_WD); S.nbp = (const LAS int*)(F.lds + MISC_OFF) + 32; S.G = F.G; S.c = (int)blockIdx.x; S.estepB = (size_t)D * DFF;
        const int nu = moe_down_table(F, S);
        const TabSched<MoeDownSched> TS(S, (const LAS int*)(F.lds + MISC_OFF) + UDESC_WORD, nu);
        EpiDown E{(const LAS float*)(F.lds + ETAB_OFF), (const LAS float*)(F.lds + GTAB_OFF), (unsigned char*)(ws + WS_Y)};
        REPS(8) pg8::gemm_phase<EpiDown, TabSched<MoeDownSched>, true, false, true>(F.lds, DFF, DFF, TS, E, nullptr);
    }
    SEAM(8);
    if (IN(9)) { MKFRAME(); moe_tables(F); if ((REP_MASK >> 9) & 1) p10_final(F, (float*)(ws + WS_ACT)); p10_final(F, F.out); }
    if ((TP_SEAM >= 0 || LRU_TP > 0) && blockIdx.x == 0) { const unsigned long long te_ = __builtin_amdgcn_s_memrealtime(); if (TP_SEAM == 9) tp1_ = te_; unsigned long long w_ = 4ull * (tp1_ - tp0_); if (LRU_TP > 0) w_ = 4ull * *(volatile LAS unsigned*)(lds + MISC_OFF + 4 * 204); while (__builtin_amdgcn_s_memrealtime() - te_ < w_) __builtin_amdgcn_s_sleep(8); }
#undef IN
#undef SEAM
}

#ifndef MK_N_LAUNCHES
#define MK_N_LAUNCHES 1
#endif
extern "C" void kernel_launch(void* const* d_in, const int* in_sizes, int n_in, void* d_out, int out_size, void* d_ws, size_t ws_size, hipStream_t stream) {
    static int grid = 0;
    if (grid == 0) {
        if (n_in != 24 || in_sizes[0] != T * D || out_size != T * D || ws_size < WS_END) { fprintf(stderr, "kernel_launch: unexpected shapes (n_in %d, in0 %d, out %d, ws %zu < %zu)\n", n_in, n_in > 0 ? in_sizes[0] : -1, out_size, ws_size, (size_t)WS_END); grid = -1; return; }
        int dev = 0, cus = 0, per_cu = 0;
        if (hipGetDevice(&dev) != hipSuccess || hipDeviceGetAttribute(&cus, hipDeviceAttributeMultiprocessorCount, dev) != hipSuccess) { grid = -1; return; }
        if (hipFuncSetAttribute((const void*)mk_fwd, hipFuncAttributeMaxDynamicSharedMemorySize, LDS_BYTES) != hipSuccess) { fprintf(stderr, "kernel_launch: hipFuncSetAttribute failed\n"); grid = -1; return; }
        if (hipOccupancyMaxActiveBlocksPerMultiprocessor(&per_cu, (const void*)mk_fwd, NWAVES * 64, LDS_BYTES) != hipSuccess || per_cu < 1) { fprintf(stderr, "kernel_launch: occupancy query reports %d\n", per_cu); per_cu = 1; }
        (void)hipGetLastError();
        grid = cus;
    }
    if (grid < 0) return;
    Args a{};
    for (int i = 0; i < 24; ++i) a.in[i] = (const float*)d_in[i];
    a.out = (float*)d_out; a.ws = (unsigned char*)d_ws;
    const int nl = 1;
    for (int li = 0; li < nl; ++li) {
        a.ph_lo = (nl == 1) ? 0 : li; a.ph_hi = (nl == 1) ? N_PHASES : li + 1;
        void* kargs[] = {&a};
        if (hipMemsetAsync((char*)d_ws + WS_CTL, 0, CTL_ZERO_BYTES, stream) != hipSuccess) { fprintf(stderr, "kernel_launch: hipMemsetAsync failed\n"); return; }
        const hipError_t le = hipLaunchCooperativeKernel((const void*)mk_fwd, dim3(grid), dim3(NWAVES * 64), kargs, LDS_BYTES, stream);
        if (le != hipSuccess) { fprintf(stderr, "kernel_launch: launch %d failed: %s (grid %d)\n", li, hipGetErrorName(le), grid); break; }
    }
}
```

```cpp
#include <hip/hip_runtime.h>
#include <hip/hip_cooperative_groups.h>
#include <cstdio>
#include <cstdint>
#ifndef PG_TP
#define PG_TP 0
#endif
#ifndef PG8_TOUCH
#define PG8_TOUCH 0
#endif
#ifndef PG8_TOUCH_SEL
#define PG8_TOUCH_SEL 0
#endif
#define PG8_JUNK_OFF (160768 - 2048 + 1280)
#ifndef PG_IT
#define PG_IT 0
#endif
#ifndef PG_SEL
#define PG_SEL 7
#endif
#ifndef PG_AUX
#define PG_AUX -1
#endif
namespace pg8 {
#define PG8_LAS __attribute__((address_space(3)))
typedef unsigned short bf16_t;
typedef short bf16x8 __attribute__((ext_vector_type(8)));
typedef float f32x4 __attribute__((ext_vector_type(4)));
typedef float f32x2 __attribute__((ext_vector_type(2)));
typedef unsigned u32x4 __attribute__((ext_vector_type(4)));
typedef unsigned u32x2 __attribute__((ext_vector_type(2)));
typedef int v8i32 __attribute__((ext_vector_type(8)));
typedef int v4i32 __attribute__((ext_vector_type(4)));
constexpr int BM = 256, BK = 64, HALF = 128, HTB = HALF * BK * 2  , STAGE_BYTES = 8 * HTB, NXCD = 8, WGM = 8;

__host__ __device__ __forceinline__ int lds_byte(int r, int c) { const int st = (r >> 4) * 2 + (c >> 5), rr = r & 15, cc = c & 31, ob = rr * 64 + cc * 2; return st * 1024 + (ob ^ (((ob >> 9) & 1) << 5)); }
__host__ __device__ __forceinline__ void stage_rc(int b, int& R, int& C) { const int st = b / 1024, sb = b % 1024, swz = sb ^ (((sb >> 9) & 1) << 5); R = (st >> 1) * 16 + swz / 64; C = (st & 1) * 32 + (swz % 64) / 2; }
__host__ __device__ __forceinline__ int perm32(int rho) { const int n = rho >> 4, i = rho & 15; return 8 * (i >> 2) + 4 * n + (i & 3); }

struct Unit { int pm, pn, aux, ui; };

__device__ __forceinline__ void dense_tile(int L, int nM, int nN, int& pm, int& pn) {
    const int nwg = nM * nN; int wgid = L;
    { const int q = nwg / NXCD, r = nwg % NXCD, xcd = wgid % NXCD, off = wgid / NXCD; wgid = (xcd < r ? xcd * (q + 1) : r * (q + 1) + (xcd - r) * q) + off; }
    const int nig = WGM * nN, gid = wgid / nig, fm = gid * WGM, gsz = (nM - fm) < WGM ? (nM - fm) : WGM;
    pm = fm + ((wgid % nig) % gsz); pn = (wgid % nig) / gsz;
}

__device__ __forceinline__ unsigned cvt_pk_bf16(float lo, float hi) { unsigned r; asm volatile("v_cvt_pk_bf16_f32 %0, %1, %2" : "=v"(r) : "v"(lo), "v"(hi)); return r; }
__device__ __forceinline__ float bf_lo(unsigned w) { return __uint_as_float(w << 16); }
__device__ __forceinline__ float bf_hi(unsigned w) { return __uint_as_float(w & 0xffff0000u); }
__device__ __forceinline__ float fast_sigmoid(float x) { return __builtin_amdgcn_rcpf(1.0f + __builtin_amdgcn_exp2f(-1.4426950408889634f * x)); }

template <class Epi, class Sched, bool ALIGN_EPI, bool GATHER, bool FP8 = false>
__device__ __forceinline__ void gemm_phase(PG8_LAS unsigned char* lds, const int lda, const int ldb, const Sched& S, const Epi& E, const PG8_LAS unsigned short* gtab) {
    const int tid = threadIdx.x, wid = __builtin_amdgcn_readfirstlane(tid >> 6), lane = tid & 63, wr = wid >> 2, wc = wid & 3, fr = lane & 15, fq = lane >> 4;
    unsigned voffA[2], voffB[2]; int RA[2];
#pragma unroll
    for (int i = 0; i < 2; ++i) { int R, C; stage_rc(tid * 16 + i * 8192, R, C); const int Rb = Epi::PERM ? ((R & ~31) + perm32(R & 31)) : R;
        voffA[i] = GATHER ? (unsigned)(C * 2) : (unsigned)(R * lda + C * 2); voffB[i] = (unsigned)(Rb * ldb + C * 2); RA[i] = R; }
    const size_t kstep = (size_t)(BK * 2);
    const size_t hstepA = GATHER ? 0 : (size_t)HALF * lda;
    const size_t hstepB = (size_t)HALF * ldb;
    const unsigned ldsw = (unsigned)wid * 1024u;
    const int aoff = lds_byte(wr * 64 + fr, fq * 8), boff = lds_byte(wc * 32 + fr, fq * 8);
    const int aoff8 = lds_byte(wr * 64 + fr, (fq >> 1) * 32 + (fq & 1) * 16), boff8 = lds_byte(wc * 32 + fr, (fq >> 1) * 32 + (fq & 1) * 16);
    unsigned gC[2][2], gN[2][2];
#define PG8_SA(b, h) (((b) * 2 + (h)) * HTB)
#define PG8_SB(b, h) ((4 + (b) * 2 + (h)) * HTB)
#define PG8_GLDS(gp, bufoff, i) __builtin_amdgcn_global_load_lds((const unsigned*)(gp), (PG8_LAS unsigned*)(lds + (bufoff) + ldsw + (i) * 8192), 16, 0, 0)
#define PG8_STAGE_B(bufoff, gbase) do { _Pragma("unroll") for (int _i = 0; _i < 2; ++_i) PG8_GLDS((const char*)(gbase) + voffB[_i], bufoff, _i); } while (0)
#define PG8_STAGE_A(bufoff, gbase, h, nx) do { _Pragma("unroll") for (int _i = 0; _i < 2; ++_i) { \
        if constexpr (GATHER) PG8_GLDS((const char*)(gbase) + ((nx) ? gN[h][_i] : gC[h][_i]) + voffA[_i], bufoff, _i); \
        else PG8_GLDS((const char*)(gbase) + voffA[_i], bufoff, _i); } } while (0)
#define PG8_LDA(dst, b, h) do { if constexpr (FP8) { _Pragma("unroll") for (int m = 0; m < 4; ++m) dst##8[m] = __builtin_shufflevector(*(const PG8_LAS v4i32*)(lds + PG8_SA(b, h) + aoff + m * 2048), *(const PG8_LAS v4i32*)(lds + PG8_SA(b, h) + aoff + m * 2048 + 1024), 0, 1, 2, 3, 4, 5, 6, 7); } \
        else { _Pragma("unroll") for (int m = 0; m < 4; ++m) _Pragma("unroll") for (int k = 0; k < 2; ++k) dst[m][k] = *(const PG8_LAS bf16x8*)(lds + PG8_SA(b, h) + aoff + m * 2048 + k * 1024); } } while (0)
#define PG8_LDB(dst, b, h) do { if constexpr (FP8) { _Pragma("unroll") for (int n = 0; n < 2; ++n) dst##8[n] = __builtin_shufflevector(*(const PG8_LAS v4i32*)(lds + PG8_SB(b, h) + boff + n * 2048), *(const PG8_LAS v4i32*)(lds + PG8_SB(b, h) + boff + n * 2048 + 1024), 0, 1, 2, 3, 4, 5, 6, 7); } \
        else { _Pragma("unroll") for (int n = 0; n < 2; ++n) _Pragma("unroll") for (int k = 0; k < 2; ++k) dst[n][k] = *(const PG8_LAS bf16x8*)(lds + PG8_SB(b, h) + boff + n * 2048 + k * 1024); } } while (0)
#define PG8_MMA(ai, bj, At, Bt) do { __builtin_amdgcn_s_setprio(1); _Pragma("unroll") for (int m = 0; m < 4; ++m) _Pragma("unroll") for (int n = 0; n < 2; ++n) { \
        if constexpr (FP8) { asm volatile("v_mfma_scale_f32_16x16x128_f8f6f4 %0, %1, %2, %0, %3, %3 op_sel_hi:[0,0,0]" : "+v"(acc[ai][bj][m][n]) : "v"(Bt##8[n]), "v"(At##8[m]), "v"(scale1)); } \
        else { _Pragma("unroll") for (int k = 0; k < 2; ++k) acc[ai][bj][m][n] = __builtin_amdgcn_mfma_f32_16x16x32_bf16(Bt[n][k], At[m][k], acc[ai][bj][m][n], 0, 0, 0); } } \
        __builtin_amdgcn_s_setprio(0); } while (0)
#define PG8_WAIT_V(n) asm volatile("s_waitcnt vmcnt(" #n ")" ::: "memory")
#define PG8_WAIT_L(n) asm volatile("s_waitcnt lgkmcnt(" #n ")" ::: "memory")
#define PG8_BAR __builtin_amdgcn_s_barrier()
#define PG8_SCHED __builtin_amdgcn_sched_barrier(0)
#define PG8_GOFF(dst, ui_) do { if constexpr (GATHER) { _Pragma("unroll") for (int _h = 0; _h < 2; ++_h) _Pragma("unroll") for (int _i = 0; _i < 2; ++_i) \
        dst[_h][_i] = (unsigned)gtab[(ui_) * 256 + _h * HALF + RA[_i]] * (unsigned)lda; } } while (0)
    Unit cur, nxt; int ui = 0; unsigned long long tpacc_ = 0;
    if (!S.next(0, cur)) return;
    cur.ui = 0;
    f32x4 acc[2][2][4][2];
#pragma unroll
    for (int a = 0; a < 2; ++a)
#pragma unroll
        for (int b = 0; b < 2; ++b)
#pragma unroll
            for (int m = 0; m < 4; ++m)
#pragma unroll
                for (int n = 0; n < 2; ++n) acc[a][b][m][n] = (f32x4){0.f, 0.f, 0.f, 0.f};
    bf16x8 At[4][2], B0[2][2], B1[2][2]; v8i32 At8[4], B08[2], B18[2];
    int scale1 = 0x7f7f7f7f; asm volatile("" : "+v"(scale1));
    const char* cA = S.a_ptr(cur); const char* cB = S.b_ptr(cur);
    PG8_GOFF(gC, 0);
#pragma unroll
    for (int _h = 0; _h < 2; ++_h)
#pragma unroll
        for (int _i = 0; _i < 2; ++_i) gN[_h][_i] = gC[_h][_i];
    PG8_STAGE_B(PG8_SB(0, 0), cB); PG8_STAGE_B(PG8_SB(0, 1), cB + hstepB); PG8_STAGE_A(PG8_SA(0, 0), cA, 0, false); PG8_STAGE_A(PG8_SA(0, 1), cA + hstepA, 1, false);
    if (wr == 1) PG8_BAR;
    PG8_WAIT_V(2); PG8_BAR;
    PG8_STAGE_B(PG8_SB(1, 0), cB + kstep); PG8_STAGE_A(PG8_SA(1, 0), cA + kstep, 0, false); PG8_STAGE_B(PG8_SB(1, 1), cB + hstepB + kstep);
    PG8_WAIT_V(6); PG8_BAR;
    for (;;) {
        const bool has_next = S.next(ui + 1, nxt); nxt.ui = ui + 1;
        const int nt = S.ntiles(cur);
        const char* nA = has_next ? S.a_ptr(nxt) : cA; const char* nB = has_next ? S.b_ptr(nxt) : cB;
        if (has_next) PG8_GOFF(gN, ui + 1);
        unsigned long long k0_ = 0; if (PG_TP == 4 && Epi::TPID == PG_SEL && wid == 0) k0_ = __builtin_amdgcn_s_memrealtime(); if (PG_TP == 5 && Epi::TPID == PG_SEL && wid == 0) k0_ = __builtin_amdgcn_s_memtime();
#pragma unroll 1
        for (int t = 0; t < nt; t += 2) {
            const bool last = (t == nt - 2);
            unsigned long long i0_ = 0; if (PG_TP == 6 && Epi::TPID == PG_SEL && wid == 0 && t == PG_IT) i0_ = __builtin_amdgcn_s_memrealtime();
            const char* a1 = cA + (size_t)(t + 1) * kstep;
            const char* a2 = last ? nA : cA + (size_t)(t + 2) * kstep; const char* b2 = last ? nB : cB + (size_t)(t + 2) * kstep;
            const char* a3 = a2 + kstep; const char* b3 = b2 + kstep;
            PG8_LDB(B0, 0, 0); PG8_LDB(B1, 0, 1); PG8_SCHED; PG8_LDA(At, 0, 0); PG8_STAGE_A(PG8_SA(1, 1), a1 + hstepA, 1, false);
            if (PG_TP == 1 && Epi::TPID == PG_SEL && t == 0 && ui > 0 && wid == 0) { const unsigned long long a_ = __builtin_amdgcn_s_memrealtime(); PG8_WAIT_V(8); tpacc_ += __builtin_amdgcn_s_memrealtime() - a_; } else PG8_WAIT_V(8);
            PG8_WAIT_L(0); PG8_BAR; PG8_MMA(0, 0, At, B0); PG8_MMA(0, 1, At, B1); PG8_BAR; PG8_SCHED;
            PG8_LDA(At, 0, 1); PG8_STAGE_B(PG8_SB(0, 0), b2); PG8_STAGE_B(PG8_SB(0, 1), b2 + hstepB); PG8_STAGE_A(PG8_SA(0, 0), a2, 0, last);
            PG8_WAIT_V(8); PG8_WAIT_L(0); PG8_BAR; PG8_MMA(1, 0, At, B0); PG8_MMA(1, 1, At, B1); PG8_BAR; PG8_SCHED;
            PG8_LDB(B0, 1, 0); PG8_LDB(B1, 1, 1); PG8_SCHED; PG8_LDA(At, 1, 0); PG8_STAGE_A(PG8_SA(0, 1), a2 + hstepA, 1, last);
            PG8_WAIT_V(8); PG8_WAIT_L(0); PG8_BAR; PG8_MMA(0, 0, At, B0); PG8_MMA(0, 1, At, B1); PG8_BAR; PG8_SCHED;
            PG8_LDA(At, 1, 1); PG8_STAGE_B(PG8_SB(1, 0), b3); PG8_STAGE_B(PG8_SB(1, 1), b3 + hstepB); PG8_STAGE_A(PG8_SA(1, 0), a3, 0, last);
            PG8_WAIT_V(8); PG8_WAIT_L(0); PG8_BAR; PG8_MMA(1, 0, At, B0); PG8_MMA(1, 1, At, B1); PG8_BAR; PG8_SCHED;
            if (PG_TP == 6 && Epi::TPID == PG_SEL && wid == 0 && t == PG_IT) tpacc_ += __builtin_amdgcn_s_memrealtime() - i0_;
        }
        if (PG_TP == 4 && Epi::TPID == PG_SEL && wid == 0) tpacc_ += __builtin_amdgcn_s_memrealtime() - k0_; if (PG_TP == 5 && Epi::TPID == PG_SEL && wid == 0) tpacc_ += (__builtin_amdgcn_s_memtime() - k0_) >> 4;
        if (PG8_TOUCH && (PG8_TOUCH_SEL == 0 || Epi::TPID == PG8_TOUCH_SEL) && has_next) { const int ntn = S.ntiles(nxt), r_ = tid & 255;
            unsigned ro_; if constexpr (GATHER) ro_ = (unsigned)gtab[(ui + 1) * 256 + r_] * (unsigned)lda; else ro_ = (unsigned)r_ * (unsigned)lda;
            const char* tp_ = nA + ro_;
            for (int kt = 2 + (tid >> 8); kt < ntn; kt += 2) __builtin_amdgcn_global_load_lds((const unsigned*)(tp_ + (size_t)kt * kstep), (PG8_LAS unsigned*)(lds + PG8_JUNK_OFF), 4, 0, 0); }
        if constexpr (ALIGN_EPI) { if (wr == 0) PG8_BAR; }
        if constexpr (FP8) asm volatile("s_nop 15\n\ts_nop 15" ::: "memory");
        unsigned long long e0_ = 0; if (PG_TP == 2 && Epi::TPID == PG_SEL && (PG_AUX < 0 || cur.aux == PG_AUX) && wid == 0) e0_ = __builtin_amdgcn_s_memrealtime();
        { int fr_ = fr, fq_ = fq; asm volatile("" : "+v"(fr_), "+v"(fq_));
          E(acc, cur, wr, wc, fr_, fq_); }
        if (PG_TP == 2 && Epi::TPID == PG_SEL && (PG_AUX < 0 || cur.aux == PG_AUX) && wid == 0) { asm volatile("s_waitcnt vmcnt(0)" ::: "memory"); tpacc_ += __builtin_amdgcn_s_memrealtime() - e0_; }
        if (!E.keep(cur)) {
#pragma unroll
        for (int a = 0; a < 2; ++a)
#pragma unroll
            for (int b = 0; b < 2; ++b)
#pragma unroll
                for (int m = 0; m < 4; ++m)
#pragma unroll
                    for (int n = 0; n < 2; ++n) acc[a][b][m][n] = (f32x4){0.f, 0.f, 0.f, 0.f};
        }
        if (!has_next) break;
        cur = nxt; cA = nA; cB = nB; ++ui;
#pragma unroll
        for (int _h = 0; _h < 2; ++_h)
#pragma unroll
            for (int _i = 0; _i < 2; ++_i) gC[_h][_i] = gN[_h][_i];
        if constexpr (ALIGN_EPI) { if (wr == 1) PG8_BAR; }
    }
    if (PG_TP > 0 && Epi::TPID == PG_SEL && blockIdx.x == 0 && tid == 0) *(volatile PG8_LAS unsigned*)(lds + 160768 - 2048 + 4 * 204) = (unsigned)tpacc_;
    PG8_WAIT_V(0);
    if constexpr (!ALIGN_EPI) { if (wr == 0) PG8_BAR; }
    PG8_BAR;
#undef PG8_SA
#undef PG8_SB
#undef PG8_GLDS
#undef PG8_STAGE_A
#undef PG8_STAGE_B
#undef PG8_LDA
#undef PG8_LDB
#undef PG8_MMA
#undef PG8_WAIT_V
#undef PG8_WAIT_L
#undef PG8_BAR
#undef PG8_SCHED
#undef PG8_GOFF
}
}
#include <hip/hip_bf16.h>
#include <cmath>
#ifndef ATT_TP
#define ATT_TP 0
#endif
namespace attn_body {
#define TPK7() do{ if(ATT_TP>0&&wid==0){ const unsigned long long n_=__builtin_amdgcn_s_memrealtime(); if(ATT_TP==7||ATT_TP==5)tacc_+=n_-tlast_; tlast_=n_; } }while(0)
constexpr int ATT_TP_WORD_OFF=160768-2048+4*204;
using bf16=__hip_bfloat16;
using bf16x8=__attribute__((ext_vector_type(8)))short;
using s16x4=__attribute__((ext_vector_type(4)))short;
using f32x16=__attribute__((ext_vector_type(16)))float;
using u32x4=__attribute__((ext_vector_type(4)))unsigned;
constexpr int BATCH=8,NHEAD=8,NKV=2,SEQ=4096,D=64;
constexpr int QP=512,KVP=256,OP=1536;
constexpr int NW=8,QBLK=32,QB=QBLK*NW,KVBLK=64,NQB=SEQ/QB;
constexpr int ATTN_UNIT_ROWS=QB;
__device__ __forceinline__ int crow(int r,int hi){return (r&3)+8*(r>>2)+4*hi;}
#define SBAR() __builtin_amdgcn_sched_barrier(0)
constexpr int NSLOT=3, SLOTB=8192;
#ifndef ATTN_QK8
#define ATTN_QK8 1
#endif
typedef int v8i_t __attribute__((ext_vector_type(8))); typedef int v4i_t __attribute__((ext_vector_type(4)));
#define MF8(a,b,c) __builtin_amdgcn_mfma_scale_f32_32x32x64_f8f6f4(a,b,c,0,0,0,0x7f7f7f7f,0,0x7c7c7c7c)
constexpr int LDS_K=0, LDS_V=NSLOT*SLOTB, LDS_WS=2*NSLOT*SLOTB, LDS_OST=LDS_WS+NW*64*4, LDS_BYTES=LDS_OST+NW*4096;
constexpr float C2=0.125f*1.4426950408889634f;
__device__ __forceinline__ void glds16(const void*gsrc,unsigned lds_dst){unsigned keep;
  asm volatile("s_mov_b32 %0, m0\n\ts_mov_b32 m0, %2\n\ts_nop 0\n\tglobal_load_lds_dwordx4 %1, off\n\ts_mov_b32 m0, %0":"=&s"(keep):"v"(gsrc),"s"(lds_dst):"memory");}
__device__ __forceinline__ float max3f(float a,float b,float c){float r;asm("v_max3_f32 %0, %1, %2, %3":"=v"(r):"v"(a),"v"(b),"v"(c));return r;}
__device__ __forceinline__ float max2f(float a,float b){float r;asm("v_max_f32_e32 %0, %1, %2":"=v"(r):"v"(a),"v"(b));return r;}
__device__ __forceinline__ float fadd_s(float a,float b){float r;asm("v_add_f32_e32 %0, %1, %2":"=v"(r):"v"(a),"v"(b));return r;}
__device__ __forceinline__ float fsub_s(float a,float b){float r;asm("v_sub_f32_e32 %0, %1, %2":"=v"(r):"v"(a),"v"(b));return r;}
typedef float f32x2_t __attribute__((ext_vector_type(2))); typedef __bf16 bf16x2_t __attribute__((ext_vector_type(2)));
__device__ __forceinline__ unsigned cvtpk_s(float lo,float hi){f32x2_t v={lo,hi};bf16x2_t b=__builtin_convertvector(v,bf16x2_t);return __builtin_bit_cast(unsigned,b);}
#define WAIT_BAR(N) asm volatile("s_waitcnt vmcnt(" #N ") lgkmcnt(0)\n\ts_barrier":::"memory")

__device__ __forceinline__ void qkt(f32x16&p0,f32x16&p1,const char*Kslot,const bf16x8*qr,const f32x16&negm,int r32,int hi){
  const char*kb=Kslot+hi*1024+r32*16;
  #pragma unroll
  for(int d0=0;d0<4;++d0){
    const bf16x8 b0=*reinterpret_cast<const bf16x8*>(kb+d0*2048);
    const bf16x8 b1=*reinterpret_cast<const bf16x8*>(kb+d0*2048+512);
    if(d0==0){p0=__builtin_amdgcn_mfma_f32_32x32x16_bf16(b0,qr[0],negm,0,0,0);p1=__builtin_amdgcn_mfma_f32_32x32x16_bf16(b1,qr[0],negm,0,0,0);}
    else{p0=__builtin_amdgcn_mfma_f32_32x32x16_bf16(b0,qr[d0],p0,0,0,0);p1=__builtin_amdgcn_mfma_f32_32x32x16_bf16(b1,qr[d0],p1,0,0,0);}}
}
typedef __attribute__((address_space(3))) const char* lds_cptr;
typedef short v4i16_t __attribute__((ext_vector_type(4)));
__device__ __forceinline__ void kload8(bf16x8*kf,lds_cptr kp){
  kf[0]=*(const __attribute__((address_space(3))) bf16x8*)(kp);      kf[1]=*(const __attribute__((address_space(3))) bf16x8*)(kp+512);
  kf[2]=*(const __attribute__((address_space(3))) bf16x8*)(kp+2048); kf[3]=*(const __attribute__((address_space(3))) bf16x8*)(kp+2560);
  kf[4]=*(const __attribute__((address_space(3))) bf16x8*)(kp+4096); kf[5]=*(const __attribute__((address_space(3))) bf16x8*)(kp+4608);
  kf[6]=*(const __attribute__((address_space(3))) bf16x8*)(kp+6144); kf[7]=*(const __attribute__((address_space(3))) bf16x8*)(kp+6656);
}
__device__ __forceinline__ void kload2(bf16x8*kf,lds_cptr kp,int j){ kf[2*j]=*(const __attribute__((address_space(3))) bf16x8*)(kp+j*2048); kf[2*j+1]=*(const __attribute__((address_space(3))) bf16x8*)(kp+j*2048+512); }
__device__ __forceinline__ s16x4 vtr(lds_cptr p){ return __builtin_bit_cast(s16x4,__builtin_amdgcn_ds_read_tr16_b64_v4i16((__attribute__((address_space(3))) v4i16_t*)p)); }
__device__ __forceinline__ float rowmax(const f32x16&p0,const f32x16&p1){
  float a=max3f(p0[0],p0[1],p1[0]),b=max3f(p0[2],p0[3],p1[1]);a=max3f(a,p1[2],p1[3]);
  #pragma unroll
  for(int r=4;r<16;r+=4){a=max3f(a,p0[r],p0[r+1]);b=max3f(b,p0[r+2],p0[r+3]);a=max3f(a,p1[r],p1[r+1]);b=max3f(b,p1[r+2],p1[r+3]);}
  const float m=max2f(a,b);
  auto rr=__builtin_amdgcn_permlane32_swap(__float_as_uint(m),__float_as_uint(m),false,false);
  return max2f(__uint_as_float(rr[0]),__uint_as_float(rr[1]));
}
__device__ __forceinline__ void pv(f32x16*o,int vb,bf16x8 pa0,bf16x8 pa1,bf16x8 pa2,bf16x8 pa3){
  #pragma unroll
  for(int d0=0;d0<2;++d0){s16x4 lo[4],hi[4];
    #pragma unroll
    for(int ks=0;ks<4;++ks){
      asm volatile("ds_read_b64_tr_b16 %0,%1 offset:%c2":"=&v"(lo[ks]):"v"(vb),"i"(d0*4096+ks*1024):"memory");
      asm volatile("ds_read_b64_tr_b16 %0,%1 offset:%c2":"=&v"(hi[ks]):"v"(vb),"i"(d0*4096+ks*1024+512):"memory");}
    asm volatile("s_waitcnt lgkmcnt(0)":::"memory");SBAR();
    #define PK(k) (bf16x8){lo[k][0],lo[k][1],lo[k][2],lo[k][3],hi[k][0],hi[k][1],hi[k][2],hi[k][3]}
    o[d0]=__builtin_amdgcn_mfma_f32_32x32x16_bf16(pa0,PK(0),o[d0],0,0,0);
    o[d0]=__builtin_amdgcn_mfma_f32_32x32x16_bf16(pa1,PK(1),o[d0],0,0,0);
    o[d0]=__builtin_amdgcn_mfma_f32_32x32x16_bf16(pa2,PK(2),o[d0],0,0,0);
    o[d0]=__builtin_amdgcn_mfma_f32_32x32x16_bf16(pa3,PK(3),o[d0],0,0,0);
    #undef PK
  }
}

#ifndef ATTN_STORE16
#define ATTN_STORE16(p,v) (*(u32x4*)(p)=(v))
#endif
template<int THRL,bool NOMAX> __device__ __forceinline__ void attn_unit(int b,int h,int qb,const bf16*Q,const bf16*__restrict__ K,const bf16*__restrict__ V,bf16*O,char*shm,const unsigned char*__restrict__ K8){
  const int tid=threadIdx.x,lane=tid&63,r32=lane&31,hi=lane>>5; const int wid=__builtin_amdgcn_readfirstlane(tid>>6);
  const long rowbase=(long)b*SEQ; const int q0=qb*QB;
  unsigned long long tacc_=0,tlast_=0; if(ATT_TP>0&&wid==0)tlast_=__builtin_amdgcn_s_memrealtime();
  const bf16*Qw=Q+(rowbase+q0+wid*QBLK)*QP+h*D; const int kvh=h/(NHEAD/NKV);
  const bf16*Kh=K+rowbase*KVP+kvh*D,*Vh=V+rowbase*KVP+kvh*D;
  const unsigned lds0=(unsigned)(uintptr_t)shm;
  float*wsf=(float*)(shm+LDS_WS)+wid*64;
#if ATTN_QK8
  const int kkey=8*wid+(lane>>2); const unsigned char*ksrc8=K8+(rowbase+kkey)*128+kvh*64+(((lane&3)^((kkey>>2)&3))<<4);
#else
  const bf16*ksrc=Kh+(long)lane*KVP+wid*8;
#endif
  const bf16*vsrc=Vh+(long)(16*(wid&3)+(lane>>2))*KVP+(wid>>2)*32+(lane&3)*8;
#if ATTN_QK8
  const unsigned kdst=lds0+LDS_K+wid*512, vdst=lds0+LDS_V+wid*1024;
  #define DMA_K(t,slot) do{ const unsigned kd_=(unsigned)__builtin_amdgcn_readfirstlane(kdst+(slot)); if(lane<32) glds16(ksrc8+(long)(t)*KVBLK*128,kd_); }while(0)
#else
  const unsigned kdst=lds0+LDS_K+wid*1024, vdst=lds0+LDS_V+wid*1024;
  #define DMA_K(t,slot) glds16(ksrc+(long)(t)*KVBLK*KVP,(unsigned)__builtin_amdgcn_readfirstlane(kdst+(slot)))
#endif
  #define DMA_V(t,slot) glds16(vsrc+(long)(t)*KVBLK*KVP,(unsigned)__builtin_amdgcn_readfirstlane(vdst+(slot)))
  const int vb0=(int)(lds0+LDS_V)+((lane>>4)&1)*32+(lane&3)*8+(4*hi+((lane&15)>>2))*64;
  const char*Kbase=shm+LDS_K; (void)Kbase;
#if !ATTN_QK8
  bf16x8 kf[8];
#endif
  const lds_cptr shm3=(lds_cptr)shm; const lds_cptr kp0=shm3+LDS_K+hi*1024+r32*16; const lds_cptr vp0=shm3+LDS_V+((lane>>4)&1)*32+(lane&3)*8+(4*hi+((lane&15)>>2))*64;
  constexpr int NT=SEQ/KVBLK;
  DMA_K(0,0);DMA_V(0,0);DMA_K(1,SLOTB);
#if ATTN_QK8
  v8i_t q8;
  { u32x4 qa[4];
    #pragma unroll
    for(int i=0;i<4;++i)qa[i]=*reinterpret_cast<const u32x4*>(&Qw[(long)r32*QP+32*hi+8*i]);
    #pragma unroll
    for(int i=0;i<4;++i){ int lo_=0,hi_=0;
      lo_=__builtin_amdgcn_cvt_pk_fp8_f32(8.f*__uint_as_float(qa[i].x<<16),8.f*__uint_as_float(qa[i].x&0xffff0000u),lo_,false); lo_=__builtin_amdgcn_cvt_pk_fp8_f32(8.f*__uint_as_float(qa[i].y<<16),8.f*__uint_as_float(qa[i].y&0xffff0000u),lo_,true);
      hi_=__builtin_amdgcn_cvt_pk_fp8_f32(8.f*__uint_as_float(qa[i].z<<16),8.f*__uint_as_float(qa[i].z&0xffff0000u),hi_,false); hi_=__builtin_amdgcn_cvt_pk_fp8_f32(8.f*__uint_as_float(qa[i].w<<16),8.f*__uint_as_float(qa[i].w&0xffff0000u),hi_,true);
      q8[2*i]=lo_; q8[2*i+1]=hi_; } }
  v8i_t kf8[2];
  const int ksw_=(r32>>2)&3; const lds_cptr kp8=(lds_cptr)shm+LDS_K+r32*64; const int kol_=((2*hi)^ksw_)<<4, koh_=((2*hi+1)^ksw_)<<4;
  #define KLD8(h_,base_) kf8[h_]=__builtin_shufflevector(*(const __attribute__((address_space(3))) v4i_t*)((base_)+(h_)*2048+kol_),*(const __attribute__((address_space(3))) v4i_t*)((base_)+(h_)*2048+koh_),0,1,2,3,4,5,6,7)
#else
  bf16x8 qr[4];
  #pragma unroll
  for(int d0=0;d0<4;++d0)qr[d0]=*reinterpret_cast<const bf16x8*>(&Qw[(long)r32*QP+d0*16+hi*8]);
#endif
  float mhat=0.f,l_reg=0.f;f32x16 o[2];o[0]=f32x16{};o[1]=f32x16{};f32x16 negm=f32x16{};if(!NOMAX)asm volatile("":"+v"(negm));
  f32x16 o2=f32x16{}; bf16x8 ones=(bf16x8){0x3F80,0x3F80,0x3F80,0x3F80,0x3F80,0x3F80,0x3F80,0x3F80}; asm volatile("":"+v"(ones));
  #define CMASK(P0,P1,t) do{}while(0)
  bool resc=false;
  #define START(P0,P1) do{ if(!NOMAX){ const float rm=rowmax(P0,P1); resc=false; \
    { const float dl=rm; mhat=fadd_s(mhat,dl); \
      _Pragma("unroll") for(int r=0;r<16;++r){P0[r]=fsub_s(P0[r],dl);P1[r]=fsub_s(P1[r],dl);} \
      _Pragma("unroll") for(int r=0;r<16;++r)negm[r]=-mhat; asm volatile("":"+v"(negm)); } } \
    _Pragma("unroll") for(int r=0;r<16;++r)P0[r]=__builtin_amdgcn_exp2f(P0[r]); }while(0)
  #define RESC() do{ if(!NOMAX&&resc){ asm volatile("s_waitcnt lgkmcnt(0)":::"memory"); \
      _Pragma("unroll") for(int d_=0;d_<2;++d_) _Pragma("unroll") for(int r=0;r<16;++r)o[d_][r]*=wsf[crow(r,hi)]; } }while(0)
  f32x16 pA0,pA1,pB0,pB1;
  int sl_prev=0,sl_cur=0,sl_next=SLOTB;
  #define ROT() do{sl_prev=sl_cur;sl_cur=sl_next;sl_next=(sl_next==(NSLOT-1)*SLOTB)?0:sl_next+SLOTB;}while(0)
  DMA_K(2,2*SLOTB);
  WAIT_BAR(3);
#if ATTN_QK8
  KLD8(0,kp8); KLD8(1,kp8); pA0=MF8(kf8[0],q8,negm); pA1=MF8(kf8[1],q8,negm);
#else
  qkt(pA0,pA1,Kbase,qr,negm,r32,hi);asm volatile("s_nop 15\n\ts_nop 7":"+v"(pA0),"+v"(pA1));CMASK(pA0,pA1,0);
#endif
  START(pA0,pA1);
  _Pragma("unroll") for(int r=0;r<16;++r)pA1[r]=__builtin_amdgcn_exp2f(pA1[r]);
  WAIT_BAR(0);
  DMA_K(3,0);DMA_V(1,SLOTB);
  ROT();
#if ATTN_QK8
  KLD8(0,kp8+sl_cur); KLD8(1,kp8+sl_cur);
#else
  kload8(kf,kp0+sl_cur);
#endif
  WAIT_BAR(2);
#if ATTN_QK8
  #define QK_A0(C) C=MF8(kf8[0],q8,negm)
  #define QK_A1(C) C=MF8(kf8[1],q8,negm)
  #define QK_A2(C) (void)0
  #define QK_A3(C) (void)0
  #define QK_A4(C) (void)0
  #define QK_A5(C) (void)0
  #define QK_A6(C) (void)0
  #define QK_A7(C) (void)0
#else
  #define QK_A0(C) C=__builtin_amdgcn_mfma_f32_32x32x16_bf16(kf[0],qr[0],negm,0,0,0)
  #define QK_A1(C) C=__builtin_amdgcn_mfma_f32_32x32x16_bf16(kf[1],qr[0],negm,0,0,0)
  #define QK_A2(C) C=__builtin_amdgcn_mfma_f32_32x32x16_bf16(kf[2],qr[1],C,0,0,0)
  #define QK_A3(C) C=__builtin_amdgcn_mfma_f32_32x32x16_bf16(kf[3],qr[1],C,0,0,0)
  #define QK_A4(C) C=__builtin_amdgcn_mfma_f32_32x32x16_bf16(kf[4],qr[2],C,0,0,0)
  #define QK_A5(C) C=__builtin_amdgcn_mfma_f32_32x32x16_bf16(kf[5],qr[2],C,0,0,0)
  #define QK_A6(C) C=__builtin_amdgcn_mfma_f32_32x32x16_bf16(kf[6],qr[3],C,0,0,0)
  #define QK_A7(C) C=__builtin_amdgcn_mfma_f32_32x32x16_bf16(kf[7],qr[3],C,0,0,0)
#endif
  s16x4 vlo[8],vhi[8]; u32x4 pw0,pw1,pw2,pw3;
  #define PKW(P,B) cvtpk_s(P[B],P[B+1])
  #define PAF(k) __builtin_bit_cast(bf16x8,pw##k)
  #define VFR(i) (bf16x8){vlo[i][0],vlo[i][1],vlo[i][2],vlo[i][3],vhi[i][0],vhi[i][1],vhi[i][2],vhi[i][3]}
  #define PIN(x) asm volatile("":"+v"(x))
  #define MX3(a,b,c) __builtin_fmaxf(__builtin_fmaxf((a),(b)),(c))
  #define GAPA(MF,A0,A1,A2,A3,W0,W1,PW) do{ MF; sacc+=A0; sacc+=A1; sacc+=A2; sacc+=A3; PIN(sacc); W0; W1; PIN(PW); SBAR(); }while(0)
  #define EX(v) __builtin_amdgcn_exp2f(v)
  #define GAPB(MF,X,B) do{ MF; X[B]=EX(X[B]); X[B+1]=EX(X[B+1]); X[B+2]=EX(X[B+2]); X[B+3]=EX(X[B+3]); PIN(X); SBAR(); }while(0)
  #define VRD(i) do{ vlo[i]=vtr(vp_+(((i)>>2)*4096+((i)&3)*1024)); vhi[i]=vtr(vp_+(((i)>>2)*4096+((i)&3)*1024+512)); }while(0)
#if ATTN_QK8
  #define KRD(G,j) do{ if((G)&&(j)<2){ KLD8(j,kp8+sl_next); SBAR(); } }while(0)
#else
  #define KRD(G,j) do{ if(G){ kload2(kf,kp0+sl_next,j); SBAR(); } }while(0)
#endif
  #define STEP(C0,C1,P0,P1,t,GK,GV,GL) do{ SBAR(); \
    const lds_cptr vp_=vp0+sl_prev; \
    VRD(0); SBAR(); float sacc=(P0[0]+P0[1]); \
    GAPA(QK_A0(C0), P0[2],P0[3],P0[4],P0[5],     pw0[0]=PKW(P0,0), pw0[1]=PKW(P0,2), pw0); \
    VRD(4); SBAR(); GAPA(QK_A1(C1), P0[6],P0[7],P0[8],P0[9],     pw0[2]=PKW(P0,4), pw0[3]=PKW(P0,6), pw0); \
    VRD(1); SBAR(); GAPA(QK_A2(C0),   P0[10],P0[11],P0[12],P0[13], pw1[0]=PKW(P0,8), pw1[1]=PKW(P0,10), pw1); \
    VRD(5); SBAR(); GAPA(QK_A3(C1),   P0[14],P0[15],P1[0],P1[1],   pw1[2]=PKW(P0,12),pw1[3]=PKW(P0,14), pw1); \
    VRD(2); SBAR(); GAPA(QK_A4(C0),   P1[2],P1[3],P1[4],P1[5],     pw2[0]=PKW(P1,0), pw2[1]=PKW(P1,2), pw2); \
    VRD(6); SBAR(); GAPA(QK_A5(C1),   P1[6],P1[7],P1[8],P1[9],     pw2[2]=PKW(P1,4), pw2[3]=PKW(P1,6), pw2); \
    VRD(3); SBAR(); GAPA(QK_A6(C0),   P1[10],P1[11],P1[12],P1[13], pw3[0]=PKW(P1,8), pw3[1]=PKW(P1,10), pw3); \
    VRD(7); SBAR(); GAPA(QK_A7(C1),   P1[14],P1[15],0.f,0.f,       pw3[2]=PKW(P1,12),pw3[3]=PKW(P1,14), pw3); \
    l_reg+=sacc; \
    if(GK){DMA_K((t)+3,sl_cur);} if(GV){DMA_V((t)+1,sl_next);} \
    CMASK(C0,C1,t); \
    { float a=MX3(C0[0],C0[1],C1[0]),b=MX3(C0[2],C0[3],C1[1]); a=MX3(a,C1[2],C1[3]); \
      _Pragma("unroll") for(int r=4;r<16;r+=4){a=MX3(a,C0[r],C0[r+1]);b=MX3(b,C0[r+2],C0[r+3]);a=MX3(a,C1[r],C1[r+1]);b=MX3(b,C1[r+2],C1[r+3]);} \
      float rm=__builtin_fmaxf(a,b); { auto rr=__builtin_amdgcn_permlane32_swap(__float_as_uint(rm),__float_as_uint(rm),false,false); rm=__builtin_fmaxf(__uint_as_float(rr[0]),__uint_as_float(rr[1])); } \
      resc=false; \
      if(__builtin_expect(__any(rm>(float)THRL),0)){ const float dl=__builtin_fmaxf(rm,0.f); mhat+=dl; \
        _Pragma("unroll") for(int r=0;r<16;++r){C0[r]-=dl;C1[r]-=dl;} \
        _Pragma("unroll") for(int r=0;r<16;++r)negm[r]=-mhat; asm volatile("":"+v"(negm)); \
        const float f=__builtin_amdgcn_exp2f(-dl); l_reg*=f; if(hi==0)wsf[r32]=f; resc=true; } } \
    SBAR(); \
    GAPB(o[0]=__builtin_amdgcn_mfma_f32_32x32x16_bf16(PAF(0),VFR(0),o[0],0,0,0), C0,0); \
    GAPB(o[1]=__builtin_amdgcn_mfma_f32_32x32x16_bf16(PAF(0),VFR(4),o[1],0,0,0), C0,4); \
    KRD(GL,0); GAPB(o[0]=__builtin_amdgcn_mfma_f32_32x32x16_bf16(PAF(1),VFR(1),o[0],0,0,0), C0,8); \
    KRD(GL,1); GAPB(o[1]=__builtin_amdgcn_mfma_f32_32x32x16_bf16(PAF(1),VFR(5),o[1],0,0,0), C0,12); \
    KRD(GL,2); GAPB(o[0]=__builtin_amdgcn_mfma_f32_32x32x16_bf16(PAF(2),VFR(2),o[0],0,0,0), C1,0); \
    KRD(GL,3); GAPB(o[1]=__builtin_amdgcn_mfma_f32_32x32x16_bf16(PAF(2),VFR(6),o[1],0,0,0), C1,4); \
    GAPB(o[0]=__builtin_amdgcn_mfma_f32_32x32x16_bf16(PAF(3),VFR(3),o[0],0,0,0), C1,8); \
    GAPB(o[1]=__builtin_amdgcn_mfma_f32_32x32x16_bf16(PAF(3),VFR(7),o[1],0,0,0), C1,12); \
    }while(0)
  #define TPK(k) do{ if(ATT_TP>0&&wid==0){ const unsigned long long n_=__builtin_amdgcn_s_memrealtime(); if(ATT_TP==(k)||ATT_TP==5)tacc_+=n_-tlast_; tlast_=n_; } }while(0)
  #define GAPAN(MF,W0,W1,PW) do{ MF; W0; W1; PIN(PW); SBAR(); }while(0)
  #define GAPBN3(MF,X,B) do{ MF; X[B]=EX(X[B]); X[B+1]=EX(X[B+1]); X[B+2]=EX(X[B+2]); PIN(X); SBAR(); }while(0)
  #define GAPBN2(MF,X,B) do{ MF; X[B]=EX(X[B]); X[B+1]=EX(X[B+1]); PIN(X); SBAR(); }while(0)
  #define MF32(a,b,c) __builtin_amdgcn_mfma_f32_32x32x16_bf16(a,b,c,0,0,0)
#if ATTN_QK8
  #define QKA_PHASE(C0,C1,P0,P1) do{ \
    VRD(0); VRD(4); VRD(1); VRD(5); SBAR(); \
    QK_A0(C0); pw0[0]=PKW(P0,0); pw0[1]=PKW(P0,2); pw0[2]=PKW(P0,4); pw0[3]=PKW(P0,6); PIN(pw0); pw1[0]=PKW(P0,8); pw1[1]=PKW(P0,10); pw1[2]=PKW(P0,12); pw1[3]=PKW(P0,14); PIN(pw1); SBAR(); \
    VRD(2); VRD(6); VRD(3); VRD(7); SBAR(); \
    QK_A1(C1); pw2[0]=PKW(P1,0); pw2[1]=PKW(P1,2); pw2[2]=PKW(P1,4); pw2[3]=PKW(P1,6); PIN(pw2); pw3[0]=PKW(P1,8); pw3[1]=PKW(P1,10); pw3[2]=PKW(P1,12); pw3[3]=PKW(P1,14); PIN(pw3); SBAR(); }while(0)
#else
  #define QKA_PHASE(C0,C1,P0,P1) do{ \
    VRD(0); SBAR(); \
    GAPAN(QK_A0(C0), pw0[0]=PKW(P0,0), pw0[1]=PKW(P0,2), pw0); \
    VRD(4); SBAR(); GAPAN(QK_A1(C1), pw0[2]=PKW(P0,4), pw0[3]=PKW(P0,6), pw0); \
    VRD(1); SBAR(); GAPAN(QK_A2(C0),   pw1[0]=PKW(P0,8), pw1[1]=PKW(P0,10), pw1); \
    VRD(5); SBAR(); GAPAN(QK_A3(C1),   pw1[2]=PKW(P0,12),pw1[3]=PKW(P0,14), pw1); \
    VRD(2); SBAR(); GAPAN(QK_A4(C0),   pw2[0]=PKW(P1,0), pw2[1]=PKW(P1,2), pw2); \
    VRD(6); SBAR(); GAPAN(QK_A5(C1),   pw2[2]=PKW(P1,4), pw2[3]=PKW(P1,6), pw2); \
    VRD(3); SBAR(); GAPAN(QK_A6(C0),   pw3[0]=PKW(P1,8), pw3[1]=PKW(P1,10), pw3); \
    VRD(7); SBAR(); GAPAN(QK_A7(C1),   pw3[2]=PKW(P1,12),pw3[3]=PKW(P1,14), pw3); }while(0)
#endif
  #define STEPN(C0,C1,P0,P1,t,GK,GV,GL) do{ SBAR(); TPK(1); \
    const lds_cptr vp_=vp0+sl_prev; \
    QKA_PHASE(C0,C1,P0,P1); \
    TPK(2); if(GK){DMA_K((t)+3,sl_cur);} if(GV){DMA_V((t)+1,sl_next);} \
    SBAR(); \
    GAPBN3(o[0]=MF32(PAF(0),VFR(0),o[0]), C0,0); \
    GAPBN3(o[1]=MF32(PAF(0),VFR(4),o[1]), C0,3); \
    GAPBN2(o2=MF32(PAF(0),ones,o2), C0,6); \
    KRD(GL,0); GAPBN3(o[0]=MF32(PAF(1),VFR(1),o[0]), C0,8); \
    KRD(GL,1); GAPBN3(o[1]=MF32(PAF(1),VFR(5),o[1]), C0,11); \
    GAPBN2(o2=MF32(PAF(1),ones,o2), C0,14); \
    KRD(GL,2); GAPBN3(o[0]=MF32(PAF(2),VFR(2),o[0]), C1,0); \
    KRD(GL,3); GAPBN3(o[1]=MF32(PAF(2),VFR(6),o[1]), C1,3); \
    GAPBN2(o2=MF32(PAF(2),ones,o2), C1,6); \
    GAPBN3(o[0]=MF32(PAF(3),VFR(3),o[0]), C1,8); \
    GAPBN3(o[1]=MF32(PAF(3),VFR(7),o[1]), C1,11); \
    GAPBN2(o2=MF32(PAF(3),ones,o2), C1,14); TPK(3); \
    }while(0)
  #define STEPX(C0,C1,P0,P1,t,GK,GV,GL) do{ if(NOMAX){ STEPN(C0,C1,P0,P1,t,GK,GV,GL); } else { STEP(C0,C1,P0,P1,t,GK,GV,GL); } }while(0)
  TPK(6);
  int t=1;
  for(;t+5<NT;t+=2){
    STEPX(pB0,pB1,pA0,pA1,t,true,true,true);     WAIT_BAR(2); TPK(4); RESC(); ROT();
    STEPX(pA0,pA1,pB0,pB1,t+1,true,true,true);   WAIT_BAR(2); TPK(4); RESC(); ROT();
  }
  #define ENDW(tt) do{ if((tt)+3<NT){WAIT_BAR(2);} else if((tt)+2<NT){WAIT_BAR(1);} else {WAIT_BAR(0);} }while(0)
  for(;t+1<NT;t+=2){
    STEPX(pB0,pB1,pA0,pA1,t,(t+3<NT),(t+1<NT),(t+1<NT));       ENDW(t);   RESC(); ROT();
    STEPX(pA0,pA1,pB0,pB1,t+1,(t+4<NT),(t+2<NT),(t+2<NT));     ENDW(t+1); RESC(); ROT();
  }
  STEPX(pB0,pB1,pA0,pA1,NT-1,false,false,false); RESC();
  { if(!NOMAX){ float sacc=pB0[0]+pB0[1]; _Pragma("unroll") for(int r=2;r<16;++r)sacc+=pB0[r]; _Pragma("unroll") for(int r=0;r<16;++r)sacc+=pB1[r]; l_reg+=sacc; }
    pw0=(u32x4){PKW(pB0,0),PKW(pB0,2),PKW(pB0,4),PKW(pB0,6)};pw1=(u32x4){PKW(pB0,8),PKW(pB0,10),PKW(pB0,12),PKW(pB0,14)};pw2=(u32x4){PKW(pB1,0),PKW(pB1,2),PKW(pB1,4),PKW(pB1,6)};pw3=(u32x4){PKW(pB1,8),PKW(pB1,10),PKW(pB1,12),PKW(pB1,14)};
    SBAR(); pv(o,vb0+sl_cur,PAF(0),PAF(1),PAF(2),PAF(3));
    if(NOMAX){ o2=MF32(PAF(0),ones,o2); o2=MF32(PAF(1),ones,o2); o2=MF32(PAF(2),ones,o2); o2=MF32(PAF(3),ones,o2); } }
  #undef PKW
  #undef PAF
  #undef VFR
  #undef PIN
  #undef MX3
  #undef GAPA
  #undef GAPB
  #undef EX
  #undef VRD
  #undef KRD
  #undef STEP
  #undef STEPN
  #undef TPK
  #undef STEPX
  #undef GAPAN
  #undef GAPBN3
  #undef GAPBN2
  #undef MF32
  #undef ENDW
  float rli[16];
  if(NOMAX){
    #pragma unroll
    for(int r=0;r<16;++r)rli[r]=__builtin_amdgcn_rcpf(o2[r]);
  } else {
  {auto rr=__builtin_amdgcn_permlane32_swap(__float_as_uint(l_reg),__float_as_uint(l_reg),false,false);l_reg=__uint_as_float(rr[0])+__uint_as_float(rr[1]);}
  if(hi==0)wsf[32+r32]=l_reg;asm volatile("s_waitcnt lgkmcnt(0)":::"memory");
  #pragma unroll
  for(int r=0;r<16;++r)rli[r]=__builtin_amdgcn_rcpf(wsf[32+crow(r,hi)]);
  }
  bf16*Ow=O+(rowbase+q0+wid*QBLK)*OP+h*D;
  { bf16*stg=(bf16*)(shm+LDS_OST)+wid*2048;
    #pragma unroll
    for(int r=0;r<16;++r){const int orow=crow(r,hi);
      #pragma unroll
      for(int d0=0;d0<2;++d0)stg[orow*64+d0*32+r32]=__float2bfloat16(o[d0][r]*rli[r]);}
    asm volatile("s_waitcnt lgkmcnt(0)":::"memory");
    #pragma unroll
    for(int i=0;i<4;++i){const int row=i*8+(lane>>3),ch=lane&7; const u32x4 v=*(const u32x4*)(stg+row*64+ch*8); ATTN_STORE16(Ow+(long)row*OP+ch*8,v);} }
  if(ATT_TP>0){ asm volatile("s_waitcnt vmcnt(0) lgkmcnt(0)\n\ts_barrier":::"memory"); TPK7(); }
  if(ATT_TP>0&&wid==0&&lane==0){ volatile unsigned* w_=(volatile unsigned*)(shm+ATT_TP_WORD_OFF); *w_=*w_+(unsigned)tacc_; }
  asm volatile("s_waitcnt lgkmcnt(0)\n\ts_barrier":::"memory");
  #undef DMA_K
  #undef DMA_V
  #undef CMASK
  #undef START
  #undef RESC
  #undef ROT
}
constexpr int ATTN_LDS_BYTES=LDS_BYTES;
struct AttnTensors { const bf16* Q; const bf16* K; const bf16* V; bf16* O; const unsigned char* K8; };
struct AttnUnit { int bh; int qb; };
struct StaticOrder {
  int vcu,G;
  __device__ __forceinline__ explicit StaticOrder(int grid,int v):vcu(v),G(grid){}
  __device__ __forceinline__ bool next(int i,AttnUnit&u)const{ const int L=i*G+vcu; if(L>=BATCH*NHEAD*NQB)return false;
    const int pairhalf=L>>5,l=L&31; const int pair=pairhalf>>1,uu=l+32*(pairhalf&1); const int b=pair>>1,kvh=pair&1; u.bh=b*NHEAD+kvh*(NHEAD/NKV)+(uu>>4); u.qb=uu&15; return true; }
  __device__ __forceinline__ void a_ready(const AttnUnit&)const{}
  __device__ __forceinline__ void done(const AttnUnit&)const{}
};
template<class Sched,int THRL=8,class Hook> __device__ __forceinline__ void attn_phase(char*lds,const AttnTensors&T,const Sched&S,bool nomax,const Hook&hook){
  AttnUnit u; int i=0;
  if(nomax){ for(;S.next(i,u);++i){ hook(i,false); S.a_ready(u); attn_unit<THRL,true>(u.bh/NHEAD,u.bh%NHEAD,u.qb,T.Q,T.K,T.V,T.O,lds,T.K8); S.done(u); } }
  else     { for(;S.next(i,u);++i){ hook(i,false); S.a_ready(u); attn_unit<THRL,false>(u.bh/NHEAD,u.bh%NHEAD,u.qb,T.Q,T.K,T.V,T.O,lds,T.K8); S.done(u); } }
  hook(i,true);
}
#undef SBAR
#undef WAIT_BAR
}
namespace cg = cooperative_groups;
constexpr int NWAVES = 8;
#ifndef CONV_ST_NT
#define CONV_ST_NT 1
#endif
#ifndef GA_NT
#define GA_NT 2
#endif
#ifndef XN_NT
#define XN_NT 0
#endif
constexpr int BATCH = 8, SEQ = 4096, D = 1024, T = BATCH * SEQ;
constexpr int HD = 64, NQH = 8, NKVH = 2, QW = NQH * HD, KVW = NKVH * HD;
constexpr int LRU_W = 1024, LRU_NB = 16, LRU_BW = 64;
constexpr int INW = QW + 2 * KVW + 2 * LRU_W + 2 * D;
constexpr int NE = 32, TOPK = 4, DFF = 1024;
constexpr float NORM_EPS = 1e-6f;
constexpr int ARW = QW + LRU_W;
constexpr int ECAP = T;
constexpr int MAXBLK = (T * TOPK) / 256 + NE;
constexpr int MAX_GUNITS = 18;

constexpr size_t MiB = 1u << 20;
constexpr size_t WS_CTL = 0, CTL_ZERO_BYTES = 64 * 1024;
constexpr size_t WS_TOKL = 1 * MiB, WS_GATEL = 5 * MiB, WS_TOKREC = 9 * MiB, WS_RSTDT = 9 * MiB + 512 * 1024;
constexpr size_t WS_WIN = 10 * MiB, WS_WCAT = 20 * MiB, WS_WO = 23 * MiB, WS_WGU = 26 * MiB, WS_WD = 154 * MiB;
constexpr size_t WS_XN = 218 * MiB;
constexpr size_t WS_Q = 282 * MiB, WS_KV = 314 * MiB, WS_AR = 330 * MiB, WS_XR = 426 * MiB, WS_YR = 490 * MiB, WS_GL = 554 * MiB;
constexpr size_t WS_MERGED = WS_XR;
constexpr size_t WS_MIXB = WS_YR;
constexpr size_t WS_X1B = WS_XR;
constexpr size_t WS_ACT = 282 * MiB, WS_Y = 554 * MiB, WS_XN8 = 826 * MiB, WS_WIN8 = 858 * MiB, WS_K8 = 864 * MiB, WS_END = 868 * MiB;
constexpr size_t WS_Y_END = 826 * MiB;
static_assert(WS_ACT + (size_t)MAXBLK * 256 * DFF * 2 <= WS_Y && WS_Y + (size_t)MAXBLK * 256 * D * 2 <= WS_Y_END, "ws map");
constexpr int CW_CNT = 0;
constexpr int CW_BAR = 1024;

constexpr int RING_BYTES = 131072;
constexpr int GTAB_OFF = RING_BYTES;
constexpr int ETAB_OFF = GTAB_OFF + MAX_GUNITS * 512;
constexpr int MISC_OFF = ETAB_OFF + MAX_GUNITS * 1024;
constexpr int LDS_BYTES = MISC_OFF + 2048;
static_assert(LDS_BYTES <= 163840, "LDS");

#define GAS __attribute__((address_space(1)))
#define LAS __attribute__((address_space(3)))
typedef unsigned short bf16;
typedef unsigned v4u __attribute__((ext_vector_type(4)));
typedef unsigned v2u __attribute__((ext_vector_type(2)));
typedef float f32x4 __attribute__((ext_vector_type(4)));
typedef float f32x2 __attribute__((ext_vector_type(2)));
typedef short bf16x8 __attribute__((ext_vector_type(8)));
#define LDS_WAIT() asm volatile("s_waitcnt lgkmcnt(0)" ::: "memory")
__device__ __forceinline__ unsigned f2bf(float f) { unsigned u = __builtin_bit_cast(unsigned, f); return (u + 0x7fffu + ((u >> 16) & 1u)) >> 16; }
__device__ __forceinline__ unsigned pk2(float lo, float hi) { unsigned r; asm("v_cvt_pk_bf16_f32 %0, %1, %2" : "=v"(r) : "v"(lo), "v"(hi)); return r; }
__device__ __forceinline__ float bflo(unsigned w) { return __uint_as_float(w << 16); }
__device__ __forceinline__ float bfhi(unsigned w) { return __uint_as_float(w & 0xffff0000u); }
__device__ __forceinline__ float wave_sum(float v) {
#pragma unroll
    for (int o = 1; o < 64; o <<= 1) v += __shfl_xor(v, o);
    return v;
}
__device__ __forceinline__ float sigmoidf_fast(float x) { return __builtin_amdgcn_rcpf(1.0f + __builtin_amdgcn_exp2f(-1.4426950408889634f * x)); }

constexpr float YSCALE = 16.0f, YSCALE_INV = 1.0f / 16.0f;
constexpr float WSCALE = 32.0f, WSCALE_INV = 1.0f / 32.0f;
struct Frame {
    LAS unsigned char* lds;
    int tid, lane, wave, vcu, G;
    const float* const* in;
    float* out; unsigned char* ws;
};
enum { I_X = 0, I_N1G, I_WIN, I_BIN, I_QNG, I_KNG, I_CONVW, I_CONVB, I_WA, I_BA, I_WI, I_BI, I_LAM, I_WAO, I_WLO, I_WOUT, I_N2G, I_WR, I_BR, I_WGU, I_BGU, I_WDN, I_BDN, I_FG };

#ifndef P1_F8_MASK
#define P1_F8_MASK 0x7F807u
#endif
constexpr int P0_WIN_BF_NB = 64, P0_WIN_F8_NB = INW / 32 - 64;
static_assert(P1_F8_MASK == 0x7F807u, "P0 converts each W_in column in ONE precision: keep p0_decode's column split in step with P1_F8_MASK");
constexpr int P0_MIXER_ITEMS = 16 * P0_WIN_BF_NB + 8 * 32 + 16 * 32 + 16 * 32 + 16 * P0_WIN_F8_NB, P0_NITEMS = P0_MIXER_ITEMS + NE * 16 * 64 + NE * 16 * 32;
struct P0Item { const float* src; int N; unsigned char* dst; int ldtB; int fp8; };
__device__ __forceinline__ P0Item p0_decode(const Frame& F, int it) {
    constexpr int I_IN = 16 * P0_WIN_BF_NB, I_IN8 = 16 * P0_WIN_F8_NB, I_AO = 8 * 32, I_LO = 16 * 32, I_OUT = 16 * 32, I_GU1 = 16 * 64, I_DN1 = 16 * 32;
    unsigned char* ws = F.ws; P0Item d; int r = it;
    if (r < I_IN) { const int nblk = P0_WIN_BF_NB, kb = r / nblk, nb = 24 + r % nblk; d.src = F.in[I_WIN] + (size_t)(64 * kb) * INW + 32 * nb; d.N = INW; d.dst = ws + WS_WIN + ((size_t)(32 * nb) * D + 64 * kb) * 2; d.ldtB = D * 2; d.fp8 = 0; return d; } r -= I_IN;
    if (r < I_AO) { const int kb = r / 32, nb = r % 32; d.src = F.in[I_WAO] + (size_t)(64 * kb) * D + 32 * nb; d.N = D; d.dst = ws + WS_WCAT + ((size_t)(32 * nb) * ARW + 64 * kb) * 2; d.ldtB = ARW * 2; d.fp8 = 0; return d; } r -= I_AO;
    if (r < I_LO) { const int kb = r / 32, nb = r % 32; d.src = F.in[I_WLO] + (size_t)(64 * kb) * D + 32 * nb; d.N = D; d.dst = ws + WS_WCAT + ((size_t)(32 * nb) * ARW + QW + 64 * kb) * 2; d.ldtB = ARW * 2; d.fp8 = 0; return d; } r -= I_LO;
    if (r < I_OUT) { const int kb = r / 32, nb = r % 32; d.src = F.in[I_WOUT] + (size_t)(64 * kb) * D + 32 * nb; d.N = D; d.dst = ws + WS_WO + ((size_t)(32 * nb) * D + 64 * kb) * 2; d.ldtB = D * 2; d.fp8 = 0; return d; } r -= I_OUT;
    if (r < I_IN8) { const int nblk = P0_WIN_F8_NB, kb = r / nblk, q = r % nblk, nb = q < 24 ? q : q + 64; d.src = F.in[I_WIN] + (size_t)(64 * kb) * INW + 32 * nb; d.N = INW; d.dst = ws + WS_WIN8 + ((size_t)(32 * nb) * D + 64 * kb); d.ldtB = D; d.fp8 = 1; return d; } r -= I_IN8;
    if (r < NE * I_GU1) { const int e = r / I_GU1, q = r % I_GU1, kb = q / 64, nb = q % 64, n0 = 32 * nb;
        const int cc = n0 & 1023, isu = n0 >> 10, rowb = 256 * (cc >> 7) + 128 * isu + (cc & 127);
        d.src = F.in[I_WGU] + (size_t)e * D * 2 * DFF + (size_t)(64 * kb) * (2 * DFF) + n0; d.N = 2 * DFF; d.dst = ws + WS_WGU + (size_t)e * 2 * DFF * D + (size_t)rowb * D + 64 * kb; d.ldtB = D; d.fp8 = 1; return d; } r -= NE * I_GU1;
    { const int e = r / I_DN1, q = r % I_DN1, kb = q / 32, nb = q % 32;
        d.src = F.in[I_WDN] + (size_t)e * DFF * D + (size_t)(64 * kb) * D + 32 * nb; d.N = D; d.dst = ws + WS_WD + (size_t)e * D * DFF + (size_t)(32 * nb) * DFF + 64 * kb; d.ldtB = DFF; d.fp8 = 1; return d; }
}
__device__ __forceinline__ void p0_items3(Frame& F, const int it_lo, const int it_hi) {
    LAS float* scr = (LAS float*)(F.lds + F.wave * 16384);
    const int gw = F.vcu * NWAVES + F.wave, NGW = F.G * NWAVES, lane = F.lane;
#define P0_LOAD3(dst_, item_) do { const float* p_ = (item_).src + (size_t)(lane >> 3) * (item_).N + 4 * (lane & 7); const size_t st_ = (size_t)8 * (item_).N; _Pragma("unroll") for (int i_ = 0; i_ < 8; ++i_) { const f32x4 t_ = __builtin_nontemporal_load((const GAS f32x4*)(p_ + i_ * st_)); dst_[4 * i_] = t_.x; dst_[4 * i_ + 1] = t_.y; dst_[4 * i_ + 2] = t_.z; dst_[4 * i_ + 3] = t_.w; } } while (0)
#define P0_EMIT3(v_, cur_) do { _Pragma("unroll") for (int i_ = 0; i_ < 32; ++i_) scr[((lane >> 3) + 8 * (i_ >> 2)) * 33 + 4 * (lane & 7) + (i_ & 3)] = v_[i_]; \
        LDS_WAIT(); asm volatile("" ::: "memory"); const int c_ = lane & 7; \
        _Pragma("unroll") for (int j_ = 0; j_ < 4; ++j_) { const int n_ = (lane >> 3) + 8 * j_; const LAS float* s_ = scr + (8 * c_) * 33 + n_; \
            if ((cur_).fp8) { int lo_ = 0, hi_ = 0; \
                lo_ = __builtin_amdgcn_cvt_pk_fp8_f32(s_[0 * 33] * WSCALE, s_[1 * 33] * WSCALE, lo_, false); lo_ = __builtin_amdgcn_cvt_pk_fp8_f32(s_[2 * 33] * WSCALE, s_[3 * 33] * WSCALE, lo_, true); \
                hi_ = __builtin_amdgcn_cvt_pk_fp8_f32(s_[4 * 33] * WSCALE, s_[5 * 33] * WSCALE, hi_, false); hi_ = __builtin_amdgcn_cvt_pk_fp8_f32(s_[6 * 33] * WSCALE, s_[7 * 33] * WSCALE, hi_, true); \
                if (CONV_ST_NT) __builtin_nontemporal_store((v2u){(unsigned)lo_, (unsigned)hi_}, (GAS v2u*)((cur_).dst + (size_t)n_ * (cur_).ldtB + 8 * c_)); else *(GAS v2u*)((cur_).dst + (size_t)n_ * (cur_).ldtB + 8 * c_) = (v2u){(unsigned)lo_, (unsigned)hi_}; \
            } else { v4u o_; o_.x = pk2(s_[0 * 33], s_[1 * 33]); o_.y = pk2(s_[2 * 33], s_[3 * 33]); o_.z = pk2(s_[4 * 33], s_[5 * 33]); o_.w = pk2(s_[6 * 33], s_[7 * 33]); \
                *(GAS v4u*)((cur_).dst + (size_t)n_ * (cur_).ldtB + 16 * c_) = o_; } } \
        LDS_WAIT(); asm volatile("" ::: "memory"); } while (0)
    const int i0 = it_lo + gw;
    float va[32], vb[32], vc[32];
    P0Item da = p0_decode(F, i0 < it_hi ? i0 : it_lo), db = p0_decode(F, i0 + NGW < it_hi ? i0 + NGW : it_lo), dc = p0_decode(F, i0 + 2 * NGW < it_hi ? i0 + 2 * NGW : it_lo);
    if (i0 < it_hi) P0_LOAD3(va, da);
    if (i0 + NGW < it_hi) P0_LOAD3(vb, db);
    if (i0 + 2 * NGW < it_hi) P0_LOAD3(vc, dc);
    for (int it = i0; it < it_hi; it += 3 * NGW) {
        { P0_EMIT3(va, da); const int nx = it + 3 * NGW; if (nx < it_hi) { da = p0_decode(F, nx); P0_LOAD3(va, da); } }
        if (it + NGW < it_hi) { P0_EMIT3(vb, db); const int nx = it + 4 * NGW; if (nx < it_hi) { db = p0_decode(F, nx); P0_LOAD3(vb, db); } }
        if (it + 2 * NGW < it_hi) { P0_EMIT3(vc, dc); const int nx = it + 5 * NGW; if (nx < it_hi) { dc = p0_decode(F, nx); P0_LOAD3(vc, dc); } }
    }
#undef P0_LOAD3
#undef P0_EMIT3
}
__device__ __forceinline__ void p0_prologue(Frame& F, const int it_lo, const int it_hi, const bool do_norm) {
    LAS float* scr = (LAS float*)(F.lds + F.wave * 16384);
    const int gw = F.vcu * NWAVES + F.wave, NGW = F.G * NWAVES, lane = F.lane;
    unsigned char* ws = F.ws;
    float v[32];
    P0Item cur = p0_decode(F, it_lo + gw < it_hi ? it_lo + gw : it_lo);
#define P0_LOAD(dst_, item_) do { const float* p_ = (item_).src + (size_t)(lane >> 5) * (item_).N + (lane & 31); const size_t st_ = (size_t)2 * (item_).N; _Pragma("unroll") for (int i_ = 0; i_ < 32; ++i_) dst_[i_] = __builtin_nontemporal_load(p_ + i_ * st_); } while (0)
    if (it_lo + gw < it_hi) P0_LOAD(v, cur);
    for (int it = it_lo + gw; it < it_hi; it += NGW) {
        const int nit = it + NGW; const bool hn = nit < it_hi;
        const P0Item nxt = p0_decode(F, hn ? nit : it);
        float vn[32];
        if (hn) P0_LOAD(vn, nxt);
#pragma unroll
        for (int i = 0; i < 32; ++i) scr[(2 * i + (lane >> 5)) * 33 + (lane & 31)] = v[i];
        LDS_WAIT(); asm volatile("" ::: "memory");
        const int c = lane & 7;
#pragma unroll
        for (int j = 0; j < 4; ++j) { const int n = (lane >> 3) + 8 * j; const LAS float* s = scr + (8 * c) * 33 + n;
            if (cur.fp8) { int lo = 0, hi = 0;
                lo = __builtin_amdgcn_cvt_pk_fp8_f32(s[0 * 33] * WSCALE, s[1 * 33] * WSCALE, lo, false); lo = __builtin_amdgcn_cvt_pk_fp8_f32(s[2 * 33] * WSCALE, s[3 * 33] * WSCALE, lo, true);
                hi = __builtin_amdgcn_cvt_pk_fp8_f32(s[4 * 33] * WSCALE, s[5 * 33] * WSCALE, hi, false); hi = __builtin_amdgcn_cvt_pk_fp8_f32(s[6 * 33] * WSCALE, s[7 * 33] * WSCALE, hi, true);
                *(GAS v2u*)(cur.dst + (size_t)n * cur.ldtB + 8 * c) = (v2u){(unsigned)lo, (unsigned)hi};
            } else { v4u o; o.x = pk2(s[0 * 33], s[1 * 33]); o.y = pk2(s[2 * 33], s[3 * 33]); o.z = pk2(s[4 * 33], s[5 * 33]); o.w = pk2(s[6 * 33], s[7 * 33]);
                *(GAS v4u*)(cur.dst + (size_t)n * cur.ldtB + 16 * c) = o; } }
        LDS_WAIT(); asm volatile("" ::: "memory");
        cur = nxt;
#pragma unroll
        for (int i = 0; i < 32; ++i) v[i] = vn[i];
    }
#undef P0_LOAD
    if (!do_norm) return;
    const GAS f32x4* gp = (const GAS f32x4*)F.in[I_N1G] + lane;
    f32x4 g[4];
#pragma unroll
    for (int j = 0; j < 4; ++j) g[j] = gp[64 * j];
    bf16* XN = (bf16*)(ws + WS_XN); unsigned char* XN8 = ws + WS_XN8;
    for (int m = gw; m < T; m += 2 * NGW) {
        const int m2 = (m + NGW < T) ? m + NGW : m;
        const GAS f32x4* xr = (const GAS f32x4*)(F.in[I_X] + (size_t)m * D) + lane; const GAS f32x4* xr2 = (const GAS f32x4*)(F.in[I_X] + (size_t)m2 * D) + lane;
        f32x4 va[4], vb[4]; float sa = 0.f, sb = 0.f;
#pragma unroll
        for (int j = 0; j < 4; ++j) { va[j] = __builtin_nontemporal_load(xr + 64 * j); vb[j] = __builtin_nontemporal_load(xr2 + 64 * j); }
#pragma unroll
        for (int j = 0; j < 4; ++j) { sa += (va[j].x * va[j].x + va[j].y * va[j].y) + (va[j].z * va[j].z + va[j].w * va[j].w); sb += (vb[j].x * vb[j].x + vb[j].y * vb[j].y) + (vb[j].z * vb[j].z + vb[j].w * vb[j].w); }
        const float ra = 1.0f / sqrtf(wave_sum(sa) * (1.f / D) + NORM_EPS), rb = 1.0f / sqrtf(wave_sum(sb) * (1.f / D) + NORM_EPS);
        GAS unsigned long long* oa = (GAS unsigned long long*)(XN + (size_t)m * D) + lane; GAS unsigned long long* ob = (GAS unsigned long long*)(XN + (size_t)m2 * D) + lane;
#pragma unroll
        for (int j = 0; j < 4; ++j) { const f32x4 ya = va[j] * ra * g[j], yb = vb[j] * rb * g[j];
            if (XN_NT) { __builtin_nontemporal_store((unsigned long long)pk2(ya.x, ya.y) | ((unsigned long long)pk2(ya.z, ya.w) << 32), oa + 64 * j); __builtin_nontemporal_store((unsigned long long)pk2(yb.x, yb.y) | ((unsigned long long)pk2(yb.z, yb.w) << 32), ob + 64 * j); }
            else { oa[64 * j] = (unsigned long long)pk2(ya.x, ya.y) | ((unsigned long long)pk2(ya.z, ya.w) << 32); ob[64 * j] = (unsigned long long)pk2(yb.x, yb.y) | ((unsigned long long)pk2(yb.z, yb.w) << 32); }
            int pa = 0, pb = 0; pa = __builtin_amdgcn_cvt_pk_fp8_f32(ya.x, ya.y, pa, false); pa = __builtin_amdgcn_cvt_pk_fp8_f32(ya.z, ya.w, pa, true); pb = __builtin_amdgcn_cvt_pk_fp8_f32(yb.x, yb.y, pb, false); pb = __builtin_amdgcn_cvt_pk_fp8_f32(yb.z, yb.w, pb, true);
            if (XN_NT) { __builtin_nontemporal_store((unsigned)pa, (GAS unsigned*)(XN8 + (size_t)m * D) + lane + 64 * j); __builtin_nontemporal_store((unsigned)pb, (GAS unsigned*)(XN8 + (size_t)m2 * D) + lane + 64 * j); }
            else { ((GAS unsigned*)(XN8 + (size_t)m * D))[lane + 64 * j] = (unsigned)pa; ((GAS unsigned*)(XN8 + (size_t)m2 * D))[lane + 64 * j] = (unsigned)pb; } }
    }
}

#ifndef REP_MASK
#define REP_MASK 0
#endif
#ifndef PROBE_K2X
#define PROBE_K2X 0
#endif
#ifndef GL_NT
#define GL_NT 1
#endif
#ifndef Y_NT
#define Y_NT 1
#endif
#ifndef EPI_LDS_STAGE
#define EPI_LDS_STAGE 1
#endif
#ifndef EPI_LDS_STAGE_GU
#define EPI_LDS_STAGE_GU 0
#endif
#ifndef DOWN_REVERSE
#define DOWN_REVERSE 0
#endif
struct DenseSched {
    const char* A; const char* B; int nM, nN, nt, G, c; size_t tstepA, tstepB; int rs; int rot;
    __device__ __forceinline__ bool next(int i, pg8::Unit& u) const { const long L = (long)(i >> rs) * G + c; if (L >= (long)nM * nN) return false; pg8::dense_tile((int)L, nM, nN, u.pm, u.pn); u.pn = (u.pn + rot) % nN; u.aux = 0; return true; }
    __device__ __forceinline__ const char* a_ptr(const pg8::Unit& u) const { return A + (size_t)u.pm * tstepA; }
    __device__ __forceinline__ const char* b_ptr(const pg8::Unit& u) const { return B + (size_t)u.pn * tstepB; }
    __device__ __forceinline__ int ntiles(const pg8::Unit&) const { return nt; }
};
struct InProjSched {
    const char* A; const char* B; int nN, nt, G, c; size_t tstepA, tstepB; unsigned mask; int comp, rb;
    __device__ __forceinline__ bool next(int i, pg8::Unit& u) const {
        long L;
        if (comp > 0 && c >= rb) L = (i < 2) ? (long)(c - rb) + (long)i * (G - rb) : (long)comp + (long)(i - 2) * G + c;
        else L = (long)comp + (long)i * G + c;
        if (L >= (long)(T / 256) * nN) return false;
        int j; pg8::dense_tile((int)L, T / 256, nN, u.pm, j);
        unsigned m = mask; for (int k = 0; k < j; ++k) m &= m - 1u;
        u.pn = __builtin_ctz(m); u.aux = 0; return true; }
    __device__ __forceinline__ const char* a_ptr(const pg8::Unit& u) const { return A + (size_t)u.pm * tstepA; }
    __device__ __forceinline__ const char* b_ptr(const pg8::Unit& u) const { return B + (size_t)u.pn * tstepB; }
    __device__ __forceinline__ int ntiles(const pg8::Unit&) const { return nt; }
};
struct MergeSched {
    const char* A; const char* B; int G, c;
    __device__ __forceinline__ bool next(int i, pg8::Unit& u) const { const long L = (long)(i >> (1 + ((REP_MASK >> 4) & 1))) * G + c; if (L >= 128 * 4) return false; pg8::dense_tile((int)L, 128, 4, u.pm, u.pn); u.aux = i & 1; return true; }
    __device__ __forceinline__ const char* a_ptr(const pg8::Unit& u) const { return A + (size_t)u.pm * (256 * ARW * 2) + (u.aux ? QW * 2 : 0); }
    __device__ __forceinline__ const char* b_ptr(const pg8::Unit& u) const { return B + (size_t)u.pn * (256 * ARW * 2) + (u.aux ? QW * 2 : 0); }
    __device__ __forceinline__ int ntiles(const pg8::Unit& u) const { return u.aux ? (LRU_W / 64) : (QW / 64); }
};
template <int NTN> struct MoeSched {
    const char* A; const char* B; const LAS int* nbp; int G, c; size_t estepB;
    __device__ __forceinline__ bool next(int i, pg8::Unit& u) const {
        const int NB = nbp[NE], U = NB * NTN; const long L = (long)(i >> ((NTN == 4) ? ((REP_MASK >> 8) & 1) : 0)) * G + c; if (L >= U) return false; const int seg_ = i & 1;
        int w = (int)L; { const int q = U / 8, r = U % 8, xcd = w % 8, off = w / 8; w = (xcd < r ? xcd * (q + 1) : r * (q + 1) + (xcd - r) * q) + off; }
        if (NTN == 4 && DOWN_REVERSE) w = U - 1 - w;
        int e = 0;
        for (int k = 1; k < NE; ++k) e += (w >= nbp[k] * NTN) ? 1 : 0;
        const int b0 = nbp[e], nM = nbp[e + 1] - b0, wl = w - b0 * NTN;
        const int nig = 8 * NTN, gid = wl / nig, fm = gid * 8, gsz = (nM - fm) < 8 ? (nM - fm) : 8;
        const int rb = fm + ((wl % nig) % gsz); u.pn = (wl % nig) / gsz; u.pm = b0 + rb; u.aux = e | (rb << 8) | ((PROBE_K2X && NTN == 4) ? (seg_ << 30) : 0); return true;
    }
    __device__ __forceinline__ const char* a_ptr(const pg8::Unit& u) const { return A; }
    __device__ __forceinline__ const char* b_ptr(const pg8::Unit& u) const { return B + (size_t)(u.aux & 0xff) * estepB + (size_t)u.pn * (256 * D); }
    __device__ __forceinline__ int ntiles(const pg8::Unit&) const { return D / 128; }
};
struct MoeDownSched : MoeSched<4> {
    __device__ __forceinline__ const char* a_ptr(const pg8::Unit& u) const { return A + (size_t)u.pm * (256 * DFF); }
};

__device__ __forceinline__ float gelu_tanh_f(float y) { const float z = y * (0.7978845608028654f + 0.035677408136300125f * y * y); return y * __builtin_amdgcn_rcpf(1.0f + __builtin_amdgcn_exp2f(-2.0f * 1.4426950408889634f * z)); }
__device__ __forceinline__ pg8::bf16_t* glf_ptr(pg8::bf16_t* GLF, int pm, int gt, int wave, int ai, int m, int bj, int lane) {
    return GLF + ((((((size_t)pm * 8 + gt) * 8 + wave) * 2 + ai) * 4 + m) * 2 + bj) * 512 + lane * 8; }
template <bool F8> struct EpiInProjT {
    static constexpr int TPID = F8 ? 11 : 1;
    static constexpr bool PERM = true;
    unsigned char* ws; const LAS float* etab;
    __device__ __forceinline__ bool keep(const pg8::Unit&) const { return false; }
    __device__ __forceinline__ void operator()(pg8::f32x4 (&acc)[2][2][4][2], const pg8::Unit& u, int wr, int wc, int fr, int fq) const {
        using namespace pg8;
        const int pn = u.pn; bf16_t* base; int ldc, colt;
        if (pn < 2) { base = (bf16_t*)(ws + WS_Q); ldc = QW; colt = pn * 256; }
        else if (pn == 2) { base = (bf16_t*)(ws + WS_KV); ldc = 2 * KVW; colt = 0; }
        else if (pn < 7) { base = (bf16_t*)(ws + WS_XR); ldc = LRU_W; colt = (pn - 3) * 256; }
        else if (pn < 11) { base = (bf16_t*)(ws + WS_YR); ldc = LRU_W; colt = (pn - 7) * 256; }
        else { base = (bf16_t*)(ws + WS_GL); ldc = 2 * D; colt = (pn - 11) * 256; }
        const int row0 = u.pm * BM + wr * 64 + fr, col0 = colt + wc * 32 + 8 * fq; const bool isyr = (pn >= 7 && pn < 11);
        const LAS float* bias = etab + u.ui * 256 + wc * 32 + 8 * fq;
        f32x4 bv[2][2];
#pragma unroll
        for (int bj = 0; bj < 2; ++bj)
#pragma unroll
            for (int n = 0; n < 2; ++n) bv[bj][n] = *(const LAS f32x4*)(bias + bj * HALF + 4 * n);
#pragma unroll
        for (int ai = 0; ai < 2; ++ai)
#pragma unroll
            for (int m = 0; m < 4; ++m) { bf16_t* rowp = base + (size_t)(row0 + ai * HALF + m * 16) * ldc + col0;
#pragma unroll
                for (int bj = 0; bj < 2; ++bj) { f32x4 v0 = F8 ? acc[ai][bj][m][0] * WSCALE_INV + bv[bj][0] : acc[ai][bj][m][0] + bv[bj][0], v1 = F8 ? acc[ai][bj][m][1] * WSCALE_INV + bv[bj][1] : acc[ai][bj][m][1] + bv[bj][1];
                    if (isyr) {
#pragma unroll
                        for (int j = 0; j < 4; ++j) { v0[j] = gelu_tanh_f(v0[j]); v1[j] = gelu_tanh_f(v1[j]); } }
                    u32x4 w; w.x = cvt_pk_bf16(v0[0], v0[1]); w.y = cvt_pk_bf16(v0[2], v0[3]); w.z = cvt_pk_bf16(v1[0], v1[1]); w.w = cvt_pk_bf16(v1[2], v1[3]);
                    if (pn >= 11) { if (GL_NT) __builtin_nontemporal_store(w, (u32x4*)(glf_ptr((bf16_t*)(ws + WS_GL), u.pm, pn - 11, wr * 4 + wc, ai, m, bj, fq * 16 + fr))); else *(u32x4*)(glf_ptr((bf16_t*)(ws + WS_GL), u.pm, pn - 11, wr * 4 + wc, ai, m, bj, fq * 16 + fr)) = w; }
                    else *(u32x4*)(rowp + bj * HALF) = w; } }
    }
};
struct EpiMerge {
    static constexpr int TPID = 4;
    static constexpr bool PERM = true;
    const bf16* GL; bf16* MG;
    __device__ __forceinline__ bool keep(const pg8::Unit& u) const { return u.aux == 0; }
    __device__ __forceinline__ void operator()(pg8::f32x4 (&acc)[2][2][4][2], const pg8::Unit& u, int wr, int wc, int fr, int fq) const {
        using namespace pg8;
        const int row0 = u.pm * BM + wr * 64 + fr, col0 = u.pn * BM + wc * 32 + 8 * fq;
        if (u.aux == 0) {
#pragma unroll
            for (int ai = 0; ai < 2; ++ai) { u32x4 gav[4][2], grw[4][2];
#pragma unroll
                for (int m = 0; m < 4; ++m) {
#pragma unroll
                    for (int bj = 0; bj < 2; ++bj) { gav[m][bj] = GA_NT ? __builtin_nontemporal_load((const u32x4*)glf_ptr((bf16_t*)GL, u.pm, u.pn, wr * 4 + wc, ai, m, bj, fq * 16 + fr)) : *(const u32x4*)glf_ptr((bf16_t*)GL, u.pm, u.pn, wr * 4 + wc, ai, m, bj, fq * 16 + fr); grw[m][bj] = (GA_NT > 1) ? __builtin_nontemporal_load((const u32x4*)glf_ptr((bf16_t*)GL, u.pm, u.pn + 4, wr * 4 + wc, ai, m, bj, fq * 16 + fr)) : *(const u32x4*)glf_ptr((bf16_t*)GL, u.pm, u.pn + 4, wr * 4 + wc, ai, m, bj, fq * 16 + fr); } }
                asm volatile("" ::: "memory");
#pragma unroll
                for (int m = 0; m < 4; ++m) {
#pragma unroll
                    for (int bj = 0; bj < 2; ++bj) asm volatile("" : "+v"(gav[m][bj]), "+v"(grw[m][bj]));
                }
#pragma unroll
                for (int m = 0; m < 4; ++m) {
#pragma unroll
                    for (int bj = 0; bj < 2; ++bj) { const u32x4 ga = gav[m][bj], gr = grw[m][bj];
#pragma unroll
                        for (int q = 0; q < 4; ++q) { const float a0 = bf_lo(ga[q]), a1 = bf_hi(ga[q]), r0 = bf_lo(gr[q]), r1 = bf_hi(gr[q]);
                            const float f0 = (1.0f + __builtin_amdgcn_exp2f(-1.4426950408889634f * r0)) * __builtin_amdgcn_rcpf(1.0f + __builtin_amdgcn_exp2f(-1.4426950408889634f * a0));
                            const float f1 = (1.0f + __builtin_amdgcn_exp2f(-1.4426950408889634f * r1)) * __builtin_amdgcn_rcpf(1.0f + __builtin_amdgcn_exp2f(-1.4426950408889634f * a1));
                            acc[ai][bj][m][q >> 1][(q & 1) * 2] *= f0; acc[ai][bj][m][q >> 1][(q & 1) * 2 + 1] *= f1; } } } }
        } else {
#pragma unroll
            for (int ai = 0; ai < 2; ++ai) { u32x4 grv[4][2];
#pragma unroll
                for (int m = 0; m < 4; ++m) {
#pragma unroll
                    for (int bj = 0; bj < 2; ++bj) grv[m][bj] = (GA_NT > 2) ? __builtin_nontemporal_load((const u32x4*)glf_ptr((bf16_t*)GL, u.pm, u.pn + 4, wr * 4 + wc, ai, m, bj, fq * 16 + fr)) : *(const u32x4*)glf_ptr((bf16_t*)GL, u.pm, u.pn + 4, wr * 4 + wc, ai, m, bj, fq * 16 + fr); }
#pragma unroll
                for (int m = 0; m < 4; ++m) { bf16* op = MG + (size_t)(row0 + ai * HALF + m * 16) * D + col0;
#pragma unroll
                    for (int bj = 0; bj < 2; ++bj) { const u32x4 gr = grv[m][bj]; u32x4 w;
#pragma unroll
                        for (int q = 0; q < 4; ++q) { const float s0 = fast_sigmoid(bf_lo(gr[q])), s1 = fast_sigmoid(bf_hi(gr[q]));
                            w[q] = cvt_pk_bf16(acc[ai][bj][m][q >> 1][(q & 1) * 2] * s0, acc[ai][bj][m][q >> 1][(q & 1) * 2 + 1] * s1); }
                        *(u32x4*)(op + bj * HALF) = w; } } }
        }
    }
};
struct EpiResF32 {
    static constexpr int TPID = 5;
    static constexpr bool PERM = true;
    bf16* O;
    __device__ __forceinline__ bool keep(const pg8::Unit&) const { return false; }
    __device__ __forceinline__ void operator()(pg8::f32x4 (&acc)[2][2][4][2], const pg8::Unit& u, int wr, int wc, int fr, int fq) const {
        using namespace pg8;
        const int row0 = u.pm * BM + wr * 64 + fr, col0 = u.pn * BM + wc * 32 + 8 * fq;
#pragma unroll
        for (int ai = 0; ai < 2; ++ai)
#pragma unroll
            for (int m = 0; m < 4; ++m) { bf16* rowp = O + (size_t)(row0 + ai * HALF + m * 16) * D + col0;
#pragma unroll
                for (int bj = 0; bj < 2; ++bj) { const f32x4 v0 = acc[ai][bj][m][0], v1 = acc[ai][bj][m][1];
                    u32x4 w; w.x = cvt_pk_bf16(v0[0], v0[1]); w.y = cvt_pk_bf16(v0[2], v0[3]); w.z = cvt_pk_bf16(v1[0], v1[1]); w.w = cvt_pk_bf16(v1[2], v1[3]);
                    *(u32x4*)(rowp + bj * HALF) = w; } }
    }
};
struct EpiSwiGLU {
    static constexpr int TPID = 7;
    static constexpr bool PERM = true;
    const LAS unsigned short* etab; const LAS unsigned short* rtab; unsigned char* ACT; LAS unsigned char* stg;
    __device__ __forceinline__ bool keep(const pg8::Unit&) const { return false; }
    __device__ __forceinline__ void operator()(pg8::f32x4 (&acc)[2][2][4][2], const pg8::Unit& u, int wr, int wc, int fr, int fq) const {
        using namespace pg8;
        const int cl = wc * 32 + 8 * fq, col0 = u.pn * 128 + cl, row0 = u.pm * BM + wr * 64 + fr;
        const LAS unsigned short* bp = etab + u.ui * 256 + cl; const LAS unsigned short* rp = rtab + u.ui * 256 + wr * 64 + fr;
        const u32x4 bgw = *(const LAS u32x4*)(bp), buw = *(const LAS u32x4*)(bp + 128);
        const f32x4 bg0 = (f32x4){bf_lo(bgw.x), bf_hi(bgw.x), bf_lo(bgw.y), bf_hi(bgw.y)}, bg1 = (f32x4){bf_lo(bgw.z), bf_hi(bgw.z), bf_lo(bgw.w), bf_hi(bgw.w)};
        const f32x4 bu0 = (f32x4){bf_lo(buw.x), bf_hi(buw.x), bf_lo(buw.y), bf_hi(buw.y)}, bu1 = (f32x4){bf_lo(buw.z), bf_hi(buw.z), bf_lo(buw.w), bf_hi(buw.w)};
#if EPI_LDS_STAGE_GU
        const int tid_ = (wr * 4 + wc) * 64 + fq * 16 + fr, lr2 = tid_ >> 3, ch2 = tid_ & 7;
#pragma unroll
        for (int pp = 0; pp < 4; ++pp) { const int ai = pp >> 1; LAS unsigned char* buf = stg + (pp & 1) * 8192;
#pragma unroll
            for (int ml = 0; ml < 2; ++ml) { const int m = 2 * (pp & 1) + ml; u32x2 w; const float rs = __uint_as_float((unsigned)rp[ai * HALF + m * 16] << 16) * WSCALE_INV;
#pragma unroll
                for (int n = 0; n < 2; ++n) { const f32x4 g = acc[ai][0][m][n] * rs + (n ? bg1 : bg0), uu = acc[ai][1][m][n] * rs + (n ? bu1 : bu0); float a[4];
#pragma unroll
                    for (int j = 0; j < 4; ++j) { const float gg = fminf(g[j], 7.0f), uc = fminf(fmaxf(uu[j], -7.0f), 7.0f);
                        a[j] = gg * __builtin_amdgcn_rcpf(1.0f + __builtin_amdgcn_exp2f(-1.702f * 1.4426950408889634f * gg)) * (uc + 1.0f); }
                    int pk = 0; pk = __builtin_amdgcn_cvt_pk_fp8_f32(a[0], a[1], pk, false); pk = __builtin_amdgcn_cvt_pk_fp8_f32(a[2], a[3], pk, true); w[n] = (unsigned)pk; }
                const int lr = ml * 32 + wr * 16 + fr;
                *(LAS u32x2*)(buf + lr * 128 + (((wc * 2 + (fq >> 1)) ^ (lr & 7)) << 4) + (fq & 1) * 8) = w; }
            asm volatile("s_waitcnt lgkmcnt(0)\n\ts_barrier" ::: "memory");
            const u32x4 v = *(const LAS u32x4*)(buf + lr2 * 128 + ((ch2 ^ (lr2 & 7)) << 4));
            const int m2 = 2 * (pp & 1) + (lr2 >> 5), wr2 = (lr2 >> 4) & 1, fr2 = lr2 & 15;
            *(u32x4*)(ACT + (size_t)(u.pm * BM + ai * HALF + wr2 * 64 + m2 * 16 + fr2) * DFF + u.pn * 128 + ch2 * 16) = v; }
        asm volatile("s_waitcnt lgkmcnt(0)\n\ts_barrier" ::: "memory");
#else
#pragma unroll
        for (int ai = 0; ai < 2; ++ai)
#pragma unroll
            for (int m = 0; m < 4; ++m) { u32x2 w; const float rs = __uint_as_float((unsigned)rp[ai * HALF + m * 16] << 16) * WSCALE_INV;
#pragma unroll
                for (int n = 0; n < 2; ++n) { const f32x4 g = acc[ai][0][m][n] * rs + (n ? bg1 : bg0), uu = acc[ai][1][m][n] * rs + (n ? bu1 : bu0); float a[4];
#pragma unroll
                    for (int j = 0; j < 4; ++j) { const float gg = fminf(g[j], 7.0f), uc = fminf(fmaxf(uu[j], -7.0f), 7.0f);
                        a[j] = gg * __builtin_amdgcn_rcpf(1.0f + __builtin_amdgcn_exp2f(-1.702f * 1.4426950408889634f * gg)) * (uc + 1.0f); }
                    int pk = 0; pk = __builtin_amdgcn_cvt_pk_fp8_f32(a[0], a[1], pk, false); pk = __builtin_amdgcn_cvt_pk_fp8_f32(a[2], a[3], pk, true); w[n] = (unsigned)pk; }
                *(u32x2*)(ACT + (size_t)(row0 + ai * HALF + m * 16) * DFF + col0) = w; }
#endif
    }
};
struct EpiDown {
    static constexpr int TPID = 8;
    static constexpr bool PERM = true;
    const LAS float* etab; const LAS float* gtab2; unsigned char* Y; LAS unsigned char* stg;
    __device__ __forceinline__ bool keep(const pg8::Unit& u) const { return PROBE_K2X && ((u.aux >> 30) & 1) == 0; }
    __device__ __forceinline__ void operator()(pg8::f32x4 (&acc)[2][2][4][2], const pg8::Unit& u, int wr, int wc, int fr, int fq) const {
        using namespace pg8;
        if (PROBE_K2X && ((u.aux >> 30) & 1) == 0) return;
        const int tui = PROBE_K2X ? (u.ui >> 1) : u.ui; const float ksc = PROBE_K2X ? 0.5f * WSCALE_INV : WSCALE_INV;
        const int col0 = u.pn * BM + wc * 32 + 8 * fq, rl0 = wr * 64 + fr;
        const LAS float* bias = etab + tui * 256 + wc * 32 + 8 * fq;
        f32x4 bv[2][2];
#pragma unroll
        for (int bj = 0; bj < 2; ++bj)
#pragma unroll
            for (int n = 0; n < 2; ++n) bv[bj][n] = *(const LAS f32x4*)(bias + bj * HALF + 4 * n);
        const LAS float* gl = gtab2 + tui * 256;
#if EPI_LDS_STAGE
        const int tid_ = (wr * 4 + wc) * 64 + fq * 16 + fr, lr2 = tid_ >> 4, ch2 = tid_ & 15;
#pragma unroll
        for (int p = 0; p < 8; ++p) { const int ai = p >> 2, m = p & 3; LAS unsigned char* buf = stg + (p & 1) * 8192;
            const int rl = rl0 + ai * HALF + m * 16; const float gt = gl[rl] * YSCALE;
#pragma unroll
            for (int bj = 0; bj < 2; ++bj) { const f32x4 v0 = (acc[ai][bj][m][0] * ksc + bv[bj][0]) * gt, v1 = (acc[ai][bj][m][1] * ksc + bv[bj][1]) * gt;
                int p0 = 0, p1 = 0; p0 = __builtin_amdgcn_cvt_pk_fp8_f32(v0[0], v0[1], p0, false); p0 = __builtin_amdgcn_cvt_pk_fp8_f32(v0[2], v0[3], p0, true);
                p1 = __builtin_amdgcn_cvt_pk_fp8_f32(v1[0], v1[1], p1, false); p1 = __builtin_amdgcn_cvt_pk_fp8_f32(v1[2], v1[3], p1, true);
                *(LAS u32x2*)(buf + (wr * 16 + fr) * 256 + (((bj * 8 + wc * 2 + (fq >> 1)) ^ fr) << 4) + (fq & 1) * 8) = (u32x2){(unsigned)p0, (unsigned)p1}; }
            asm volatile("s_waitcnt lgkmcnt(0)\n\ts_barrier" ::: "memory");
            const u32x4 v = *(const LAS u32x4*)(buf + lr2 * 256 + ((ch2 ^ (lr2 & 15)) << 4));
#if Y_NT
            __builtin_nontemporal_store(v, (u32x4*)(Y + (size_t)(u.pm * BM + ai * HALF + (lr2 >> 4) * 64 + m * 16 + (lr2 & 15)) * D + u.pn * BM + ch2 * 16)); }
#else
            *(u32x4*)(Y + (size_t)(u.pm * BM + ai * HALF + (lr2 >> 4) * 64 + m * 16 + (lr2 & 15)) * D + u.pn * BM + ch2 * 16) = v; }
#endif
        asm volatile("s_waitcnt lgkmcnt(0)\n\ts_barrier" ::: "memory");
#else
#pragma unroll
        for (int ai = 0; ai < 2; ++ai)
#pragma unroll
            for (int m = 0; m < 4; ++m) { const int rl = rl0 + ai * HALF + m * 16; const float gt = gl[rl] * YSCALE; unsigned char* rowp = Y + (size_t)(u.pm * BM + rl) * D + col0;
#pragma unroll
                for (int bj = 0; bj < 2; ++bj) { const f32x4 v0 = (acc[ai][bj][m][0] * ksc + bv[bj][0]) * gt, v1 = (acc[ai][bj][m][1] * ksc + bv[bj][1]) * gt;
                    int p0 = 0, p1 = 0; p0 = __builtin_amdgcn_cvt_pk_fp8_f32(v0[0], v0[1], p0, false); p0 = __builtin_amdgcn_cvt_pk_fp8_f32(v0[2], v0[3], p0, true);
                    p1 = __builtin_amdgcn_cvt_pk_fp8_f32(v1[0], v1[1], p1, false); p1 = __builtin_amdgcn_cvt_pk_fp8_f32(v1[2], v1[3], p1, true);
                    *(u32x2*)(rowp + bj * HALF) = (u32x2){(unsigned)p0, (unsigned)p1};
#ifdef PROBE_DUPST
                    { unsigned char* p2_ = rowp; asm volatile("" : "+v"(p2_) :: "memory"); *(u32x2*)(p2_ + bj * HALF) = (u32x2){(unsigned)p0, (unsigned)p1}; }
#endif
                    } }
#endif
    }
};

__device__ __forceinline__ v4u fix_vals(const v4u raw, const float* g8, float scale, int c, int prow, int pcol, const LAS f32x2* tab) {
    float v[8];
#pragma unroll
    for (int q = 0; q < 4; ++q) { v[2 * q] = bflo(raw[q]); v[2 * q + 1] = bfhi(raw[q]); }
    float ss = 0.f;
#pragma unroll
    for (int j = 0; j < 8; ++j) ss += v[j] * v[j];
    ss += __shfl_xor(ss, 1); ss += __shfl_xor(ss, 2); ss += __shfl_xor(ss, 4);
    const float rstd = 1.0f / sqrtf(ss * (1.0f / HD) + NORM_EPS);
    const int pos = (c >> 2) ? pcol : prow; const bool second = (c >> 1) & 1; const int f0 = (c & 1) * 8;
    float o[8];
#pragma unroll
    for (int j = 0; j < 8; ++j) { const float y = v[j] * rstd * g8[j]; const float pr = __shfl_xor(y, 2); const f32x2 cs = tab[pos * 16 + f0 + j];
        o[j] = (second ? (y * cs.x + pr * cs.y) : (y * cs.x - pr * cs.y)) * scale; }
    v4u w; w.x = pk2(o[0], o[1]); w.y = pk2(o[2], o[3]); w.z = pk2(o[4], o[5]); w.w = pk2(o[6], o[7]);
    return w;
}
__device__ __forceinline__ void p2_fixup(Frame& F) {
    LAS f32x2* tab = (LAS f32x2*)(F.lds);
    for (int idx = F.tid; idx < 1024; idx += NWAVES * 64) { const int pos = idx >> 4, f = idx & 15; const float inv = powf(10000.0f, -(float)f / 16.0f); const float ang = (float)pos * inv;
        tab[idx] = (f32x2){cosf(ang), sinf(ang)}; }
    __syncthreads();
    const int gw = F.vcu * NWAVES + F.wave, NGW = F.G * NWAVES, c = F.lane & 7;
    float gq[8], gk[8];
#pragma unroll
    for (int j = 0; j < 8; ++j) { gq[j] = F.in[I_QNG][8 * c + j]; gk[j] = F.in[I_KNG][8 * c + j]; }
    bf16* Q = (bf16*)(F.ws + WS_Q); bf16* KV = (bf16*)(F.ws + WS_KV);
    for (int t0 = gw; t0 < T; t0 += 4 * NGW) {
        v4u rq[4], rk[4]; int tt[4];
#pragma unroll
        for (int i = 0; i < 4; ++i) { const int t = t0 + i * NGW; tt[i] = t < T ? t : t0;
            rq[i] = *(const GAS v4u*)(Q + (size_t)tt[i] * QW + F.lane * 8); rk[i] = *(const GAS v4u*)(KV + (size_t)tt[i] * (2 * KVW) + (F.lane & 15) * 8); }
#pragma unroll
        for (int i = 0; i < 4; ++i) { const int t = tt[i], s = t & (SEQ - 1), prow = s >> 6, pcol = s & 63;
            const v4u wq = fix_vals(rq[i], gq, attn_body::C2, c, prow, pcol, tab);
            const v4u wk = fix_vals(rk[i], gk, 1.0f, c, prow, pcol, tab);
            if (t0 + i * NGW < T) { *(GAS v4u*)(Q + (size_t)t * QW + F.lane * 8) = wq; if (F.lane < 16) *(GAS v4u*)(KV + (size_t)t * (2 * KVW) + F.lane * 8) = wk; } }
    }
    __syncthreads();
}
constexpr int LRU_CH = 256;
constexpr int LRU_XC_STRIDE = 144;
constexpr int LRU_BUF = LRU_CH * LRU_XC_STRIDE;
constexpr int LRU_WT = 4 * LRU_BUF;
static_assert(LRU_BUF >= 256 * 33 * 4 && LRU_WT + 2048 + 5 * 64 * 4 <= MISC_OFF, "lru lds");

__device__ __forceinline__ float gelu_tanh(float y) { const float z = 0.7978845608028654f * (y + 0.044715f * y * y * y); return y * sigmoidf_fast(2.0f * z); }

#ifndef LRU_DUP
#define LRU_DUP 0
#endif
#ifndef LRU_TP
#define LRU_TP 0
#endif
template <int DIR> __device__ __forceinline__ void lru_dir(Frame& F, int b, int n, int half) {
    LAS unsigned char* lds = F.lds;
    int tid_ = F.tid; asm volatile("" : "+v"(tid_));
    unsigned char* ws_ = F.ws; asm volatile("" : "+s"(ws_));
    const int tid = tid_, lane = tid & 63, wave = __builtin_amdgcn_readfirstlane(tid >> 6);
    constexpr int g = DIR; const int w = wave & 3, tl = tid & 255;
#define PHY(p_) (DIR ? 255 - (p_) : (p_))
    const int ch16 = lane & 15, q = lane >> 4, ct = w & 1, th = w >> 1;
    const int cl = 16 * ct + ch16, co_l = 32 * half + cl, cgl = 64 * n + co_l;
    constexpr float NL2E = -1.4426950408889634f;
    bf16x8 Ba[2], Bi[2], Bid;
    { const float* wa = F.in[I_WA] + ((size_t)(g * LRU_NB + n) * 64) * 64 + co_l; const float* wi = F.in[I_WI] + ((size_t)(g * LRU_NB + n) * 64) * 64 + co_l;
      float ta[16], ti[16];
#pragma unroll
      for (int ks = 0; ks < 2; ++ks)
#pragma unroll
          for (int j = 0; j < 8; ++j) { const int k = 32 * ks + 8 * q + j; ta[8 * ks + j] = wa[(size_t)k * 64]; ti[8 * ks + j] = wi[(size_t)k * 64]; }
#pragma unroll
      for (int ks = 0; ks < 2; ++ks)
#pragma unroll
          for (int j = 0; j < 8; ++j) { Ba[ks][j] = (short)f2bf(NL2E * ta[8 * ks + j]); Bi[ks][j] = (short)f2bf(NL2E * ti[8 * ks + j]); }
#pragma unroll
      for (int j = 0; j < 8; ++j) Bid[j] = (short)((8 * q + j == 16 * ct + ch16) ? 0x3F80 : 0); }
    const float ba = NL2E * F.in[I_BA][(g * LRU_NB + n) * 64 + co_l], bi = NL2E * F.in[I_BI][(g * LRU_NB + n) * 64 + co_l];
    const float lam = F.in[I_LAM][g * LRU_W + cgl];
    const float clam = -8.0f * log1pf(expf(-lam)) * 1.4426950408889634f;
    const int c8 = tl & 7, tg = tl >> 3;
    const int c4 = tl & 3, tok0 = (tl & ~63) + ((tl & 63) >> 2);
    LAS float* cwl = (LAS float*)(lds + LRU_WT + 2048);
    if (tid < 5 * 64) { const int j = tid >> 6, c = tid & 63; const float* src = (j < 4) ? (F.in[I_CONVW] + j * LRU_W) : F.in[I_CONVB]; cwl[tid] = src[64 * n + c]; }
    __syncthreads();
    const bf16* XR = (const bf16*)(ws_ + WS_XR) + (size_t)b * SEQ * LRU_W + 64 * n + 8 * c8;
    const bf16* YR = (const bf16*)(ws_ + WS_YR) + (size_t)b * SEQ * LRU_W + 64 * n + 32 * half;
    bf16* AR = (bf16*)(ws_ + WS_AR) + (size_t)b * SEQ * ARW + QW + 64 * n + 32 * half;
    constexpr int NST = SEQ / LRU_CH;
    v4u xrp[11];
#define LRU_LOADX(pc_) do { const int s0_ = (pc_) * LRU_CH + 8 * tg - 1; _Pragma("unroll") for (int i_ = 0; i_ < 11; ++i_) { const int s_ = s0_ + i_; \
        const int sc_ = s_ < 0 ? 0 : (s_ >= SEQ ? SEQ - 1 : s_); xrp[i_] = *(const GAS v4u*)(XR + (size_t)sc_ * LRU_W); } } while (0)
    LRU_LOADX(g ? NST - 1 : 0);
    float hcarry = 0.f;
    unsigned long long tpacc_ = 0, tps_ = 0;
    v4u dwv[4]; unsigned dtoff = 0;
#pragma unroll
    for (int i = 0; i < 4; ++i) dwv[i] = (v4u){0u, 0u, 0u, 0u};
    for (int k = 0; k < NST; ++k) {
        if (LRU_TP == 1 || LRU_TP == 5) tps_ = __builtin_amdgcn_s_memrealtime();
        const int pc = g ? (NST - 1 - k) : k, par = k & 1;
        LAS unsigned char* buf = lds + (g * 2 + par) * LRU_BUF;
        unsigned aA = (unsigned)((DIR ? (255 - 128 * th - ch16 - 112) : (128 * th + ch16)) * LRU_XC_STRIDE + q * 16);
        unsigned aX = (unsigned)((DIR ? (255 - 128 * th - 4 * q - 115) : (128 * th + 4 * q)) * LRU_XC_STRIDE + co_l * 2);
        unsigned aH = (unsigned)(((DIR ? (255 - 128 * th - 4 * q - 115) : (128 * th + 4 * q)) * 33 + cl) * 4);
        asm volatile("" : "+v"(aA), "+v"(aX), "+v"(aH));
#define OFS(c_, m_) (DIR ? ((m_) - (c_)) : (c_))
#pragma unroll 1
        for (int dup_ = 0; dup_ < 1 + (LRU_DUP & 1); ++dup_) { asm volatile("" : "+v"(xrp[0].x));
        { const int s0c = pc * LRU_CH + 8 * tg - 1;
#pragma unroll
          for (int i = 0; i < 11; ++i) { const unsigned m_ = ((unsigned)(s0c + i) < (unsigned)SEQ) ? 0xffffffffu : 0u; xrp[i] = (v4u){xrp[i].x & m_, xrp[i].y & m_, xrp[i].z & m_, xrp[i].w & m_}; } }
        { f32x2 cw[4][4], cb[4];
#pragma unroll
          for (int j = 0; j < 4; ++j) { const f32x4 c0 = *(const LAS f32x4*)(cwl + j * 64 + 8 * c8), c1 = *(const LAS f32x4*)(cwl + j * 64 + 8 * c8 + 4);
              cw[j][0] = (f32x2){c0.x, c0.y}; cw[j][1] = (f32x2){c0.z, c0.w}; cw[j][2] = (f32x2){c1.x, c1.y}; cw[j][3] = (f32x2){c1.z, c1.w}; }
          { const f32x4 c0 = *(const LAS f32x4*)(cwl + 256 + 8 * c8), c1 = *(const LAS f32x4*)(cwl + 256 + 8 * c8 + 4); cb[0] = (f32x2){c0.x, c0.y}; cb[1] = (f32x2){c0.z, c0.w}; cb[2] = (f32x2){c1.x, c1.y}; cb[3] = (f32x2){c1.z, c1.w}; }
#pragma unroll
          for (int tt = 0; tt < 8; ++tt) { f32x2 o[4];
#pragma unroll
            for (int i = 0; i < 4; ++i) o[i] = cb[i];
#pragma unroll
            for (int j = 0; j < 4; ++j) { const v4u raw = xrp[tt + j];
#pragma unroll
                for (int qq = 0; qq < 4; ++qq) { const f32x2 xv = (f32x2){bflo(raw[qq]), bfhi(raw[qq])}; o[qq] = __builtin_elementwise_fma(cw[j][qq], xv, o[qq]); } }
            v4u wv; wv.x = pk2(o[0].x, o[0].y); wv.y = pk2(o[1].x, o[1].y); wv.z = pk2(o[2].x, o[2].y); wv.w = pk2(o[3].x, o[3].y);
            *(LAS v4u*)(buf + (8 * tg + tt) * LRU_XC_STRIDE + c8 * 16) = wv; } } }
        if (LRU_TP == 5) tpacc_ += __builtin_amdgcn_s_memrealtime() - tps_; if (LRU_TP == 6) tps_ = __builtin_amdgcn_s_memrealtime();
        if (k > 0) {
#pragma unroll
            for (int i = 0; i < 4; ++i) *(GAS v4u*)((GAS unsigned char*)AR + (dtoff + (unsigned)(16 * i * ARW * 2))) = dwv[i]; }
        if (k + 1 < NST) LRU_LOADX(g ? (NST - 2 - k) : (k + 1));
        const unsigned trow = (unsigned)(pc * LRU_CH + tok0);
        const unsigned aoff = trow * (unsigned)(ARW * 2) + 16u * c4, yoff = trow * (unsigned)(LRU_W * 2) + 16u * c4;
        if (LRU_TP == 6) tpacc_ += __builtin_amdgcn_s_memrealtime() - tps_;
        if (k == NST / 2) asm volatile("s_waitcnt vmcnt(0)" ::: "memory");
        __syncthreads();
        if (LRU_TP == 1) tpacc_ += __builtin_amdgcn_s_memrealtime() - tps_; if (LRU_TP == 2) tps_ = __builtin_amdgcn_s_memrealtime();
        v4u yv[4], ov[4];
        if (k >= NST / 2) {
#pragma unroll
            for (int i = 0; i < 4; ++i) { yv[i] = __builtin_nontemporal_load((const GAS v4u*)((const GAS unsigned char*)YR + (yoff + (unsigned)(16 * i * LRU_W * 2)))); ov[i] = *(const GAS v4u*)((const GAS unsigned char*)AR + (aoff + (unsigned)(16 * i * ARW * 2))); } }
        float Aloc[8][4], Hloc[8][4]; float AR_ = 1.f, HR_ = 0.f;
#pragma unroll 1
        for (int dup_ = 0; dup_ < 1 + ((LRU_DUP >> 1) & 1); ++dup_) { asm volatile("" : "+v"(aA), "+v"(aX));
#pragma unroll
        for (int rt = 0; rt < 8; ++rt) {
            const bf16x8 a0 = *(const LAS bf16x8*)(buf + aA + OFS(16 * rt, 112) * LRU_XC_STRIDE), a1 = *(const LAS bf16x8*)(buf + aA + OFS(16 * rt, 112) * LRU_XC_STRIDE + 64);
            f32x4 Da = (f32x4){ba, ba, ba, ba}, Di = (f32x4){bi, bi, bi, bi}, Dx = (f32x4){0.f, 0.f, 0.f, 0.f};
            Da = __builtin_amdgcn_mfma_f32_16x16x32_bf16(a0, Ba[0], Da, 0, 0, 0); Da = __builtin_amdgcn_mfma_f32_16x16x32_bf16(a1, Ba[1], Da, 0, 0, 0);
            Di = __builtin_amdgcn_mfma_f32_16x16x32_bf16(a0, Bi[0], Di, 0, 0, 0); Di = __builtin_amdgcn_mfma_f32_16x16x32_bf16(a1, Bi[1], Di, 0, 0, 0);
            Dx = __builtin_amdgcn_mfma_f32_16x16x32_bf16(half ? a1 : a0, Bid, Dx, 0, 0, 0);
#pragma unroll
            for (int j = 0; j < 4; ++j) {
                const float r = __builtin_amdgcn_rcpf(1.0f + __builtin_amdgcn_exp2f(Da[j])), ig = __builtin_amdgcn_rcpf(1.0f + __builtin_amdgcn_exp2f(Di[j]));
                const float a = __builtin_amdgcn_exp2f(clam * r);
                Aloc[rt][j] = a; Hloc[rt][j] = __builtin_amdgcn_sqrtf(__builtin_fmaf(-a, a, 1.0f)) * (ig * Dx[j]); }
        }
        float Ai[8], Hi[8], Ae[8], He[8];
#pragma unroll
        for (int rt = 0; rt < 8; ++rt) {
#pragma unroll
            for (int j = 1; j < 4; ++j) { Hloc[rt][j] = Aloc[rt][j] * Hloc[rt][j - 1] + Hloc[rt][j]; Aloc[rt][j] = Aloc[rt][j - 1] * Aloc[rt][j]; }
            Ai[rt] = Aloc[rt][3]; Hi[rt] = Hloc[rt][3]; }
#pragma unroll
        for (int rt = 0; rt < 8; ++rt) { const float An = __shfl(Ai[rt], (lane - 16) & 63), Hn = __shfl(Hi[rt], (lane - 16) & 63); if (q >= 1) { Hi[rt] = Ai[rt] * Hn + Hi[rt]; Ai[rt] = An * Ai[rt]; } }
#pragma unroll
        for (int rt = 0; rt < 8; ++rt) { const float An = __shfl(Ai[rt], (lane - 32) & 63), Hn = __shfl(Hi[rt], (lane - 32) & 63); if (q >= 2) { Hi[rt] = Ai[rt] * Hn + Hi[rt]; Ai[rt] = An * Ai[rt]; } }
#pragma unroll
        for (int rt = 0; rt < 8; ++rt) { Ae[rt] = __shfl(Ai[rt], (lane - 16) & 63); He[rt] = __shfl(Hi[rt], (lane - 16) & 63); if (q == 0) { Ae[rt] = 1.f; He[rt] = 0.f; }
            Ai[rt] = __shfl(Ai[rt], ch16 + 48); Hi[rt] = __shfl(Hi[rt], ch16 + 48); }
        AR_ = 1.f; HR_ = 0.f;
#pragma unroll
        for (int rt = 0; rt < 8; ++rt) {
            const float Ap = AR_ * Ae[rt], Hp = Ae[rt] * HR_ + He[rt];
#pragma unroll
            for (int j = 0; j < 4; ++j) { Hloc[rt][j] = Aloc[rt][j] * Hp + Hloc[rt][j]; Aloc[rt][j] = Ap * Aloc[rt][j]; }
            HR_ = Ai[rt] * HR_ + Hi[rt]; AR_ = AR_ * Ai[rt]; }
        }
        LAS f32x2* WT = (LAS f32x2*)(lds + LRU_WT) + (g * 2 + par) * 64;
        if (q == 0) WT[th * 32 + cl] = (f32x2){AR_, HR_};
        __syncthreads();
        if (LRU_TP == 2) tpacc_ += __builtin_amdgcn_s_memrealtime() - tps_; if (LRU_TP == 3) tps_ = __builtin_amdgcn_s_memrealtime();
        const f32x2 w0 = WT[cl], w1 = WT[32 + cl];
        const float hmid = w0.x * hcarry + w0.y;
        const float hin = th ? hmid : hcarry;
        hcarry = w1.x * hmid + w1.y;
        LAS float* HS = (LAS float*)buf;
#pragma unroll
        for (int rt = 0; rt < 8; ++rt)
#pragma unroll
            for (int j = 0; j < 4; ++j) *(LAS float*)(buf + aH + OFS(16 * rt + j, 115) * 132) = Hloc[rt][j] + Aloc[rt][j] * hin;
        __syncthreads();
        if (LRU_TP == 3) tpacc_ += __builtin_amdgcn_s_memrealtime() - tps_; if (LRU_TP == 4) tps_ = __builtin_amdgcn_s_memrealtime();
#pragma unroll 1
        for (int dup_ = 0; dup_ < 1 + ((LRU_DUP >> 2) & 1); ++dup_) { asm volatile("" : "+v"(yv[0].x));
          float hv[32];
#pragma unroll
          for (int i = 0; i < 32; ++i) hv[i] = HS[(tok0 + 16 * (i >> 3)) * 33 + 8 * c4 + (i & 7)];
          v4u wv[4];
          if (k < NST / 2) {
#pragma unroll
              for (int i = 0; i < 4; ++i) { wv[i].x = pk2(hv[8 * i], hv[8 * i + 1]); wv[i].y = pk2(hv[8 * i + 2], hv[8 * i + 3]); wv[i].z = pk2(hv[8 * i + 4], hv[8 * i + 5]); wv[i].w = pk2(hv[8 * i + 6], hv[8 * i + 7]); }
          } else {
#pragma unroll
              for (int i = 0; i < 4; ++i)
#pragma unroll
                  for (int qq = 0; qq < 4; ++qq) wv[i][qq] = pk2((hv[8 * i + 2 * qq] + bflo(ov[i][qq])) * bflo(yv[i][qq]), (hv[8 * i + 2 * qq + 1] + bfhi(ov[i][qq])) * bfhi(yv[i][qq]));
          }
#pragma unroll
          for (int i = 0; i < 4; ++i) dwv[i] = wv[i];
          dtoff = aoff; }
        if (LRU_TP == 4) tpacc_ += __builtin_amdgcn_s_memrealtime() - tps_;
    }
    {
#pragma unroll
      for (int i = 0; i < 4; ++i) *(GAS v4u*)((GAS unsigned char*)AR + (dtoff + (unsigned)(16 * i * ARW * 2))) = dwv[i]; }
#undef LRU_LOADX
#undef PHY
#undef OFS
    if (LRU_TP > 0 && blockIdx.x == 0 && tid == 0) *(LAS unsigned*)(F.lds + MISC_OFF + 4 * 204) = (unsigned)tpacc_;
    __syncthreads();
}
__device__ __forceinline__ void p2_lru(Frame& F) {
    for (int it = F.vcu; it < BATCH * LRU_NB * 2; it += F.G) { if (F.wave < 4) lru_dir<0>(F, it >> 5, (it & 31) >> 1, it & 1); else lru_dir<1>(F, it >> 5, (it & 31) >> 1, it & 1); }
}

constexpr int RW_STRIDE = 1032;
constexpr int RT_WBH = 0, RT_WBL = 32 * RW_STRIDE * 2, RT_G2 = 2 * RT_WBL, RT_LG = RT_G2 + 4096, RT_ROWINFO = RT_LG + 8 * 16 * 33 * 4, RT_RS = RT_ROWINFO + 4096;
static_assert(RT_RS + 512 <= MISC_OFF, "router lds");
__device__ __forceinline__ void p6_router(Frame& F, const bool dry) {
    LAS unsigned char* lds = F.lds;
    LAS unsigned short* WBH = (LAS unsigned short*)(lds + RT_WBH); LAS unsigned short* WBL = (LAS unsigned short*)(lds + RT_WBL);
    LAS float* G2 = (LAS float*)(lds + RT_G2); LAS float* LG = (LAS float*)(lds + RT_LG); LAS v2u* rowinfo = (LAS v2u*)(lds + RT_ROWINFO); LAS float* RS = (LAS float*)(lds + RT_RS);
    LAS unsigned* misc = (LAS unsigned*)(lds + MISC_OFF);
    LAS unsigned* hist = misc + 128; LAS unsigned* basew = misc + 160;
    const int tid = F.tid, lane = F.lane, wave = F.wave;
    for (int i0 = 0; i0 < (D * NE) / (NWAVES * 64); i0 += 16) {
        float tw[16];
#pragma unroll
        for (int i = 0; i < 16; ++i) tw[i] = F.in[I_WR][tid + (NWAVES * 64) * (i0 + i)];
        asm volatile("" ::: "memory");
#pragma unroll
        for (int i = 0; i < 16; ++i) { const int idx = tid + (NWAVES * 64) * (i0 + i), k = idx >> 5, e = idx & 31; const unsigned hi = f2bf(tw[i]); const unsigned lo = f2bf(tw[i] - __uint_as_float(hi << 16));
            WBH[e * RW_STRIDE + k] = (unsigned short)hi; WBL[e * RW_STRIDE + k] = (unsigned short)lo; } }
    for (int i = tid; i < D; i += NWAVES * 64) G2[i] = F.in[I_N2G][i];
    if (tid < 32) hist[tid] = 0u;
    const float brl0 = F.in[I_BR][lane & 15], brl1 = F.in[I_BR][16 + (lane & 15)];
    __syncthreads();
    bf16* X1B = (bf16*)(F.ws + WS_X1B); const bf16* MIXB = (const bf16*)(F.ws + WS_MIXB);
    unsigned char* H2 = (unsigned char*)(F.ws + WS_XN);
    unsigned* gcnt = (unsigned*)(F.ws + WS_CTL) + CW_CNT;
    int* TOKL = (int*)(F.ws + WS_TOKL); float* GATEL = (float*)(F.ws + WS_GATEL); int* TOKREC = (int*)(F.ws + WS_TOKREC); float* RSTDT = (float*)(F.ws + WS_RSTDT);
    const int r16 = lane & 15, kq = lane >> 4;
    for (int bi = F.vcu; bi < T / 128; bi += F.G) {
        const int rbase = bi * 128; const size_t row = (size_t)rbase + 16 * wave + r16;
        const float* xp = F.in[I_X] + row * D + 8 * kq; const bf16* mp = MIXB + row * D + 8 * kq; bf16* x1p = X1B + row * D + 8 * kq; unsigned char* hp = H2 + row * D + 8 * kq;
        f32x4 acc0 = (f32x4){0.f, 0.f, 0.f, 0.f}, acc1 = (f32x4){0.f, 0.f, 0.f, 0.f}; float ss = 0.f;
        const LAS unsigned char* bh0 = lds + RT_WBH + (r16 * RW_STRIDE + 8 * kq) * 2; const LAS unsigned char* bl0 = lds + RT_WBL + (r16 * RW_STRIDE + 8 * kq) * 2;
#pragma unroll 1
        for (int s4 = 0; s4 < 32; s4 += 4) {
            f32x4 xa[4], xb[4]; v4u mw[4];
#pragma unroll
            for (int u = 0; u < 4; ++u) { const int k0 = 32 * (s4 + u); xa[u] = __builtin_nontemporal_load((const GAS f32x4*)(xp + k0)); xb[u] = __builtin_nontemporal_load((const GAS f32x4*)(xp + k0 + 4)); mw[u] = __builtin_nontemporal_load((const GAS v4u*)(mp + k0)); }
#pragma unroll
            for (int u = 0; u < 4; ++u) { const int k0 = 32 * (s4 + u);
                const f32x4 ga = *(const LAS f32x4*)(G2 + k0 + 8 * kq), gb = *(const LAS f32x4*)(G2 + k0 + 8 * kq + 4);
                float x1[8]; x1[0] = xa[u].x + bflo(mw[u].x); x1[1] = xa[u].y + bfhi(mw[u].x); x1[2] = xa[u].z + bflo(mw[u].y); x1[3] = xa[u].w + bfhi(mw[u].y);
                x1[4] = xb[u].x + bflo(mw[u].z); x1[5] = xb[u].y + bfhi(mw[u].z); x1[6] = xb[u].z + bflo(mw[u].w); x1[7] = xb[u].w + bfhi(mw[u].w);
#pragma unroll
                for (int j = 0; j < 8; ++j) ss += x1[j] * x1[j];
                *(GAS v4u*)(x1p + k0) = (v4u){pk2(x1[0], x1[1]), pk2(x1[2], x1[3]), pk2(x1[4], x1[5]), pk2(x1[6], x1[7])};
                float h[8]; h[0] = x1[0] * ga.x; h[1] = x1[1] * ga.y; h[2] = x1[2] * ga.z; h[3] = x1[3] * ga.w; h[4] = x1[4] * gb.x; h[5] = x1[5] * gb.y; h[6] = x1[6] * gb.z; h[7] = x1[7] * gb.w;
                { int p0 = 0, p1 = 0; p0 = __builtin_amdgcn_cvt_pk_fp8_f32(h[0], h[1], p0, false); p0 = __builtin_amdgcn_cvt_pk_fp8_f32(h[2], h[3], p0, true);
                  p1 = __builtin_amdgcn_cvt_pk_fp8_f32(h[4], h[5], p1, false); p1 = __builtin_amdgcn_cvt_pk_fp8_f32(h[6], h[7], p1, true); *(GAS v2u*)(hp + k0) = (v2u){(unsigned)p0, (unsigned)p1}; }
                v4u ahi, alo;
#pragma unroll
                for (int q2 = 0; q2 < 4; ++q2) { ahi[q2] = pk2(h[2 * q2], h[2 * q2 + 1]); alo[q2] = pk2(h[2 * q2] - bflo(ahi[q2]), h[2 * q2 + 1] - bfhi(ahi[q2])); }
                const bf16x8 Ahi = __builtin_bit_cast(bf16x8, ahi), Alo = __builtin_bit_cast(bf16x8, alo);
                const bf16x8 Bh0 = *(const LAS bf16x8*)(bh0 + k0 * 2), Bh1 = *(const LAS bf16x8*)(bh0 + 16 * RW_STRIDE * 2 + k0 * 2), Bl0 = *(const LAS bf16x8*)(bl0 + k0 * 2), Bl1 = *(const LAS bf16x8*)(bl0 + 16 * RW_STRIDE * 2 + k0 * 2);
                acc0 = __builtin_amdgcn_mfma_f32_16x16x32_bf16(Ahi, Bh0, acc0, 0, 0, 0); acc1 = __builtin_amdgcn_mfma_f32_16x16x32_bf16(Ahi, Bh1, acc1, 0, 0, 0);
                acc0 = __builtin_amdgcn_mfma_f32_16x16x32_bf16(Alo, Bh0, acc0, 0, 0, 0); acc1 = __builtin_amdgcn_mfma_f32_16x16x32_bf16(Alo, Bh1, acc1, 0, 0, 0);
                acc0 = __builtin_amdgcn_mfma_f32_16x16x32_bf16(Ahi, Bl0, acc0, 0, 0, 0); acc1 = __builtin_amdgcn_mfma_f32_16x16x32_bf16(Ahi, Bl1, acc1, 0, 0, 0); }
        }
        ss += __shfl_xor(ss, 16); ss += __shfl_xor(ss, 32);
        const float rstd = 1.0f / sqrtf(ss * (1.f / D) + NORM_EPS);
        LAS float* lgw = LG + wave * (16 * 33);
#pragma unroll
        for (int i = 0; i < 4; ++i) { const float rsi = __shfl(rstd, 4 * kq + i);
            lgw[(4 * kq + i) * 33 + r16] = acc0[i] * rsi + brl0; lgw[(4 * kq + i) * 33 + 16 + r16] = acc1[i] * rsi + brl1; }
        LDS_WAIT(); asm volatile("" ::: "memory");
        if (lane < 16) {
            LAS float* lr = lgw + lane * 33; int te[4]; float tv[4];
#pragma unroll
            for (int k = 0; k < 4; ++k) { float best = -INFINITY; int bi2 = 0;
#pragma unroll
                for (int e = 0; e < 32; ++e) { const float v = lr[e]; if (v > best) { best = v; bi2 = e; } }
                te[k] = bi2; tv[k] = best; lr[bi2] = -INFINITY; LDS_WAIT(); asm volatile("" ::: "memory"); }
            const float p1 = __expf(tv[1] - tv[0]), p2 = __expf(tv[2] - tv[0]), p3 = __expf(tv[3] - tv[0]); const float inv = 1.0f / (1.0f + p1 + p2 + p3);
            const float gts[4] = {inv, p1 * inv, p2 * inv, p3 * inv};
            const int rl = 16 * wave + lane;
#pragma unroll
            for (int k = 0; k < 4; ++k) { const unsigned rank = atomicAdd((unsigned*)(hist + te[k]), 1u); rowinfo[rl * 4 + k] = (v2u){(unsigned)te[k] | (rank << 8), __float_as_uint(gts[k])}; }
            RS[rl] = rstd;
        }
        __syncthreads();
        if (tid < 32) basew[tid] = dry ? 0u : __hip_atomic_fetch_add(gcnt + tid, hist[tid], __ATOMIC_RELAXED, __HIP_MEMORY_SCOPE_AGENT);
        __syncthreads();
        { const int rl = tid >> 2, k = tid & 3; const v2u inf = rowinfo[rl * 4 + k]; const int e = inf.x & 0xff; const unsigned slot = basew[e] + (inf.x >> 8); const int t = rbase + rl;
          if (!dry) { TOKL[(size_t)e * ECAP + slot] = t; GATEL[(size_t)e * ECAP + slot] = __uint_as_float(inf.y); TOKREC[t * 4 + k] = (int)(((unsigned)e << 20) | slot); if (k == 0) RSTDT[t] = RS[rl]; } }
        __syncthreads();
        if (tid < 32) hist[tid] = 0u;
        __syncthreads();
    }
}

__device__ __forceinline__ void moe_tables(Frame& F) {
    LAS int* misc = (LAS int*)(F.lds + MISC_OFF);
    const unsigned* gcnt = (const unsigned*)(F.ws + WS_CTL) + CW_CNT;
    if (F.tid < 32) misc[F.tid] = (int)__hip_atomic_load(gcnt + F.tid, __ATOMIC_RELAXED, __HIP_MEMORY_SCOPE_AGENT);
    __syncthreads();
    if (F.tid == 0) { int s = 0; for (int e = 0; e < NE; ++e) { misc[32 + e] = s; s += (misc[e] + 255) >> 8; } misc[32 + NE] = s; }
    __syncthreads();
}
constexpr int UDESC_WORD = 208;
template <class Sched> __device__ __forceinline__ int resolve_units(Frame& F, const Sched& S, int maxu, int stride) {
    LAS int* misc = (LAS int*)(F.lds + MISC_OFF);
    if (F.tid == 0) misc[UDESC_WORD - 1] = 0;
    __syncthreads();
    pg8::Unit u;
    for (int ui = F.wave; ui < maxu; ui += NWAVES) { if (!S.next(ui * stride, u)) break;
        if (F.lane == 0) { misc[UDESC_WORD + 3 * ui] = u.aux; misc[UDESC_WORD + 3 * ui + 1] = u.pn; misc[UDESC_WORD + 3 * ui + 2] = u.pm; atomicMax((int*)(misc + UDESC_WORD - 1), ui + 1); } }
    __syncthreads();
    return misc[UDESC_WORD - 1];
}
template <class Base> struct TabSched : Base {
    const LAS int* desc; int nu;
    __device__ __forceinline__ TabSched(const Base& b, const LAS int* d, int n) : Base(b), desc(d), nu(n) {}
    __device__ __forceinline__ bool next(int i, pg8::Unit& u) const { if (i >= nu) return false; u.aux = desc[3 * i]; u.pn = desc[3 * i + 1]; u.pm = desc[3 * i + 2]; return true; }
};
__device__ __forceinline__ int moe_gather_table(Frame& F, const MoeSched<8>& S) {
    LAS int* misc = (LAS int*)(F.lds + MISC_OFF); LAS unsigned short* gtab = (LAS unsigned short*)(F.lds + GTAB_OFF);
    LAS unsigned short* etab = (LAS unsigned short*)(F.lds + ETAB_OFF); LAS unsigned short* rtab = etab + MAX_GUNITS * 256;
    const int* TOKL = (const int*)(F.ws + WS_TOKL); const float* RSTDT = (const float*)(F.ws + WS_RSTDT);
    const int nu = resolve_units(F, S, MAX_GUNITS, 1);
    if (nu == 0) return 0;
    int tv[MAX_GUNITS / 2]; float bv[MAX_GUNITS / 2], rv[MAX_GUNITS / 2];
#pragma unroll
    for (int j = 0; j < MAX_GUNITS / 2; ++j) { const int idx = F.tid + 512 * j, uiu = idx >> 8, ui = uiu < nu ? uiu : nu - 1, r = idx & 255;
        const int aux = misc[UDESC_WORD + 3 * ui], pn = misc[UDESC_WORD + 3 * ui + 1], e = aux & 0xff, rb = aux >> 8, slot = rb * 256 + r; const bool ok = slot < misc[e];
        tv[j] = TOKL[(size_t)e * ECAP + (ok ? slot : 0)]; tv[j] = ok ? tv[j] : 0;
        bv[j] = F.in[I_BGU][(size_t)e * (2 * DFF) + (r < 128 ? 0 : DFF - 128) + pn * 128 + r]; }
    asm volatile("" ::: "memory");
#pragma unroll
    for (int j = 0; j < MAX_GUNITS / 2; ++j) rv[j] = RSTDT[tv[j]];
    asm volatile("" ::: "memory");
#pragma unroll
    for (int j = 0; j < MAX_GUNITS / 2; ++j) { const int idx = F.tid + 512 * j; if ((idx >> 8) < nu) { gtab[idx] = (unsigned short)tv[j]; etab[idx] = (unsigned short)f2bf(bv[j]); rtab[idx] = (unsigned short)f2bf(rv[j]); } }
    __syncthreads();
    return nu;
}
__device__ __forceinline__ int moe_down_table(Frame& F, const MoeDownSched& S) {
    LAS int* misc = (LAS int*)(F.lds + MISC_OFF); LAS float* etab = (LAS float*)(F.lds + ETAB_OFF); LAS float* gt2 = (LAS float*)(F.lds + GTAB_OFF);
    const float* GATEL = (const float*)(F.ws + WS_GATEL);
    const int nu = resolve_units(F, S, 9, PROBE_K2X ? 2 : 1);
    if (nu == 0) return 0;
    float bv[5], gv[5];
#pragma unroll
    for (int j = 0; j < 5; ++j) { const int idx = F.tid + 512 * j, uiu = idx >> 8, ui = uiu < nu ? uiu : nu - 1, r = idx & 255;
        const int aux = misc[UDESC_WORD + 3 * ui], pn = misc[UDESC_WORD + 3 * ui + 1], e = aux & 0xff, rb = (aux >> 8) & 0xffff;
        bv[j] = F.in[I_BDN][(size_t)e * D + pn * 256 + r]; gv[j] = GATEL[(size_t)e * ECAP + rb * 256 + r]; }
    asm volatile("" ::: "memory");
#pragma unroll
    for (int j = 0; j < 5; ++j) { const int idx = F.tid + 512 * j; if ((idx >> 8) < nu) { etab[idx] = bv[j]; gt2[idx] = gv[j]; } }
    __syncthreads();
    return nu;
}
template <class Sched> __device__ __forceinline__ int inproj_table(Frame& F, const Sched& S) {
    LAS int* misc = (LAS int*)(F.lds + MISC_OFF); LAS float* etab = (LAS float*)(F.lds + ETAB_OFF);
    const int nu = resolve_units(F, S, MAX_GUNITS, 1);
    if (nu == 0) return 0;
    float bv[MAX_GUNITS / 2];
#pragma unroll
    for (int j = 0; j < MAX_GUNITS / 2; ++j) { const int idx = F.tid + 512 * j, uiu = idx >> 8, ui = uiu < nu ? uiu : nu - 1, r = idx & 255; bv[j] = F.in[I_BIN][misc[UDESC_WORD + 3 * ui + 1] * 256 + r]; }
    asm volatile("" ::: "memory");
#pragma unroll
    for (int j = 0; j < MAX_GUNITS / 2; ++j) { const int idx = F.tid + 512 * j; if ((idx >> 8) < nu) etab[idx] = bv[j]; }
    __syncthreads();
    return nu;
}

__device__ __forceinline__ void p1_fixup_own(Frame& F, int nu) {
    LAS int* misc = (LAS int*)(F.lds + MISC_OFF);
    bool any = false;
    for (int ui = 0; ui < nu; ++ui) any |= (misc[UDESC_WORD + 3 * ui + 1] <= 2);
    if (!any) return;
    asm volatile("s_waitcnt vmcnt(0)" ::: "memory"); __syncthreads();
    LAS f32x2* tab = (LAS f32x2*)(F.lds);
    for (int idx = F.tid; idx < 1024; idx += NWAVES * 64) { const int pos = idx >> 4, f = idx & 15; const float inv = powf(10000.0f, -(float)f / 16.0f); const float ang = (float)pos * inv;
        tab[idx] = (f32x2){cosf(ang), sinf(ang)}; }
    __syncthreads();
    const int c = F.lane & 7;
    float gq[8], gk[8];
#pragma unroll
    for (int j = 0; j < 8; ++j) { gq[j] = F.in[I_QNG][8 * c + j]; gk[j] = F.in[I_KNG][8 * c + j]; }
    bf16* Q = (bf16*)(F.ws + WS_Q); bf16* KV = (bf16*)(F.ws + WS_KV);
    for (int ui = 0; ui < nu; ++ui) {
        const int pn = misc[UDESC_WORD + 3 * ui + 1], pm = misc[UDESC_WORD + 3 * ui + 2];
        if (pn > 2) continue;
        if (pn < 2) {
            for (int it = 0; it < 16; it += 4) { v4u rq[4]; bf16* pp[4]; int tt[4];
#pragma unroll
                for (int i = 0; i < 4; ++i) { tt[i] = pm * 256 + 2 * (F.wave + 8 * (it + i)) + (F.lane >> 5); pp[i] = Q + (size_t)tt[i] * QW + pn * 256 + (F.lane & 31) * 8; rq[i] = *(const GAS v4u*)pp[i]; }
#pragma unroll
                for (int i = 0; i < 4; ++i) { const int sq = tt[i] & (SEQ - 1); *(GAS v4u*)pp[i] = fix_vals(rq[i], gq, attn_body::C2, c, sq >> 6, sq & 63, tab); } }
        } else {
            for (int it = 0; it < 8; it += 4) { v4u rk[4]; bf16* pp[4]; int tt[4];
#pragma unroll
                for (int i = 0; i < 4; ++i) { tt[i] = pm * 256 + 4 * (F.wave + 8 * (it + i)) + (F.lane >> 4); pp[i] = KV + (size_t)tt[i] * (2 * KVW) + (F.lane & 15) * 8; rk[i] = *(const GAS v4u*)pp[i]; }
#pragma unroll
                for (int i = 0; i < 4; ++i) { const int sq = tt[i] & (SEQ - 1); const v4u w_ = fix_vals(rk[i], gk, 1.0f, c, sq >> 6, sq & 63, tab); *(GAS v4u*)pp[i] = w_;
                    int l8 = 0, h8 = 0;
                    l8 = __builtin_amdgcn_cvt_pk_fp8_f32(bflo(w_.x), bfhi(w_.x), l8, false); l8 = __builtin_amdgcn_cvt_pk_fp8_f32(bflo(w_.y), bfhi(w_.y), l8, true);
                    h8 = __builtin_amdgcn_cvt_pk_fp8_f32(bflo(w_.z), bfhi(w_.z), h8, false); h8 = __builtin_amdgcn_cvt_pk_fp8_f32(bflo(w_.w), bfhi(w_.w), h8, true);
                    *(GAS v2u*)(F.ws + WS_K8 + (size_t)tt[i] * 128 + (F.lane & 15) * 8) = (v2u){(unsigned)l8, (unsigned)h8}; } }
        }
    }
    __syncthreads();
}

__device__ __forceinline__ void p10_final(Frame& F, float* dst) {
    LAS int* misc = (LAS int*)(F.lds + MISC_OFF);
    const int gw = F.vcu * NWAVES + F.wave, NGW = F.G * NWAVES, lane = F.lane;
    f32x4 g[4];
#pragma unroll
    for (int j = 0; j < 4; ++j) g[j] = *((const GAS f32x4*)F.in[I_FG] + lane + 64 * j);
    const int* TOKREC = (const int*)(F.ws + WS_TOKREC); const unsigned char* Y = (const unsigned char*)(F.ws + WS_Y); const bf16* X1B = (const bf16*)(F.ws + WS_X1B);
    typedef int v4i __attribute__((ext_vector_type(4)));
    v4i rec = (gw < T) ? *(const GAS v4i*)(TOKREC + (size_t)gw * 4) : (v4i){0, 0, 0, 0};
    for (int t = gw; t < T; t += NGW) {
        const int tn = t + NGW;
        const v4i recn = (tn < T) ? *(const GAS v4i*)(TOKREC + (size_t)tn * 4) : rec;
        const GAS v2u* xp = (const GAS v2u*)(X1B + (size_t)t * D) + lane;
        f32x4 v[4]; unsigned yv[4][4];
#pragma unroll
        for (int k = 0; k < 4; ++k) { const unsigned rk = (unsigned)rec[k]; const int e = rk >> 20, slot = rk & 0xfffff;
            const GAS unsigned* yp = (const GAS unsigned*)(Y + ((size_t)misc[32 + e] * 256 + slot) * D) + lane;
#pragma unroll
            for (int j = 0; j < 4; ++j) yv[k][j] = __builtin_nontemporal_load(yp + 64 * j); }
#pragma unroll
        for (int j = 0; j < 4; ++j) { const v2u w = __builtin_nontemporal_load(xp + 64 * j); v[j] = (f32x4){bflo(w.x), bfhi(w.x), bflo(w.y), bfhi(w.y)}; }
        f32x4 ys[4];
#pragma unroll
        for (int j = 0; j < 4; ++j) ys[j] = (f32x4){0.f, 0.f, 0.f, 0.f};
#pragma unroll
        for (int k = 0; k < 4; ++k)
#pragma unroll
            for (int j = 0; j < 4; ++j) { const f32x2 lo = __builtin_amdgcn_cvt_pk_f32_fp8((int)yv[k][j], false), hi = __builtin_amdgcn_cvt_pk_f32_fp8((int)yv[k][j], true);
                ys[j].x += lo.x; ys[j].y += lo.y; ys[j].z += hi.x; ys[j].w += hi.y; }
#pragma unroll
        for (int j = 0; j < 4; ++j) v[j] = v[j] + ys[j] * YSCALE_INV;
        float s = 0.f;
#pragma unroll
        for (int j = 0; j < 4; ++j) s += (v[j].x * v[j].x + v[j].y * v[j].y) + (v[j].z * v[j].z + v[j].w * v[j].w);
        const float rstd = 1.0f / sqrtf(wave_sum(s) * (1.f / D) + NORM_EPS);
        GAS f32x4* op = (GAS f32x4*)(dst + (size_t)t * D) + lane;
#pragma unroll
        for (int j = 0; j < 4; ++j) __builtin_nontemporal_store(v[j] * rstd * g[j], op + 64 * j);
        rec = recn;
    }
}
typedef GAS unsigned gu32;
#define RLX_AGENT __ATOMIC_RELAXED, __HIP_MEMORY_SCOPE_AGENT
#define XB_TMO      128
#define XB_XCNT(j)  (256  + 64 * (j))
#define XB_XSUB(j)  (1280 + 64 * (j))
#define XB_XGEN(j)  (2304 + 64 * (j))
#define XB_TOP      3328
#define XB_TOPGEN   3392
#define XCD_BAR_WORDS 3456
#define XB_SPIN_CAP (1u << 18)

__device__ __forceinline__ unsigned xb_ld(unsigned* p)              { return __hip_atomic_load(p, __ATOMIC_RELAXED, __HIP_MEMORY_SCOPE_AGENT); }
__device__ __forceinline__ unsigned xb_add(unsigned* p, unsigned v) { return __hip_atomic_fetch_add(p, v, __ATOMIC_RELAXED, __HIP_MEMORY_SCOPE_AGENT); }
__device__ __forceinline__ unsigned xb_xcc_id() { return (unsigned)__builtin_amdgcn_s_getreg((3 << 11) | 20) & 0xFu; }
#define XB_SPIN(cond, bar) do { unsigned _sp = 0; while (cond) { __builtin_amdgcn_s_sleep(1); \
    if ((++_sp & 255u) == 0u) { if (xb_ld(&(bar)[XB_TMO])) break; if (_sp > XB_SPIN_CAP) { atomicAdd(&(bar)[XB_TMO], 1u); break; } } } } while (0)

struct XcdBarrier {
    unsigned* bar; unsigned x;
    volatile LAS unsigned* st;
};

__device__ __forceinline__ XcdBarrier xcd_barrier_post(unsigned* bar, volatile LAS unsigned* st) {
    XcdBarrier b; b.bar = bar; b.x = xb_xcc_id(); b.st = st;
    if (threadIdx.x == 0) (void)xb_add(&bar[XB_XCNT(b.x)], 1u);
    return b;
}
__device__ __forceinline__ void xcd_barrier_complete(unsigned* bar, unsigned x, unsigned& nloc, unsigned& nx) {
    const unsigned G = gridDim.x * gridDim.y * gridDim.z;
    unsigned sum, cnt, mine, sp = 0u;
    for (;;) {
        sum = 0u; cnt = 0u; mine = 0u;
#pragma unroll
        for (unsigned j = 0; j < 16; ++j) { const unsigned c = xb_ld(&bar[XB_XCNT(j)]); sum += c; cnt += (c > 0u) ? 1u : 0u; mine = (j == x) ? c : mine; }
        if (sum == G) break;
        __builtin_amdgcn_s_sleep(1);
        if ((++sp & 255u) == 0u) { if (xb_ld(&bar[XB_TMO])) break; if (sp > XB_SPIN_CAP) { atomicAdd(&bar[XB_TMO], 1u); break; } }
    }
    nloc = mine > 0u ? mine : 1u; nx = cnt > 0u ? cnt : 1u;
}

__device__ __forceinline__ void xcd_barrier(const XcdBarrier& b) {
    asm volatile("s_waitcnt vmcnt(0)" ::: "memory");
    __syncthreads();
    if (threadIdx.x == 0) {
        unsigned* bar = b.bar;
        __builtin_amdgcn_s_waitcnt(0);
        unsigned nloc = b.st[0], nx = b.st[1];
        if (nloc == 0u) { xcd_barrier_complete(bar, b.x, nloc, nx); b.st[0] = nloc; b.st[1] = nx; }
        const unsigned old = xb_add(&bar[XB_XSUB(b.x)], 1u);
        const unsigned gen = old / nloc;
        if (old + 1u == (gen + 1u) * nloc) {
            __builtin_amdgcn_fence(__ATOMIC_RELEASE, "agent");
            asm volatile("s_waitcnt vmcnt(0)" ::: "memory");
            const unsigned og = xb_add(&bar[XB_TOP], 1u);
            const unsigned tg = og / nx;
            if (og + 1u == (tg + 1u) * nx) xb_add(&bar[XB_TOPGEN], 1u);
            else XB_SPIN(xb_ld(&bar[XB_TOPGEN]) == tg, bar);
            __builtin_amdgcn_fence(__ATOMIC_ACQUIRE, "agent");
            xb_add(&bar[XB_XGEN(b.x)], 1u);
            asm volatile("s_waitcnt vmcnt(0)" ::: "memory");
        } else {
            XB_SPIN(xb_ld(&bar[XB_XGEN(b.x)]) == gen, bar);
            __builtin_amdgcn_fence(__ATOMIC_ACQUIRE, "agent");
            asm volatile("s_waitcnt vmcnt(0)" ::: "memory");
        }
    }
    __syncthreads();
}

constexpr int N_PHASES = 10;
#define MK_NOMAX(nomax_) { const int l_ = F.lane; float mq = fabsf(F.in[I_QNG][l_]), mk = fabsf(F.in[I_KNG][l_]); _Pragma("unroll")           for (int m_ = 32; m_ >= 1; m_ >>= 1) { mq = fmaxf(mq, __shfl_xor(mq, m_)); mk = fmaxf(mk, __shfl_xor(mk, m_)); }           const float bound = 1.15f * 64.f * attn_body::C2 * mq * mk; nomax_ = __builtin_amdgcn_readfirstlane((int)(bound <= ATTN_NOMAX_BOUND)) != 0; }

#ifndef ATTN_NOMAX_BOUND
#define ATTN_NOMAX_BOUND 60.f
#endif
#ifndef P1_F8_MASK
#define P1_F8_MASK 0x7F807u
#endif
struct Args { const float* in[24]; float* out; unsigned char* ws; int ph_lo, ph_hi; };
__global__ void __launch_bounds__(NWAVES * 64, 2) mk_fwd(Args args) {
    extern __shared__ __attribute__((aligned(16))) unsigned char lds[];
#define MKFRAME() Frame F; { int t_ = threadIdx.x; asm volatile("" : "+v"(t_)); F.lds = (LAS unsigned char*)lds; F.tid = t_; F.lane = t_ & 63; F.wave = __builtin_amdgcn_readfirstlane(t_ >> 6); \
        F.G = gridDim.x; const int bx = blockIdx.x; F.vcu = (F.G % 8 == 0) ? (bx % 8) * (F.G / 8) + bx / 8 : bx; F.in = args.in; F.out = args.out; F.ws = args.ws; }
    unsigned char* ws = args.ws;
    const int lo = args.ph_lo, hi = args.ph_hi;
#ifndef TP_SEAM
#define TP_SEAM -1
#endif
    unsigned long long tp0_ = 0, tp1_ = 0; if (TP_SEAM >= 0) tp0_ = __builtin_amdgcn_s_memrealtime();
#ifndef PH_MASK
#define PH_MASK 0x3ff
#endif
#define IN(k) (((PH_MASK >> (k)) & 1) && lo <= (k) && (k) < hi)
#ifndef REP_MASK
#define REP_MASK 0
#endif
#define REPS(k) for (int rep_ = 0; rep_ < ((((REP_MASK) >> (k)) & 1) ? 2 : 1); ++rep_)
#ifndef XTRA_BAR
#define XTRA_BAR 0
#endif
#ifndef DIST_TP
#define DIST_TP 0
#endif
#define DSTAMP(k) do { if (DIST_TP > 0 && threadIdx.x == 0) ((unsigned long long*)(ws + WS_CTL + 32768))[blockIdx.x * 4 + (k)] = __builtin_amdgcn_s_memrealtime(); } while (0)
#define SEAM(k) do { if (IN(k) && IN((k) + 1)) { xcd_barrier(bar); for (int xb_ = 0; xb_ < XTRA_BAR; ++xb_) xcd_barrier(bar); if (TP_SEAM == (k)) tp1_ = __builtin_amdgcn_s_memrealtime(); } } while (0)

    XcdBarrier bar;
    { volatile LAS unsigned* st = (volatile LAS unsigned*)(lds + MISC_OFF) + 200; if (threadIdx.x == 0) { st[0] = 0u; st[1] = 0u; if (ATT_TP > 0) st[4] = 0u; } __syncthreads(); bar = xcd_barrier_post((unsigned*)(ws + WS_CTL) + CW_BAR, st); }
#ifndef LATE_EXPERT_CONV
#define LATE_EXPERT_CONV 3
#endif
    if (IN(0)) { MKFRAME(); REPS(0) p0_prologue(F, 0, LATE_EXPERT_CONV ? P0_MIXER_ITEMS : P0_NITEMS, true); }
    SEAM(0);
    if (IN(1)) { MKFRAME();
        constexpr int N8 = __builtin_popcount(P1_F8_MASK), N16 = INW / 256 - N8;
        const int G_ = (int)F.G, rb = (int)(((long)(T / 256) * N16) % G_), comp = rb ? 2 * (G_ - rb) : 0;
        if (N8 > 0) {
            InProjSched S{(const char*)(ws + WS_XN8), (const char*)(ws + WS_WIN8), N8, D / 128, G_, (int)blockIdx.x, (size_t)256 * D, (size_t)256 * D, P1_F8_MASK, comp, rb};
            const int nu = inproj_table(F, S);
            const TabSched<InProjSched> TS(S, (const LAS int*)(F.lds + MISC_OFF) + UDESC_WORD, nu);
            EpiInProjT<true> E{ws, (const LAS float*)(F.lds + ETAB_OFF)};
            pg8::gemm_phase<EpiInProjT<true>, TabSched<InProjSched>, true, false, true>(F.lds, D, D, TS, E, nullptr);
            p1_fixup_own(F, nu);
        }
        { InProjSched S{(const char*)(ws + WS_XN), (const char*)(ws + WS_WIN), N16, D / 64, G_, (int)blockIdx.x, (size_t)256 * D * 2, (size_t)256 * D * 2, ((1u << (INW / 256)) - 1u) & ~P1_F8_MASK, 0, 0};
            const int nu = inproj_table(F, S);
            const TabSched<InProjSched> TS(S, (const LAS int*)(F.lds + MISC_OFF) + UDESC_WORD, nu);
            EpiInProjT<false> E{ws, (const LAS float*)(F.lds + ETAB_OFF)};
            pg8::gemm_phase<EpiInProjT<false>, TabSched<InProjSched>, true, false, false>(F.lds, D * 2, D * 2, TS, E, nullptr);
            p1_fixup_own(F, nu);
        }
    }
    SEAM(1);
    if (IN(3)) { if (DIST_TP < 32) DSTAMP(0); { MKFRAME(); REPS(2) p2_lru(F); } if (DIST_TP < 32) DSTAMP(1); if (TP_SEAM == 2) tp1_ = __builtin_amdgcn_s_memrealtime();
      MKFRAME();
        const attn_body::AttnTensors AT{(const attn_body::bf16*)(ws + WS_Q), (const attn_body::bf16*)(ws + WS_KV), (const attn_body::bf16*)(ws + WS_KV) + KVW, (attn_body::bf16*)(ws + WS_AR), (const unsigned char*)(ws + WS_K8)};
        const attn_body::StaticOrder S((int)F.G, F.vcu);
        bool nomax; MK_NOMAX(nomax);
        const int cpos = (int)(F.vcu % 5);
        bool conv_done = false;
        const auto hook = [&](int i, bool last) { if (LATE_EXPERT_CONV == 3 && nomax && !conv_done && (i == cpos || last)) {     conv_done = true; __syncthreads(); p0_items3(F, P0_MIXER_ITEMS, P0_NITEMS); asm volatile("s_waitcnt vmcnt(0)" ::: "memory"); __syncthreads(); } };
        REPS(3) attn_body::attn_phase<attn_body::StaticOrder, 8>((char*)lds, AT, S, nomax, hook);
        if (DIST_TP < 32) DSTAMP(2);
    }
    SEAM(3);
    if (IN(4)) { MKFRAME();
        MergeSched S{(const char*)(ws + WS_AR), (const char*)(ws + WS_WCAT), F.G, (int)blockIdx.x};
        EpiMerge E{(const bf16*)(ws + WS_GL), (bf16*)(ws + WS_MERGED)};
        pg8::gemm_phase<EpiMerge, MergeSched, true, false>(F.lds, ARW * 2, ARW * 2, S, E, nullptr);
    }
    SEAM(4);
    if (IN(5)) { MKFRAME();
        DenseSched S{(const char*)(ws + WS_MERGED), (const char*)(ws + WS_WO), T / 256, D / 256, D / 64, F.G, (int)blockIdx.x, (size_t)256 * D * 2, (size_t)256 * D * 2, (REP_MASK >> 5) & 1, 0};
        EpiResF32 E{(bf16*)(ws + WS_MIXB)};
        pg8::gemm_phase<EpiResF32, DenseSched, true, false>(F.lds, D * 2, D * 2, S, E, nullptr);
    }
    SEAM(5);
    if (IN(6)) { MKFRAME(); if (DIST_TP >= 32) DSTAMP(0); { bool conv_here = (LATE_EXPERT_CONV == 2); if (LATE_EXPERT_CONV == 3) { bool nm_; MK_NOMAX(nm_); conv_here = !nm_; } if (conv_here) { p0_prologue(F, P0_MIXER_ITEMS, P0_NITEMS, false); __syncthreads(); } } if (DIST_TP >= 32) DSTAMP(1);
        if ((REP_MASK >> 6) & 1) p6_router(F, true); p6_router(F, false); if (DIST_TP >= 32) DSTAMP(2);
        if (LATE_EXPERT_CONV == 1) { __syncthreads(); p0_prologue(F, P0_MIXER_ITEMS, P0_NITEMS, false); } }
    SEAM(6);
    if (IN(7)) { MKFRAME();
        moe_tables(F);
        MoeSched<8> S{(const char*)(ws + WS_XN), (const char*)(ws + WS_WGU), (const LAS int*)(F.lds + MISC_OFF) + 32, F.G, (int)blockIdx.x, (size_t)2 * DFF * D};
        const int nu = moe_gather_table(F, S);
        const TabSched<MoeSched<8>> TS(S, (const LAS int*)(F.lds + MISC_OFF) + UDESC_WORD, nu);
        EpiSwiGLU E{(const LAS unsigned short*)(F.lds + ETAB_OFF), (const LAS unsigned short*)(F.lds + ETAB_OFF) + MAX_GUNITS * 256, (unsigned char*)(ws + WS_ACT), F.lds + 3 * pg8::HTB};
        REPS(7) pg8::gemm_phase<EpiSwiGLU, TabSched<MoeSched<8>>, true, true, true>(F.lds, D, D, TS, E, (const LAS unsigned short*)(F.lds + GTAB_OFF));
    }
    SEAM(7);
    if (IN(8)) { MKFRAME();
        moe_tables(F);
        MoeDownSched S; S.A = (const char*)(ws + WS_ACT); S.B = (const char*)(ws + WS_WD); S.nbp = (const LAS int*)(F.lds + MISC_OFF) + 32; S.G = F.G; S.c = (int)blockIdx.x; S.estepB = (size_t)D * DFF;
        const int nu = moe_down_table(F, S);
        const TabSched<MoeDownSched> TS(S, (const LAS int*)(F.lds + MISC_OFF) + UDESC_WORD, nu);
        EpiDown E{(const LAS float*)(F.lds + ETAB_OFF), (const LAS float*)(F.lds + GTAB_OFF), (unsigned char*)(ws + WS_Y), F.lds + 3 * pg8::HTB};
        REPS(8) pg8::gemm_phase<EpiDown, TabSched<MoeDownSched>, true, false, true>(F.lds, DFF, DFF, TS, E, nullptr);
    }
    SEAM(8);
    if (IN(9)) { MKFRAME(); moe_tables(F); if ((REP_MASK >> 9) & 1) p10_final(F, (float*)(ws + WS_ACT)); p10_final(F, F.out); }
    if (DIST_TP > 0 && blockIdx.x == 0) {
        volatile LAS unsigned* acc_ = (volatile LAS unsigned*)(lds + MISC_OFF) + 204;
        __syncthreads(); if (threadIdx.x == 0) acc_[0] = (DIST_TP & 1) ? 0u : 0xffffffffu; __syncthreads();
        if (threadIdx.x < gridDim.x) { const unsigned long long* sp_ = (const unsigned long long*)(ws + WS_CTL + 32768) + threadIdx.x * 4;
            const unsigned long long a_ = __builtin_nontemporal_load(sp_ + (((DIST_TP & 15) - 1) >> 1)), b_ = __builtin_nontemporal_load(sp_ + (((DIST_TP & 15) - 1) >> 1) + 1); const unsigned d_ = (unsigned)(b_ - a_);
            if (DIST_TP & 1) __hip_atomic_fetch_max((LAS unsigned*)acc_, d_, __ATOMIC_RELAXED, __HIP_MEMORY_SCOPE_WORKGROUP); else __hip_atomic_fetch_min((LAS unsigned*)acc_, d_, __ATOMIC_RELAXED, __HIP_MEMORY_SCOPE_WORKGROUP); }
        __syncthreads();
        if (DIST_TP >= 16 && DIST_TP < 32) {
            const unsigned ext_ = acc_[0]; __syncthreads();
            if (threadIdx.x < gridDim.x) { const unsigned long long* sp_ = (const unsigned long long*)(ws + WS_CTL + 32768) + threadIdx.x * 4;
                const unsigned long long a_ = __builtin_nontemporal_load(sp_ + (((DIST_TP & 15) - 1) >> 1)), b_ = __builtin_nontemporal_load(sp_ + (((DIST_TP & 15) - 1) >> 1) + 1);
                if ((unsigned)(b_ - a_) == ext_) acc_[0] = 200u * threadIdx.x; }
            __syncthreads(); }
        const unsigned long long te_ = __builtin_amdgcn_s_memrealtime(); const unsigned long long w_ = 4ull * acc_[0]; while (__builtin_amdgcn_s_memrealtime() - te_ < w_) __builtin_amdgcn_s_sleep(8);
    }
    if ((TP_SEAM >= 0 || LRU_TP > 0 || ATT_TP > 0 || PG_TP > 0) && blockIdx.x == 0) { const unsigned long long te_ = __builtin_amdgcn_s_memrealtime(); if (TP_SEAM == 9) tp1_ = te_; unsigned long long w_ = 4ull * (tp1_ - tp0_); if (LRU_TP > 0 || ATT_TP > 0 || PG_TP > 0) w_ = 4ull * *(volatile LAS unsigned*)(lds + MISC_OFF + 4 * 204); while (__builtin_amdgcn_s_memrealtime() - te_ < w_) __builtin_amdgcn_s_sleep(8); }
#undef IN
#undef SEAM
}

#ifndef MK_N_LAUNCHES
#define MK_N_LAUNCHES 1
#endif
extern "C" void kernel_launch(void* const* d_in, const int* in_sizes, int n_in, void* d_out, int out_size, void* d_ws, size_t ws_size, hipStream_t stream) {
    static int grid = 0;
    if (grid == 0) {
        if (n_in != 24 || in_sizes[0] != T * D || out_size != T * D || ws_size < WS_END) { fprintf(stderr, "kernel_launch: unexpected shapes (n_in %d, in0 %d, out %d, ws %zu < %zu)\n", n_in, n_in > 0 ? in_sizes[0] : -1, out_size, ws_size, (size_t)WS_END); grid = -1; return; }
        int dev = 0, cus = 0, per_cu = 0;
        if (hipGetDevice(&dev) != hipSuccess || hipDeviceGetAttribute(&cus, hipDeviceAttributeMultiprocessorCount, dev) != hipSuccess) { grid = -1; return; }
        if (hipFuncSetAttribute((const void*)mk_fwd, hipFuncAttributeMaxDynamicSharedMemorySize, LDS_BYTES) != hipSuccess) { fprintf(stderr, "kernel_launch: hipFuncSetAttribute failed\n"); grid = -1; return; }
        if (hipOccupancyMaxActiveBlocksPerMultiprocessor(&per_cu, (const void*)mk_fwd, NWAVES * 64, LDS_BYTES) != hipSuccess || per_cu < 1) { fprintf(stderr, "kernel_launch: occupancy query reports %d\n", per_cu); per_cu = 1; }
        (void)hipGetLastError();
        grid = cus;
    }
    if (grid < 0) return;
    Args a{};
    for (int i = 0; i < 24; ++i) a.in[i] = (const float*)d_in[i];
    a.out = (float*)d_out; a.ws = (unsigned char*)d_ws;
    const int nl = 1;
    for (int li = 0; li < nl; ++li) {
        a.ph_lo = (nl == 1) ? 0 : li; a.ph_hi = (nl == 1) ? N_PHASES : li + 1;
        void* kargs[] = {&a};
        if (hipMemsetAsync((char*)d_ws + WS_CTL, 0, CTL_ZERO_BYTES, stream) != hipSuccess) { fprintf(stderr, "kernel_launch: hipMemsetAsync failed\n"); return; }
        const hipError_t le = hipLaunchCooperativeKernel((const void*)mk_fwd, dim3(grid), dim3(NWAVES * 64), kargs, LDS_BYTES, stream);
        if (le != hipSuccess) { fprintf(stderr, "kernel_launch: launch %d failed: %s (grid %d)\n", li, hipGetErrorName(le), grid); break; }
    }
}
```
